# Optimizing an MI355X kernel written in HIP

```python
import jax
import jax.numpy as jnp
from jax import lax
import numpy as np

D_MODEL = 1024
BATCH = 2
SEQ = 8192
DEPTH = 1

CTX_LEN = 256
GRID_W = 64
MIX_W = D_MODEL
A_W = MIX_W // 2
A_GROUPS = 4
A_GROUP_DIM = A_W // A_GROUPS
A_CHUNK = 128
ROWS_PER_CHUNK = A_CHUNK // GRID_W
B_W = MIX_W - A_W
B_HEADS = 4
B_HEAD_DIM = B_W // B_HEADS
CONV_K = 3
GDN_CHUNK = 64
N_EXPERTS = 16
EC_CAPACITY = 2
EXPERT_FF = 1024
N_MOD = 6
NORM_EPS = 1e-6
COL_QKV = 3 * B_W
N_STATE_COLS = COL_QKV + 4 * B_HEADS
COL_Z_END = N_STATE_COLS + B_W
IN_COLS = COL_Z_END + 2 * A_W

kernel_name = "hybrid_gmlp_gdn_ec_dit_layer"


def rms_norm(x, g):
    xf = x.astype(jnp.float32)
    y = xf * lax.rsqrt(jnp.mean(xf * xf, axis=-1, keepdims=True) + NORM_EPS)
    return (y * g.astype(jnp.float32)).astype(x.dtype)


def l2_normalize(x):
    return x * lax.rsqrt(jnp.sum(x * x, axis=-1, keepdims=True) + NORM_EPS)


def short_conv(x, w):
    pad = (CONV_K - 1) // 2
    y = lax.conv_general_dilated(
        x, w[:, None, :].astype(x.dtype), window_strides=(1,), padding=[(pad, pad)],
        dimension_numbers=("NWC", "WIO", "NWC"), feature_group_count=x.shape[-1])
    return jax.nn.silu(y)


def chunk_mlp(uv, n_chunks, norm_g, ws, bs):
    B, T, _ = uv.shape
    u, v = jnp.split(jax.nn.gelu(uv, approximate=False), 2, axis=-1)
    v = rms_norm(v.reshape(B, T, A_GROUPS, A_GROUP_DIM), norm_g.reshape(A_GROUPS, A_GROUP_DIM))
    vc = v.reshape(B, n_chunks, A_CHUNK, A_GROUPS, A_GROUP_DIM)
    s = jnp.einsum("gts,bnsgd->bntgd", ws, vc) + jnp.swapaxes(bs, 0, 1)[None, None, :, :, None]
    return u * s.reshape(B, T, A_W)


def gdn_streams(p, conv_w, a_log, dt_bias):
    B, T, _ = p.shape
    qkv = short_conv(p[..., :COL_QKV], conv_w).astype(jnp.float32)
    qkv = qkv.reshape(B, T, 3, B_HEADS, B_HEAD_DIM)
    q = l2_normalize(qkv[:, :, 0]) * (B_HEAD_DIM ** -0.5)
    k = l2_normalize(qkv[:, :, 1])
    v = qkv[:, :, 2]
    ab = p[..., COL_QKV:N_STATE_COLS].astype(jnp.float32).reshape(B, T, 2, 2, B_HEADS)
    g = -jnp.exp(a_log.astype(jnp.float32)) * jax.nn.softplus(ab[:, :, 0] + dt_bias.astype(jnp.float32))
    beta = jax.nn.sigmoid(ab[:, :, 1])
    return q, k, v, g, beta


def gdn_chunked(q, k, v, g, beta, s0):
    B, T, H, Dk = q.shape
    C = GDN_CHUNK
    N = T // C

    def chunks(t):
        t = t.reshape(B, N, C, H, *t.shape[3:])
        return jnp.moveaxis(t, (1, 3), (0, 2))

    qc, kc, vc = chunks(q), chunks(k), chunks(v)
    gcum = jnp.cumsum(chunks(g), axis=-1)
    bc = chunks(beta)
    tri = jnp.tril(jnp.ones((C, C), dtype=bool))
    strict = jnp.tril(jnp.ones((C, C), dtype=bool), -1)
    diff = gcum[..., :, None] - gcum[..., None, :]
    decay = jnp.where(tri, jnp.exp(jnp.where(tri, diff, 0.0)), 0.0)
    kb = kc * bc[..., None]
    a_mat = jnp.where(strict, jnp.einsum("nbhid,nbhjd->nbhij", kb, kc) * decay, 0.0)
    eye = jnp.eye(C, dtype=jnp.float32)
    t_inv = lax.linalg.triangular_solve(eye + a_mat, jnp.broadcast_to(eye, a_mat.shape),
                                        left_side=True, lower=True, unit_diagonal=True)
    u = t_inv @ (vc * bc[..., None])
    w = t_inv @ (kb * jnp.exp(gcum)[..., None])
    attn = jnp.einsum("nbhid,nbhjd->nbhij", qc, kc) * decay
    q_g = qc * jnp.exp(gcum)[..., None]
    g_last = gcum[..., -1]
    k_g = kc * jnp.exp(g_last[..., None] - gcum)[..., None]

    def step(state, xs):
        q_i, k_i, u_i, w_i, a_i, gl_i = xs
        v_new = u_i - w_i @ state
        o_i = q_i @ state + a_i @ v_new
        state = state * jnp.exp(gl_i)[..., None, None] + jnp.swapaxes(k_i, -1, -2) @ v_new
        return state, o_i

    s_final, o = lax.scan(step, s0, (q_g, k_g, u, w, attn, g_last))
    o = jnp.moveaxis(o, (0, 2), (1, 3)).reshape(B, T, H, v.shape[-1])
    return o, s_final


def gdn_two_dirs(q, k, v, g, beta, s0_f, s0_b):
    o_f, s_f = gdn_chunked(q, k, v, g[:, :, 0], beta[:, :, 0], s0_f)
    flip = lambda t: jnp.flip(t, axis=1)
    o_b, s_b = gdn_chunked(flip(q), flip(k), flip(v), flip(g[:, :, 1]), flip(beta[:, :, 1]), s0_b)
    return o_f + flip(o_b), s_f, s_b


def gdn_out(o, z, norm_g):
    B, T = o.shape[:2]
    zh = z.reshape(B, T, B_HEADS, B_HEAD_DIM).astype(jnp.float32)
    y = o * lax.rsqrt(jnp.mean(o * o, axis=-1, keepdims=True) + NORM_EPS)
    y = y * norm_g.astype(jnp.float32) * jax.nn.silu(zh)
    return y.reshape(B, T, B_W)


def mix_out(p, o, n_chunks, gdn_norm_g, gm_norm_g, gm_ws, gm_bs, w_out):
    y_a = chunk_mlp(p[..., COL_Z_END:], n_chunks, gm_norm_g, gm_ws, gm_bs)
    y_b = gdn_out(o, p[..., N_STATE_COLS:COL_Z_END], gdn_norm_g).astype(p.dtype)
    return jnp.concatenate([y_a, y_b], axis=-1) @ w_out


def expert_choice_ffn(h, w_router, b_router, w_gate, w_up, w_down):
    B, N, D = h.shape
    cap = EC_CAPACITY * N // N_EXPERTS
    aff = jax.nn.softmax((h @ w_router + b_router).astype(jnp.float32), axis=-1)
    gate, idx = lax.top_k(jnp.swapaxes(aff, 1, 2), cap)
    xe = jax.vmap(lambda hb, ib: hb[ib])(h, idx)
    hid = jax.nn.silu(jnp.einsum("becd,edf->becf", xe, w_gate)) * jnp.einsum("becd,edf->becf", xe, w_up)
    ye = jnp.einsum("becf,efd->becd", hid, w_down) * gate[..., None].astype(h.dtype)
    return jax.vmap(lambda ib, yb: jnp.zeros((N, D), yb.dtype).at[ib.reshape(-1)].add(yb.reshape(-1, D)))(idx, ye)


def setup_inputs(seed: int = 0) -> dict:
    key = jax.random.key(seed)
    ks = jax.random.split(key, 24)
    f32 = jnp.float32
    nrm = lambda k, shape, s: jax.random.normal(k, shape, f32) * s
    dt = jnp.exp(jax.random.uniform(ks[10], (DEPTH, 2, B_HEADS), f32, np.log(1e-3), np.log(1e-1)))
    return {
        "x": nrm(ks[0], (BATCH, SEQ, D_MODEL), 1.0),
        "c": nrm(ks[1], (BATCH, D_MODEL), 1.0),
        "ctx": nrm(ks[2], (BATCH, CTX_LEN, D_MODEL), 1.0),
        "c_ctx": nrm(ks[3], (D_MODEL,), 1.0),
        "w_mod": nrm(ks[4], (DEPTH, D_MODEL, N_MOD * D_MODEL), 0.5 * D_MODEL ** -0.5),
        "b_mod": nrm(ks[5], (DEPTH, N_MOD * D_MODEL), 0.02),
        "norm1_g": 1.0 + nrm(ks[6], (DEPTH, D_MODEL), 0.05),
        "norm2_g": 1.0 + nrm(ks[7], (DEPTH, D_MODEL), 0.05),
        "w_in": nrm(ks[8], (DEPTH, D_MODEL, IN_COLS), D_MODEL ** -0.5),
        "conv_w": nrm(ks[9], (DEPTH, CONV_K, COL_QKV), CONV_K ** -0.5),
        "a_log": jnp.log(jax.random.uniform(ks[11], (DEPTH, 2, B_HEADS), f32, 1.0, 16.0)),
        "dt_bias": dt + jnp.log(-jnp.expm1(-dt)),
        "gdn_norm_g": 1.0 + nrm(ks[12], (DEPTH, B_HEAD_DIM), 0.05),
        "gm_norm_g": 1.0 + nrm(ks[13], (DEPTH, A_W), 0.05),
        "gm_ws": nrm(ks[14], (DEPTH, A_GROUPS, A_CHUNK, A_CHUNK), A_CHUNK ** -0.5),
        "gm_bs": 1.0 + nrm(ks[15], (DEPTH, A_GROUPS, A_CHUNK), 0.1),
        "w_out": nrm(ks[16], (DEPTH, MIX_W, D_MODEL), MIX_W ** -0.5),
        "w_router": nrm(ks[17], (DEPTH, D_MODEL, N_EXPERTS), D_MODEL ** -0.5),
        "b_router": nrm(ks[18], (DEPTH, N_EXPERTS), 0.01),
        "w_gate": nrm(ks[19], (DEPTH, N_EXPERTS, D_MODEL, EXPERT_FF), D_MODEL ** -0.5),
        "w_up": nrm(ks[20], (DEPTH, N_EXPERTS, D_MODEL, EXPERT_FF), D_MODEL ** -0.5),
        "w_down": nrm(ks[21], (DEPTH, N_EXPERTS, EXPERT_FF, D_MODEL), EXPERT_FF ** -0.5),
        "final_norm_g": 1.0 + nrm(ks[22], (D_MODEL,), 0.05),
    }


def reference(x, c, ctx, c_ctx, w_mod, b_mod, norm1_g, norm2_g, w_in, conv_w, a_log, dt_bias,
              gdn_norm_g, gm_norm_g, gm_ws, gm_bs, w_out, w_router, b_router, w_gate, w_up, w_down,
              final_norm_g):
    B, T, _ = x.shape
    rows = T // GRID_W
    n_lat_chunks = rows // ROWS_PER_CHUNK
    n_ctx_chunks = ctx.shape[1] // A_CHUNK
    h_lat, h_ctx = x, ctx
    for layer in range(DEPTH):
        last = layer == DEPTH - 1
        mod = jax.nn.silu(c) @ w_mod[layer] + b_mod[layer]
        mod_c = jax.nn.silu(c_ctx) @ w_mod[layer] + b_mod[layer]
        sh1, sc1, gt1, sh2, sc2, gt2 = jnp.split(mod[:, None, :], N_MOD, axis=-1)
        csh1, csc1, cgt1, csh2, csc2, cgt2 = jnp.split(mod_c, N_MOD, axis=-1)
        wl = w_in[layer]

        c_in = rms_norm(h_ctx, norm1_g[layer]) * (1.0 + csc1) + csh1
        p_ctx = c_in @ (wl[:, :N_STATE_COLS] if last else wl)
        qc, kc, vc, gc, bc = gdn_streams(p_ctx[..., :N_STATE_COLS], conv_w[layer], a_log[layer], dt_bias[layer])
        zero_state = jnp.zeros((B, B_HEADS, B_HEAD_DIM, B_HEAD_DIM), jnp.float32)
        o_ctx, s_f, s_b = gdn_two_dirs(qc, kc, vc, gc, bc, zero_state, zero_state)

        a_in = rms_norm(h_lat, norm1_g[layer]) * (1.0 + sc1) + sh1
        p_lat = a_in @ wl
        ql, kl, vl, gl, bl = gdn_streams(p_lat[..., :N_STATE_COLS], conv_w[layer], a_log[layer], dt_bias[layer])
        o_lat, _, _ = gdn_two_dirs(ql, kl, vl, gl, bl, s_f, s_b)
        h_lat = h_lat + gt1 * mix_out(p_lat, o_lat, n_lat_chunks, gdn_norm_g[layer], gm_norm_g[layer],
                                      gm_ws[layer], gm_bs[layer], w_out[layer])
        f_in = rms_norm(h_lat, norm2_g[layer]) * (1.0 + sc2) + sh2
        h_lat = h_lat + gt2 * expert_choice_ffn(f_in, w_router[layer], b_router[layer],
                                                w_gate[layer], w_up[layer], w_down[layer])

        if not last:
            h_ctx = h_ctx + cgt1 * mix_out(p_ctx, o_ctx, n_ctx_chunks, gdn_norm_g[layer], gm_norm_g[layer],
                                           gm_ws[layer], gm_bs[layer], w_out[layer])
            cf_in = rms_norm(h_ctx, norm2_g[layer]) * (1.0 + csc2) + csh2
            h_ctx = h_ctx + cgt2 * expert_choice_ffn(cf_in, w_router[layer], b_router[layer],
                                                     w_gate[layer], w_up[layer], w_down[layer])
    return rms_norm(h_lat, final_norm_g)
```

```cpp
#include <hip/hip_runtime.h>
#include <cstdio>
#include <cstdint>
namespace pg8 {
#define PG8_LAS __attribute__((address_space(3)))
typedef unsigned short bf16_t;
typedef short bf16x8 __attribute__((ext_vector_type(8)));
typedef float f32x4 __attribute__((ext_vector_type(4)));
typedef unsigned u32x4 __attribute__((ext_vector_type(4)));
constexpr int BM = 256, BK = 64, HALF = 128, HTB = HALF * BK * 2  , STAGE_BYTES = 8 * HTB, NXCD = 8, WGM = 8;

__host__ __device__ __forceinline__ int lds_byte(int r, int c) { const int st = (r >> 4) * 2 + (c >> 5), rr = r & 15, cc = c & 31, ob = rr * 64 + cc * 2; return st * 1024 + (ob ^ (((ob >> 9) & 1) << 5)); }
__host__ __device__ __forceinline__ void stage_rc(int b, int& R, int& C) { const int st = b / 1024, sb = b % 1024, swz = sb ^ (((sb >> 9) & 1) << 5); R = (st >> 1) * 16 + swz / 64; C = (st & 1) * 32 + (swz % 64) / 2; }
__host__ __device__ __forceinline__ int perm32(int rho) { const int n = rho >> 4, i = rho & 15; return 8 * (i >> 2) + 4 * n + (i & 3); }

struct Unit { int pm, pn; };
struct Gemm { const bf16_t* A; const bf16_t* Bt; int M, N, K; size_t bgs; int gsh, gmask; };

struct StaticOrder {
    int nM, nN, nwg, G, c;
    __host__ __device__ void init(int M, int N, int G_, int c_) { nM = M / BM; nN = N / BM; nwg = nM * nN; G = G_; c = c_; }
    __host__ __device__ bool next(int i, Unit& u) const {
        const long L = (long)i * G + c; if (L >= nwg) return false;
        int wgid = (int)L; { const int q = nwg / NXCD, r = nwg % NXCD, xcd = wgid % NXCD, off = wgid / NXCD; wgid = (xcd < r ? xcd * (q + 1) : r * (q + 1) + (xcd - r) * q) + off; }
        const int nig = WGM * nN, gid = wgid / nig, fm = gid * WGM, gsz = (nM - fm) < WGM ? (nM - fm) : WGM;
        u.pm = fm + ((wgid % nig) % gsz); u.pn = (wgid % nig) / gsz; return true;
    }
    __device__ __forceinline__ void a_ready(const Unit&) const {}
    __device__ __forceinline__ void done(const Unit&) const {}
};

__device__ __forceinline__ unsigned cvt_pk_bf16(float lo, float hi) { unsigned r; asm volatile("v_cvt_pk_bf16_f32 %0, %1, %2" : "=v"(r) : "v"(lo), "v"(hi)); return r; }
typedef float f32x2 __attribute__((ext_vector_type(2)));
__device__ __forceinline__ f32x2 gelu_pk(f32x2 v) {
    const f32x2 av = __builtin_elementwise_abs(v), d = av * 0.2316418882f + 1.0f;
    f32x2 t; t.x = __builtin_amdgcn_rcpf(d.x); t.y = __builtin_amdgcn_rcpf(d.y);
    f32x2 q = t * 0.5307027145f + (-0.7265760135f); q = q * t + 0.7107068705f; q = q * t + (-0.142248368f); q = q * t + 0.127414796f; q = q * t;
    const f32x2 s = (v * v) * (-0.72134752044f);
    f32x2 e; e.x = __builtin_amdgcn_exp2f(s.x); e.y = __builtin_amdgcn_exp2f(s.y);
    const f32x2 m = v * (q * e), r = v - m;
    f32x2 o; o.x = v.x < 0.f ? m.x : r.x; o.y = v.y < 0.f ? m.y : r.y; return o;
}
__device__ __forceinline__ float silu_f(float x) { return x * __builtin_amdgcn_rcpf(1.0f + __expf(-x)); }
__device__ __forceinline__ void st8(bf16_t* p, const f32x4 v0, const f32x4 v1) { u32x4 w; w.x = cvt_pk_bf16(v0[0], v0[1]); w.y = cvt_pk_bf16(v0[2], v0[3]); w.z = cvt_pk_bf16(v1[0], v1[1]); w.w = cvt_pk_bf16(v1[2], v1[3]); *(u32x4*)p = w; }
struct EpiInProj {
    static constexpr bool PERM = true, AFTER_DRAIN = false;
    bf16_t* QKV; bf16_t* Z; bf16_t* UV; float* AB;
    __device__ __forceinline__ void operator()(const f32x4 (&acc)[2][2][4][2], const Unit& u, int wr, int wc, int fr, int fq) const {
        const int row0 = u.pm * BM + wr * 64 + fr, pn = u.pn;
        if (pn == 12) {
            if (wc == 0 && fq < 2) {
#pragma unroll
                for (int ai = 0; ai < 2; ++ai)
#pragma unroll
                    for (int m = 0; m < 4; ++m) { float* p = AB + (size_t)(row0 + ai * HALF + m * 16) * 16 + 8 * fq; *(f32x4*)p = acc[ai][0][m][0]; *(f32x4*)(p + 4) = acc[ai][0][m][1]; }
            }
            return;
        }
        bf16_t* base; int ldc, colt; bool act = false;
        if (pn < 6) { base = QKV; ldc = 1536; colt = pn * 256; }
        else { if (u.pm >= 64) return; if (pn < 8) { base = Z; ldc = 512; colt = (pn - 6) * 256; } else { base = UV; ldc = 1024; colt = (pn - 8) * 256; act = true; } }
        const int col0 = colt + wc * 32 + 8 * fq;
#pragma unroll
        for (int ai = 0; ai < 2; ++ai)
#pragma unroll
            for (int m = 0; m < 4; ++m) { bf16_t* rowp = base + (size_t)(row0 + ai * HALF + m * 16) * ldc + col0;
#pragma unroll
                for (int bj = 0; bj < 2; ++bj) { f32x4 v0 = acc[ai][bj][m][0], v1 = acc[ai][bj][m][1];
                    if (act) { f32x2 a = gelu_pk((f32x2){v0[0], v0[1]}), b = gelu_pk((f32x2){v0[2], v0[3]}), c = gelu_pk((f32x2){v1[0], v1[1]}), d = gelu_pk((f32x2){v1[2], v1[3]});
                        v0 = (f32x4){a.x, a.y, b.x, b.y}; v1 = (f32x4){c.x, c.y, d.x, d.y}; }
                    st8(rowp + bj * HALF, v0, v1); } }
    }
};
struct EpiOutProj {
    static constexpr bool PERM = false, AFTER_DRAIN = false;
    const float* x; const float* mod; float* H1;
    __device__ __forceinline__ void operator()(const f32x4 (&acc)[2][2][4][2], const Unit& u, int wr, int wc, int fr, int fq) const {
        const int row0 = u.pm * BM + wr * 64 + fr, col0 = u.pn * BM + wc * 32 + 4 * fq; const float* gt = mod + (u.pm >= 32 ? 6144 : 0) + 2048;
        f32x4 gv[2][2];
#pragma unroll
        for (int bj = 0; bj < 2; ++bj)
#pragma unroll
            for (int n = 0; n < 2; ++n) gv[bj][n] = *(const f32x4*)(gt + col0 + bj * HALF + n * 16);
#pragma unroll
        for (int ai = 0; ai < 2; ++ai)
#pragma unroll
            for (int m = 0; m < 4; ++m) { const size_t off = (size_t)(row0 + ai * HALF + m * 16) * 1024 + col0;
#pragma unroll
                for (int bj = 0; bj < 2; ++bj)
#pragma unroll
                    for (int n = 0; n < 2; ++n) { const f32x4 xv = *(const f32x4*)(x + off + bj * HALF + n * 16); *(f32x4*)(H1 + off + bj * HALF + n * 16) = xv + gv[bj][n] * acc[ai][bj][m][n]; } }
    }
};
struct EpiSwiGLU {
    static constexpr bool PERM = true, AFTER_DRAIN = false;
    bf16_t* HID;
    __device__ __forceinline__ void operator()(const f32x4 (&acc)[2][2][4][2], const Unit& u, int wr, int wc, int fr, int fq) const {
        const int row0 = u.pm * BM + wr * 64 + fr, col0 = u.pn * HALF + wc * 32 + 8 * fq;
#pragma unroll
        for (int ai = 0; ai < 2; ++ai)
#pragma unroll
            for (int m = 0; m < 4; ++m) { bf16_t* rowp = HID + (size_t)(row0 + ai * HALF + m * 16) * 1024 + col0; f32x4 h0, h1;
#pragma unroll
                for (int j = 0; j < 4; ++j) { h0[j] = silu_f(acc[ai][0][m][0][j]) * acc[ai][1][m][0][j]; h1[j] = silu_f(acc[ai][0][m][1][j]) * acc[ai][1][m][1][j]; }
                st8(rowp, h0, h1); }
    }
};
struct EpiDown {
    static constexpr bool PERM = true, AFTER_DRAIN = false;
    bf16_t* YE; const float* gate;
    __device__ __forceinline__ void operator()(const f32x4 (&acc)[2][2][4][2], const Unit& u, int wr, int wc, int fr, int fq) const {
        const int row0 = u.pm * BM + wr * 64 + fr, col0 = u.pn * BM + wc * 32 + 8 * fq;
#pragma unroll
        for (int ai = 0; ai < 2; ++ai)
#pragma unroll
            for (int m = 0; m < 4; ++m) { const int row = row0 + ai * HALF + m * 16; const float gv = gate[row]; bf16_t* rowp = YE + (size_t)row * 1024 + col0;
#pragma unroll
                for (int bj = 0; bj < 2; ++bj) st8(rowp + bj * HALF, acc[ai][bj][m][0] * gv, acc[ai][bj][m][1] * gv); }
    }
};
template <class Epi, class Sched, bool ALIGN_EPI = false, bool SP2 = false>
__device__ __forceinline__ void gemm_phase(PG8_LAS unsigned char* lds, const Gemm g, const Sched& S, const Epi& E) {
    const int tid = threadIdx.x, wid = __builtin_amdgcn_readfirstlane(tid >> 6), lane = tid & 63, wr = wid >> 2, wc = wid & 3, fr = lane & 15, fq = lane >> 4;
    const int K = g.K, nt = K / BK;
    unsigned voffA[2], voffB[2];
#pragma unroll
    for (int i = 0; i < 2; ++i) { int R, C; stage_rc(tid * 16 + i * 8192, R, C); const int Rb = Epi::PERM ? ((R & ~31) + perm32(R & 31)) : R;
        voffA[i] = (unsigned)(R * K + C) * 2u; voffB[i] = (unsigned)(Rb * K + C) * 2u; }
    const size_t kstep = (size_t)(BK * 2);
    const size_t hstep = (size_t)HALF * K * 2;
    const size_t tstep = 2 * hstep;
    const unsigned ldsw = (unsigned)wid * 1024u;
    const int aoff = lds_byte(wr * 64 + fr, fq * 8), boff = lds_byte(wc * 32 + fr, fq * 8);
#define PG8_SA(b, h) (((b) * 2 + (h)) * HTB)
#define PG8_SB(b, h) ((4 + (b) * 2 + (h)) * HTB)
#define PG8_STAGE(bufoff, gbase, voff) do { _Pragma("unroll") for (int _i = 0; _i < 2; ++_i) \
        __builtin_amdgcn_global_load_lds((const unsigned*)((const char*)(gbase) + (voff)[_i]), (PG8_LAS unsigned*)(lds + (bufoff) + ldsw + _i * 8192), 16, 0, 0); } while (0)
#define PG8_LDA(dst, b, h) do { _Pragma("unroll") for (int m = 0; m < 4; ++m) _Pragma("unroll") for (int k = 0; k < 2; ++k) dst[m][k] = *(const PG8_LAS bf16x8*)(lds + PG8_SA(b, h) + aoff + m * 2048 + k * 1024); } while (0)
#define PG8_LDB(dst, b, h) do { _Pragma("unroll") for (int n = 0; n < 2; ++n) _Pragma("unroll") for (int k = 0; k < 2; ++k) dst[n][k] = *(const PG8_LAS bf16x8*)(lds + PG8_SB(b, h) + boff + n * 2048 + k * 1024); } while (0)
#define PG8_MMA(ai, bj, At, Bt) do { __builtin_amdgcn_s_setprio(1); _Pragma("unroll") for (int m = 0; m < 4; ++m) _Pragma("unroll") for (int n = 0; n < 2; ++n) _Pragma("unroll") for (int k = 0; k < 2; ++k) \
        acc[ai][bj][m][n] = __builtin_amdgcn_mfma_f32_16x16x32_bf16(Bt[n][k], At[m][k], acc[ai][bj][m][n], 0, 0, 0); __builtin_amdgcn_s_setprio(0); } while (0)
#define PG8_WAIT_V(n) asm volatile("s_waitcnt vmcnt(" #n ")" ::: "memory")
#define PG8_WAIT_L(n) asm volatile("s_waitcnt lgkmcnt(" #n ")" ::: "memory")
#define PG8_BAR __builtin_amdgcn_s_barrier()
#define PG8_SCHED __builtin_amdgcn_sched_barrier(0)
    Unit cur, nxt; int ui = 0;
    if (!S.next(0, cur)) return;
    f32x4 acc[2][2][4][2];
#pragma unroll
    for (int a = 0; a < 2; ++a)
#pragma unroll
        for (int b = 0; b < 2; ++b)
#pragma unroll
            for (int m = 0; m < 4; ++m)
#pragma unroll
                for (int n = 0; n < 2; ++n) acc[a][b][m][n] = (f32x4){0.f, 0.f, 0.f, 0.f};
    bf16x8 At[4][2], B0[2][2], B1[2][2];
    const char* cA = (const char*)g.A + (size_t)cur.pm * tstep; const char* cB = (const char*)g.Bt + (size_t)((cur.pm >> g.gsh) & g.gmask) * g.bgs + (size_t)cur.pn * tstep;
    S.a_ready(cur);
    if constexpr (SP2) {
        PG8_STAGE(PG8_SB(0, 0), cB, voffB); PG8_STAGE(PG8_SB(0, 1), cB + hstep, voffB); PG8_STAGE(PG8_SA(0, 0), cA, voffA); PG8_STAGE(PG8_SA(0, 1), cA + hstep, voffA);
        if (wr == 1) PG8_BAR;
        PG8_WAIT_V(2); PG8_BAR;
        PG8_STAGE(PG8_SB(1, 0), cB + kstep, voffB); PG8_STAGE(PG8_SA(1, 0), cA + kstep, voffA); PG8_STAGE(PG8_SB(1, 1), cB + hstep + kstep, voffB);
        PG8_WAIT_V(6); PG8_BAR;
    } else {
        PG8_STAGE(PG8_SB(0, 0), cB, voffB); PG8_STAGE(PG8_SA(0, 0), cA, voffA); PG8_STAGE(PG8_SB(0, 1), cB + hstep, voffB); PG8_STAGE(PG8_SA(0, 1), cA + hstep, voffA);
        if (wr == 1) PG8_BAR;
        PG8_WAIT_V(4); PG8_BAR;
        PG8_STAGE(PG8_SB(1, 0), cB + kstep, voffB); PG8_STAGE(PG8_SA(1, 0), cA + kstep, voffA); PG8_STAGE(PG8_SB(1, 1), cB + hstep + kstep, voffB);
        PG8_WAIT_V(6); PG8_BAR;
    }
    for (;;) {
        const bool has_next = S.next(ui + 1, nxt);
        const char* nA = has_next ? (const char*)g.A + (size_t)nxt.pm * tstep : cA; const char* nB = has_next ? (const char*)g.Bt + (size_t)((nxt.pm >> g.gsh) & g.gmask) * g.bgs + (size_t)nxt.pn * tstep : cB;
        for (int t = 0; t < nt; t += 2) {
            const bool last = (t == nt - 2);
            const char* a1 = cA + (size_t)(t + 1) * kstep;
            const char* a2 = last ? nA : cA + (size_t)(t + 2) * kstep; const char* b2 = last ? nB : cB + (size_t)(t + 2) * kstep;
            const char* a3 = a2 + kstep; const char* b3 = b2 + kstep;
            if (last && has_next) S.a_ready(nxt);
            if constexpr (SP2) {
            PG8_LDB(B0, 0, 0); PG8_LDB(B1, 0, 1); PG8_SCHED; PG8_LDA(At, 0, 0); PG8_STAGE(PG8_SA(1, 1), a1 + hstep, voffA);
            PG8_WAIT_V(8); PG8_WAIT_L(0); PG8_BAR; PG8_MMA(0, 0, At, B0); PG8_MMA(0, 1, At, B1); PG8_BAR; PG8_SCHED;
            PG8_LDA(At, 0, 1); PG8_STAGE(PG8_SB(0, 0), b2, voffB); PG8_STAGE(PG8_SB(0, 1), b2 + hstep, voffB); PG8_STAGE(PG8_SA(0, 0), a2, voffA);
            PG8_WAIT_V(8); PG8_WAIT_L(0); PG8_BAR; PG8_MMA(1, 0, At, B0); PG8_MMA(1, 1, At, B1); PG8_BAR; PG8_SCHED;
            PG8_LDB(B0, 1, 0); PG8_LDB(B1, 1, 1); PG8_SCHED; PG8_LDA(At, 1, 0); PG8_STAGE(PG8_SA(0, 1), a2 + hstep, voffA);
            PG8_WAIT_V(8); PG8_WAIT_L(0); PG8_BAR; PG8_MMA(0, 0, At, B0); PG8_MMA(0, 1, At, B1); PG8_BAR; PG8_SCHED;
            PG8_LDA(At, 1, 1); PG8_STAGE(PG8_SB(1, 0), b3, voffB); PG8_STAGE(PG8_SB(1, 1), b3 + hstep, voffB); PG8_STAGE(PG8_SA(1, 0), a3, voffA);
            PG8_WAIT_V(8); PG8_WAIT_L(0); PG8_BAR; PG8_MMA(1, 0, At, B0); PG8_MMA(1, 1, At, B1); PG8_BAR; PG8_SCHED;
            } else {
            PG8_LDB(B0, 0, 0); PG8_SCHED; PG8_LDA(At, 0, 0); PG8_STAGE(PG8_SA(1, 1), a1 + hstep, voffA);
            PG8_WAIT_L(8); PG8_BAR; PG8_WAIT_L(0); PG8_MMA(0, 0, At, B0); PG8_BAR; PG8_SCHED;
            PG8_LDB(B1, 0, 1); PG8_STAGE(PG8_SB(0, 0), b2, voffB);
            PG8_BAR; PG8_WAIT_L(0); PG8_MMA(0, 1, At, B1); PG8_BAR;
            PG8_LDA(At, 0, 1); PG8_STAGE(PG8_SA(0, 0), a2, voffA);
            PG8_BAR; PG8_WAIT_L(0); PG8_MMA(1, 0, At, B0); PG8_BAR; PG8_SCHED;
            PG8_STAGE(PG8_SB(0, 1), b2 + hstep, voffB);
            PG8_WAIT_V(6); PG8_BAR; PG8_MMA(1, 1, At, B1); PG8_BAR;
            PG8_LDB(B0, 1, 0); PG8_SCHED; PG8_LDA(At, 1, 0); PG8_STAGE(PG8_SA(0, 1), a2 + hstep, voffA);
            PG8_WAIT_L(8); PG8_BAR; PG8_WAIT_L(0); PG8_MMA(0, 0, At, B0); PG8_BAR; PG8_SCHED;
            PG8_LDB(B1, 1, 1); PG8_STAGE(PG8_SB(1, 0), b3, voffB);
            PG8_BAR; PG8_WAIT_L(0); PG8_MMA(0, 1, At, B1); PG8_BAR;
            PG8_LDA(At, 1, 1); PG8_STAGE(PG8_SA(1, 0), a3, voffA);
            PG8_BAR; PG8_WAIT_L(0); PG8_MMA(1, 0, At, B0); PG8_BAR; PG8_SCHED;
            PG8_STAGE(PG8_SB(1, 1), b3 + hstep, voffB);
            PG8_WAIT_V(6); PG8_BAR; PG8_MMA(1, 1, At, B1); PG8_BAR;
            }
        }
        if constexpr (ALIGN_EPI) { if (wr == 0) PG8_BAR; }
        if constexpr (!Epi::AFTER_DRAIN) { E(acc, cur, wr, wc, fr, fq); S.done(cur); }
        if (!has_next) break;
#pragma unroll
        for (int a = 0; a < 2; ++a)
#pragma unroll
            for (int b = 0; b < 2; ++b)
#pragma unroll
                for (int m = 0; m < 4; ++m)
#pragma unroll
                    for (int n = 0; n < 2; ++n) acc[a][b][m][n] = (f32x4){0.f, 0.f, 0.f, 0.f};
        cur = nxt; cA = nA; cB = nB; ++ui;
        if constexpr (ALIGN_EPI) { if (wr == 1) PG8_BAR; }
    }
    PG8_WAIT_V(0);
    if constexpr (!ALIGN_EPI) { if (wr == 0) PG8_BAR; }
    PG8_BAR;
    if constexpr (Epi::AFTER_DRAIN) { E.fused(acc, cur, wr, wc, fr, fq, lds, wid, lane); S.done(cur); }
#undef PG8_SA
#undef PG8_SB
#undef PG8_STAGE
#undef PG8_LDA
#undef PG8_LDB
#undef PG8_MMA
#undef PG8_WAIT_V
#undef PG8_WAIT_L
#undef PG8_BAR
#undef PG8_SCHED
}
}
#ifndef PG8_SP2
#define PG8_SP2 true
#endif
#ifndef PG8_ALIGN
#define PG8_ALIGN true
#endif
constexpr int NWAVES = 8;
#ifndef MK_PER_PHASE
#define MK_PER_PHASE 0
#endif
constexpr int NPHASE = 14;
constexpr int BATCH = 2, T = 8192, D = 1024, TC = 256, M = BATCH * T, MC = BATCH * TC, MA = M + MC;
constexpr int NEXP = 16, CAP = 1024, FF = 1024;
constexpr float EPS = 1e-6f;
constexpr size_t MiB = 1u << 20;
constexpr size_t WS_CTL = 0, CTL_ZERO_BYTES = 1 * MiB;
constexpr size_t WS_MOD = 1 * MiB;
constexpr size_t WS_EGL = 1 * MiB + 128 * 1024;
constexpr size_t WS_IDX = 1 * MiB + 512 * 1024;
constexpr size_t WS_GATE = WS_IDX + 128 * 1024;
constexpr size_t WS_AFF = 2 * MiB;
constexpr size_t WS_SEL = 3 * MiB;
constexpr size_t WS_WIN = 4 * MiB;
constexpr size_t WS_WOUT = 11 * MiB;
constexpr size_t WS_AIN = 13 * MiB;
constexpr size_t WS_MIX = 13 * MiB;
constexpr size_t WS_FIN = 13 * MiB;
constexpr size_t WS_QKV = 46 * MiB;
constexpr size_t WS_OF = 46 * MiB, WS_OB = 62 * MiB;
constexpr size_t WS_Z = 96 * MiB;
constexpr size_t WS_UV = 112 * MiB;
constexpr size_t WS_AB = 144 * MiB;
constexpr size_t WS_GDN = 146 * MiB;
constexpr size_t GDN_UNIT = 73728;
constexpr size_t WS_WGU = 132 * MiB;
constexpr size_t WS_H1 = 232 * MiB;
constexpr size_t WS_XE = 68 * MiB;
constexpr size_t WS_HID = 4 * MiB;
constexpr size_t WS_WD = 68 * MiB;
constexpr size_t WS_YE = 132 * MiB;
constexpr size_t WS_END = 296 * MiB;
static_assert(WS_GDN + 2112 * GDN_UNIT <= WS_END && WS_AB + (size_t)MA * 64 <= WS_GDN && WS_QKV + (size_t)MA * 3072 <= WS_Z, "ws map");
constexpr int CW_BAR = 4096;
constexpr int LDS_BYTES = 155648;
constexpr int MISC_OFF = LDS_BYTES - 256;
#define LAS __attribute__((address_space(3)))
typedef unsigned short bf16;
typedef unsigned v4u __attribute__((ext_vector_type(4)));
typedef unsigned v2u __attribute__((ext_vector_type(2)));
typedef float f32x4 __attribute__((ext_vector_type(4)));
typedef short bf16x8 __attribute__((ext_vector_type(8)));
#define LDS_WAIT() asm volatile("s_waitcnt lgkmcnt(0)" ::: "memory")
#define VM_WAIT() asm volatile("s_waitcnt vmcnt(0)" ::: "memory")
__device__ __forceinline__ unsigned f2bf(float f) { unsigned u = __builtin_bit_cast(unsigned, f); return (u + 0x7fffu + ((u >> 16) & 1u)) >> 16; }
__device__ __forceinline__ unsigned pk2(float lo, float hi) { return f2bf(lo) | (f2bf(hi) << 16); }
__device__ __forceinline__ float bflo(unsigned w) { return __builtin_bit_cast(float, w << 16); }
__device__ __forceinline__ float bfhi(unsigned w) { return __builtin_bit_cast(float, w & 0xffff0000u); }
__device__ __forceinline__ float bf1(bf16 h) { return __builtin_bit_cast(float, (unsigned)h << 16); }
__device__ __forceinline__ float wave_sum(float v) {
#pragma unroll
    for (int o = 1; o < 64; o <<= 1) v += __shfl_xor(v, o);
    return v;
}
__device__ __forceinline__ float silu1(float x) { return x / (1.0f + __expf(-x)); }

#define XB_TMO      128
#define XB_XCNT(j)  (256  + 64 * (j))
#define XB_XSUB(j)  (1280 + 64 * (j))
#define XB_XGEN(j)  (2304 + 64 * (j))
#define XB_TOP      3328
#define XB_TOPGEN   3392
#define XCD_BAR_WORDS 3456
#define XB_SPIN_CAP (1u << 18)
__device__ __forceinline__ unsigned xb_ld(unsigned* p)              { return __hip_atomic_load(p, __ATOMIC_RELAXED, __HIP_MEMORY_SCOPE_AGENT); }
__device__ __forceinline__ unsigned xb_add(unsigned* p, unsigned v) { return __hip_atomic_fetch_add(p, v, __ATOMIC_RELAXED, __HIP_MEMORY_SCOPE_AGENT); }
__device__ __forceinline__ unsigned xb_xcc_id() { return (unsigned)__builtin_amdgcn_s_getreg((3 << 11) | 20) & 0xFu; }
#define XB_SPIN(cond, bar) do { unsigned _sp = 0; while (cond) { __builtin_amdgcn_s_sleep(1); \
    if ((++_sp & 255u) == 0u) { if (xb_ld(&(bar)[XB_TMO])) break; if (_sp > XB_SPIN_CAP) { atomicAdd(&(bar)[XB_TMO], 1u); break; } } } } while (0)
struct XcdBarrier { unsigned* bar; unsigned x; volatile LAS unsigned* st; };
__device__ __forceinline__ XcdBarrier xcd_barrier_post(unsigned* bar, volatile LAS unsigned* st) {
    XcdBarrier b; b.bar = bar; b.x = xb_xcc_id(); b.st = st;
    if (threadIdx.x == 0) (void)xb_add(&bar[XB_XCNT(b.x)], 1u);
    return b;
}
__device__ __forceinline__ void xcd_barrier_complete(unsigned* bar, unsigned x, unsigned& nloc, unsigned& nx) {
    const unsigned G = gridDim.x * gridDim.y * gridDim.z;
    unsigned sum, cnt, mine, sp = 0u;
    for (;;) {
        sum = 0u; cnt = 0u; mine = 0u;
#pragma unroll
        for (unsigned j = 0; j < 16; ++j) { const unsigned c = xb_ld(&bar[XB_XCNT(j)]); sum += c; cnt += (c > 0u) ? 1u : 0u; mine = (j == x) ? c : mine; }
        if (sum == G) break;
        __builtin_amdgcn_s_sleep(1);
        if ((++sp & 255u) == 0u) { if (xb_ld(&bar[XB_TMO])) break; if (sp > XB_SPIN_CAP) { atomicAdd(&bar[XB_TMO], 1u); break; } }
    }
    nloc = mine > 0u ? mine : 1u; nx = cnt > 0u ? cnt : 1u;
}
__device__ __forceinline__ void xcd_barrier(const XcdBarrier& b) {
    asm volatile("s_waitcnt vmcnt(0)" ::: "memory");
    __syncthreads();
    if (threadIdx.x == 0) {
        unsigned* bar = b.bar;
        __builtin_amdgcn_s_waitcnt(0);
        unsigned nloc = b.st[0], nx = b.st[1];
        if (nloc == 0u) { xcd_barrier_complete(bar, b.x, nloc, nx); b.st[0] = nloc; b.st[1] = nx; }
        const unsigned old = xb_add(&bar[XB_XSUB(b.x)], 1u);
        const unsigned gen = old / nloc;
        if (old + 1u == (gen + 1u) * nloc) {
            __builtin_amdgcn_fence(__ATOMIC_RELEASE, "agent");
            asm volatile("s_waitcnt vmcnt(0)" ::: "memory");
            const unsigned og = xb_add(&bar[XB_TOP], 1u);
            const unsigned tg = og / nx;
            if (og + 1u == (tg + 1u) * nx) xb_add(&bar[XB_TOPGEN], 1u);
            else XB_SPIN(xb_ld(&bar[XB_TOPGEN]) == tg, bar);
            __builtin_amdgcn_fence(__ATOMIC_ACQUIRE, "agent");
            xb_add(&bar[XB_XGEN(b.x)], 1u);
            asm volatile("s_waitcnt vmcnt(0)" ::: "memory");
        } else {
            XB_SPIN(xb_ld(&bar[XB_XGEN(b.x)]) == gen, bar);
            __builtin_amdgcn_fence(__ATOMIC_ACQUIRE, "agent");
            asm volatile("s_waitcnt vmcnt(0)" ::: "memory");
        }
    }
    __syncthreads();
}

struct Frame {
    LAS unsigned char* lds;
    int tid, lane, wave, vcu, G;
    unsigned char* ws;
    const float *x, *c, *ctx, *c_ctx, *w_mod, *b_mod, *norm1_g, *norm2_g, *w_in, *conv_w, *a_log, *dt_bias, *gdn_norm_g, *gm_norm_g, *gm_ws, *gm_bs, *w_out, *w_router, *b_router, *w_gate, *w_up, *w_down, *final_norm_g;
    float* out;
};
__device__ __forceinline__ f32x4 mma_tile(const LAS bf16* A, int lda, int r0, const LAS bf16* Bt, int ldb, int c0, int K, f32x4 acc, int lane) {
    const int fr = lane & 15, fq = lane >> 4;
    const LAS bf16* ap = A + (r0 + fr) * lda + 8 * fq; const LAS bf16* bp = Bt + (c0 + fr) * ldb + 8 * fq;
#pragma unroll 4
    for (int k0 = 0; k0 < K; k0 += 32) { const bf16x8 a = *(const LAS bf16x8*)(ap + k0), b = *(const LAS bf16x8*)(bp + k0); acc = __builtin_amdgcn_mfma_f32_16x16x32_bf16(a, b, acc, 0, 0, 0); }
    return acc;
}
__device__ __forceinline__ void transpose_item(const float* W, int ldw, int src_col0, int k0, bf16* WT, int Kp, int dst_row0, LAS float* scr, int lane) {
#pragma unroll 8
    for (int i = 0; i < 32; ++i) { const int kk = 2 * i + (lane >> 5); scr[kk * 33 + (lane & 31)] = W[(size_t)(k0 + kk) * ldw + src_col0 + (lane & 31)]; }
    LDS_WAIT(); asm volatile("" ::: "memory");
    const int c = lane & 7;
#pragma unroll
    for (int j = 0; j < 4; ++j) { const int n = (lane >> 3) + 8 * j; const LAS float* s = scr + (8 * c) * 33 + n;
        v4u o; o.x = pk2(s[0 * 33], s[1 * 33]); o.y = pk2(s[2 * 33], s[3 * 33]); o.z = pk2(s[4 * 33], s[5 * 33]); o.w = pk2(s[6 * 33], s[7 * 33]);
        *(v4u*)(WT + (size_t)(dst_row0 + n) * Kp + k0 + 8 * c) = o; }
    LDS_WAIT(); asm volatile("" ::: "memory");
}
__device__ __forceinline__ void p0_phase(Frame& F) {
    float* MOD = (float*)(F.ws + WS_MOD);
    if (F.vcu < 96) {
        LAS float* sv = (LAS float*)F.lds;
        LAS float* red = sv + 3072;
        for (int i = F.tid; i < 3072; i += 512) { const int v = i >> 10, k = i & 1023; const float s = v < 2 ? F.c[v * 1024 + k] : F.c_ctx[k]; sv[i] = silu1(s); }
        __syncthreads();
        for (int item = F.vcu; item < 96; item += F.G) {
            const int kq = F.tid >> 4, cq = F.tid & 15, col = item * 64 + cq * 4;
            f32x4 a0 = {0.f, 0.f, 0.f, 0.f}, a1 = a0, a2 = a0;
#pragma unroll 8
            for (int kk = 0; kk < 32; ++kk) { const int k = kq * 32 + kk; const f32x4 w = *(const f32x4*)(F.w_mod + (size_t)k * 6144 + col); a0 += sv[k] * w; a1 += sv[1024 + k] * w; a2 += sv[2048 + k] * w; }
            *(LAS f32x4*)(red + (kq * 3 + 0) * 64 + cq * 4) = a0; *(LAS f32x4*)(red + (kq * 3 + 1) * 64 + cq * 4) = a1; *(LAS f32x4*)(red + (kq * 3 + 2) * 64 + cq * 4) = a2;
            __syncthreads();
            if (F.tid < 192) { const int v = F.tid >> 6, cc = F.tid & 63; float s = F.b_mod[item * 64 + cc];
                for (int q = 0; q < 32; ++q) s += red[(q * 3 + v) * 64 + cc];
                MOD[v * 6144 + item * 64 + cc] = s; }
            __syncthreads();
        }
    }
    __syncthreads();
    LAS float* scr = (LAS float*)(F.lds + F.wave * 16384);
    const int gw = F.vcu * NWAVES + F.wave, NGW = F.G * NWAVES;
    bf16* WIN = (bf16*)(F.ws + WS_WIN); bf16* WOUT = (bf16*)(F.ws + WS_WOUT);
    constexpr int I_IN = 97 * 16, I_OUT = 32 * 16;
    for (int it = gw; it < I_IN + I_OUT; it += NGW) {
        if (it < I_IN) { const int blk = it >> 4, kb = it & 15;
            const int src = blk < 48 ? 32 * blk : (blk < 64 ? 1552 + 32 * (blk - 48) : (blk < 96 ? 2064 + 32 * (blk - 64) : 1536));
            transpose_item(F.w_in, 3088, src, kb * 64, WIN, 1024, blk * 32, scr, F.lane); }
        else { const int r = it - I_IN, blk = r >> 4, kb = r & 15; transpose_item(F.w_out, 1024, blk * 32, kb * 64, WOUT, 1024, blk * 32, scr, F.lane); }
    }
}
__device__ __forceinline__ void wgu_convert(Frame& F) {
    LAS float* scr = (LAS float*)(F.lds + F.wave * 16384);
    const int gw = F.vcu * NWAVES + F.wave, NGW = F.G * NWAVES;
    bf16* WGU = (bf16*)(F.ws + WS_WGU);
    for (int it = gw; it < 16 * 2 * 512; it += NGW) {
        const int kb = it & 15, fb = (it >> 4) & 31, mat = (it >> 9) & 1, e = it >> 10;
        const float* W = (mat ? F.w_up : F.w_gate) + (size_t)e * 1024 * 1024;
        const int f0 = fb * 32, pn = f0 >> 7, dst = 256 * pn + (mat ? 128 : 0) + (f0 & 127);
        transpose_item(W, 1024, f0, kb * 64, WGU + (size_t)e * 2048 * 1024, 1024, dst, scr, F.lane);
    }
}
__device__ __forceinline__ void wd_convert(Frame& F) {
    LAS float* scr = (LAS float*)(F.lds + F.wave * 16384);
    const int gw = F.vcu * NWAVES + F.wave, NGW = F.G * NWAVES;
    bf16* WD = (bf16*)(F.ws + WS_WD);
    for (int it = gw; it < 16 * 512; it += NGW) { const int kb = it & 15, nb = (it >> 4) & 31, e = it >> 9;
        transpose_item(F.w_down + (size_t)e * 1024 * 1024, 1024, nb * 32, kb * 64, WD + (size_t)e * 1024 * 1024, 1024, nb * 32, scr, F.lane); }
}
__device__ __forceinline__ void p1_phase(Frame& F) {
    const float* MOD = (const float*)(F.ws + WS_MOD); bf16* AIN = (bf16*)(F.ws + WS_AIN);
    const int gw = F.vcu * NWAVES + F.wave, NGW = F.G * NWAVES;
#pragma unroll 1
    for (int seg = 0; seg < 3; ++seg) {
        const int r_lo = seg < 2 ? seg * T : M, r_hi = seg < 2 ? (seg + 1) * T : MA;
        const float* mv = MOD + seg * 6144;
        f32x4 sc[4], sh[4];
#pragma unroll
        for (int j = 0; j < 4; ++j) { const int k = 4 * F.lane + 256 * j; const f32x4 g = *(const f32x4*)(F.norm1_g + k), s1 = *(const f32x4*)(mv + 1024 + k); sc[j] = g * (1.0f + s1); sh[j] = *(const f32x4*)(mv + k); }
        for (int m = r_lo + gw; m < r_hi; m += NGW) {
            const float* xr = seg < 2 ? F.x + (size_t)m * D : F.ctx + (size_t)(m - M) * D;
            f32x4 v[4]; float ss = 0.f;
#pragma unroll
            for (int j = 0; j < 4; ++j) { v[j] = *(const f32x4*)(xr + 4 * F.lane + 256 * j); ss += (v[j].x * v[j].x + v[j].y * v[j].y) + (v[j].z * v[j].z + v[j].w * v[j].w); }
            const float rstd = 1.0f / sqrtf(wave_sum(ss) * (1.0f / D) + EPS);
            bf16* orow = AIN + (size_t)m * D;
#pragma unroll
            for (int j = 0; j < 4; ++j) { const f32x4 a = v[j] * rstd * sc[j] + sh[j]; v2u o; o.x = pk2(a.x, a.y); o.y = pk2(a.z, a.w); *(v2u*)(orow + 4 * F.lane + 256 * j) = o; }
        }
    }
}
__device__ __forceinline__ void gdn_item(Frame& F, int it) {
    int b, n, h, L, slot; size_t row_base;
    if (it < 1024) { b = it >> 9; n = (it >> 2) & 127; h = it & 3; L = T; row_base = (size_t)b * T; slot = (b * 4 + h) * 128 + n; }
    else { const int j = it - 1024; b = j >> 4; n = (j >> 2) & 3; h = j & 3; L = TC; row_base = (size_t)M + (size_t)b * TC; slot = 1024 + (b * 4 + h) * 4 + n; }
    const bf16* QKV = (const bf16*)(F.ws + WS_QKV); const float* AB = (const float*)(F.ws + WS_AB);
    LAS bf16* QB = (LAS bf16*)(F.lds); LAS bf16* KB = (LAS bf16*)(F.lds + 17408); LAS bf16* VB = (LAS bf16*)(F.lds + 34816);
    LAS float* KK = (LAS float*)(F.lds + 52224); LAS float* QK = (LAS float*)(F.lds + 68864);
    LAS float* AF = (LAS float*)(F.lds + 85504); LAS bf16* VBT = (LAS bf16*)(F.lds + 85504); LAS bf16* KBGT = (LAS bf16*)(F.lds + 85504 + 18432);
    LAS bf16* TB = (LAS bf16*)(F.lds + 122368); LAS float* GC = (LAS float*)(F.lds + 140800); LAS float* BT = (LAS float*)(F.lds + 141312);
    const int tid = F.tid, lane = F.lane, wave = F.wave;
    {
        const int r = tid >> 3, part = tid & 7, t = 64 * n + r; const bool hasp = t > 0, hasn = t + 1 < L;
        const bf16* prow = QKV + (row_base + t) * 1536;
#pragma unroll
        for (int s = 0; s < 3; ++s) {
            const int col = s * 512 + h * 128 + part * 16; const bf16* pc = prow + col;
            v4u cc[2], pp[2], nn[2];
            cc[0] = *(const v4u*)pc; cc[1] = *(const v4u*)(pc + 8);
            pp[0] = pp[1] = nn[0] = nn[1] = (v4u){0u, 0u, 0u, 0u};
            if (hasp) { pp[0] = *(const v4u*)(pc - 1536); pp[1] = *(const v4u*)(pc - 1536 + 8); }
            if (hasn) { nn[0] = *(const v4u*)(pc + 1536); nn[1] = *(const v4u*)(pc + 1536 + 8); }
            float y[16]; float ss = 0.f;
#pragma unroll
            for (int q = 0; q < 4; ++q) { const f32x4 w0 = *(const f32x4*)(F.conv_w + col + 4 * q), w1 = *(const f32x4*)(F.conv_w + 1536 + col + 4 * q), w2 = *(const f32x4*)(F.conv_w + 3072 + col + 4 * q);
#pragma unroll
                for (int e = 0; e < 2; ++e) { const unsigned cw = cc[q >> 1][(q & 1) * 2 + e], pw = pp[q >> 1][(q & 1) * 2 + e], nw = nn[q >> 1][(q & 1) * 2 + e];
                    const float a0 = w0[2 * e] * bflo(pw) + w1[2 * e] * bflo(cw) + w2[2 * e] * bflo(nw), a1 = w0[2 * e + 1] * bfhi(pw) + w1[2 * e + 1] * bfhi(cw) + w2[2 * e + 1] * bfhi(nw);
                    const float y0 = silu1(a0), y1 = silu1(a1); y[4 * q + 2 * e] = y0; y[4 * q + 2 * e + 1] = y1; ss += y0 * y0 + y1 * y1; } }
            float sc = 1.0f;
            if (s < 2) { ss += __shfl_xor(ss, 1); ss += __shfl_xor(ss, 2); ss += __shfl_xor(ss, 4); sc = (1.0f / sqrtf(ss + EPS)) * (s == 0 ? 0.08838834764831845f : 1.0f); }
            LAS bf16* dst = (s == 0 ? QB : (s == 1 ? KB : VB)) + r * 136 + part * 16;
            v4u o0, o1;
            o0.x = pk2(y[0] * sc, y[1] * sc); o0.y = pk2(y[2] * sc, y[3] * sc); o0.z = pk2(y[4] * sc, y[5] * sc); o0.w = pk2(y[6] * sc, y[7] * sc);
            o1.x = pk2(y[8] * sc, y[9] * sc); o1.y = pk2(y[10] * sc, y[11] * sc); o1.z = pk2(y[12] * sc, y[13] * sc); o1.w = pk2(y[14] * sc, y[15] * sc);
            *(LAS v4u*)dst = o0; *(LAS v4u*)(dst + 8) = o1;
        }
        if (wave < 2) { const int d = wave, i = lane, tl = d ? 63 - i : i; const float* abr = AB + (row_base + 64 * n + tl) * 16;
            const float a = abr[d * 4 + h], bb = abr[8 + d * 4 + h];
            const float xx = a + F.dt_bias[d * 4 + h]; const float sp = fmaxf(xx, 0.f) + log1pf(expf(-fabsf(xx)));
            float g = -expf(F.a_log[d * 4 + h]) * sp;
#pragma unroll
            for (int o = 1; o < 64; o <<= 1) { const float yv = __shfl_up(g, o); if (i >= o) g += yv; }
            GC[d * 64 + i] = g; BT[d * 64 + i] = 1.0f / (1.0f + expf(-bb)); }
    }
    __syncthreads();
    {
        const int mat = wave >> 2, tr = wave & 3, fr = lane & 15, fq = lane >> 4;
#pragma unroll
        for (int tc = 0; tc < 4; ++tc) { f32x4 acc = {0.f, 0.f, 0.f, 0.f}; acc = mma_tile(mat ? QB : KB, 136, 16 * tr, KB, 136, 16 * tc, 128, acc, lane);
            LAS float* dst = (mat ? QK : KK) + (16 * tr + 4 * fq) * 65 + 16 * tc + fr;
#pragma unroll
            for (int j = 0; j < 4; ++j) dst[j * 65] = acc[j]; }
    }
    __syncthreads();
    for (int idx = tid; idx < 8192; idx += 512) { const int d = idx >> 12, i = (idx >> 6) & 63, j = idx & 63; const int ti = d ? 63 - i : i, tj = d ? 63 - j : j;
        AF[idx] = (i > j) ? BT[d * 64 + i] * KK[ti * 65 + tj] * expf(GC[d * 64 + i] - GC[d * 64 + j]) : 0.f; }
    __syncthreads();
    unsigned char* gout = F.ws + WS_GDN + (size_t)slot * 2 * GDN_UNIT;
    if (wave < 2) {
        const int d = wave; const LAS float* A = AF + d * 4096; LAS bf16* TBd = TB + d * 4608;
        float Tc[64];
#pragma unroll
        for (int i = 0; i < 64; ++i) { float s0 = (i == lane) ? 1.f : 0.f, s1 = 0.f, s2 = 0.f, s3 = 0.f;
#pragma unroll
            for (int j = 0; j < i; ++j) { const float a = A[i * 64 + j]; if ((j & 3) == 0) s0 -= a * Tc[j]; else if ((j & 3) == 1) s1 -= a * Tc[j]; else if ((j & 3) == 2) s2 -= a * Tc[j]; else s3 -= a * Tc[j]; }
            Tc[i] = (s0 + s1) + (s2 + s3); TBd[i * 72 + lane] = (bf16)f2bf(Tc[i]); }
    } else {
        const int t2 = tid - 128;
        for (int q = t2; q < 2048; q += 384) { const int d = q >> 10, i = (q >> 4) & 63, cg = q & 15, tok = d ? 63 - i : i; const float e = expf(GC[d * 64 + i]);
            const v4u s = *(const LAS v4u*)(QB + tok * 136 + cg * 8); v4u o;
            o.x = pk2(bflo(s.x) * e, bfhi(s.x) * e); o.y = pk2(bflo(s.y) * e, bfhi(s.y) * e); o.z = pk2(bflo(s.z) * e, bfhi(s.z) * e); o.w = pk2(bflo(s.w) * e, bfhi(s.w) * e);
            *(v4u*)(gout + (size_t)d * GDN_UNIT + 16384 + (i * 128 + cg * 8) * 2) = o; }
        for (int q = t2; q < 2048; q += 384) { const int d = q >> 10, c = (q >> 3) & 127, ig = q & 7; const float gl = GC[d * 64 + 63]; float v[8];
#pragma unroll
            for (int ii = 0; ii < 8; ++ii) { const int i = ig * 8 + ii, tok = d ? 63 - i : i; v[ii] = bf1(KB[tok * 136 + c]) * expf(gl - GC[d * 64 + i]); }
            v4u o; o.x = pk2(v[0], v[1]); o.y = pk2(v[2], v[3]); o.z = pk2(v[4], v[5]); o.w = pk2(v[6], v[7]);
            *(v4u*)(gout + (size_t)d * GDN_UNIT + 32768 + (c * 64 + ig * 8) * 2) = o; }
        for (int q = t2; q < 1024; q += 384) { const int d = q >> 9, i = (q >> 3) & 63, jg = q & 7, ti = d ? 63 - i : i; const float gi = GC[d * 64 + i]; float v[8];
#pragma unroll
            for (int jj = 0; jj < 8; ++jj) { const int j = jg * 8 + jj, tj = d ? 63 - j : j; v[jj] = (i >= j) ? QK[ti * 65 + tj] * expf(gi - GC[d * 64 + j]) : 0.f; }
            v4u o; o.x = pk2(v[0], v[1]); o.y = pk2(v[2], v[3]); o.z = pk2(v[4], v[5]); o.w = pk2(v[6], v[7]);
            *(v4u*)(gout + (size_t)d * GDN_UNIT + 49152 + (i * 64 + jg * 8) * 2) = o; }
        if (t2 < 2) ((float*)(F.ws + WS_EGL))[slot * 2 + t2] = expf(GC[t2 * 64 + 63]);
    }
    __syncthreads();
#pragma unroll 1
    for (int d = 0; d < 2; ++d) {
        for (int q = tid; q < 2048; q += 512) { const int which = q >> 10, c = (q >> 3) & 127, jg = q & 7; float v[8];
#pragma unroll
            for (int jj = 0; jj < 8; ++jj) { const int j = jg * 8 + jj, tok = d ? 63 - j : j; const float bt = BT[d * 64 + j];
                v[jj] = which ? bf1(KB[tok * 136 + c]) * bt * expf(GC[d * 64 + j]) : bf1(VB[tok * 136 + c]) * bt; }
            v4u o; o.x = pk2(v[0], v[1]); o.y = pk2(v[2], v[3]); o.z = pk2(v[4], v[5]); o.w = pk2(v[6], v[7]);
            *(LAS v4u*)((which ? KBGT : VBT) + c * 72 + jg * 8) = o; }
        __syncthreads();
        const LAS bf16* TBd = TB + d * 4608; unsigned char* go = gout + (size_t)d * GDN_UNIT; const int fr = lane & 15, fq = lane >> 4;
#pragma unroll 1
        for (int q = 0; q < 8; ++q) { const int tile = wave * 8 + q, kind = tile >> 5, ti = (tile >> 3) & 3, tc = tile & 7; f32x4 acc = {0.f, 0.f, 0.f, 0.f};
            if (kind == 0) { acc = mma_tile(TBd, 72, 16 * ti, VBT, 72, 16 * tc, 64, acc, lane);
                v2u o; o.x = pk2(acc[0], acc[1]); o.y = pk2(acc[2], acc[3]); *(v2u*)(go + 57344 + ((16 * tc + fr) * 64 + 16 * ti + 4 * fq) * 2) = o; }
            else { acc = mma_tile(KBGT, 72, 16 * tc, TBd, 72, 16 * ti, 64, acc, lane);
                v2u o; o.x = pk2(acc[0], acc[1]); o.y = pk2(acc[2], acc[3]); *(v2u*)(go + ((16 * ti + fr) * 128 + 16 * tc + 4 * fq) * 2) = o; } }
        __syncthreads();
    }
}
__device__ __forceinline__ void gmlp_item(Frame& F, int it) {
    const int g = it & 3, nc = (it >> 2) & 63, b = it >> 8; const size_t r0 = (size_t)b * T + (size_t)nc * 128;
    const bf16* UV = (const bf16*)(F.ws + WS_UV); bf16* MIX = (bf16*)(F.ws + WS_MIX);
    LAS bf16* VNT = (LAS bf16*)(F.lds); LAS bf16* WSB = (LAS bf16*)(F.lds + 34816);
    const int tid = F.tid, lane = F.lane, wave = F.wave;
    {
        const int t = tid >> 2, part = tid & 3; const bf16* vp = UV + (r0 + t) * 1024 + 512 + 128 * g + part * 32;
        float v[32]; float ss = 0.f;
#pragma unroll
        for (int q = 0; q < 4; ++q) { const v4u xw = *(const v4u*)(vp + 8 * q);
#pragma unroll
            for (int e = 0; e < 4; ++e) { v[8 * q + 2 * e] = bflo(xw[e]); v[8 * q + 2 * e + 1] = bfhi(xw[e]); ss += v[8 * q + 2 * e] * v[8 * q + 2 * e] + v[8 * q + 2 * e + 1] * v[8 * q + 2 * e + 1]; } }
        ss += __shfl_xor(ss, 1); ss += __shfl_xor(ss, 2);
        const float rstd = 1.0f / sqrtf(ss * (1.0f / 128.0f) + EPS); const float* gn = F.gm_norm_g + 128 * g + part * 32;
#pragma unroll
        for (int cc = 0; cc < 32; ++cc) VNT[(part * 32 + cc) * 136 + t] = (bf16)f2bf(v[cc] * rstd * gn[cc]);
        const float* wp = F.gm_ws + ((size_t)g * 128 + t) * 128 + part * 32;
#pragma unroll
        for (int q = 0; q < 4; ++q) { const f32x4 w0 = *(const f32x4*)(wp + 8 * q), w1 = *(const f32x4*)(wp + 8 * q + 4); v4u o; o.x = pk2(w0.x, w0.y); o.y = pk2(w0.z, w0.w); o.z = pk2(w1.x, w1.y); o.w = pk2(w1.z, w1.w);
            *(LAS v4u*)(WSB + t * 136 + part * 32 + 8 * q) = o; }
    }
    __syncthreads();
    {
        const int td = wave, fr = lane & 15, fq = lane >> 4;
#pragma unroll 1
        for (int tt = 0; tt < 8; ++tt) { f32x4 acc = {0.f, 0.f, 0.f, 0.f}; acc = mma_tile(VNT, 136, 16 * td, WSB, 136, 16 * tt, 128, acc, lane);
            const int tl = 16 * tt + fr; const size_t off = (r0 + tl) * 1024 + 128 * g + 16 * td + 4 * fq; const float bsv = F.gm_bs[g * 128 + tl];
            const v2u uw = *(const v2u*)(UV + off); v2u o;
            o.x = pk2(bflo(uw.x) * (acc[0] + bsv), bfhi(uw.x) * (acc[1] + bsv)); o.y = pk2(bflo(uw.y) * (acc[2] + bsv), bfhi(uw.y) * (acc[3] + bsv));
            *(v2u*)(MIX + off) = o; }
    }
    __syncthreads();
}
__device__ __forceinline__ void p3_phase(Frame& F) {
    for (int it = F.vcu; it < 1056 + 512; it += F.G) { if (it < 1056) gdn_item(F, it); else gmlp_item(F, it - 1056); }
}
__device__ __forceinline__ void p4_scan(Frame& F) {
    if ((F.vcu & 31) >= 16) return;
    const int chain = 2 * (F.vcu >> 5) + ((F.vcu & 31) >> 3), slice = F.vcu & 7;
    const int b = chain >> 3, h = (chain >> 1) & 3, d = chain & 1, c0 = slice * 16;
    constexpr int NS = 4 + 128, BUFB = 57344, ST_OFF = 2 * BUFB, ST_B = 4608, VNT_OFF = ST_OFF + 2 * ST_B;
    const unsigned char* gdn = F.ws + WS_GDN; const float* EGL = (const float*)(F.ws + WS_EGL);
    const int lane = F.lane, wave = F.wave;
#define P4_SLOT(s) ((s) < 4 ? 1024 + (b * 4 + h) * 4 + (d ? 3 - (s) : (s)) : (b * 4 + h) * 128 + (d ? 127 - ((s) - 4) : ((s) - 4)))
#define P4_BAR() do { asm volatile("s_waitcnt lgkmcnt(0)" ::: "memory"); __builtin_amdgcn_s_barrier(); asm volatile("" ::: "memory"); } while (0)
    if (wave >= 4) {
        const int lw = wave - 4;
#define P4_ISSUE(s, bufi) do { const unsigned char* gb = gdn + (size_t)(P4_SLOT(s) * 2 + d) * GDN_UNIT; \
            _Pragma("unroll") for (int q = 0; q < 14; ++q) { const int k = lw + 4 * q; unsigned so; \
                if (k < 32) { const int qi = (k & 15) * 64 + lane, r = qi >> 4, sl = qi & 15; so = (unsigned)((k >> 4) * 16384 + r * 256 + ((sl ^ (r & 15)) << 4)); } \
                else { const int kk = k < 48 ? k - 32 : k - 48, qi = kk * 64 + lane, r = qi >> 3, sl = qi & 7; so = (unsigned)((k < 48 ? 32768 : 49152) + r * 128 + ((sl ^ ((r >> 1) & 7)) << 4)); } \
                __builtin_amdgcn_global_load_lds((const unsigned*)(gb + so), (LAS unsigned*)(F.lds + (bufi) * BUFB + k * 1024), 16, 0, 0); } } while (0)
        P4_ISSUE(0, 0);
        VM_WAIT(); P4_BAR();
#pragma unroll 1
        for (int s = 0; s < NS; ++s) {
            const int cur = s & 1;
            if (s + 1 < NS) P4_ISSUE(s + 1, cur ^ 1);
            P4_BAR();
            VM_WAIT();
            P4_BAR();
        }
#undef P4_ISSUE
    } else {
        const int m = wave, fr = lane & 15, fq = lane >> 4;
        for (int i = F.tid; i < ST_B / 4; i += 256) ((LAS unsigned*)(F.lds + ST_OFF))[i] = 0u;
        f32x4 S0 = {0.f, 0.f, 0.f, 0.f}, S1 = S0;
        bf16* OD = (bf16*)(F.ws + (d ? WS_OB : WS_OF));
        v2u un; float egn;
        { const unsigned char* gb = gdn + (size_t)(P4_SLOT(0) * 2 + d) * GDN_UNIT; un = *(const v2u*)(gb + 57344 + ((c0 + fr) * 64 + 16 * m + 4 * fq) * 2); egn = EGL[P4_SLOT(0) * 2 + d]; }
        P4_BAR();
#pragma unroll 1
        for (int s = 0; s < NS; ++s) {
            const int cur = s & 1; const LAS unsigned char* buf = F.lds + cur * BUFB; const LAS unsigned char* STc = F.lds + ST_OFF + cur * ST_B; LAS unsigned char* STn = F.lds + ST_OFF + (cur ^ 1) * ST_B;
            const v2u uc = un; const float eg = egn;
            if (s + 1 < NS) { const int sl = P4_SLOT(s + 1); const unsigned char* gb = gdn + (size_t)(sl * 2 + d) * GDN_UNIT; un = *(const v2u*)(gb + 57344 + ((c0 + fr) * 64 + 16 * m + 4 * fq) * 2); egn = EGL[sl * 2 + d]; }
            bf16x8 bS[4]; f32x4 acc = {0.f, 0.f, 0.f, 0.f};
            const int r = 16 * m + fr;
#pragma unroll
            for (int ks = 0; ks < 4; ++ks) { bS[ks] = *(const LAS bf16x8*)(STc + fr * 288 + (32 * ks + 8 * fq) * 2);
                const bf16x8 a = *(const LAS bf16x8*)(buf + r * 256 + (((4 * ks + fq) ^ fr) << 4)); acc = __builtin_amdgcn_mfma_f32_16x16x32_bf16(a, bS[ks], acc, 0, 0, 0); }
            { const float v0 = bflo(uc.x) - acc[0], v1 = bfhi(uc.x) - acc[1], v2 = bflo(uc.y) - acc[2], v3 = bfhi(uc.y) - acc[3]; v2u o; o.x = pk2(v0, v1); o.y = pk2(v2, v3);
              *(LAS v2u*)(F.lds + VNT_OFF + fr * 160 + (16 * m + 4 * fq) * 2) = o; }
            P4_BAR();
            bf16x8 bV[2];
#pragma unroll
            for (int ks = 0; ks < 2; ++ks) bV[ks] = *(const LAS bf16x8*)(F.lds + VNT_OFF + fr * 160 + (32 * ks + 8 * fq) * 2);
            if (s >= 4) {
                f32x4 o = {0.f, 0.f, 0.f, 0.f};
#pragma unroll
                for (int ks = 0; ks < 4; ++ks) { const bf16x8 a = *(const LAS bf16x8*)(buf + 16384 + r * 256 + (((4 * ks + fq) ^ fr) << 4)); o = __builtin_amdgcn_mfma_f32_16x16x32_bf16(a, bS[ks], o, 0, 0, 0); }
#pragma unroll
                for (int ks = 0; ks < 2; ++ks) { const bf16x8 a = *(const LAS bf16x8*)(buf + 49152 + r * 128 + (((4 * ks + fq) ^ ((r >> 1) & 7)) << 4)); o = __builtin_amdgcn_mfma_f32_16x16x32_bf16(a, bV[ks], o, 0, 0, 0); }
                const int n = d ? 127 - (s - 4) : (s - 4);
#pragma unroll
                for (int j = 0; j < 4; ++j) { const int i = 16 * m + 4 * fq + j, tl = d ? 63 - i : i; OD[((size_t)b * T + 64 * n + tl) * 512 + h * 128 + c0 + fr] = (bf16)f2bf(o[j]); }
            }
            S0 *= eg; S1 *= eg;
#pragma unroll
            for (int ks = 0; ks < 2; ++ks) {
                const int r0 = 32 * m + fr, r1 = r0 + 16;
                const bf16x8 a0 = *(const LAS bf16x8*)(buf + 32768 + r0 * 128 + (((4 * ks + fq) ^ ((r0 >> 1) & 7)) << 4)); S0 = __builtin_amdgcn_mfma_f32_16x16x32_bf16(a0, bV[ks], S0, 0, 0, 0);
                const bf16x8 a1 = *(const LAS bf16x8*)(buf + 32768 + r1 * 128 + (((4 * ks + fq) ^ ((r1 >> 1) & 7)) << 4)); S1 = __builtin_amdgcn_mfma_f32_16x16x32_bf16(a1, bV[ks], S1, 0, 0, 0);
            }
            { v2u o; o.x = pk2(S0[0], S0[1]); o.y = pk2(S0[2], S0[3]); *(LAS v2u*)(STn + fr * 288 + (32 * m + 4 * fq) * 2) = o;
              o.x = pk2(S1[0], S1[1]); o.y = pk2(S1[2], S1[3]); *(LAS v2u*)(STn + fr * 288 + (32 * m + 16 + 4 * fq) * 2) = o; }
            P4_BAR();
        }
    }
#undef P4_SLOT
#undef P4_BAR
}
__device__ __forceinline__ void p5a_combine(Frame& F) {
    const bf16* OFp = (const bf16*)(F.ws + WS_OF); const bf16* OBp = (const bf16*)(F.ws + WS_OB); const bf16* Z = (const bf16*)(F.ws + WS_Z); bf16* MIX = (bf16*)(F.ws + WS_MIX);
    const int gw = F.vcu * NWAVES + F.wave, NGW = F.G * NWAVES, lane = F.lane;
    float gn[8];
#pragma unroll
    for (int e = 0; e < 8; ++e) gn[e] = F.gdn_norm_g[(lane & 15) * 8 + e];
    for (int m = gw; m < M; m += NGW) {
        const v4u a = *(const v4u*)(OFp + (size_t)m * 512 + lane * 8), bq = *(const v4u*)(OBp + (size_t)m * 512 + lane * 8), zz = *(const v4u*)(Z + (size_t)m * 512 + lane * 8);
        float o[8]; float ss = 0.f;
#pragma unroll
        for (int e = 0; e < 4; ++e) { o[2 * e] = bflo(a[e]) + bflo(bq[e]); o[2 * e + 1] = bfhi(a[e]) + bfhi(bq[e]); ss += o[2 * e] * o[2 * e] + o[2 * e + 1] * o[2 * e + 1]; }
        ss += __shfl_xor(ss, 1); ss += __shfl_xor(ss, 2); ss += __shfl_xor(ss, 4); ss += __shfl_xor(ss, 8);
        const float rstd = 1.0f / sqrtf(ss * (1.0f / 128.0f) + EPS);
        float y[8];
#pragma unroll
        for (int e = 0; e < 4; ++e) { y[2 * e] = o[2 * e] * rstd * gn[2 * e] * silu1(bflo(zz[e])); y[2 * e + 1] = o[2 * e + 1] * rstd * gn[2 * e + 1] * silu1(bfhi(zz[e])); }
        v4u w; w.x = pk2(y[0], y[1]); w.y = pk2(y[2], y[3]); w.z = pk2(y[4], y[5]); w.w = pk2(y[6], y[7]);
        *(v4u*)(MIX + (size_t)m * 1024 + 512 + lane * 8) = w;
    }
}
__device__ __forceinline__ void p6_phase(Frame& F) {
    const float* MOD = (const float*)(F.ws + WS_MOD); const float* H1 = (const float*)(F.ws + WS_H1); bf16* FIN = (bf16*)(F.ws + WS_FIN);
    float* AFF = (float*)(F.ws + WS_AFF); int* SEL = (int*)(F.ws + WS_SEL);
    LAS float* WR = (LAS float*)F.lds;
    for (int i = F.tid; i < 1024 * 4; i += 512) { const int k = i >> 2, q = i & 3; *(LAS f32x4*)(WR + k * 20 + q * 4) = *(const f32x4*)(F.w_router + k * 16 + q * 4); }
    __syncthreads();
    const int gw = F.vcu * NWAVES + F.wave, NGW = F.G * NWAVES, lane = F.lane;
#pragma unroll 1
    for (int b = 0; b < 2; ++b) {
        const float* mv = MOD + b * 6144;
        float sc[16], sh[16];
#pragma unroll
        for (int j = 0; j < 16; ++j) { const int k = lane + 64 * j; sc[j] = F.norm2_g[k] * (1.0f + mv[4096 + k]); sh[j] = mv[3072 + k]; }
        for (int m = b * T + gw; m < (b + 1) * T; m += NGW) {
            const float* hr = H1 + (size_t)m * D; float v[16]; float ss = 0.f;
#pragma unroll
            for (int j = 0; j < 16; ++j) { v[j] = hr[lane + 64 * j]; ss += v[j] * v[j]; }
            const float rstd = 1.0f / sqrtf(wave_sum(ss) * (1.0f / D) + EPS);
            float lg[16];
#pragma unroll
            for (int e = 0; e < 16; ++e) lg[e] = 0.f;
            bf16* fr_ = FIN + (size_t)m * D;
#pragma unroll
            for (int j = 0; j < 16; ++j) { const float f = v[j] * rstd * sc[j] + sh[j]; fr_[lane + 64 * j] = (bf16)f2bf(f);
                const LAS float* wr = WR + (lane + 64 * j) * 20;
#pragma unroll
                for (int q = 0; q < 4; ++q) { const f32x4 w = *(const LAS f32x4*)(wr + 4 * q); lg[4 * q] += f * w.x; lg[4 * q + 1] += f * w.y; lg[4 * q + 2] += f * w.z; lg[4 * q + 3] += f * w.w; }
                asm volatile("" ::: "memory"); }
            float mx = -3.0e38f;
#pragma unroll
            for (int e = 0; e < 16; ++e) { lg[e] = wave_sum(lg[e]) + F.b_router[e]; mx = fmaxf(mx, lg[e]); }
            float den = 0.f;
#pragma unroll
            for (int e = 0; e < 16; ++e) { lg[e] = expf(lg[e] - mx); den += lg[e]; }
            float mine = 0.f;
#pragma unroll
            for (int e = 0; e < 16; ++e) mine = (lane == e) ? lg[e] : mine;
            if (lane < 16) { AFF[((size_t)b * 16 + lane) * T + (m - b * T)] = mine / den; SEL[(size_t)m * 16 + lane] = -1; }
        }
    }
}
__device__ __forceinline__ void p7_topk(Frame& F) {
    const float* AFF = (const float*)(F.ws + WS_AFF); int* SEL = (int*)(F.ws + WS_SEL); int* IDX = (int*)(F.ws + WS_IDX); float* GATE = (float*)(F.ws + WS_GATE);
    LAS unsigned long long* key = (LAS unsigned long long*)F.lds;
    for (int u = F.vcu; u < 32; u += F.G) {
        const int b = u >> 4, e = u & 15; const float* ar = AFF + (size_t)u * T;
        for (int t = F.tid; t < T; t += 512) key[t] = ((unsigned long long)__builtin_bit_cast(unsigned, ar[t]) << 13) | (unsigned long long)(8191 - t);
        __syncthreads();
#pragma unroll 1
        for (int k = 2; k <= T; k <<= 1)
#pragma unroll 1
            for (int j = k >> 1; j > 0; j >>= 1) {
                for (int q = F.tid; q < T / 2; q += 512) { const int i = ((q & ~(j - 1)) << 1) | (q & (j - 1)), l = i | j; const bool asc = (i & k) != 0;
                    const unsigned long long a = key[i], c = key[l]; if (asc ? (a > c) : (a < c)) { key[i] = c; key[l] = a; } }
                __syncthreads();
            }
        for (int cpos = F.tid; cpos < CAP; cpos += 512) { const unsigned long long kv = key[cpos]; const int t = 8191 - (int)(kv & 8191ull); const float g = __builtin_bit_cast(float, (unsigned)(kv >> 13));
            IDX[u * CAP + cpos] = b * T + t; GATE[u * CAP + cpos] = g; SEL[((size_t)b * T + t) * 16 + e] = cpos; }
        __syncthreads();
    }
}
__device__ __forceinline__ void p7b_gather(Frame& F) {
    const int* IDX = (const int*)(F.ws + WS_IDX); const bf16* FIN = (const bf16*)(F.ws + WS_FIN); bf16* XE = (bf16*)(F.ws + WS_XE);
    const int gw = F.vcu * NWAVES + F.wave, NGW = F.G * NWAVES, lane = F.lane;
    for (int r = gw; r < 32 * CAP; r += NGW) { const int src = IDX[r]; const v4u* sp = (const v4u*)(FIN + (size_t)src * D); v4u* dp = (v4u*)(XE + (size_t)r * D);
        const v4u a = sp[lane], c = sp[lane + 64]; dp[lane] = a; dp[lane + 64] = c; }
}
__device__ __forceinline__ void p10_final(Frame& F) {
    const float* MOD = (const float*)(F.ws + WS_MOD); const float* H1 = (const float*)(F.ws + WS_H1); const bf16* YE = (const bf16*)(F.ws + WS_YE); const int* SEL = (const int*)(F.ws + WS_SEL);
    const int gw = F.vcu * NWAVES + F.wave, NGW = F.G * NWAVES, lane = F.lane;
#pragma unroll 1
    for (int b = 0; b < 2; ++b) {
        f32x4 gt[4], fg[4];
#pragma unroll
        for (int j = 0; j < 4; ++j) { gt[j] = *(const f32x4*)(MOD + b * 6144 + 5120 + 4 * lane + 256 * j); fg[j] = *(const f32x4*)(F.final_norm_g + 4 * lane + 256 * j); }
        for (int m = b * T + gw; m < (b + 1) * T; m += NGW) {
            const int selv = lane < 16 ? SEL[(size_t)m * 16 + lane] : -1;
            f32x4 acc[4];
#pragma unroll
            for (int j = 0; j < 4; ++j) acc[j] = (f32x4){0.f, 0.f, 0.f, 0.f};
#pragma unroll 1
            for (int e = 0; e < 16; ++e) { const int cpos = __shfl(selv, e);
                if (cpos >= 0) { const bf16* yr = YE + ((size_t)(b * 16 + e) * CAP + cpos) * D + 4 * lane;
#pragma unroll
                    for (int j = 0; j < 4; ++j) { const v2u w = *(const v2u*)(yr + 256 * j); acc[j] += (f32x4){bflo(w.x), bfhi(w.x), bflo(w.y), bfhi(w.y)}; } } }
            f32x4 hv[4]; float ss = 0.f;
#pragma unroll
            for (int j = 0; j < 4; ++j) { hv[j] = *(const f32x4*)(H1 + (size_t)m * D + 4 * lane + 256 * j) + gt[j] * acc[j]; ss += (hv[j].x * hv[j].x + hv[j].y * hv[j].y) + (hv[j].z * hv[j].z + hv[j].w * hv[j].w); }
            const float rstd = 1.0f / sqrtf(wave_sum(ss) * (1.0f / D) + EPS);
#pragma unroll
            for (int j = 0; j < 4; ++j) *(f32x4*)(F.out + (size_t)m * D + 4 * lane + 256 * j) = hv[j] * rstd * fg[j];
        }
    }
}
struct Args { const float* in[23]; float* out; unsigned char* ws; int ph_lo, ph_hi; };
__global__ void __launch_bounds__(NWAVES * 64, 2) fwd_kernel(Args args) {
    extern __shared__ __attribute__((aligned(16))) unsigned char lds_raw[];
    Frame F;
    F.lds = (LAS unsigned char*)lds_raw;
    volatile LAS unsigned* MISC = (volatile LAS unsigned*)(F.lds + MISC_OFF);
    F.tid = threadIdx.x; F.lane = F.tid & 63; F.wave = __builtin_amdgcn_readfirstlane(F.tid >> 6);
    F.G = gridDim.x; { const int bx = blockIdx.x; F.vcu = (F.G % 8 == 0) ? (bx % 8) * (F.G / 8) + bx / 8 : bx; }
    F.ws = args.ws; F.out = args.out;
    F.x = args.in[0]; F.c = args.in[1]; F.ctx = args.in[2]; F.c_ctx = args.in[3]; F.w_mod = args.in[4]; F.b_mod = args.in[5]; F.norm1_g = args.in[6]; F.norm2_g = args.in[7];
    F.w_in = args.in[8]; F.conv_w = args.in[9]; F.a_log = args.in[10]; F.dt_bias = args.in[11]; F.gdn_norm_g = args.in[12]; F.gm_norm_g = args.in[13]; F.gm_ws = args.in[14]; F.gm_bs = args.in[15];
    F.w_out = args.in[16]; F.w_router = args.in[17]; F.b_router = args.in[18]; F.w_gate = args.in[19]; F.w_up = args.in[20]; F.w_down = args.in[21]; F.final_norm_g = args.in[22];
    for (int u = F.tid; u < 64; u += NWAVES * 64) MISC[u] = 0u;
    __syncthreads();
    XcdBarrier bar; bar.bar = (unsigned*)(F.ws + WS_CTL) + CW_BAR; bar.x = 0; bar.st = nullptr;
    if (!MK_PER_PHASE) bar = xcd_barrier_post((unsigned*)(F.ws + WS_CTL) + CW_BAR, MISC + 8);
    const int lo = args.ph_lo, hi = args.ph_hi;
#define IN(k) (lo <= (k) && (k) < hi)
#define SEAM(k) do { if (IN(k) && IN((k) + 1)) xcd_barrier(bar); } while (0)
    if (IN(0)) { p0_phase(F); } SEAM(0);
    if (IN(1)) { p1_phase(F); } SEAM(1);
    if (IN(2)) {
        pg8::Gemm g{(const bf16*)(F.ws + WS_AIN), (const bf16*)(F.ws + WS_WIN), MA, 3328, D, 0, 0, 0}; pg8::StaticOrder S; S.init(MA, 3328, F.G, (int)blockIdx.x);
        pg8::EpiInProj E{(bf16*)(F.ws + WS_QKV), (bf16*)(F.ws + WS_Z), (bf16*)(F.ws + WS_UV), (float*)(F.ws + WS_AB)};
        pg8::gemm_phase<pg8::EpiInProj, pg8::StaticOrder, PG8_ALIGN, PG8_SP2>(F.lds, g, S, E);
    } SEAM(2);
    if (IN(3)) { p3_phase(F); } SEAM(3);
    if (IN(4)) { p4_scan(F); } SEAM(4);
    if (IN(5)) { p5a_combine(F); wgu_convert(F); } SEAM(5);
    if (IN(6)) {
        pg8::Gemm g{(const bf16*)(F.ws + WS_MIX), (const bf16*)(F.ws + WS_WOUT), M, D, D, 0, 0, 0}; pg8::StaticOrder S; S.init(M, D, F.G, (int)blockIdx.x);
        pg8::EpiOutProj E{F.x, (const float*)(F.ws + WS_MOD), (float*)(F.ws + WS_H1)};
        pg8::gemm_phase<pg8::EpiOutProj, pg8::StaticOrder, PG8_ALIGN, PG8_SP2>(F.lds, g, S, E);
    } SEAM(6);
    if (IN(7)) { p6_phase(F); } SEAM(7);
    if (IN(8)) { p7_topk(F); } SEAM(8);
    if (IN(9)) { p7b_gather(F); } SEAM(9);
    if (IN(10)) {
        pg8::Gemm g{(const bf16*)(F.ws + WS_XE), (const bf16*)(F.ws + WS_WGU), 32 * CAP, 2 * FF, D, (size_t)2 * FF * D * 2, 2, 15}; pg8::StaticOrder S; S.init(32 * CAP, 2 * FF, F.G, (int)blockIdx.x);
        pg8::EpiSwiGLU E{(bf16*)(F.ws + WS_HID)};
        pg8::gemm_phase<pg8::EpiSwiGLU, pg8::StaticOrder, PG8_ALIGN, PG8_SP2>(F.lds, g, S, E);
    } SEAM(10);
    if (IN(11)) { wd_convert(F); } SEAM(11);
    if (IN(12)) {
        pg8::Gemm g{(const bf16*)(F.ws + WS_HID), (const bf16*)(F.ws + WS_WD), 32 * CAP, D, FF, (size_t)D * FF * 2, 2, 15}; pg8::StaticOrder S; S.init(32 * CAP, D, F.G, (int)blockIdx.x);
        pg8::EpiDown E{(bf16*)(F.ws + WS_YE), (const float*)(F.ws + WS_GATE)};
        pg8::gemm_phase<pg8::EpiDown, pg8::StaticOrder, PG8_ALIGN, PG8_SP2>(F.lds, g, S, E);
    } SEAM(12);
    if (IN(13)) { p10_final(F); }
#undef IN
#undef SEAM
}

extern "C" void kernel_launch(void* const* d_in, const int* in_sizes, int n_in, void* d_out, int out_size, void* d_ws, size_t ws_size, hipStream_t stream) {
    static int grid = 0;
    if (grid == 0) {
        if (n_in != 23 || out_size != M * D || ws_size < WS_END) { fprintf(stderr, "kernel_launch: unexpected problem (n_in %d, out %d, ws %zu)\n", n_in, out_size, ws_size); grid = -1; return; }
        int dev = 0, cus = 0;
        if (hipGetDevice(&dev) != hipSuccess || hipDeviceGetAttribute(&cus, hipDeviceAttributeMultiprocessorCount, dev) != hipSuccess) { grid = -1; return; }
        if (hipFuncSetAttribute((const void*)fwd_kernel, hipFuncAttributeMaxDynamicSharedMemorySize, LDS_BYTES) != hipSuccess) { fprintf(stderr, "kernel_launch: hipFuncSetAttribute failed\n"); grid = -1; return; }
        grid = cus;
    }
    if (grid < 0) return;
    if (hipMemsetAsync((char*)d_ws + WS_CTL, 0, CTL_ZERO_BYTES, stream) != hipSuccess) return;
    Args a{};
    for (int i = 0; i < 23; ++i) a.in[i] = (const float*)d_in[i];
    a.out = (float*)d_out; a.ws = (unsigned char*)d_ws;
#if MK_PER_PHASE
    for (int p = 0; p < NPHASE; ++p) { a.ph_lo = p; a.ph_hi = p + 1; hipLaunchKernelGGL(fwd_kernel, dim3(grid), dim3(NWAVES * 64), LDS_BYTES, stream, a); }
#else
    a.ph_lo = 0; a.ph_hi = NPHASE;
    hipLaunchKernelGGL(fwd_kernel, dim3(grid), dim3(NWAVES * 64), LDS_BYTES, stream, a);
#endif
}
```

```cpp
#include <hip/hip_runtime.h>
#include <cstdio>
#include <cstdint>
namespace pg8 {
#define PG8_LAS __attribute__((address_space(3)))
typedef unsigned short bf16_t;
typedef short bf16x8 __attribute__((ext_vector_type(8)));
typedef float f32x4 __attribute__((ext_vector_type(4)));
typedef unsigned u32x4 __attribute__((ext_vector_type(4)));
constexpr int BM = 256, BK = 64, HALF = 128, HTB = HALF * BK * 2  , STAGE_BYTES = 8 * HTB, NXCD = 8, WGM = 8;

__host__ __device__ __forceinline__ int lds_byte(int r, int c) { const int st = (r >> 4) * 2 + (c >> 5), rr = r & 15, cc = c & 31, ob = rr * 64 + cc * 2; return st * 1024 + (ob ^ (((ob >> 9) & 1) << 5)); }
__host__ __device__ __forceinline__ void stage_rc(int b, int& R, int& C) { const int st = b / 1024, sb = b % 1024, swz = sb ^ (((sb >> 9) & 1) << 5); R = (st >> 1) * 16 + swz / 64; C = (st & 1) * 32 + (swz % 64) / 2; }
__host__ __device__ __forceinline__ int perm32(int rho) { const int n = rho >> 4, i = rho & 15; return 8 * (i >> 2) + 4 * n + (i & 3); }

struct Unit { int pm, pn; };
struct Gemm { const bf16_t* A; const bf16_t* Bt; int M, N, K; size_t bgs; int gsh, gmask; };

struct StaticOrder {
    int nM, nN, nwg, G, c;
    __host__ __device__ void init(int M, int N, int G_, int c_) { nM = M / BM; nN = N / BM; nwg = nM * nN; G = G_; c = c_; }
    __host__ __device__ bool next(int i, Unit& u) const {
        const long L = (long)i * G + c; if (L >= nwg) return false;
        int wgid = (int)L; { const int q = nwg / NXCD, r = nwg % NXCD, xcd = wgid % NXCD, off = wgid / NXCD; wgid = (xcd < r ? xcd * (q + 1) : r * (q + 1) + (xcd - r) * q) + off; }
        const int nig = WGM * nN, gid = wgid / nig, fm = gid * WGM, gsz = (nM - fm) < WGM ? (nM - fm) : WGM;
        u.pm = fm + ((wgid % nig) % gsz); u.pn = (wgid % nig) / gsz; return true;
    }
    __device__ __forceinline__ void a_ready(const Unit&) const {}
    __device__ __forceinline__ void done(const Unit&) const {}
};

__device__ __forceinline__ unsigned cvt_pk_bf16(float lo, float hi) { unsigned r; asm volatile("v_cvt_pk_bf16_f32 %0, %1, %2" : "=v"(r) : "v"(lo), "v"(hi)); return r; }
typedef float f32x2 __attribute__((ext_vector_type(2)));
__device__ __forceinline__ f32x2 gelu_pk(f32x2 v) {
    const f32x2 av = __builtin_elementwise_abs(v), d = av * 0.2316418882f + 1.0f;
    f32x2 t; t.x = __builtin_amdgcn_rcpf(d.x); t.y = __builtin_amdgcn_rcpf(d.y);
    f32x2 q = t * 0.5307027145f + (-0.7265760135f); q = q * t + 0.7107068705f; q = q * t + (-0.142248368f); q = q * t + 0.127414796f; q = q * t;
    const f32x2 s = (v * v) * (-0.72134752044f);
    f32x2 e; e.x = __builtin_amdgcn_exp2f(s.x); e.y = __builtin_amdgcn_exp2f(s.y);
    const f32x2 m = v * (q * e), r = v - m;
    f32x2 o; o.x = v.x < 0.f ? m.x : r.x; o.y = v.y < 0.f ? m.y : r.y; return o;
}
__device__ __forceinline__ float silu_f(float x) { return x * __builtin_amdgcn_rcpf(1.0f + __expf(-x)); }
__device__ __forceinline__ void st8(bf16_t* p, const f32x4 v0, const f32x4 v1) { u32x4 w; w.x = cvt_pk_bf16(v0[0], v0[1]); w.y = cvt_pk_bf16(v0[2], v0[3]); w.z = cvt_pk_bf16(v1[0], v1[1]); w.w = cvt_pk_bf16(v1[2], v1[3]); *(u32x4*)p = w; }
struct EpiInProj {
    static constexpr bool PERM = true, AFTER_DRAIN = false;
    bf16_t* QKV; bf16_t* Z; bf16_t* UV; float* AB;
    __device__ __forceinline__ void operator()(const f32x4 (&acc)[2][2][4][2], const Unit& u, int wr, int wc, int fr, int fq) const {
        const int row0 = u.pm * BM + wr * 64 + fr, pn = u.pn;
        if (pn == 12) {
            if (wc == 0 && fq < 2) {
#pragma unroll
                for (int ai = 0; ai < 2; ++ai)
#pragma unroll
                    for (int m = 0; m < 4; ++m) { float* p = AB + (size_t)(row0 + ai * HALF + m * 16) * 16 + 8 * fq; *(f32x4*)p = acc[ai][0][m][0]; *(f32x4*)(p + 4) = acc[ai][0][m][1]; }
            }
            return;
        }
        bf16_t* base; int ldc, colt; bool act = false;
        if (pn < 6) { base = QKV; ldc = 1536; colt = pn * 256; }
        else { if (u.pm >= 64) return; if (pn < 8) { base = Z; ldc = 512; colt = (pn - 6) * 256; } else { base = UV; ldc = 1024; colt = (pn - 8) * 256; act = true; } }
        const int col0 = colt + wc * 32 + 8 * fq;
#pragma unroll
        for (int ai = 0; ai < 2; ++ai)
#pragma unroll
            for (int m = 0; m < 4; ++m) { bf16_t* rowp = base + (size_t)(row0 + ai * HALF + m * 16) * ldc + col0;
#pragma unroll
                for (int bj = 0; bj < 2; ++bj) { f32x4 v0 = acc[ai][bj][m][0], v1 = acc[ai][bj][m][1];
                    if (act) { f32x2 a = gelu_pk((f32x2){v0[0], v0[1]}), b = gelu_pk((f32x2){v0[2], v0[3]}), c = gelu_pk((f32x2){v1[0], v1[1]}), d = gelu_pk((f32x2){v1[2], v1[3]});
                        v0 = (f32x4){a.x, a.y, b.x, b.y}; v1 = (f32x4){c.x, c.y, d.x, d.y}; }
                    st8(rowp + bj * HALF, v0, v1); } }
    }
};
struct EpiOutProj {
    static constexpr bool PERM = false, AFTER_DRAIN = false;
    const float* x; const float* mod; float* H1;
    __device__ __forceinline__ void operator()(const f32x4 (&acc)[2][2][4][2], const Unit& u, int wr, int wc, int fr, int fq) const {
        const int row0 = u.pm * BM + wr * 64 + fr, col0 = u.pn * BM + wc * 32 + 4 * fq; const float* gt = mod + (u.pm >= 32 ? 6144 : 0) + 2048;
        f32x4 gv[2][2];
#pragma unroll
        for (int bj = 0; bj < 2; ++bj)
#pragma unroll
            for (int n = 0; n < 2; ++n) gv[bj][n] = *(const f32x4*)(gt + col0 + bj * HALF + n * 16);
#pragma unroll
        for (int ai = 0; ai < 2; ++ai)
#pragma unroll
            for (int m = 0; m < 4; ++m) { const size_t off = (size_t)(row0 + ai * HALF + m * 16) * 1024 + col0;
#pragma unroll
                for (int bj = 0; bj < 2; ++bj)
#pragma unroll
                    for (int n = 0; n < 2; ++n) { const f32x4 xv = *(const f32x4*)(x + off + bj * HALF + n * 16); *(f32x4*)(H1 + off + bj * HALF + n * 16) = xv + gv[bj][n] * acc[ai][bj][m][n]; } }
    }
};
struct EpiSwiGLU {
    static constexpr bool PERM = true, AFTER_DRAIN = false;
    bf16_t* HID;
    __device__ __forceinline__ void operator()(const f32x4 (&acc)[2][2][4][2], const Unit& u, int wr, int wc, int fr, int fq) const {
        const int row0 = u.pm * BM + wr * 64 + fr, col0 = u.pn * HALF + wc * 32 + 8 * fq;
#pragma unroll
        for (int ai = 0; ai < 2; ++ai)
#pragma unroll
            for (int m = 0; m < 4; ++m) { bf16_t* rowp = HID + (size_t)(row0 + ai * HALF + m * 16) * 1024 + col0; f32x4 h0, h1;
#pragma unroll
                for (int j = 0; j < 4; ++j) { h0[j] = silu_f(acc[ai][0][m][0][j]) * acc[ai][1][m][0][j]; h1[j] = silu_f(acc[ai][0][m][1][j]) * acc[ai][1][m][1][j]; }
                st8(rowp, h0, h1); }
    }
};
struct EpiDown {
    static constexpr bool PERM = true, AFTER_DRAIN = false;
    bf16_t* YE; const float* gate;
    __device__ __forceinline__ void operator()(const f32x4 (&acc)[2][2][4][2], const Unit& u, int wr, int wc, int fr, int fq) const {
        const int row0 = u.pm * BM + wr * 64 + fr, col0 = u.pn * BM + wc * 32 + 8 * fq;
#pragma unroll
        for (int ai = 0; ai < 2; ++ai)
#pragma unroll
            for (int m = 0; m < 4; ++m) { const int row = row0 + ai * HALF + m * 16; const float gv = gate[row]; bf16_t* rowp = YE + (size_t)row * 1024 + col0;
#pragma unroll
                for (int bj = 0; bj < 2; ++bj) st8(rowp + bj * HALF, acc[ai][bj][m][0] * gv, acc[ai][bj][m][1] * gv); }
    }
};
template <class Epi, class Sched, bool ALIGN_EPI = false, bool SP2 = false>
__device__ __forceinline__ void gemm_phase(PG8_LAS unsigned char* lds, const Gemm g, const Sched& S, const Epi& E) {
    const int tid = threadIdx.x, wid = __builtin_amdgcn_readfirstlane(tid >> 6), lane = tid & 63, wr = wid >> 2, wc = wid & 3, fr = lane & 15, fq = lane >> 4;
    const int K = g.K, nt = K / BK;
    unsigned voffA[2], voffB[2];
#pragma unroll
    for (int i = 0; i < 2; ++i) { int R, C; stage_rc(tid * 16 + i * 8192, R, C); const int Rb = Epi::PERM ? ((R & ~31) + perm32(R & 31)) : R;
        voffA[i] = (unsigned)(R * K + C) * 2u; voffB[i] = (unsigned)(Rb * K + C) * 2u; }
    const size_t kstep = (size_t)(BK * 2);
    const size_t hstep = (size_t)HALF * K * 2;
    const size_t tstep = 2 * hstep;
    const unsigned ldsw = (unsigned)wid * 1024u;
    const int aoff = lds_byte(wr * 64 + fr, fq * 8), boff = lds_byte(wc * 32 + fr, fq * 8);
#define PG8_SA(b, h) (((b) * 2 + (h)) * HTB)
#define PG8_SB(b, h) ((4 + (b) * 2 + (h)) * HTB)
#define PG8_STAGE(bufoff, gbase, voff) do { _Pragma("unroll") for (int _i = 0; _i < 2; ++_i) \
        __builtin_amdgcn_global_load_lds((const unsigned*)((const char*)(gbase) + (voff)[_i]), (PG8_LAS unsigned*)(lds + (bufoff) + ldsw + _i * 8192), 16, 0, 0); } while (0)
#define PG8_LDA(dst, b, h) do { _Pragma("unroll") for (int m = 0; m < 4; ++m) _Pragma("unroll") for (int k = 0; k < 2; ++k) dst[m][k] = *(const PG8_LAS bf16x8*)(lds + PG8_SA(b, h) + aoff + m * 2048 + k * 1024); } while (0)
#define PG8_LDB(dst, b, h) do { _Pragma("unroll") for (int n = 0; n < 2; ++n) _Pragma("unroll") for (int k = 0; k < 2; ++k) dst[n][k] = *(const PG8_LAS bf16x8*)(lds + PG8_SB(b, h) + boff + n * 2048 + k * 1024); } while (0)
#define PG8_MMA(ai, bj, At, Bt) do { __builtin_amdgcn_s_setprio(1); _Pragma("unroll") for (int m = 0; m < 4; ++m) _Pragma("unroll") for (int n = 0; n < 2; ++n) _Pragma("unroll") for (int k = 0; k < 2; ++k) \
        acc[ai][bj][m][n] = __builtin_amdgcn_mfma_f32_16x16x32_bf16(Bt[n][k], At[m][k], acc[ai][bj][m][n], 0, 0, 0); __builtin_amdgcn_s_setprio(0); } while (0)
#define PG8_WAIT_V(n) asm volatile("s_waitcnt vmcnt(" #n ")" ::: "memory")
#define PG8_WAIT_L(n) asm volatile("s_waitcnt lgkmcnt(" #n ")" ::: "memory")
#define PG8_BAR __builtin_amdgcn_s_barrier()
#define PG8_SCHED __builtin_amdgcn_sched_barrier(0)
    Unit cur, nxt; int ui = 0;
    if (!S.next(0, cur)) return;
    f32x4 acc[2][2][4][2];
#pragma unroll
    for (int a = 0; a < 2; ++a)
#pragma unroll
        for (int b = 0; b < 2; ++b)
#pragma unroll
            for (int m = 0; m < 4; ++m)
#pragma unroll
                for (int n = 0; n < 2; ++n) acc[a][b][m][n] = (f32x4){0.f, 0.f, 0.f, 0.f};
    bf16x8 At[4][2], B0[2][2], B1[2][2];
    const char* cA = (const char*)g.A + (size_t)cur.pm * tstep; const char* cB = (const char*)g.Bt + (size_t)((cur.pm >> g.gsh) & g.gmask) * g.bgs + (size_t)cur.pn * tstep;
    S.a_ready(cur);
    if constexpr (SP2) {
        PG8_STAGE(PG8_SB(0, 0), cB, voffB); PG8_STAGE(PG8_SB(0, 1), cB + hstep, voffB); PG8_STAGE(PG8_SA(0, 0), cA, voffA); PG8_STAGE(PG8_SA(0, 1), cA + hstep, voffA);
        if (wr == 1) PG8_BAR;
        PG8_WAIT_V(2); PG8_BAR;
        PG8_STAGE(PG8_SB(1, 0), cB + kstep, voffB); PG8_STAGE(PG8_SA(1, 0), cA + kstep, voffA); PG8_STAGE(PG8_SB(1, 1), cB + hstep + kstep, voffB);
        PG8_WAIT_V(6); PG8_BAR;
    } else {
        PG8_STAGE(PG8_SB(0, 0), cB, voffB); PG8_STAGE(PG8_SA(0, 0), cA, voffA); PG8_STAGE(PG8_SB(0, 1), cB + hstep, voffB); PG8_STAGE(PG8_SA(0, 1), cA + hstep, voffA);
        if (wr == 1) PG8_BAR;
        PG8_WAIT_V(4); PG8_BAR;
        PG8_STAGE(PG8_SB(1, 0), cB + kstep, voffB); PG8_STAGE(PG8_SA(1, 0), cA + kstep, voffA); PG8_STAGE(PG8_SB(1, 1), cB + hstep + kstep, voffB);
        PG8_WAIT_V(6); PG8_BAR;
    }
    for (;;) {
        const bool has_next = S.next(ui + 1, nxt);
        const char* nA = has_next ? (const char*)g.A + (size_t)nxt.pm * tstep : cA; const char* nB = has_next ? (const char*)g.Bt + (size_t)((nxt.pm >> g.gsh) & g.gmask) * g.bgs + (size_t)nxt.pn * tstep : cB;
        for (int t = 0; t < nt; t += 2) {
            const bool last = (t == nt - 2);
            const char* a1 = cA + (size_t)(t + 1) * kstep;
            const char* a2 = last ? nA : cA + (size_t)(t + 2) * kstep; const char* b2 = last ? nB : cB + (size_t)(t + 2) * kstep;
            const char* a3 = a2 + kstep; const char* b3 = b2 + kstep;
            if (last && has_next) S.a_ready(nxt);
            if constexpr (SP2) {
            PG8_LDB(B0, 0, 0); PG8_LDB(B1, 0, 1); PG8_SCHED; PG8_LDA(At, 0, 0); PG8_STAGE(PG8_SA(1, 1), a1 + hstep, voffA);
            PG8_WAIT_V(8); PG8_WAIT_L(0); PG8_BAR; PG8_MMA(0, 0, At, B0); PG8_MMA(0, 1, At, B1); PG8_BAR; PG8_SCHED;
            PG8_LDA(At, 0, 1); PG8_STAGE(PG8_SB(0, 0), b2, voffB); PG8_STAGE(PG8_SB(0, 1), b2 + hstep, voffB); PG8_STAGE(PG8_SA(0, 0), a2, voffA);
            PG8_WAIT_V(8); PG8_WAIT_L(0); PG8_BAR; PG8_MMA(1, 0, At, B0); PG8_MMA(1, 1, At, B1); PG8_BAR; PG8_SCHED;
            PG8_LDB(B0, 1, 0); PG8_LDB(B1, 1, 1); PG8_SCHED; PG8_LDA(At, 1, 0); PG8_STAGE(PG8_SA(0, 1), a2 + hstep, voffA);
            PG8_WAIT_V(8); PG8_WAIT_L(0); PG8_BAR; PG8_MMA(0, 0, At, B0); PG8_MMA(0, 1, At, B1); PG8_BAR; PG8_SCHED;
            PG8_LDA(At, 1, 1); PG8_STAGE(PG8_SB(1, 0), b3, voffB); PG8_STAGE(PG8_SB(1, 1), b3 + hstep, voffB); PG8_STAGE(PG8_SA(1, 0), a3, voffA);
            PG8_WAIT_V(8); PG8_WAIT_L(0); PG8_BAR; PG8_MMA(1, 0, At, B0); PG8_MMA(1, 1, At, B1); PG8_BAR; PG8_SCHED;
            } else {
            PG8_LDB(B0, 0, 0); PG8_SCHED; PG8_LDA(At, 0, 0); PG8_STAGE(PG8_SA(1, 1), a1 + hstep, voffA);
            PG8_WAIT_L(8); PG8_BAR; PG8_WAIT_L(0); PG8_MMA(0, 0, At, B0); PG8_BAR; PG8_SCHED;
            PG8_LDB(B1, 0, 1); PG8_STAGE(PG8_SB(0, 0), b2, voffB);
            PG8_BAR; PG8_WAIT_L(0); PG8_MMA(0, 1, At, B1); PG8_BAR;
            PG8_LDA(At, 0, 1); PG8_STAGE(PG8_SA(0, 0), a2, voffA);
            PG8_BAR; PG8_WAIT_L(0); PG8_MMA(1, 0, At, B0); PG8_BAR; PG8_SCHED;
            PG8_STAGE(PG8_SB(0, 1), b2 + hstep, voffB);
            PG8_WAIT_V(6); PG8_BAR; PG8_MMA(1, 1, At, B1); PG8_BAR;
            PG8_LDB(B0, 1, 0); PG8_SCHED; PG8_LDA(At, 1, 0); PG8_STAGE(PG8_SA(0, 1), a2 + hstep, voffA);
            PG8_WAIT_L(8); PG8_BAR; PG8_WAIT_L(0); PG8_MMA(0, 0, At, B0); PG8_BAR; PG8_SCHED;
            PG8_LDB(B1, 1, 1); PG8_STAGE(PG8_SB(1, 0), b3, voffB);
            PG8_BAR; PG8_WAIT_L(0); PG8_MMA(0, 1, At, B1); PG8_BAR;
            PG8_LDA(At, 1, 1); PG8_STAGE(PG8_SA(1, 0), a3, voffA);
            PG8_BAR; PG8_WAIT_L(0); PG8_MMA(1, 0, At, B0); PG8_BAR; PG8_SCHED;
            PG8_STAGE(PG8_SB(1, 1), b3 + hstep, voffB);
            PG8_WAIT_V(6); PG8_BAR; PG8_MMA(1, 1, At, B1); PG8_BAR;
            }
        }
        if constexpr (ALIGN_EPI) { if (wr == 0) PG8_BAR; }
        if constexpr (!Epi::AFTER_DRAIN) { E(acc, cur, wr, wc, fr, fq); S.done(cur); }
        if (!has_next) break;
#pragma unroll
        for (int a = 0; a < 2; ++a)
#pragma unroll
            for (int b = 0; b < 2; ++b)
#pragma unroll
                for (int m = 0; m < 4; ++m)
#pragma unroll
                    for (int n = 0; n < 2; ++n) acc[a][b][m][n] = (f32x4){0.f, 0.f, 0.f, 0.f};
        cur = nxt; cA = nA; cB = nB; ++ui;
        if constexpr (ALIGN_EPI) { if (wr == 1) PG8_BAR; }
    }
    PG8_WAIT_V(0);
    if constexpr (!ALIGN_EPI) { if (wr == 0) PG8_BAR; }
    PG8_BAR;
    if constexpr (Epi::AFTER_DRAIN) { E.fused(acc, cur, wr, wc, fr, fq, lds, wid, lane); S.done(cur); }
#undef PG8_SA
#undef PG8_SB
#undef PG8_STAGE
#undef PG8_LDA
#undef PG8_LDB
#undef PG8_MMA
#undef PG8_WAIT_V
#undef PG8_WAIT_L
#undef PG8_BAR
#undef PG8_SCHED
}
}
#ifndef PG8_SP2
#define PG8_SP2 true
#endif
#ifndef PG8_ALIGN
#define PG8_ALIGN true
#endif
constexpr int NWAVES = 8;
#ifndef MK_PER_PHASE
#define MK_PER_PHASE 0
#endif
constexpr int NPHASE = 14;
constexpr int BATCH = 2, T = 8192, D = 1024, TC = 256, M = BATCH * T, MC = BATCH * TC, MA = M + MC;
constexpr int NEXP = 16, CAP = 1024, FF = 1024;
constexpr float EPS = 1e-6f;
constexpr size_t MiB = 1u << 20;
constexpr size_t WS_CTL = 0, CTL_ZERO_BYTES = 1 * MiB;
constexpr size_t WS_MOD = 1 * MiB;
constexpr size_t WS_EGL = 1 * MiB + 128 * 1024;
constexpr size_t WS_IDX = 1 * MiB + 512 * 1024;
constexpr size_t WS_GATE = WS_IDX + 128 * 1024;
constexpr size_t WS_AFF = 2 * MiB;
constexpr size_t WS_SEL = 3 * MiB;
constexpr size_t WS_WIN = 4 * MiB;
constexpr size_t WS_WOUT = 11 * MiB;
constexpr size_t WS_AIN = 13 * MiB;
constexpr size_t WS_MIX = 13 * MiB;
constexpr size_t WS_FIN = 13 * MiB;
constexpr size_t WS_QKV = 46 * MiB;
constexpr size_t WS_OF = 46 * MiB, WS_OB = 62 * MiB;
constexpr size_t WS_Z = 96 * MiB;
constexpr size_t WS_UV = 112 * MiB;
constexpr size_t WS_AB = 144 * MiB;
constexpr size_t WS_GDN = 146 * MiB;
constexpr size_t GDN_UNIT = 73728;
constexpr size_t WS_WGU = 132 * MiB;
constexpr size_t WS_H1 = 232 * MiB;
constexpr size_t WS_XE = 68 * MiB;
constexpr size_t WS_HID = 4 * MiB;
constexpr size_t WS_WD = 68 * MiB;
constexpr size_t WS_YE = 132 * MiB;
constexpr size_t WS_END = 296 * MiB;
static_assert(WS_GDN + 2112 * GDN_UNIT <= WS_END && WS_AB + (size_t)MA * 64 <= WS_GDN && WS_QKV + (size_t)MA * 3072 <= WS_Z, "ws map");
constexpr int CW_BAR = 4096;
constexpr int LDS_BYTES = 155648;
constexpr int MISC_OFF = LDS_BYTES - 256;
#define LAS __attribute__((address_space(3)))
typedef unsigned short bf16;
typedef unsigned v4u __attribute__((ext_vector_type(4)));
typedef unsigned v2u __attribute__((ext_vector_type(2)));
typedef float f32x4 __attribute__((ext_vector_type(4)));
typedef short bf16x8 __attribute__((ext_vector_type(8)));
#define LDS_WAIT() asm volatile("s_waitcnt lgkmcnt(0)" ::: "memory")
#define VM_WAIT() asm volatile("s_waitcnt vmcnt(0)" ::: "memory")
__device__ __forceinline__ unsigned f2bf(float f) { unsigned u = __builtin_bit_cast(unsigned, f); return (u + 0x7fffu + ((u >> 16) & 1u)) >> 16; }
__device__ __forceinline__ unsigned pk2(float lo, float hi) { return f2bf(lo) | (f2bf(hi) << 16); }
__device__ __forceinline__ float bflo(unsigned w) { return __builtin_bit_cast(float, w << 16); }
__device__ __forceinline__ float bfhi(unsigned w) { return __builtin_bit_cast(float, w & 0xffff0000u); }
__device__ __forceinline__ float bf1(bf16 h) { return __builtin_bit_cast(float, (unsigned)h << 16); }
__device__ __forceinline__ float wave_sum(float v) {
#pragma unroll
    for (int o = 1; o < 64; o <<= 1) v += __shfl_xor(v, o);
    return v;
}
__device__ __forceinline__ float silu1(float x) { return x / (1.0f + __expf(-x)); }

#define XB_TMO      128
#define XB_XCNT(j)  (256  + 64 * (j))
#define XB_XSUB(j)  (1280 + 64 * (j))
#define XB_XGEN(j)  (2304 + 64 * (j))
#define XB_TOP      3328
#define XB_TOPGEN   3392
#define XCD_BAR_WORDS 3456
#define XB_SPIN_CAP (1u << 18)
__device__ __forceinline__ unsigned xb_ld(unsigned* p)              { return __hip_atomic_load(p, __ATOMIC_RELAXED, __HIP_MEMORY_SCOPE_AGENT); }
__device__ __forceinline__ unsigned xb_add(unsigned* p, unsigned v) { return __hip_atomic_fetch_add(p, v, __ATOMIC_RELAXED, __HIP_MEMORY_SCOPE_AGENT); }
__device__ __forceinline__ unsigned xb_xcc_id() { return (unsigned)__builtin_amdgcn_s_getreg((3 << 11) | 20) & 0xFu; }
#define XB_SPIN(cond, bar) do { unsigned _sp = 0; while (cond) { __builtin_amdgcn_s_sleep(1); \
    if ((++_sp & 255u) == 0u) { if (xb_ld(&(bar)[XB_TMO])) break; if (_sp > XB_SPIN_CAP) { atomicAdd(&(bar)[XB_TMO], 1u); break; } } } } while (0)
struct XcdBarrier { unsigned* bar; unsigned x; volatile LAS unsigned* st; };
__device__ __forceinline__ XcdBarrier xcd_barrier_post(unsigned* bar, volatile LAS unsigned* st) {
    XcdBarrier b; b.bar = bar; b.x = xb_xcc_id(); b.st = st;
    if (threadIdx.x == 0) (void)xb_add(&bar[XB_XCNT(b.x)], 1u);
    return b;
}
__device__ __forceinline__ void xcd_barrier_complete(unsigned* bar, unsigned x, unsigned& nloc, unsigned& nx) {
    const unsigned G = gridDim.x * gridDim.y * gridDim.z;
    unsigned sum, cnt, mine, sp = 0u;
    for (;;) {
        sum = 0u; cnt = 0u; mine = 0u;
#pragma unroll
        for (unsigned j = 0; j < 16; ++j) { const unsigned c = xb_ld(&bar[XB_XCNT(j)]); sum += c; cnt += (c > 0u) ? 1u : 0u; mine = (j == x) ? c : mine; }
        if (sum == G) break;
        __builtin_amdgcn_s_sleep(1);
        if ((++sp & 255u) == 0u) { if (xb_ld(&bar[XB_TMO])) break; if (sp > XB_SPIN_CAP) { atomicAdd(&bar[XB_TMO], 1u); break; } }
    }
    nloc = mine > 0u ? mine : 1u; nx = cnt > 0u ? cnt : 1u;
}
__device__ __forceinline__ void xcd_barrier(const XcdBarrier& b) {
    asm volatile("s_waitcnt vmcnt(0)" ::: "memory");
    __syncthreads();
    if (threadIdx.x == 0) {
        unsigned* bar = b.bar;
        __builtin_amdgcn_s_waitcnt(0);
        unsigned nloc = b.st[0], nx = b.st[1];
        if (nloc == 0u) { xcd_barrier_complete(bar, b.x, nloc, nx); b.st[0] = nloc; b.st[1] = nx; }
        const unsigned old = xb_add(&bar[XB_XSUB(b.x)], 1u);
        const unsigned gen = old / nloc;
        if (old + 1u == (gen + 1u) * nloc) {
            __builtin_amdgcn_fence(__ATOMIC_RELEASE, "agent");
            asm volatile("s_waitcnt vmcnt(0)" ::: "memory");
            const unsigned og = xb_add(&bar[XB_TOP], 1u);
            const unsigned tg = og / nx;
            if (og + 1u == (tg + 1u) * nx) xb_add(&bar[XB_TOPGEN], 1u);
            else XB_SPIN(xb_ld(&bar[XB_TOPGEN]) == tg, bar);
            __builtin_amdgcn_fence(__ATOMIC_ACQUIRE, "agent");
            xb_add(&bar[XB_XGEN(b.x)], 1u);
            asm volatile("s_waitcnt vmcnt(0)" ::: "memory");
        } else {
            XB_SPIN(xb_ld(&bar[XB_XGEN(b.x)]) == gen, bar);
            __builtin_amdgcn_fence(__ATOMIC_ACQUIRE, "agent");
            asm volatile("s_waitcnt vmcnt(0)" ::: "memory");
        }
    }
    __syncthreads();
}

struct Frame {
    LAS unsigned char* lds;
    int tid, lane, wave, vcu, G;
    unsigned char* ws;
    const float *x, *c, *ctx, *c_ctx, *w_mod, *b_mod, *norm1_g, *norm2_g, *w_in, *conv_w, *a_log, *dt_bias, *gdn_norm_g, *gm_norm_g, *gm_ws, *gm_bs, *w_out, *w_router, *b_router, *w_gate, *w_up, *w_down, *final_norm_g;
    float* out;
};
__device__ __forceinline__ f32x4 mma_tile(const LAS bf16* A, int lda, int r0, const LAS bf16* Bt, int ldb, int c0, int K, f32x4 acc, int lane) {
    const int fr = lane & 15, fq = lane >> 4;
    const LAS bf16* ap = A + (r0 + fr) * lda + 8 * fq; const LAS bf16* bp = Bt + (c0 + fr) * ldb + 8 * fq;
#pragma unroll 4
    for (int k0 = 0; k0 < K; k0 += 32) { const bf16x8 a = *(const LAS bf16x8*)(ap + k0), b = *(const LAS bf16x8*)(bp + k0); acc = __builtin_amdgcn_mfma_f32_16x16x32_bf16(a, b, acc, 0, 0, 0); }
    return acc;
}
__device__ __forceinline__ void transpose_item(const float* W, int ldw, int src_col0, int k0, bf16* WT, int Kp, int dst_row0, LAS float* scr, int lane) {
#pragma unroll 8
    for (int i = 0; i < 32; ++i) { const int kk = 2 * i + (lane >> 5); scr[kk * 33 + (lane & 31)] = W[(size_t)(k0 + kk) * ldw + src_col0 + (lane & 31)]; }
    LDS_WAIT(); asm volatile("" ::: "memory");
    const int c = lane & 7;
#pragma unroll
    for (int j = 0; j < 4; ++j) { const int n = (lane >> 3) + 8 * j; const LAS float* s = scr + (8 * c) * 33 + n;
        v4u o; o.x = pk2(s[0 * 33], s[1 * 33]); o.y = pk2(s[2 * 33], s[3 * 33]); o.z = pk2(s[4 * 33], s[5 * 33]); o.w = pk2(s[6 * 33], s[7 * 33]);
        *(v4u*)(WT + (size_t)(dst_row0 + n) * Kp + k0 + 8 * c) = o; }
    LDS_WAIT(); asm volatile("" ::: "memory");
}
__device__ __forceinline__ void p0_phase(Frame& F) {
    float* MOD = (float*)(F.ws + WS_MOD);
    if (F.vcu < 96) {
        LAS float* sv = (LAS float*)F.lds;
        LAS float* red = sv + 3072;
        for (int i = F.tid; i < 3072; i += 512) { const int v = i >> 10, k = i & 1023; const float s = v < 2 ? F.c[v * 1024 + k] : F.c_ctx[k]; sv[i] = silu1(s); }
        __syncthreads();
        for (int item = F.vcu; item < 96; item += F.G) {
            const int kq = F.tid >> 4, cq = F.tid & 15, col = item * 64 + cq * 4;
            f32x4 a0 = {0.f, 0.f, 0.f, 0.f}, a1 = a0, a2 = a0;
#pragma unroll 8
            for (int kk = 0; kk < 32; ++kk) { const int k = kq * 32 + kk; const f32x4 w = *(const f32x4*)(F.w_mod + (size_t)k * 6144 + col); a0 += sv[k] * w; a1 += sv[1024 + k] * w; a2 += sv[2048 + k] * w; }
            *(LAS f32x4*)(red + (kq * 3 + 0) * 64 + cq * 4) = a0; *(LAS f32x4*)(red + (kq * 3 + 1) * 64 + cq * 4) = a1; *(LAS f32x4*)(red + (kq * 3 + 2) * 64 + cq * 4) = a2;
            __syncthreads();
            if (F.tid < 192) { const int v = F.tid >> 6, cc = F.tid & 63; float s = F.b_mod[item * 64 + cc];
                for (int q = 0; q < 32; ++q) s += red[(q * 3 + v) * 64 + cc];
                MOD[v * 6144 + item * 64 + cc] = s; }
            __syncthreads();
        }
    }
    __syncthreads();
    LAS float* scr = (LAS float*)(F.lds + F.wave * 16384);
    const int gw = F.vcu * NWAVES + F.wave, NGW = F.G * NWAVES;
    bf16* WIN = (bf16*)(F.ws + WS_WIN); bf16* WOUT = (bf16*)(F.ws + WS_WOUT);
    constexpr int I_IN = 97 * 16, I_OUT = 32 * 16;
    for (int it = gw; it < I_IN + I_OUT; it += NGW) {
        if (it < I_IN) { const int blk = it >> 4, kb = it & 15;
            const int src = blk < 48 ? 32 * blk : (blk < 64 ? 1552 + 32 * (blk - 48) : (blk < 96 ? 2064 + 32 * (blk - 64) : 1536));
            transpose_item(F.w_in, 3088, src, kb * 64, WIN, 1024, blk * 32, scr, F.lane); }
        else { const int r = it - I_IN, blk = r >> 4, kb = r & 15; transpose_item(F.w_out, 1024, blk * 32, kb * 64, WOUT, 1024, blk * 32, scr, F.lane); }
    }
}
__device__ __forceinline__ void wgu_convert(Frame& F) {
    LAS float* scr = (LAS float*)(F.lds + F.wave * 16384);
    const int gw = F.vcu * NWAVES + F.wave, NGW = F.G * NWAVES;
    bf16* WGU = (bf16*)(F.ws + WS_WGU);
    for (int it = gw; it < 16 * 2 * 512; it += NGW) {
        const int kb = it & 15, fb = (it >> 4) & 31, mat = (it >> 9) & 1, e = it >> 10;
        const float* W = (mat ? F.w_up : F.w_gate) + (size_t)e * 1024 * 1024;
        const int f0 = fb * 32, pn = f0 >> 7, dst = 256 * pn + (mat ? 128 : 0) + (f0 & 127);
        transpose_item(W, 1024, f0, kb * 64, WGU + (size_t)e * 2048 * 1024, 1024, dst, scr, F.lane);
    }
}
__device__ __forceinline__ void wd_convert(Frame& F) {
    LAS float* scr = (LAS float*)(F.lds + F.wave * 16384);
    const int gw = F.vcu * NWAVES + F.wave, NGW = F.G * NWAVES;
    bf16* WD = (bf16*)(F.ws + WS_WD);
    for (int it = gw; it < 16 * 512; it += NGW) { const int kb = it & 15, nb = (it >> 4) & 31, e = it >> 9;
        transpose_item(F.w_down + (size_t)e * 1024 * 1024, 1024, nb * 32, kb * 64, WD + (size_t)e * 1024 * 1024, 1024, nb * 32, scr, F.lane); }
}
__device__ __forceinline__ void p1_phase(Frame& F) {
    const float* MOD = (const float*)(F.ws + WS_MOD); bf16* AIN = (bf16*)(F.ws + WS_AIN);
    const int gw = F.vcu * NWAVES + F.wave, NGW = F.G * NWAVES;
#pragma unroll 1
    for (int seg = 0; seg < 3; ++seg) {
        const int r_lo = seg < 2 ? seg * T : M, r_hi = seg < 2 ? (seg + 1) * T : MA;
        const float* mv = MOD + seg * 6144;
        f32x4 sc[4], sh[4];
#pragma unroll
        for (int j = 0; j < 4; ++j) { const int k = 4 * F.lane + 256 * j; const f32x4 g = *(const f32x4*)(F.norm1_g + k), s1 = *(const f32x4*)(mv + 1024 + k); sc[j] = g * (1.0f + s1); sh[j] = *(const f32x4*)(mv + k); }
        for (int m = r_lo + gw; m < r_hi; m += NGW) {
            const float* xr = seg < 2 ? F.x + (size_t)m * D : F.ctx + (size_t)(m - M) * D;
            f32x4 v[4]; float ss = 0.f;
#pragma unroll
            for (int j = 0; j < 4; ++j) { v[j] = *(const f32x4*)(xr + 4 * F.lane + 256 * j); ss += (v[j].x * v[j].x + v[j].y * v[j].y) + (v[j].z * v[j].z + v[j].w * v[j].w); }
            const float rstd = 1.0f / sqrtf(wave_sum(ss) * (1.0f / D) + EPS);
            bf16* orow = AIN + (size_t)m * D;
#pragma unroll
            for (int j = 0; j < 4; ++j) { const f32x4 a = v[j] * rstd * sc[j] + sh[j]; v2u o; o.x = pk2(a.x, a.y); o.y = pk2(a.z, a.w); *(v2u*)(orow + 4 * F.lane + 256 * j) = o; }
        }
    }
}
__device__ __forceinline__ void gdn_item(Frame& F, int it) {
    int b, n, h, L, slot; size_t row_base;
    if (it < 1024) { b = it >> 9; n = (it >> 2) & 127; h = it & 3; L = T; row_base = (size_t)b * T; slot = (b * 4 + h) * 128 + n; }
    else { const int j = it - 1024; b = j >> 4; n = (j >> 2) & 3; h = j & 3; L = TC; row_base = (size_t)M + (size_t)b * TC; slot = 1024 + (b * 4 + h) * 4 + n; }
    const bf16* QKV = (const bf16*)(F.ws + WS_QKV); const float* AB = (const float*)(F.ws + WS_AB);
    LAS bf16* QB = (LAS bf16*)(F.lds); LAS bf16* KB = (LAS bf16*)(F.lds + 17408); LAS bf16* VB = (LAS bf16*)(F.lds + 34816);
    LAS float* KK = (LAS float*)(F.lds + 52224); LAS float* QK = (LAS float*)(F.lds + 68864);
    LAS float* AF = (LAS float*)(F.lds + 85504); LAS bf16* VBT = (LAS bf16*)(F.lds + 85504); LAS bf16* KBGT = (LAS bf16*)(F.lds + 85504 + 18432);
    LAS bf16* TB = (LAS bf16*)(F.lds + 122368); LAS float* GC = (LAS float*)(F.lds + 140800); LAS float* BT = (LAS float*)(F.lds + 141312);
    LAS float* EG1 = (LAS float*)(F.lds + 141824); LAS float* EG2 = (LAS float*)(F.lds + 142336); LAS bf16* A10B = (LAS bf16*)(F.lds + 142848);
    const int tid = F.tid, lane = F.lane, wave = F.wave;
    {
        const int r = tid >> 3, part = tid & 7, t = 64 * n + r; const bool hasp = t > 0, hasn = t + 1 < L;
        const bf16* prow = QKV + (row_base + t) * 1536;
#pragma unroll
        for (int s = 0; s < 3; ++s) {
            const int col = s * 512 + h * 128 + part * 16; const bf16* pc = prow + col;
            v4u cc[2], pp[2], nn[2];
            cc[0] = *(const v4u*)pc; cc[1] = *(const v4u*)(pc + 8);
            pp[0] = pp[1] = nn[0] = nn[1] = (v4u){0u, 0u, 0u, 0u};
            if (hasp) { pp[0] = *(const v4u*)(pc - 1536); pp[1] = *(const v4u*)(pc - 1536 + 8); }
            if (hasn) { nn[0] = *(const v4u*)(pc + 1536); nn[1] = *(const v4u*)(pc + 1536 + 8); }
            float y[16]; float ss = 0.f;
#pragma unroll
            for (int q = 0; q < 4; ++q) { const f32x4 w0 = *(const f32x4*)(F.conv_w + col + 4 * q), w1 = *(const f32x4*)(F.conv_w + 1536 + col + 4 * q), w2 = *(const f32x4*)(F.conv_w + 3072 + col + 4 * q);
#pragma unroll
                for (int e = 0; e < 2; ++e) { const unsigned cw = cc[q >> 1][(q & 1) * 2 + e], pw = pp[q >> 1][(q & 1) * 2 + e], nw = nn[q >> 1][(q & 1) * 2 + e];
                    const float a0 = w0[2 * e] * bflo(pw) + w1[2 * e] * bflo(cw) + w2[2 * e] * bflo(nw), a1 = w0[2 * e + 1] * bfhi(pw) + w1[2 * e + 1] * bfhi(cw) + w2[2 * e + 1] * bfhi(nw);
                    const float y0 = silu1(a0), y1 = silu1(a1); y[4 * q + 2 * e] = y0; y[4 * q + 2 * e + 1] = y1; ss += y0 * y0 + y1 * y1; } }
            float sc = 1.0f;
            if (s < 2) { ss += __shfl_xor(ss, 1); ss += __shfl_xor(ss, 2); ss += __shfl_xor(ss, 4); sc = (1.0f / sqrtf(ss + EPS)) * (s == 0 ? 0.08838834764831845f : 1.0f); }
            LAS bf16* dst = (s == 0 ? QB : (s == 1 ? KB : VB)) + r * 136 + part * 16;
            v4u o0, o1;
            o0.x = pk2(y[0] * sc, y[1] * sc); o0.y = pk2(y[2] * sc, y[3] * sc); o0.z = pk2(y[4] * sc, y[5] * sc); o0.w = pk2(y[6] * sc, y[7] * sc);
            o1.x = pk2(y[8] * sc, y[9] * sc); o1.y = pk2(y[10] * sc, y[11] * sc); o1.z = pk2(y[12] * sc, y[13] * sc); o1.w = pk2(y[14] * sc, y[15] * sc);
            *(LAS v4u*)dst = o0; *(LAS v4u*)(dst + 8) = o1;
        }
        if (wave < 2) { const int d = wave, i = lane, tl = d ? 63 - i : i; const float* abr = AB + (row_base + 64 * n + tl) * 16;
            const float a = abr[d * 4 + h], bb = abr[8 + d * 4 + h];
            const float xx = a + F.dt_bias[d * 4 + h]; const float sp = fmaxf(xx, 0.f) + log1pf(expf(-fabsf(xx)));
            float g = -expf(F.a_log[d * 4 + h]) * sp;
#pragma unroll
            for (int o = 1; o < 64; o <<= 1) { const float yv = __shfl_up(g, o); if (i >= o) g += yv; }
            GC[d * 64 + i] = g; BT[d * 64 + i] = 1.0f / (1.0f + expf(-bb)); const float gl = __shfl(g, 63); EG1[d * 64 + i] = __expf(g); EG2[d * 64 + i] = __expf(gl - g); }
    }
    __syncthreads();
    {
        const int mat = wave >> 2, tr = wave & 3, fr = lane & 15, fq = lane >> 4;
#pragma unroll
        for (int tc = 0; tc < 4; ++tc) { f32x4 acc = {0.f, 0.f, 0.f, 0.f}; acc = mma_tile(mat ? QB : KB, 136, 16 * tr, KB, 136, 16 * tc, 128, acc, lane);
            LAS float* dst = (mat ? QK : KK) + (16 * tr + 4 * fq) * 65 + 16 * tc + fr;
#pragma unroll
            for (int j = 0; j < 4; ++j) dst[j * 65] = acc[j]; }
    }
    __syncthreads();
    for (int idx = tid; idx < 8192; idx += 512) { const int d = idx >> 12, i = (idx >> 6) & 63, j = idx & 63; const int ti = d ? 63 - i : i, tj = d ? 63 - j : j;
        const float av = (i > j) ? BT[d * 64 + i] * KK[ti * 65 + tj] * __expf(GC[d * 64 + i] - GC[d * 64 + j]) : 0.f; AF[idx] = av;
        if (i >= 32 && j < 32) A10B[d * 1280 + (i - 32) * 40 + j] = (bf16)f2bf(av); }
    __syncthreads();
    unsigned char* gout = F.ws + WS_GDN + (size_t)slot * 2 * GDN_UNIT;
    if (wave < 2) {
        const int d = wave, blk = lane >> 5, jc = lane & 31; const LAS float* A = AF + d * 4096 + (blk * 32) * 64 + blk * 32; LAS bf16* TBd = TB + d * 4608;
        float Tc[32];
#pragma unroll
        for (int i = 0; i < 32; ++i) { float s0 = (i == jc) ? 1.f : 0.f, s1 = 0.f, s2 = 0.f, s3 = 0.f;
#pragma unroll
            for (int j = 0; j < i; ++j) { const float a = A[i * 64 + j]; if ((j & 3) == 0) s0 -= a * Tc[j]; else if ((j & 3) == 1) s1 -= a * Tc[j]; else if ((j & 3) == 2) s2 -= a * Tc[j]; else s3 -= a * Tc[j]; }
            Tc[i] = (s0 + s1) + (s2 + s3); TBd[(blk * 32 + i) * 72 + blk * 32 + jc] = (bf16)f2bf(Tc[i]);
            if (blk) TBd[i * 72 + 32 + jc] = (bf16)0; }
        LAS bf16* DT0 = (LAS bf16*)(AF + d * 4096); LAS bf16* PT = DT0 + 1280;
        if (!blk) {
#pragma unroll
            for (int q = 0; q < 4; ++q) { v4u o; o.x = pk2(Tc[8 * q], Tc[8 * q + 1]); o.y = pk2(Tc[8 * q + 2], Tc[8 * q + 3]); o.z = pk2(Tc[8 * q + 4], Tc[8 * q + 5]); o.w = pk2(Tc[8 * q + 6], Tc[8 * q + 7]); *(LAS v4u*)(DT0 + jc * 40 + 8 * q) = o; } }
        const int fr = lane & 15, fq = lane >> 4;
#pragma unroll
        for (int tl = 0; tl < 4; ++tl) { const int ti = tl >> 1, tj = tl & 1; f32x4 acc = {0.f, 0.f, 0.f, 0.f}; acc = mma_tile(A10B + d * 1280, 40, 16 * ti, DT0, 40, 16 * tj, 32, acc, lane);
            v2u o; o.x = pk2(acc[0], acc[1]); o.y = pk2(acc[2], acc[3]); *(LAS v2u*)(PT + (16 * tj + fr) * 40 + 16 * ti + 4 * fq) = o; }
#pragma unroll
        for (int tl = 0; tl < 4; ++tl) { const int ti = tl >> 1, tj = tl & 1; f32x4 acc = {0.f, 0.f, 0.f, 0.f}; acc = mma_tile(TBd + 32 * 72 + 32, 72, 16 * ti, PT, 40, 16 * tj, 32, acc, lane);
#pragma unroll
            for (int j = 0; j < 4; ++j) TBd[(32 + 16 * ti + 4 * fq + j) * 72 + 16 * tj + fr] = (bf16)f2bf(-acc[j]); }
    } else {
        const int t2 = tid - 128;
        for (int q = t2; q < 2048; q += 384) { const int d = q >> 10, i = (q >> 4) & 63, cg = q & 15, tok = d ? 63 - i : i; const float e = EG1[d * 64 + i];
            const v4u s = *(const LAS v4u*)(QB + tok * 136 + cg * 8); v4u o;
            o.x = pk2(bflo(s.x) * e, bfhi(s.x) * e); o.y = pk2(bflo(s.y) * e, bfhi(s.y) * e); o.z = pk2(bflo(s.z) * e, bfhi(s.z) * e); o.w = pk2(bflo(s.w) * e, bfhi(s.w) * e);
            *(v4u*)(gout + (size_t)d * GDN_UNIT + 16384 + (i * 128 + cg * 8) * 2) = o; }
        for (int q = t2; q < 2048; q += 384) { const int d = q >> 10, c = (q >> 3) & 127, ig = q & 7; float v[8];
#pragma unroll
            for (int ii = 0; ii < 8; ++ii) { const int i = ig * 8 + ii, tok = d ? 63 - i : i; v[ii] = bf1(KB[tok * 136 + c]) * EG2[d * 64 + i]; }
            v4u o; o.x = pk2(v[0], v[1]); o.y = pk2(v[2], v[3]); o.z = pk2(v[4], v[5]); o.w = pk2(v[6], v[7]);
            *(v4u*)(gout + (size_t)d * GDN_UNIT + 32768 + (c * 64 + ig * 8) * 2) = o; }
        for (int q = t2; q < 1024; q += 384) { const int d = q >> 9, i = (q >> 3) & 63, jg = q & 7, ti = d ? 63 - i : i; const float gi = GC[d * 64 + i]; float v[8];
#pragma unroll
            for (int jj = 0; jj < 8; ++jj) { const int j = jg * 8 + jj, tj = d ? 63 - j : j; v[jj] = (i >= j) ? QK[ti * 65 + tj] * __expf(gi - GC[d * 64 + j]) : 0.f; }
            v4u o; o.x = pk2(v[0], v[1]); o.y = pk2(v[2], v[3]); o.z = pk2(v[4], v[5]); o.w = pk2(v[6], v[7]);
            *(v4u*)(gout + (size_t)d * GDN_UNIT + 49152 + (i * 64 + jg * 8) * 2) = o; }
        if (t2 < 2) ((float*)(F.ws + WS_EGL))[slot * 2 + t2] = EG1[t2 * 64 + 63];
    }
    __syncthreads();
#pragma unroll 1
    for (int d = 0; d < 2; ++d) {
        for (int q = tid; q < 2048; q += 512) { const int which = q >> 10, c = (q >> 3) & 127, jg = q & 7; float v[8];
#pragma unroll
            for (int jj = 0; jj < 8; ++jj) { const int j = jg * 8 + jj, tok = d ? 63 - j : j; const float bt = BT[d * 64 + j];
                v[jj] = which ? bf1(KB[tok * 136 + c]) * bt * EG1[d * 64 + j] : bf1(VB[tok * 136 + c]) * bt; }
            v4u o; o.x = pk2(v[0], v[1]); o.y = pk2(v[2], v[3]); o.z = pk2(v[4], v[5]); o.w = pk2(v[6], v[7]);
            *(LAS v4u*)((which ? KBGT : VBT) + c * 72 + jg * 8) = o; }
        __syncthreads();
        const LAS bf16* TBd = TB + d * 4608; unsigned char* go = gout + (size_t)d * GDN_UNIT; const int fr = lane & 15, fq = lane >> 4;
#pragma unroll 1
        for (int q = 0; q < 8; ++q) { const int tile = wave * 8 + q, kind = tile >> 5, ti = (tile >> 3) & 3, tc = tile & 7; f32x4 acc = {0.f, 0.f, 0.f, 0.f};
            if (kind == 0) { acc = mma_tile(TBd, 72, 16 * ti, VBT, 72, 16 * tc, 64, acc, lane);
                v2u o; o.x = pk2(acc[0], acc[1]); o.y = pk2(acc[2], acc[3]); *(v2u*)(go + 57344 + ((16 * tc + fr) * 64 + 16 * ti + 4 * fq) * 2) = o; }
            else { acc = mma_tile(KBGT, 72, 16 * tc, TBd, 72, 16 * ti, 64, acc, lane);
                v2u o; o.x = pk2(acc[0], acc[1]); o.y = pk2(acc[2], acc[3]); *(v2u*)(go + ((16 * ti + fr) * 128 + 16 * tc + 4 * fq) * 2) = o; } }
        __syncthreads();
    }
}
__device__ __forceinline__ void gmlp_item(Frame& F, int it) {
    const int g = it & 3, nc = (it >> 2) & 63, b = it >> 8; const size_t r0 = (size_t)b * T + (size_t)nc * 128;
    const bf16* UV = (const bf16*)(F.ws + WS_UV); bf16* MIX = (bf16*)(F.ws + WS_MIX);
    LAS bf16* VNT = (LAS bf16*)(F.lds); LAS bf16* WSB = (LAS bf16*)(F.lds + 34816);
    const int tid = F.tid, lane = F.lane, wave = F.wave;
    {
        const int t = tid >> 2, part = tid & 3; const bf16* vp = UV + (r0 + t) * 1024 + 512 + 128 * g + part * 32;
        float v[32]; float ss = 0.f;
#pragma unroll
        for (int q = 0; q < 4; ++q) { const v4u xw = *(const v4u*)(vp + 8 * q);
#pragma unroll
            for (int e = 0; e < 4; ++e) { v[8 * q + 2 * e] = bflo(xw[e]); v[8 * q + 2 * e + 1] = bfhi(xw[e]); ss += v[8 * q + 2 * e] * v[8 * q + 2 * e] + v[8 * q + 2 * e + 1] * v[8 * q + 2 * e + 1]; } }
        ss += __shfl_xor(ss, 1); ss += __shfl_xor(ss, 2);
        const float rstd = 1.0f / sqrtf(ss * (1.0f / 128.0f) + EPS); const float* gn = F.gm_norm_g + 128 * g + part * 32;
#pragma unroll
        for (int cc = 0; cc < 32; ++cc) VNT[(part * 32 + cc) * 136 + t] = (bf16)f2bf(v[cc] * rstd * gn[cc]);
        const float* wp = F.gm_ws + ((size_t)g * 128 + t) * 128 + part * 32;
#pragma unroll
        for (int q = 0; q < 4; ++q) { const f32x4 w0 = *(const f32x4*)(wp + 8 * q), w1 = *(const f32x4*)(wp + 8 * q + 4); v4u o; o.x = pk2(w0.x, w0.y); o.y = pk2(w0.z, w0.w); o.z = pk2(w1.x, w1.y); o.w = pk2(w1.z, w1.w);
            *(LAS v4u*)(WSB + t * 136 + part * 32 + 8 * q) = o; }
    }
    __syncthreads();
    {
        const int td = wave, fr = lane & 15, fq = lane >> 4;
#pragma unroll 1
        for (int tt = 0; tt < 8; ++tt) { f32x4 acc = {0.f, 0.f, 0.f, 0.f}; acc = mma_tile(VNT, 136, 16 * td, WSB, 136, 16 * tt, 128, acc, lane);
            const int tl = 16 * tt + fr; const size_t off = (r0 + tl) * 1024 + 128 * g + 16 * td + 4 * fq; const float bsv = F.gm_bs[g * 128 + tl];
            const v2u uw = *(const v2u*)(UV + off); v2u o;
            o.x = pk2(bflo(uw.x) * (acc[0] + bsv), bfhi(uw.x) * (acc[1] + bsv)); o.y = pk2(bflo(uw.y) * (acc[2] + bsv), bfhi(uw.y) * (acc[3] + bsv));
            *(v2u*)(MIX + off) = o; }
    }
    __syncthreads();
}
__device__ __forceinline__ void p3_phase(Frame& F) {
    for (int it = F.vcu; it < 1056 + 512; it += F.G) { if (it < 1056) gdn_item(F, it); else gmlp_item(F, it - 1056); }
}
__device__ __forceinline__ void p4_scan(Frame& F) {
    if ((F.vcu & 31) >= 16) return;
    const int chain = 2 * (F.vcu >> 5) + ((F.vcu & 31) >> 3), slice = F.vcu & 7;
    const int b = chain >> 3, h = (chain >> 1) & 3, d = chain & 1, c0 = slice * 16;
    constexpr int NS = 4 + 128, BUFB = 57344, ST_OFF = 2 * BUFB, ST_B = 4608, VNT_OFF = ST_OFF + 2 * ST_B;
    const unsigned char* gdn = F.ws + WS_GDN; const float* EGL = (const float*)(F.ws + WS_EGL);
    const int lane = F.lane, wave = F.wave;
#define P4_SLOT(s) ((s) < 4 ? 1024 + (b * 4 + h) * 4 + (d ? 3 - (s) : (s)) : (b * 4 + h) * 128 + (d ? 127 - ((s) - 4) : ((s) - 4)))
#define P4_BAR() do { asm volatile("s_waitcnt lgkmcnt(0)" ::: "memory"); __builtin_amdgcn_s_barrier(); asm volatile("" ::: "memory"); } while (0)
    if (wave >= 4) {
        const int lw = wave - 4;
#define P4_ISSUE(s, bufi) do { const unsigned char* gb = gdn + (size_t)(P4_SLOT(s) * 2 + d) * GDN_UNIT; \
            _Pragma("unroll") for (int q = 0; q < 14; ++q) { const int k = lw + 4 * q; unsigned so; \
                if (k < 32) { const int qi = (k & 15) * 64 + lane, r = qi >> 4, sl = qi & 15; so = (unsigned)((k >> 4) * 16384 + r * 256 + ((sl ^ (r & 15)) << 4)); } \
                else { const int kk = k < 48 ? k - 32 : k - 48, qi = kk * 64 + lane, r = qi >> 3, sl = qi & 7; so = (unsigned)((k < 48 ? 32768 : 49152) + r * 128 + ((sl ^ ((r >> 1) & 7)) << 4)); } \
                __builtin_amdgcn_global_load_lds((const unsigned*)(gb + so), (LAS unsigned*)(F.lds + (bufi) * BUFB + k * 1024), 16, 0, 0); } } while (0)
        P4_ISSUE(0, 0);
        VM_WAIT(); P4_BAR();
#pragma unroll 1
        for (int s = 0; s < NS; ++s) {
            const int cur = s & 1;
            if (s + 1 < NS) P4_ISSUE(s + 1, cur ^ 1);
            P4_BAR();
            VM_WAIT();
            P4_BAR();
        }
#undef P4_ISSUE
    } else {
        const int m = wave, fr = lane & 15, fq = lane >> 4;
        for (int i = F.tid; i < ST_B / 4; i += 256) ((LAS unsigned*)(F.lds + ST_OFF))[i] = 0u;
        f32x4 S0 = {0.f, 0.f, 0.f, 0.f}, S1 = S0;
        bf16* OD = (bf16*)(F.ws + (d ? WS_OB : WS_OF));
        v2u un; float egn;
        { const unsigned char* gb = gdn + (size_t)(P4_SLOT(0) * 2 + d) * GDN_UNIT; un = *(const v2u*)(gb + 57344 + ((c0 + fr) * 64 + 16 * m + 4 * fq) * 2); egn = EGL[P4_SLOT(0) * 2 + d]; }
        P4_BAR();
#pragma unroll 1
        for (int s = 0; s < NS; ++s) {
            const int cur = s & 1; const LAS unsigned char* buf = F.lds + cur * BUFB; const LAS unsigned char* STc = F.lds + ST_OFF + cur * ST_B; LAS unsigned char* STn = F.lds + ST_OFF + (cur ^ 1) * ST_B;
            const v2u uc = un; const float eg = egn;
            if (s + 1 < NS) { const int sl = P4_SLOT(s + 1); const unsigned char* gb = gdn + (size_t)(sl * 2 + d) * GDN_UNIT; un = *(const v2u*)(gb + 57344 + ((c0 + fr) * 64 + 16 * m + 4 * fq) * 2); egn = EGL[sl * 2 + d]; }
            bf16x8 bS[4]; f32x4 acc = {0.f, 0.f, 0.f, 0.f};
            const int r = 16 * m + fr;
#pragma unroll
            for (int ks = 0; ks < 4; ++ks) { bS[ks] = *(const LAS bf16x8*)(STc + fr * 288 + (32 * ks + 8 * fq) * 2);
                const bf16x8 a = *(const LAS bf16x8*)(buf + r * 256 + (((4 * ks + fq) ^ fr) << 4)); acc = __builtin_amdgcn_mfma_f32_16x16x32_bf16(a, bS[ks], acc, 0, 0, 0); }
            { const float v0 = bflo(uc.x) - acc[0], v1 = bfhi(uc.x) - acc[1], v2 = bflo(uc.y) - acc[2], v3 = bfhi(uc.y) - acc[3]; v2u o; o.x = pk2(v0, v1); o.y = pk2(v2, v3);
              *(LAS v2u*)(F.lds + VNT_OFF + fr * 160 + (16 * m + 4 * fq) * 2) = o; }
            P4_BAR();
            bf16x8 bV[2];
#pragma unroll
            for (int ks = 0; ks < 2; ++ks) bV[ks] = *(const LAS bf16x8*)(F.lds + VNT_OFF + fr * 160 + (32 * ks + 8 * fq) * 2);
            if (s >= 4) {
                f32x4 o = {0.f, 0.f, 0.f, 0.f};
#pragma unroll
                for (int ks = 0; ks < 4; ++ks) { const bf16x8 a = *(const LAS bf16x8*)(buf + 16384 + r * 256 + (((4 * ks + fq) ^ fr) << 4)); o = __builtin_amdgcn_mfma_f32_16x16x32_bf16(a, bS[ks], o, 0, 0, 0); }
#pragma unroll
                for (int ks = 0; ks < 2; ++ks) { const bf16x8 a = *(const LAS bf16x8*)(buf + 49152 + r * 128 + (((4 * ks + fq) ^ ((r >> 1) & 7)) << 4)); o = __builtin_amdgcn_mfma_f32_16x16x32_bf16(a, bV[ks], o, 0, 0, 0); }
                const int n = d ? 127 - (s - 4) : (s - 4);
#pragma unroll
                for (int j = 0; j < 4; ++j) { const int i = 16 * m + 4 * fq + j, tl = d ? 63 - i : i; OD[((size_t)b * T + 64 * n + tl) * 512 + h * 128 + c0 + fr] = (bf16)f2bf(o[j]); }
            }
            S0 *= eg; S1 *= eg;
#pragma unroll
            for (int ks = 0; ks < 2; ++ks) {
                const int r0 = 32 * m + fr, r1 = r0 + 16;
                const bf16x8 a0 = *(const LAS bf16x8*)(buf + 32768 + r0 * 128 + (((4 * ks + fq) ^ ((r0 >> 1) & 7)) << 4)); S0 = __builtin_amdgcn_mfma_f32_16x16x32_bf16(a0, bV[ks], S0, 0, 0, 0);
                const bf16x8 a1 = *(const LAS bf16x8*)(buf + 32768 + r1 * 128 + (((4 * ks + fq) ^ ((r1 >> 1) & 7)) << 4)); S1 = __builtin_amdgcn_mfma_f32_16x16x32_bf16(a1, bV[ks], S1, 0, 0, 0);
            }
            { v2u o; o.x = pk2(S0[0], S0[1]); o.y = pk2(S0[2], S0[3]); *(LAS v2u*)(STn + fr * 288 + (32 * m + 4 * fq) * 2) = o;
              o.x = pk2(S1[0], S1[1]); o.y = pk2(S1[2], S1[3]); *(LAS v2u*)(STn + fr * 288 + (32 * m + 16 + 4 * fq) * 2) = o; }
            P4_BAR();
        }
    }
#undef P4_SLOT
#undef P4_BAR
}
__device__ __forceinline__ void p5a_combine(Frame& F) {
    const bf16* OFp = (const bf16*)(F.ws + WS_OF); const bf16* OBp = (const bf16*)(F.ws + WS_OB); const bf16* Z = (const bf16*)(F.ws + WS_Z); bf16* MIX = (bf16*)(F.ws + WS_MIX);
    const int gw = F.vcu * NWAVES + F.wave, NGW = F.G * NWAVES, lane = F.lane;
    float gn[8];
#pragma unroll
    for (int e = 0; e < 8; ++e) gn[e] = F.gdn_norm_g[(lane & 15) * 8 + e];
    for (int m = gw; m < M; m += NGW) {
        const v4u a = *(const v4u*)(OFp + (size_t)m * 512 + lane * 8), bq = *(const v4u*)(OBp + (size_t)m * 512 + lane * 8), zz = *(const v4u*)(Z + (size_t)m * 512 + lane * 8);
        float o[8]; float ss = 0.f;
#pragma unroll
        for (int e = 0; e < 4; ++e) { o[2 * e] = bflo(a[e]) + bflo(bq[e]); o[2 * e + 1] = bfhi(a[e]) + bfhi(bq[e]); ss += o[2 * e] * o[2 * e] + o[2 * e + 1] * o[2 * e + 1]; }
        ss += __shfl_xor(ss, 1); ss += __shfl_xor(ss, 2); ss += __shfl_xor(ss, 4); ss += __shfl_xor(ss, 8);
        const float rstd = 1.0f / sqrtf(ss * (1.0f / 128.0f) + EPS);
        float y[8];
#pragma unroll
        for (int e = 0; e < 4; ++e) { y[2 * e] = o[2 * e] * rstd * gn[2 * e] * silu1(bflo(zz[e])); y[2 * e + 1] = o[2 * e + 1] * rstd * gn[2 * e + 1] * silu1(bfhi(zz[e])); }
        v4u w; w.x = pk2(y[0], y[1]); w.y = pk2(y[2], y[3]); w.z = pk2(y[4], y[5]); w.w = pk2(y[6], y[7]);
        *(v4u*)(MIX + (size_t)m * 1024 + 512 + lane * 8) = w;
    }
}
__device__ __forceinline__ void p6_phase(Frame& F) {
    const float* MOD = (const float*)(F.ws + WS_MOD); const float* H1 = (const float*)(F.ws + WS_H1); bf16* FIN = (bf16*)(F.ws + WS_FIN);
    float* AFF = (float*)(F.ws + WS_AFF); int* SEL = (int*)(F.ws + WS_SEL);
    LAS float* WR = (LAS float*)F.lds;
    for (int i = F.tid; i < 1024 * 4; i += 512) { const int k = i >> 2, q = i & 3; *(LAS f32x4*)(WR + k * 20 + q * 4) = *(const f32x4*)(F.w_router + k * 16 + q * 4); }
    __syncthreads();
    const int gw = F.vcu * NWAVES + F.wave, NGW = F.G * NWAVES, lane = F.lane;
#pragma unroll 1
    for (int b = 0; b < 2; ++b) {
        const float* mv = MOD + b * 6144;
        float sc[16], sh[16];
#pragma unroll
        for (int j = 0; j < 16; ++j) { const int k = lane + 64 * j; sc[j] = F.norm2_g[k] * (1.0f + mv[4096 + k]); sh[j] = mv[3072 + k]; }
        for (int m = b * T + gw; m < (b + 1) * T; m += NGW) {
            const float* hr = H1 + (size_t)m * D; float v[16]; float ss = 0.f;
#pragma unroll
            for (int j = 0; j < 16; ++j) { v[j] = hr[lane + 64 * j]; ss += v[j] * v[j]; }
            const float rstd = 1.0f / sqrtf(wave_sum(ss) * (1.0f / D) + EPS);
            float lg[16];
#pragma unroll
            for (int e = 0; e < 16; ++e) lg[e] = 0.f;
            bf16* fr_ = FIN + (size_t)m * D;
#pragma unroll
            for (int j = 0; j < 16; ++j) { const float f = v[j] * rstd * sc[j] + sh[j]; fr_[lane + 64 * j] = (bf16)f2bf(f);
                const LAS float* wr = WR + (lane + 64 * j) * 20;
#pragma unroll
                for (int q = 0; q < 4; ++q) { const f32x4 w = *(const LAS f32x4*)(wr + 4 * q); lg[4 * q] += f * w.x; lg[4 * q + 1] += f * w.y; lg[4 * q + 2] += f * w.z; lg[4 * q + 3] += f * w.w; }
                asm volatile("" ::: "memory"); }
            float mx = -3.0e38f;
#pragma unroll
            for (int e = 0; e < 16; ++e) { lg[e] = wave_sum(lg[e]) + F.b_router[e]; mx = fmaxf(mx, lg[e]); }
            float den = 0.f;
#pragma unroll
            for (int e = 0; e < 16; ++e) { lg[e] = expf(lg[e] - mx); den += lg[e]; }
            float mine = 0.f;
#pragma unroll
            for (int e = 0; e < 16; ++e) mine = (lane == e) ? lg[e] : mine;
            if (lane < 16) { AFF[((size_t)b * 16 + lane) * T + (m - b * T)] = mine / den; SEL[(size_t)m * 16 + lane] = -1; }
        }
    }
}
__device__ __forceinline__ int block_excl_scan(int v, LAS int* tmp, int lane, int wave, int& total) {
    int inc = v;
#pragma unroll
    for (int o = 1; o < 64; o <<= 1) { const int y = __shfl_up(inc, o); if (lane >= o) inc += y; }
    if (lane == 63) tmp[wave] = inc;
    __syncthreads();
    int woff = 0, tot = 0;
#pragma unroll
    for (int w = 0; w < 8; ++w) { const int sv = tmp[w]; woff += (w < wave) ? sv : 0; tot += sv; }
    __syncthreads();
    total = tot; return woff + inc - v;
}
__device__ __forceinline__ void p7_topk(Frame& F) {
    const float* AFF = (const float*)(F.ws + WS_AFF); int* SEL = (int*)(F.ws + WS_SEL); int* IDX = (int*)(F.ws + WS_IDX); float* GATE = (float*)(F.ws + WS_GATE);
    LAS unsigned* vals = (LAS unsigned*)F.lds;
    LAS unsigned* hist = vals + 8192;
    LAS int* tmp = (LAS int*)(hist + 256);
    const int tid = F.tid, lane = F.lane, wave = F.wave;
    for (int u = F.vcu; u < 32; u += F.G) {
        const int b = u >> 4, e = u & 15; const float* ar = AFF + (size_t)u * T;
        for (int t = tid; t < T; t += 512) vals[t] = __builtin_bit_cast(unsigned, ar[t]);
        if (tid == 0) { tmp[8] = 0; tmp[9] = CAP; }
        __syncthreads();
#pragma unroll 1
        for (int pass = 0; pass < 4; ++pass) {
            const int shift = 24 - 8 * pass;
            if (tid < 256) hist[tid] = 0u;
            __syncthreads();
            const unsigned prefix = (unsigned)tmp[8], himask = pass == 0 ? 0u : (0xffffffffu << (shift + 8));
            for (int t = tid; t < T; t += 512) { const unsigned v = vals[t]; if ((v & himask) == prefix) __hip_atomic_fetch_add(hist + ((v >> shift) & 255u), 1u, __ATOMIC_RELAXED, __HIP_MEMORY_SCOPE_WORKGROUP); }
            __syncthreads();
            if (wave == 0) {
                const unsigned kth = (unsigned)tmp[9];
                const unsigned c0 = hist[255 - 4 * lane], c1 = hist[254 - 4 * lane], c2 = hist[253 - 4 * lane], c3 = hist[252 - 4 * lane], sm = c0 + c1 + c2 + c3;
                unsigned inc = sm;
#pragma unroll
                for (int o = 1; o < 64; o <<= 1) { const unsigned y = __shfl_up(inc, o); if (lane >= o) inc += y; }
                const unsigned exc = inc - sm;
                if (exc < kth && kth <= inc) { unsigned r = kth - exc; int bin;
                    if (r <= c0) bin = 255 - 4 * lane; else if (r <= c0 + c1) { bin = 254 - 4 * lane; r -= c0; } else if (r <= c0 + c1 + c2) { bin = 253 - 4 * lane; r -= c0 + c1; } else { bin = 252 - 4 * lane; r -= c0 + c1 + c2; }
                    tmp[8] = (int)(prefix | ((unsigned)bin << shift)); tmp[9] = (int)r; }
            }
            __syncthreads();
        }
        const unsigned thr = (unsigned)tmp[8]; const int kth = tmp[9];
        const int t0 = tid * 16; int cg = 0, ce = 0;
#pragma unroll
        for (int i = 0; i < 16; ++i) { const unsigned v = vals[t0 + i]; cg += (v > thr) ? 1 : 0; ce += (v == thr) ? 1 : 0; }
        int tot; const int eqb = block_excl_scan(ce, tmp, lane, wave, tot);
        int take = kth - eqb; take = take < 0 ? 0 : (take > ce ? ce : take);
        int pos = block_excl_scan(cg + take, tmp, lane, wave, tot); int eqseen = 0;
#pragma unroll 1
        for (int i = 0; i < 16; ++i) { const unsigned v = vals[t0 + i]; bool sel = v > thr; if (v == thr) { sel = eqseen < take; ++eqseen; }
            if (sel) { const int t = t0 + i; IDX[u * CAP + pos] = b * T + t; GATE[u * CAP + pos] = __builtin_bit_cast(float, v); SEL[((size_t)b * T + t) * 16 + e] = pos; ++pos; } }
        __syncthreads();
    }
}
__device__ __forceinline__ void p7b_gather(Frame& F) {
    const int* IDX = (const int*)(F.ws + WS_IDX); const bf16* FIN = (const bf16*)(F.ws + WS_FIN); bf16* XE = (bf16*)(F.ws + WS_XE);
    const int gw = F.vcu * NWAVES + F.wave, NGW = F.G * NWAVES, lane = F.lane;
    for (int r = gw; r < 32 * CAP; r += NGW) { const int src = IDX[r]; const v4u* sp = (const v4u*)(FIN + (size_t)src * D); v4u* dp = (v4u*)(XE + (size_t)r * D);
        const v4u a = sp[lane], c = sp[lane + 64]; dp[lane] = a; dp[lane + 64] = c; }
}
__device__ __forceinline__ void p10_final(Frame& F) {
    const float* MOD = (const float*)(F.ws + WS_MOD); const float* H1 = (const float*)(F.ws + WS_H1); const bf16* YE = (const bf16*)(F.ws + WS_YE); const int* SEL = (const int*)(F.ws + WS_SEL);
    const int gw = F.vcu * NWAVES + F.wave, NGW = F.G * NWAVES, lane = F.lane;
#pragma unroll 1
    for (int b = 0; b < 2; ++b) {
        f32x4 gt[4], fg[4];
#pragma unroll
        for (int j = 0; j < 4; ++j) { gt[j] = *(const f32x4*)(MOD + b * 6144 + 5120 + 4 * lane + 256 * j); fg[j] = *(const f32x4*)(F.final_norm_g + 4 * lane + 256 * j); }
        for (int m = b * T + gw; m < (b + 1) * T; m += NGW) {
            const int selv = lane < 16 ? SEL[(size_t)m * 16 + lane] : -1;
            f32x4 acc[4];
#pragma unroll
            for (int j = 0; j < 4; ++j) acc[j] = (f32x4){0.f, 0.f, 0.f, 0.f};
#pragma unroll 1
            for (int e = 0; e < 16; ++e) { const int cpos = __shfl(selv, e);
                if (cpos >= 0) { const bf16* yr = YE + ((size_t)(b * 16 + e) * CAP + cpos) * D + 4 * lane;
#pragma unroll
                    for (int j = 0; j < 4; ++j) { const v2u w = *(const v2u*)(yr + 256 * j); acc[j] += (f32x4){bflo(w.x), bfhi(w.x), bflo(w.y), bfhi(w.y)}; } } }
            f32x4 hv[4]; float ss = 0.f;
#pragma unroll
            for (int j = 0; j < 4; ++j) { hv[j] = *(const f32x4*)(H1 + (size_t)m * D + 4 * lane + 256 * j) + gt[j] * acc[j]; ss += (hv[j].x * hv[j].x + hv[j].y * hv[j].y) + (hv[j].z * hv[j].z + hv[j].w * hv[j].w); }
            const float rstd = 1.0f / sqrtf(wave_sum(ss) * (1.0f / D) + EPS);
#pragma unroll
            for (int j = 0; j < 4; ++j) *(f32x4*)(F.out + (size_t)m * D + 4 * lane + 256 * j) = hv[j] * rstd * fg[j];
        }
    }
}
struct Args { const float* in[23]; float* out; unsigned char* ws; int ph_lo, ph_hi; };
__global__ void __launch_bounds__(NWAVES * 64, 2) fwd_kernel(Args args) {
    extern __shared__ __attribute__((aligned(16))) unsigned char lds_raw[];
    Frame F;
    F.lds = (LAS unsigned char*)lds_raw;
    volatile LAS unsigned* MISC = (volatile LAS unsigned*)(F.lds + MISC_OFF);
    F.tid = threadIdx.x; F.lane = F.tid & 63; F.wave = __builtin_amdgcn_readfirstlane(F.tid >> 6);
    F.G = gridDim.x; { const int bx = blockIdx.x; F.vcu = (F.G % 8 == 0) ? (bx % 8) * (F.G / 8) + bx / 8 : bx; }
    F.ws = args.ws; F.out = args.out;
    F.x = args.in[0]; F.c = args.in[1]; F.ctx = args.in[2]; F.c_ctx = args.in[3]; F.w_mod = args.in[4]; F.b_mod = args.in[5]; F.norm1_g = args.in[6]; F.norm2_g = args.in[7];
    F.w_in = args.in[8]; F.conv_w = args.in[9]; F.a_log = args.in[10]; F.dt_bias = args.in[11]; F.gdn_norm_g = args.in[12]; F.gm_norm_g = args.in[13]; F.gm_ws = args.in[14]; F.gm_bs = args.in[15];
    F.w_out = args.in[16]; F.w_router = args.in[17]; F.b_router = args.in[18]; F.w_gate = args.in[19]; F.w_up = args.in[20]; F.w_down = args.in[21]; F.final_norm_g = args.in[22];
    for (int u = F.tid; u < 64; u += NWAVES * 64) MISC[u] = 0u;
    __syncthreads();
    XcdBarrier bar; bar.bar = (unsigned*)(F.ws + WS_CTL) + CW_BAR; bar.x = 0; bar.st = nullptr;
    if (!MK_PER_PHASE) bar = xcd_barrier_post((unsigned*)(F.ws + WS_CTL) + CW_BAR, MISC + 8);
    const int lo = args.ph_lo, hi = args.ph_hi;
#define IN(k) (lo <= (k) && (k) < hi)
#define SEAM(k) do { if (IN(k) && IN((k) + 1)) xcd_barrier(bar); } while (0)
    if (IN(0)) { p0_phase(F); } SEAM(0);
    if (IN(1)) { p1_phase(F); } SEAM(1);
    if (IN(2)) {
        pg8::Gemm g{(const bf16*)(F.ws + WS_AIN), (const bf16*)(F.ws + WS_WIN), MA, 3328, D, 0, 0, 0}; pg8::StaticOrder S; S.init(MA, 3328, F.G, (int)blockIdx.x);
        pg8::EpiInProj E{(bf16*)(F.ws + WS_QKV), (bf16*)(F.ws + WS_Z), (bf16*)(F.ws + WS_UV), (float*)(F.ws + WS_AB)};
        pg8::gemm_phase<pg8::EpiInProj, pg8::StaticOrder, PG8_ALIGN, PG8_SP2>(F.lds, g, S, E);
    } SEAM(2);
    if (IN(3)) { p3_phase(F); } SEAM(3);
    if (IN(4)) { p4_scan(F); } SEAM(4);
    if (IN(5)) { p5a_combine(F); wgu_convert(F); } SEAM(5);
    if (IN(6)) {
        pg8::Gemm g{(const bf16*)(F.ws + WS_MIX), (const bf16*)(F.ws + WS_WOUT), M, D, D, 0, 0, 0}; pg8::StaticOrder S; S.init(M, D, F.G, (int)blockIdx.x);
        pg8::EpiOutProj E{F.x, (const float*)(F.ws + WS_MOD), (float*)(F.ws + WS_H1)};
        pg8::gemm_phase<pg8::EpiOutProj, pg8::StaticOrder, PG8_ALIGN, PG8_SP2>(F.lds, g, S, E);
    } SEAM(6);
    if (IN(7)) { p6_phase(F); } SEAM(7);
    if (IN(8)) { p7_topk(F); } SEAM(8);
    if (IN(9)) { p7b_gather(F); } SEAM(9);
    if (IN(10)) {
        pg8::Gemm g{(const bf16*)(F.ws + WS_XE), (const bf16*)(F.ws + WS_WGU), 32 * CAP, 2 * FF, D, (size_t)2 * FF * D * 2, 2, 15}; pg8::StaticOrder S; S.init(32 * CAP, 2 * FF, F.G, (int)blockIdx.x);
        pg8::EpiSwiGLU E{(bf16*)(F.ws + WS_HID)};
        pg8::gemm_phase<pg8::EpiSwiGLU, pg8::StaticOrder, PG8_ALIGN, PG8_SP2>(F.lds, g, S, E);
    } SEAM(10);
    if (IN(11)) { wd_convert(F); } SEAM(11);
    if (IN(12)) {
        pg8::Gemm g{(const bf16*)(F.ws + WS_HID), (const bf16*)(F.ws + WS_WD), 32 * CAP, D, FF, (size_t)D * FF * 2, 2, 15}; pg8::StaticOrder S; S.init(32 * CAP, D, F.G, (int)blockIdx.x);
        pg8::EpiDown E{(bf16*)(F.ws + WS_YE), (const float*)(F.ws + WS_GATE)};
        pg8::gemm_phase<pg8::EpiDown, pg8::StaticOrder, PG8_ALIGN, PG8_SP2>(F.lds, g, S, E);
    } SEAM(12);
    if (IN(13)) { p10_final(F); }
#undef IN
#undef SEAM
}

extern "C" void kernel_launch(void* const* d_in, const int* in_sizes, int n_in, void* d_out, int out_size, void* d_ws, size_t ws_size, hipStream_t stream) {
    static int grid = 0;
    if (grid == 0) {
        if (n_in != 23 || out_size != M * D || ws_size < WS_END) { fprintf(stderr, "kernel_launch: unexpected problem (n_in %d, out %d, ws %zu)\n", n_in, out_size, ws_size); grid = -1; return; }
        int dev = 0, cus = 0;
        if (hipGetDevice(&dev) != hipSuccess || hipDeviceGetAttribute(&cus, hipDeviceAttributeMultiprocessorCount, dev) != hipSuccess) { grid = -1; return; }
        if (hipFuncSetAttribute((const void*)fwd_kernel, hipFuncAttributeMaxDynamicSharedMemorySize, LDS_BYTES) != hipSuccess) { fprintf(stderr, "kernel_launch: hipFuncSetAttribute failed\n"); grid = -1; return; }
        grid = cus;
    }
    if (grid < 0) return;
    if (hipMemsetAsync((char*)d_ws + WS_CTL, 0, CTL_ZERO_BYTES, stream) != hipSuccess) return;
    Args a{};
    for (int i = 0; i < 23; ++i) a.in[i] = (const float*)d_in[i];
    a.out = (float*)d_out; a.ws = (unsigned char*)d_ws;
#if MK_PER_PHASE
    for (int p = 0; p < NPHASE; ++p) { a.ph_lo = p; a.ph_hi = p + 1; hipLaunchKernelGGL(fwd_kernel, dim3(grid), dim3(NWAVES * 64), LDS_BYTES, stream, a); }
#else
    a.ph_lo = 0; a.ph_hi = NPHASE;
    hipLaunchKernelGGL(fwd_kernel, dim3(grid), dim3(NWAVES * 64), LDS_BYTES, stream, a);
#endif
}
```

```cpp
#include <hip/hip_runtime.h>
#include <cstdio>
#include <cstdint>
namespace pg8 {
#define PG8_LAS __attribute__((address_space(3)))
typedef unsigned short bf16_t;
typedef short bf16x8 __attribute__((ext_vector_type(8)));
typedef float f32x4 __attribute__((ext_vector_type(4)));
typedef unsigned u32x4 __attribute__((ext_vector_type(4)));
constexpr int BM = 256, BK = 64, HALF = 128, HTB = HALF * BK * 2  , STAGE_BYTES = 8 * HTB, NXCD = 8, WGM = 8;

__host__ __device__ __forceinline__ int lds_byte(int r, int c) { const int st = (r >> 4) * 2 + (c >> 5), rr = r & 15, cc = c & 31, ob = rr * 64 + cc * 2; return st * 1024 + (ob ^ (((ob >> 9) & 1) << 5)); }
__host__ __device__ __forceinline__ void stage_rc(int b, int& R, int& C) { const int st = b / 1024, sb = b % 1024, swz = sb ^ (((sb >> 9) & 1) << 5); R = (st >> 1) * 16 + swz / 64; C = (st & 1) * 32 + (swz % 64) / 2; }
__host__ __device__ __forceinline__ int perm32(int rho) { const int n = rho >> 4, i = rho & 15; return 8 * (i >> 2) + 4 * n + (i & 3); }

struct Unit { int pm, pn; };
struct Gemm { const bf16_t* A; const bf16_t* Bt; int M, N, K; size_t bgs; int gsh, gmask; };

struct StaticOrder {
    int nM, nN, nwg, G, c;
    __host__ __device__ void init(int M, int N, int G_, int c_) { nM = M / BM; nN = N / BM; nwg = nM * nN; G = G_; c = c_; }
    __host__ __device__ bool next(int i, Unit& u) const {
        const long L = (long)i * G + c; if (L >= nwg) return false;
        int wgid = (int)L; { const int q = nwg / NXCD, r = nwg % NXCD, xcd = wgid % NXCD, off = wgid / NXCD; wgid = (xcd < r ? xcd * (q + 1) : r * (q + 1) + (xcd - r) * q) + off; }
        const int nig = WGM * nN, gid = wgid / nig, fm = gid * WGM, gsz = (nM - fm) < WGM ? (nM - fm) : WGM;
        u.pm = fm + ((wgid % nig) % gsz); u.pn = (wgid % nig) / gsz; return true;
    }
    __device__ __forceinline__ void a_ready(const Unit&) const {}
    __device__ __forceinline__ void done(const Unit&) const {}
};

__device__ __forceinline__ unsigned cvt_pk_bf16(float lo, float hi) { unsigned r; asm volatile("v_cvt_pk_bf16_f32 %0, %1, %2" : "=v"(r) : "v"(lo), "v"(hi)); return r; }
typedef float f32x2 __attribute__((ext_vector_type(2)));
__device__ __forceinline__ f32x2 gelu_pk(f32x2 v) {
    const f32x2 av = __builtin_elementwise_abs(v), d = av * 0.2316418882f + 1.0f;
    f32x2 t; t.x = __builtin_amdgcn_rcpf(d.x); t.y = __builtin_amdgcn_rcpf(d.y);
    f32x2 q = t * 0.5307027145f + (-0.7265760135f); q = q * t + 0.7107068705f; q = q * t + (-0.142248368f); q = q * t + 0.127414796f; q = q * t;
    const f32x2 s = (v * v) * (-0.72134752044f);
    f32x2 e; e.x = __builtin_amdgcn_exp2f(s.x); e.y = __builtin_amdgcn_exp2f(s.y);
    const f32x2 m = v * (q * e), r = v - m;
    f32x2 o; o.x = v.x < 0.f ? m.x : r.x; o.y = v.y < 0.f ? m.y : r.y; return o;
}
__device__ __forceinline__ float silu_f(float x) { return x * __builtin_amdgcn_rcpf(1.0f + __expf(-x)); }
__device__ __forceinline__ void st8(bf16_t* p, const f32x4 v0, const f32x4 v1) { u32x4 w; w.x = cvt_pk_bf16(v0[0], v0[1]); w.y = cvt_pk_bf16(v0[2], v0[3]); w.z = cvt_pk_bf16(v1[0], v1[1]); w.w = cvt_pk_bf16(v1[2], v1[3]); *(u32x4*)p = w; }
struct EpiInProj {
    static constexpr bool PERM = true, AFTER_DRAIN = false;
    bf16_t* QKV; bf16_t* Z; bf16_t* UV; float* AB;
    __device__ __forceinline__ void operator()(const f32x4 (&acc)[2][2][4][2], const Unit& u, int wr, int wc, int fr, int fq) const {
        const int row0 = u.pm * BM + wr * 64 + fr, pn = u.pn;
        if (pn == 12) {
            if (wc == 0 && fq < 2) {
#pragma unroll
                for (int ai = 0; ai < 2; ++ai)
#pragma unroll
                    for (int m = 0; m < 4; ++m) { float* p = AB + (size_t)(row0 + ai * HALF + m * 16) * 16 + 8 * fq; *(f32x4*)p = acc[ai][0][m][0]; *(f32x4*)(p + 4) = acc[ai][0][m][1]; }
            }
            return;
        }
        bf16_t* base; int ldc, colt; bool act = false;
        if (pn < 6) { base = QKV; ldc = 1536; colt = pn * 256; }
        else { if (u.pm >= 64) return; if (pn < 8) { base = Z; ldc = 512; colt = (pn - 6) * 256; } else { base = UV; ldc = 1024; colt = (pn - 8) * 256; act = true; } }
        const int col0 = colt + wc * 32 + 8 * fq;
#pragma unroll
        for (int ai = 0; ai < 2; ++ai)
#pragma unroll
            for (int m = 0; m < 4; ++m) { bf16_t* rowp = base + (size_t)(row0 + ai * HALF + m * 16) * ldc + col0;
#pragma unroll
                for (int bj = 0; bj < 2; ++bj) { f32x4 v0 = acc[ai][bj][m][0], v1 = acc[ai][bj][m][1];
                    if (act) { f32x2 a = gelu_pk((f32x2){v0[0], v0[1]}), b = gelu_pk((f32x2){v0[2], v0[3]}), c = gelu_pk((f32x2){v1[0], v1[1]}), d = gelu_pk((f32x2){v1[2], v1[3]});
                        v0 = (f32x4){a.x, a.y, b.x, b.y}; v1 = (f32x4){c.x, c.y, d.x, d.y}; }
                    st8(rowp + bj * HALF, v0, v1); } }
    }
};
struct EpiOutProj {
    static constexpr bool PERM = false, AFTER_DRAIN = false;
    const float* x; const float* mod; float* H1;
    __device__ __forceinline__ void operator()(const f32x4 (&acc)[2][2][4][2], const Unit& u, int wr, int wc, int fr, int fq) const {
        const int row0 = u.pm * BM + wr * 64 + fr, col0 = u.pn * BM + wc * 32 + 4 * fq; const float* gt = mod + (u.pm >= 32 ? 6144 : 0) + 2048;
        f32x4 gv[2][2];
#pragma unroll
        for (int bj = 0; bj < 2; ++bj)
#pragma unroll
            for (int n = 0; n < 2; ++n) gv[bj][n] = *(const f32x4*)(gt + col0 + bj * HALF + n * 16);
#pragma unroll
        for (int ai = 0; ai < 2; ++ai)
#pragma unroll
            for (int m = 0; m < 4; ++m) { const size_t off = (size_t)(row0 + ai * HALF + m * 16) * 1024 + col0;
#pragma unroll
                for (int bj = 0; bj < 2; ++bj)
#pragma unroll
                    for (int n = 0; n < 2; ++n) { const f32x4 xv = *(const f32x4*)(x + off + bj * HALF + n * 16); *(f32x4*)(H1 + off + bj * HALF + n * 16) = xv + gv[bj][n] * acc[ai][bj][m][n]; } }
    }
};
struct EpiSwiGLU {
    static constexpr bool PERM = true, AFTER_DRAIN = false;
    bf16_t* HID;
    __device__ __forceinline__ void operator()(const f32x4 (&acc)[2][2][4][2], const Unit& u, int wr, int wc, int fr, int fq) const {
        const int row0 = u.pm * BM + wr * 64 + fr, col0 = u.pn * HALF + wc * 32 + 8 * fq;
#pragma unroll
        for (int ai = 0; ai < 2; ++ai)
#pragma unroll
            for (int m = 0; m < 4; ++m) { bf16_t* rowp = HID + (size_t)(row0 + ai * HALF + m * 16) * 1024 + col0; f32x4 h0, h1;
#pragma unroll
                for (int j = 0; j < 4; ++j) { h0[j] = silu_f(acc[ai][0][m][0][j]) * acc[ai][1][m][0][j]; h1[j] = silu_f(acc[ai][0][m][1][j]) * acc[ai][1][m][1][j]; }
                st8(rowp, h0, h1); }
    }
};
struct EpiDown {
    static constexpr bool PERM = true, AFTER_DRAIN = false;
    bf16_t* YE; const float* gate;
    __device__ __forceinline__ void operator()(const f32x4 (&acc)[2][2][4][2], const Unit& u, int wr, int wc, int fr, int fq) const {
        const int row0 = u.pm * BM + wr * 64 + fr, col0 = u.pn * BM + wc * 32 + 8 * fq;
#pragma unroll
        for (int ai = 0; ai < 2; ++ai)
#pragma unroll
            for (int m = 0; m < 4; ++m) { const int row = row0 + ai * HALF + m * 16; const float gv = gate[row]; bf16_t* rowp = YE + (size_t)row * 1024 + col0;
#pragma unroll
                for (int bj = 0; bj < 2; ++bj) st8(rowp + bj * HALF, acc[ai][bj][m][0] * gv, acc[ai][bj][m][1] * gv); }
    }
};
template <class Epi, class Sched, bool ALIGN_EPI = false, bool SP2 = false>
__device__ __forceinline__ void gemm_phase(PG8_LAS unsigned char* lds, const Gemm g, const Sched& S, const Epi& E) {
    const int tid = threadIdx.x, wid = __builtin_amdgcn_readfirstlane(tid >> 6), lane = tid & 63, wr = wid >> 2, wc = wid & 3, fr = lane & 15, fq = lane >> 4;
    const int K = g.K, nt = K / BK;
    unsigned voffA[2], voffB[2];
#pragma unroll
    for (int i = 0; i < 2; ++i) { int R, C; stage_rc(tid * 16 + i * 8192, R, C); const int Rb = Epi::PERM ? ((R & ~31) + perm32(R & 31)) : R;
        voffA[i] = (unsigned)(R * K + C) * 2u; voffB[i] = (unsigned)(Rb * K + C) * 2u; }
    const size_t kstep = (size_t)(BK * 2);
    const size_t hstep = (size_t)HALF * K * 2;
    const size_t tstep = 2 * hstep;
    const unsigned ldsw = (unsigned)wid * 1024u;
    const int aoff = lds_byte(wr * 64 + fr, fq * 8), boff = lds_byte(wc * 32 + fr, fq * 8);
#define PG8_SA(b, h) (((b) * 2 + (h)) * HTB)
#define PG8_SB(b, h) ((4 + (b) * 2 + (h)) * HTB)
#define PG8_STAGE(bufoff, gbase, voff) do { _Pragma("unroll") for (int _i = 0; _i < 2; ++_i) \
        __builtin_amdgcn_global_load_lds((const unsigned*)((const char*)(gbase) + (voff)[_i]), (PG8_LAS unsigned*)(lds + (bufoff) + ldsw + _i * 8192), 16, 0, 0); } while (0)
#define PG8_LDA(dst, b, h) do { _Pragma("unroll") for (int m = 0; m < 4; ++m) _Pragma("unroll") for (int k = 0; k < 2; ++k) dst[m][k] = *(const PG8_LAS bf16x8*)(lds + PG8_SA(b, h) + aoff + m * 2048 + k * 1024); } while (0)
#define PG8_LDB(dst, b, h) do { _Pragma("unroll") for (int n = 0; n < 2; ++n) _Pragma("unroll") for (int k = 0; k < 2; ++k) dst[n][k] = *(const PG8_LAS bf16x8*)(lds + PG8_SB(b, h) + boff + n * 2048 + k * 1024); } while (0)
#define PG8_MMA(ai, bj, At, Bt) do { __builtin_amdgcn_s_setprio(1); _Pragma("unroll") for (int m = 0; m < 4; ++m) _Pragma("unroll") for (int n = 0; n < 2; ++n) _Pragma("unroll") for (int k = 0; k < 2; ++k) \
        acc[ai][bj][m][n] = __builtin_amdgcn_mfma_f32_16x16x32_bf16(Bt[n][k], At[m][k], acc[ai][bj][m][n], 0, 0, 0); __builtin_amdgcn_s_setprio(0); } while (0)
#define PG8_WAIT_V(n) asm volatile("s_waitcnt vmcnt(" #n ")" ::: "memory")
#define PG8_WAIT_L(n) asm volatile("s_waitcnt lgkmcnt(" #n ")" ::: "memory")
#define PG8_BAR __builtin_amdgcn_s_barrier()
#define PG8_SCHED __builtin_amdgcn_sched_barrier(0)
    Unit cur, nxt; int ui = 0;
    if (!S.next(0, cur)) return;
    f32x4 acc[2][2][4][2];
#pragma unroll
    for (int a = 0; a < 2; ++a)
#pragma unroll
        for (int b = 0; b < 2; ++b)
#pragma unroll
            for (int m = 0; m < 4; ++m)
#pragma unroll
                for (int n = 0; n < 2; ++n) acc[a][b][m][n] = (f32x4){0.f, 0.f, 0.f, 0.f};
    bf16x8 At[4][2], B0[2][2], B1[2][2];
    const char* cA = (const char*)g.A + (size_t)cur.pm * tstep; const char* cB = (const char*)g.Bt + (size_t)((cur.pm >> g.gsh) & g.gmask) * g.bgs + (size_t)cur.pn * tstep;
    S.a_ready(cur);
    if constexpr (SP2) {
        PG8_STAGE(PG8_SB(0, 0), cB, voffB); PG8_STAGE(PG8_SB(0, 1), cB + hstep, voffB); PG8_STAGE(PG8_SA(0, 0), cA, voffA); PG8_STAGE(PG8_SA(0, 1), cA + hstep, voffA);
        if (wr == 1) PG8_BAR;
        PG8_WAIT_V(2); PG8_BAR;
        PG8_STAGE(PG8_SB(1, 0), cB + kstep, voffB); PG8_STAGE(PG8_SA(1, 0), cA + kstep, voffA); PG8_STAGE(PG8_SB(1, 1), cB + hstep + kstep, voffB);
        PG8_WAIT_V(6); PG8_BAR;
    } else {
        PG8_STAGE(PG8_SB(0, 0), cB, voffB); PG8_STAGE(PG8_SA(0, 0), cA, voffA); PG8_STAGE(PG8_SB(0, 1), cB + hstep, voffB); PG8_STAGE(PG8_SA(0, 1), cA + hstep, voffA);
        if (wr == 1) PG8_BAR;
        PG8_WAIT_V(4); PG8_BAR;
        PG8_STAGE(PG8_SB(1, 0), cB + kstep, voffB); PG8_STAGE(PG8_SA(1, 0), cA + kstep, voffA); PG8_STAGE(PG8_SB(1, 1), cB + hstep + kstep, voffB);
        PG8_WAIT_V(6); PG8_BAR;
    }
    for (;;) {
        const bool has_next = S.next(ui + 1, nxt);
        const char* nA = has_next ? (const char*)g.A + (size_t)nxt.pm * tstep : cA; const char* nB = has_next ? (const char*)g.Bt + (size_t)((nxt.pm >> g.gsh) & g.gmask) * g.bgs + (size_t)nxt.pn * tstep : cB;
        for (int t = 0; t < nt; t += 2) {
            const bool last = (t == nt - 2);
            const char* a1 = cA + (size_t)(t + 1) * kstep;
            const char* a2 = last ? nA : cA + (size_t)(t + 2) * kstep; const char* b2 = last ? nB : cB + (size_t)(t + 2) * kstep;
            const char* a3 = a2 + kstep; const char* b3 = b2 + kstep;
            if (last && has_next) S.a_ready(nxt);
            if constexpr (SP2) {
            PG8_LDB(B0, 0, 0); PG8_LDB(B1, 0, 1); PG8_SCHED; PG8_LDA(At, 0, 0); PG8_STAGE(PG8_SA(1, 1), a1 + hstep, voffA);
            PG8_WAIT_V(8); PG8_WAIT_L(0); PG8_BAR; PG8_MMA(0, 0, At, B0); PG8_MMA(0, 1, At, B1); PG8_BAR; PG8_SCHED;
            PG8_LDA(At, 0, 1); PG8_STAGE(PG8_SB(0, 0), b2, voffB); PG8_STAGE(PG8_SB(0, 1), b2 + hstep, voffB); PG8_STAGE(PG8_SA(0, 0), a2, voffA);
            PG8_WAIT_V(8); PG8_WAIT_L(0); PG8_BAR; PG8_MMA(1, 0, At, B0); PG8_MMA(1, 1, At, B1); PG8_BAR; PG8_SCHED;
            PG8_LDB(B0, 1, 0); PG8_LDB(B1, 1, 1); PG8_SCHED; PG8_LDA(At, 1, 0); PG8_STAGE(PG8_SA(0, 1), a2 + hstep, voffA);
            PG8_WAIT_V(8); PG8_WAIT_L(0); PG8_BAR; PG8_MMA(0, 0, At, B0); PG8_MMA(0, 1, At, B1); PG8_BAR; PG8_SCHED;
            PG8_LDA(At, 1, 1); PG8_STAGE(PG8_SB(1, 0), b3, voffB); PG8_STAGE(PG8_SB(1, 1), b3 + hstep, voffB); PG8_STAGE(PG8_SA(1, 0), a3, voffA);
            PG8_WAIT_V(8); PG8_WAIT_L(0); PG8_BAR; PG8_MMA(1, 0, At, B0); PG8_MMA(1, 1, At, B1); PG8_BAR; PG8_SCHED;
            } else {
            PG8_LDB(B0, 0, 0); PG8_SCHED; PG8_LDA(At, 0, 0); PG8_STAGE(PG8_SA(1, 1), a1 + hstep, voffA);
            PG8_WAIT_L(8); PG8_BAR; PG8_WAIT_L(0); PG8_MMA(0, 0, At, B0); PG8_BAR; PG8_SCHED;
            PG8_LDB(B1, 0, 1); PG8_STAGE(PG8_SB(0, 0), b2, voffB);
            PG8_BAR; PG8_WAIT_L(0); PG8_MMA(0, 1, At, B1); PG8_BAR;
            PG8_LDA(At, 0, 1); PG8_STAGE(PG8_SA(0, 0), a2, voffA);
            PG8_BAR; PG8_WAIT_L(0); PG8_MMA(1, 0, At, B0); PG8_BAR; PG8_SCHED;
            PG8_STAGE(PG8_SB(0, 1), b2 + hstep, voffB);
            PG8_WAIT_V(6); PG8_BAR; PG8_MMA(1, 1, At, B1); PG8_BAR;
            PG8_LDB(B0, 1, 0); PG8_SCHED; PG8_LDA(At, 1, 0); PG8_STAGE(PG8_SA(0, 1), a2 + hstep, voffA);
            PG8_WAIT_L(8); PG8_BAR; PG8_WAIT_L(0); PG8_MMA(0, 0, At, B0); PG8_BAR; PG8_SCHED;
            PG8_LDB(B1, 1, 1); PG8_STAGE(PG8_SB(1, 0), b3, voffB);
            PG8_BAR; PG8_WAIT_L(0); PG8_MMA(0, 1, At, B1); PG8_BAR;
            PG8_LDA(At, 1, 1); PG8_STAGE(PG8_SA(1, 0), a3, voffA);
            PG8_BAR; PG8_WAIT_L(0); PG8_MMA(1, 0, At, B0); PG8_BAR; PG8_SCHED;
            PG8_STAGE(PG8_SB(1, 1), b3 + hstep, voffB);
            PG8_WAIT_V(6); PG8_BAR; PG8_MMA(1, 1, At, B1); PG8_BAR;
            }
        }
        if constexpr (ALIGN_EPI) { if (wr == 0) PG8_BAR; }
        if constexpr (!Epi::AFTER_DRAIN) { E(acc, cur, wr, wc, fr, fq); S.done(cur); }
        if (!has_next) break;
#pragma unroll
        for (int a = 0; a < 2; ++a)
#pragma unroll
            for (int b = 0; b < 2; ++b)
#pragma unroll
                for (int m = 0; m < 4; ++m)
#pragma unroll
                    for (int n = 0; n < 2; ++n) acc[a][b][m][n] = (f32x4){0.f, 0.f, 0.f, 0.f};
        cur = nxt; cA = nA; cB = nB; ++ui;
        if constexpr (ALIGN_EPI) { if (wr == 1) PG8_BAR; }
    }
    PG8_WAIT_V(0);
    if constexpr (!ALIGN_EPI) { if (wr == 0) PG8_BAR; }
    PG8_BAR;
    if constexpr (Epi::AFTER_DRAIN) { E.fused(acc, cur, wr, wc, fr, fq, lds, wid, lane); S.done(cur); }
#undef PG8_SA
#undef PG8_SB
#undef PG8_STAGE
#undef PG8_LDA
#undef PG8_LDB
#undef PG8_MMA
#undef PG8_WAIT_V
#undef PG8_WAIT_L
#undef PG8_BAR
#undef PG8_SCHED
}
}
#ifndef PG8_SP2
#define PG8_SP2 true
#endif
#ifndef PG8_ALIGN
#define PG8_ALIGN true
#endif
constexpr int NWAVES = 8;
#ifndef MK_PER_PHASE
#define MK_PER_PHASE 0
#endif
constexpr int NPHASE = 15;
constexpr int BATCH = 2, T = 8192, D = 1024, TC = 256, M = BATCH * T, MC = BATCH * TC, MA = M + MC;
constexpr int NEXP = 16, CAP = 1024, FF = 1024;
constexpr float EPS = 1e-6f;
constexpr size_t MiB = 1u << 20;
constexpr size_t WS_CTL = 0, CTL_ZERO_BYTES = 1 * MiB;
constexpr size_t WS_MOD = 1 * MiB;
constexpr size_t WS_EGL = 1 * MiB + 128 * 1024;
constexpr size_t WS_IDX = 1 * MiB + 512 * 1024;
constexpr size_t WS_GATE = WS_IDX + 128 * 1024;
constexpr size_t WS_AFF = 2 * MiB;
constexpr size_t WS_SEL = 3 * MiB;
constexpr size_t WS_WIN = 4 * MiB;
constexpr size_t WS_WOUT = 11 * MiB;
constexpr size_t WS_AIN = 13 * MiB;
constexpr size_t WS_MIX = 13 * MiB;
constexpr size_t WS_FIN = 13 * MiB;
constexpr size_t WS_QKV = 46 * MiB;
constexpr size_t WS_OF = 46 * MiB, WS_OB = 62 * MiB;
constexpr size_t WS_Z = 96 * MiB;
constexpr size_t WS_UV = 112 * MiB;
constexpr size_t WS_AB = 144 * MiB;
constexpr size_t WS_GDN = 146 * MiB;
constexpr size_t GDN_UNIT = 73728;
constexpr size_t WS_WGU = 132 * MiB;
constexpr size_t WS_H1 = 232 * MiB;
constexpr size_t WS_XE = 68 * MiB;
constexpr size_t WS_HID = 4 * MiB;
constexpr size_t WS_WD = 68 * MiB;
constexpr size_t WS_YE = 132 * MiB;
constexpr size_t WS_END = 296 * MiB;
static_assert(WS_GDN + 2112 * GDN_UNIT <= WS_END && WS_AB + (size_t)MA * 64 <= WS_GDN && WS_QKV + (size_t)MA * 3072 <= WS_Z, "ws map");
constexpr int CW_BAR = 4096;
constexpr int LDS_BYTES = 163840;
constexpr int MISC_OFF = LDS_BYTES - 256;
#define LAS __attribute__((address_space(3)))
typedef unsigned short bf16;
typedef unsigned v4u __attribute__((ext_vector_type(4)));
typedef unsigned v2u __attribute__((ext_vector_type(2)));
typedef float f32x4 __attribute__((ext_vector_type(4)));
typedef short bf16x8 __attribute__((ext_vector_type(8)));
#define LDS_WAIT() asm volatile("s_waitcnt lgkmcnt(0)" ::: "memory")
#define VM_WAIT() asm volatile("s_waitcnt vmcnt(0)" ::: "memory")
__device__ __forceinline__ unsigned f2bf(float f) { unsigned u = __builtin_bit_cast(unsigned, f); return (u + 0x7fffu + ((u >> 16) & 1u)) >> 16; }
__device__ __forceinline__ unsigned pk2(float lo, float hi) { return f2bf(lo) | (f2bf(hi) << 16); }
__device__ __forceinline__ float bflo(unsigned w) { return __builtin_bit_cast(float, w << 16); }
__device__ __forceinline__ float bfhi(unsigned w) { return __builtin_bit_cast(float, w & 0xffff0000u); }
__device__ __forceinline__ float bf1(bf16 h) { return __builtin_bit_cast(float, (unsigned)h << 16); }
__device__ __forceinline__ float wave_sum(float v) {
#pragma unroll
    for (int o = 1; o < 64; o <<= 1) v += __shfl_xor(v, o);
    return v;
}
__device__ __forceinline__ float fnma1(float a, float b, float c) { float r; asm("v_fma_f32 %0, -%1, %2, %3" : "=v"(r) : "v"(a), "v"(b), "v"(c)); return r; }
__device__ __forceinline__ float silu_r(float x) { return x * __builtin_amdgcn_rcpf(1.0f + __expf(-x)); }
__device__ __forceinline__ float silu1(float x) { return x / (1.0f + __expf(-x)); }

#define XB_TMO      128
#define XB_XCNT(j)  (256  + 64 * (j))
#define XB_XSUB(j)  (1280 + 64 * (j))
#define XB_XGEN(j)  (2304 + 64 * (j))
#define XB_TOP      3328
#define XB_TOPGEN   3392
#define XCD_BAR_WORDS 3456
#define XB_SPIN_CAP (1u << 18)
__device__ __forceinline__ unsigned xb_ld(unsigned* p)              { return __hip_atomic_load(p, __ATOMIC_RELAXED, __HIP_MEMORY_SCOPE_AGENT); }
__device__ __forceinline__ unsigned xb_add(unsigned* p, unsigned v) { return __hip_atomic_fetch_add(p, v, __ATOMIC_RELAXED, __HIP_MEMORY_SCOPE_AGENT); }
__device__ __forceinline__ unsigned xb_xcc_id() { return (unsigned)__builtin_amdgcn_s_getreg((3 << 11) | 20) & 0xFu; }
#define XB_SPIN(cond, bar) do { unsigned _sp = 0; while (cond) { __builtin_amdgcn_s_sleep(1); \
    if ((++_sp & 255u) == 0u) { if (xb_ld(&(bar)[XB_TMO])) break; if (_sp > XB_SPIN_CAP) { atomicAdd(&(bar)[XB_TMO], 1u); break; } } } } while (0)
struct XcdBarrier { unsigned* bar; unsigned x; volatile LAS unsigned* st; };
__device__ __forceinline__ XcdBarrier xcd_barrier_post(unsigned* bar, volatile LAS unsigned* st) {
    XcdBarrier b; b.bar = bar; b.x = xb_xcc_id(); b.st = st;
    if (threadIdx.x == 0) (void)xb_add(&bar[XB_XCNT(b.x)], 1u);
    return b;
}
__device__ __forceinline__ void xcd_barrier_complete(unsigned* bar, unsigned x, unsigned& nloc, unsigned& nx) {
    const unsigned G = gridDim.x * gridDim.y * gridDim.z;
    unsigned sum, cnt, mine, sp = 0u;
    for (;;) {
        sum = 0u; cnt = 0u; mine = 0u;
#pragma unroll
        for (unsigned j = 0; j < 16; ++j) { const unsigned c = xb_ld(&bar[XB_XCNT(j)]); sum += c; cnt += (c > 0u) ? 1u : 0u; mine = (j == x) ? c : mine; }
        if (sum == G) break;
        __builtin_amdgcn_s_sleep(1);
        if ((++sp & 255u) == 0u) { if (xb_ld(&bar[XB_TMO])) break; if (sp > XB_SPIN_CAP) { atomicAdd(&bar[XB_TMO], 1u); break; } }
    }
    nloc = mine > 0u ? mine : 1u; nx = cnt > 0u ? cnt : 1u;
}
__device__ __forceinline__ void xcd_barrier(const XcdBarrier& b) {
    asm volatile("s_waitcnt vmcnt(0)" ::: "memory");
    __syncthreads();
    if (threadIdx.x == 0) {
        unsigned* bar = b.bar;
        __builtin_amdgcn_s_waitcnt(0);
        unsigned nloc = b.st[0], nx = b.st[1];
        if (nloc == 0u) { xcd_barrier_complete(bar, b.x, nloc, nx); b.st[0] = nloc; b.st[1] = nx; }
        const unsigned old = xb_add(&bar[XB_XSUB(b.x)], 1u);
        const unsigned gen = old / nloc;
        if (old + 1u == (gen + 1u) * nloc) {
            __builtin_amdgcn_fence(__ATOMIC_RELEASE, "agent");
            asm volatile("s_waitcnt vmcnt(0)" ::: "memory");
            const unsigned og = xb_add(&bar[XB_TOP], 1u);
            const unsigned tg = og / nx;
            if (og + 1u == (tg + 1u) * nx) xb_add(&bar[XB_TOPGEN], 1u);
            else XB_SPIN(xb_ld(&bar[XB_TOPGEN]) == tg, bar);
            __builtin_amdgcn_fence(__ATOMIC_ACQUIRE, "agent");
            xb_add(&bar[XB_XGEN(b.x)], 1u);
            asm volatile("s_waitcnt vmcnt(0)" ::: "memory");
        } else {
            XB_SPIN(xb_ld(&bar[XB_XGEN(b.x)]) == gen, bar);
            __builtin_amdgcn_fence(__ATOMIC_ACQUIRE, "agent");
            asm volatile("s_waitcnt vmcnt(0)" ::: "memory");
        }
    }
    __syncthreads();
}

struct Frame {
    LAS unsigned char* lds;
    int tid, lane, wave, vcu, G;
    unsigned char* ws;
    const float *x, *c, *ctx, *c_ctx, *w_mod, *b_mod, *norm1_g, *norm2_g, *w_in, *conv_w, *a_log, *dt_bias, *gdn_norm_g, *gm_norm_g, *gm_ws, *gm_bs, *w_out, *w_router, *b_router, *w_gate, *w_up, *w_down, *final_norm_g;
    float* out;
};
__device__ __forceinline__ f32x4 mma_tile(const LAS bf16* A, int lda, int r0, const LAS bf16* Bt, int ldb, int c0, int K, f32x4 acc, int lane) {
    const int fr = lane & 15, fq = lane >> 4;
    const LAS bf16* ap = A + (r0 + fr) * lda + 8 * fq; const LAS bf16* bp = Bt + (c0 + fr) * ldb + 8 * fq;
#pragma unroll 4
    for (int k0 = 0; k0 < K; k0 += 32) { const bf16x8 a = *(const LAS bf16x8*)(ap + k0), b = *(const LAS bf16x8*)(bp + k0); acc = __builtin_amdgcn_mfma_f32_16x16x32_bf16(a, b, acc, 0, 0, 0); }
    return acc;
}
__device__ __forceinline__ void transpose_item(const float* W, int ldw, int src_col0, int k0, bf16* WT, int Kp, int dst_row0, LAS float* scr, int lane) {
#pragma unroll 8
    for (int i = 0; i < 32; ++i) { const int kk = 2 * i + (lane >> 5); scr[kk * 33 + (lane & 31)] = W[(size_t)(k0 + kk) * ldw + src_col0 + (lane & 31)]; }
    LDS_WAIT(); asm volatile("" ::: "memory");
    const int c = lane & 7;
#pragma unroll
    for (int j = 0; j < 4; ++j) { const int n = (lane >> 3) + 8 * j; const LAS float* s = scr + (8 * c) * 33 + n;
        v4u o; o.x = pk2(s[0 * 33], s[1 * 33]); o.y = pk2(s[2 * 33], s[3 * 33]); o.z = pk2(s[4 * 33], s[5 * 33]); o.w = pk2(s[6 * 33], s[7 * 33]);
        *(v4u*)(WT + (size_t)(dst_row0 + n) * Kp + k0 + 8 * c) = o; }
    LDS_WAIT(); asm volatile("" ::: "memory");
}
__device__ __forceinline__ void p0_phase(Frame& F) {
    float* MOD = (float*)(F.ws + WS_MOD);
    if (F.vcu < 96) {
        LAS float* sv = (LAS float*)F.lds;
        LAS float* red = sv + 3072;
        for (int i = F.tid; i < 3072; i += 512) { const int v = i >> 10, k = i & 1023; const float s = v < 2 ? F.c[v * 1024 + k] : F.c_ctx[k]; sv[i] = silu1(s); }
        __syncthreads();
        for (int item = F.vcu; item < 96; item += F.G) {
            const int kq = F.tid >> 4, cq = F.tid & 15, col = item * 64 + cq * 4;
            f32x4 a0 = {0.f, 0.f, 0.f, 0.f}, a1 = a0, a2 = a0;
#pragma unroll 8
            for (int kk = 0; kk < 32; ++kk) { const int k = kq * 32 + kk; const f32x4 w = *(const f32x4*)(F.w_mod + (size_t)k * 6144 + col); a0 += sv[k] * w; a1 += sv[1024 + k] * w; a2 += sv[2048 + k] * w; }
            *(LAS f32x4*)(red + (kq * 3 + 0) * 64 + cq * 4) = a0; *(LAS f32x4*)(red + (kq * 3 + 1) * 64 + cq * 4) = a1; *(LAS f32x4*)(red + (kq * 3 + 2) * 64 + cq * 4) = a2;
            __syncthreads();
            if (F.tid < 192) { const int v = F.tid >> 6, cc = F.tid & 63; float s = F.b_mod[item * 64 + cc];
                for (int q = 0; q < 32; ++q) s += red[(q * 3 + v) * 64 + cc];
                MOD[v * 6144 + item * 64 + cc] = s; }
            __syncthreads();
        }
    }
    __syncthreads();
    LAS float* scr = (LAS float*)(F.lds + F.wave * 16384);
    const int gw = F.vcu * NWAVES + F.wave, NGW = F.G * NWAVES;
    bf16* WIN = (bf16*)(F.ws + WS_WIN); bf16* WOUT = (bf16*)(F.ws + WS_WOUT);
    constexpr int I_IN = 97 * 16, I_OUT = 32 * 16;
    for (int it = gw; it < I_IN + I_OUT; it += NGW) {
        if (it < I_IN) { const int blk = it >> 4, kb = it & 15;
            const int src = blk < 48 ? 32 * blk : (blk < 64 ? 1552 + 32 * (blk - 48) : (blk < 96 ? 2064 + 32 * (blk - 64) : 1536));
            transpose_item(F.w_in, 3088, src, kb * 64, WIN, 1024, blk * 32, scr, F.lane); }
        else { const int r = it - I_IN, blk = r >> 4, kb = r & 15; transpose_item(F.w_out, 1024, blk * 32, kb * 64, WOUT, 1024, blk * 32, scr, F.lane); }
    }
}
__device__ __forceinline__ void wgu_convert(Frame& F) {
    LAS float* scr = (LAS float*)(F.lds + F.wave * 16384);
    const int gw = F.vcu * NWAVES + F.wave, NGW = F.G * NWAVES;
    bf16* WGU = (bf16*)(F.ws + WS_WGU);
    for (int it = gw; it < 16 * 2 * 512; it += NGW) {
        const int kb = it & 15, fb = (it >> 4) & 31, mat = (it >> 9) & 1, e = it >> 10;
        const float* W = (mat ? F.w_up : F.w_gate) + (size_t)e * 1024 * 1024;
        const int f0 = fb * 32, pn = f0 >> 7, dst = 256 * pn + (mat ? 128 : 0) + (f0 & 127);
        transpose_item(W, 1024, f0, kb * 64, WGU + (size_t)e * 2048 * 1024, 1024, dst, scr, F.lane);
    }
}
__device__ __forceinline__ void wd_convert(Frame& F) {
    LAS float* scr = (LAS float*)(F.lds + F.wave * 16384);
    const int gw = F.vcu * NWAVES + F.wave, NGW = F.G * NWAVES;
    bf16* WD = (bf16*)(F.ws + WS_WD);
    for (int it = gw; it < 16 * 512; it += NGW) { const int kb = it & 15, nb = (it >> 4) & 31, e = it >> 9;
        transpose_item(F.w_down + (size_t)e * 1024 * 1024, 1024, nb * 32, kb * 64, WD + (size_t)e * 1024 * 1024, 1024, nb * 32, scr, F.lane); }
}
__device__ __forceinline__ void p1_phase(Frame& F) {
    const float* MOD = (const float*)(F.ws + WS_MOD); bf16* AIN = (bf16*)(F.ws + WS_AIN);
    const int gw = F.vcu * NWAVES + F.wave, NGW = F.G * NWAVES;
#pragma unroll 1
    for (int seg = 0; seg < 3; ++seg) {
        const int r_lo = seg < 2 ? seg * T : M, r_hi = seg < 2 ? (seg + 1) * T : MA;
        const float* mv = MOD + seg * 6144;
        f32x4 sc[4], sh[4];
#pragma unroll
        for (int j = 0; j < 4; ++j) { const int k = 4 * F.lane + 256 * j; const f32x4 g = *(const f32x4*)(F.norm1_g + k), s1 = *(const f32x4*)(mv + 1024 + k); sc[j] = g * (1.0f + s1); sh[j] = *(const f32x4*)(mv + k); }
        for (int m = r_lo + gw; m < r_hi; m += NGW) {
            const float* xr = seg < 2 ? F.x + (size_t)m * D : F.ctx + (size_t)(m - M) * D;
            f32x4 v[4]; float ss = 0.f;
#pragma unroll
            for (int j = 0; j < 4; ++j) { v[j] = *(const f32x4*)(xr + 4 * F.lane + 256 * j); ss += (v[j].x * v[j].x + v[j].y * v[j].y) + (v[j].z * v[j].z + v[j].w * v[j].w); }
            const float rstd = 1.0f / sqrtf(wave_sum(ss) * (1.0f / D) + EPS);
            bf16* orow = AIN + (size_t)m * D;
#pragma unroll
            for (int j = 0; j < 4; ++j) { const f32x4 a = v[j] * rstd * sc[j] + sh[j]; v2u o; o.x = pk2(a.x, a.y); o.y = pk2(a.z, a.w); *(v2u*)(orow + 4 * F.lane + 256 * j) = o; }
        }
    }
}
struct PF { unsigned a, b, c, d; };
__device__ __forceinline__ unsigned touch(const void* p) { return *(const volatile unsigned*)p; }
__device__ __forceinline__ PF p3_prefetch(Frame& F, int it) {
    PF r; r.a = r.b = r.c = r.d = 0u;
    if (it >= 1056 + 512) return r;
    const int tid = F.tid;
    if (it < 1056) {
        int b, n, h, L; size_t row_base;
        if (it < 1024) { b = it >> 9; n = (it >> 2) & 127; h = it & 3; L = T; row_base = (size_t)b * T; }
        else { const int j = it - 1024; b = j >> 4; n = (j >> 2) & 3; h = j & 3; L = TC; row_base = (size_t)M + (size_t)b * TC; }
        const bf16* QKV = (const bf16*)(F.ws + WS_QKV);
        { const int p = tid, rr = p / 12, q = p % 12, s = q >> 2, piece = q & 3; int t = 64 * n - 1 + rr; t = t < 0 ? 0 : (t >= L ? L - 1 : t); r.a = touch(QKV + (row_base + t) * 1536 + s * 512 + h * 128 + piece * 32); }
        if (tid < 280) { const int p = tid + 512, rr = p / 12, q = p % 12, s = q >> 2, piece = q & 3; int t = 64 * n - 1 + rr; t = t < 0 ? 0 : (t >= L ? L - 1 : t); r.b = touch(QKV + (row_base + t) * 1536 + s * 512 + h * 128 + piece * 32); }
        if (tid < 64) r.c = touch((const float*)(F.ws + WS_AB) + (row_base + 64 * n + tid) * 16);
    } else {
        const int i2 = it - 1056, g = i2 & 3, nc = (i2 >> 2) & 63, b = i2 >> 8; const size_t r0 = (size_t)b * T + (size_t)nc * 128;
        const bf16* UV = (const bf16*)(F.ws + WS_UV);
        const int t = tid >> 2, piece = tid & 3; r.a = touch(UV + (r0 + t) * 1024 + 512 + 128 * g + piece * 32); r.b = touch(UV + (r0 + t) * 1024 + 128 * g + piece * 32);
        r.c = touch(F.gm_ws + (size_t)g * 16384 + tid * 16); r.d = touch(F.gm_ws + (size_t)g * 16384 + (tid + 512) * 16);
    }
    return r;
}
__device__ __forceinline__ void pf_sink(Frame& F, const PF& r) { if ((r.a ^ r.b ^ r.c ^ r.d) == 0x9E3779B9u && F.tid == 0x7fffffff) ((unsigned*)(F.ws + WS_CTL))[8] = 1u; }
__device__ __forceinline__ void gdn_item(Frame& F, int it) {
    int b, n, h, L, slot; size_t row_base;
    if (it < 1024) { b = it >> 9; n = (it >> 2) & 127; h = it & 3; L = T; row_base = (size_t)b * T; slot = (b * 4 + h) * 128 + n; }
    else { const int j = it - 1024; b = j >> 4; n = (j >> 2) & 3; h = j & 3; L = TC; row_base = (size_t)M + (size_t)b * TC; slot = 1024 + (b * 4 + h) * 4 + n; }
    const bf16* QKV = (const bf16*)(F.ws + WS_QKV); const float* AB = (const float*)(F.ws + WS_AB);
    LAS bf16* QB = (LAS bf16*)(F.lds); LAS bf16* KB = (LAS bf16*)(F.lds + 17408); LAS bf16* VB = (LAS bf16*)(F.lds + 34816); LAS bf16* TB = (LAS bf16*)(F.lds + 34816);
    LAS bf16* KT = (LAS bf16*)(F.lds + 52224); LAS bf16* VT = (LAS bf16*)(F.lds + 70656);
    LAS float* KK = (LAS float*)(F.lds + 89088); LAS float* QK = (LAS float*)(F.lds + 105728);
    LAS bf16* T12 = (LAS bf16*)(F.lds + 89088);
    LAS float* AF = (LAS float*)(F.lds + 122368);
    LAS float* GC = (LAS float*)(F.lds + 155136); LAS float* BT = (LAS float*)(F.lds + 155648); LAS float* EG1 = (LAS float*)(F.lds + 156160); LAS float* EG2 = (LAS float*)(F.lds + 156672);
    LAS bf16* A10B = (LAS bf16*)(F.lds + 157184);
    const int tid = F.tid, lane = F.lane, wave = F.wave, fr = lane & 15, fq = lane >> 4;
    for (int q = tid; q < 1152; q += 512) { const int tap = q / 384, rem = q % 384, s = rem >> 7, c = rem & 127; ((LAS float*)(F.lds + 89088))[q] = F.conv_w[tap * 1536 + s * 512 + h * 128 + c]; }
    __syncthreads();
    {
        const int r = tid >> 3, part = tid & 7, t = 64 * n + r; const bool hasp = t > 0, hasn = t + 1 < L;
        const bf16* prow = QKV + (row_base + t) * 1536;
        const LAS float* cwl = (const LAS float*)(F.lds + 89088) + part * 16;
        const int offp = hasp ? 1536 : 0, offn = hasn ? 1536 : 0; const unsigned mp = hasp ? 0xffffffffu : 0u, mn = hasn ? 0xffffffffu : 0u;
        v4u dc[6], dn[6];
#define S1_LOAD(dst, s_) do { const bf16* pc_ = prow + (s_) * 512 + h * 128 + part * 16; const bf16* pp_ = pc_ - offp; const bf16* pn_ = pc_ + offn; \
            dst[0] = *(const v4u*)pc_; dst[1] = *(const v4u*)(pc_ + 8); dst[2] = *(const v4u*)pp_; dst[3] = *(const v4u*)(pp_ + 8); dst[4] = *(const v4u*)pn_; dst[5] = *(const v4u*)(pn_ + 8); } while (0)
        S1_LOAD(dc, 0);
#pragma unroll 1
        for (int s = 0; s < 3; ++s) {
            if (s < 2) S1_LOAD(dn, s + 1);
            float y[16]; float ss = 0.f;
#pragma unroll
            for (int q = 0; q < 4; ++q) { const f32x4 w0 = *(const LAS f32x4*)(cwl + (0 * 3 + s) * 128 + 4 * q), w1 = *(const LAS f32x4*)(cwl + (1 * 3 + s) * 128 + 4 * q), w2 = *(const LAS f32x4*)(cwl + (2 * 3 + s) * 128 + 4 * q);
#pragma unroll
                for (int e = 0; e < 2; ++e) { const unsigned cw = dc[q >> 1][(q & 1) * 2 + e], pw = dc[2 + (q >> 1)][(q & 1) * 2 + e] & mp, nw = dc[4 + (q >> 1)][(q & 1) * 2 + e] & mn;
                    const float a0 = w0[2 * e] * bflo(pw) + w1[2 * e] * bflo(cw) + w2[2 * e] * bflo(nw), a1 = w0[2 * e + 1] * bfhi(pw) + w1[2 * e + 1] * bfhi(cw) + w2[2 * e + 1] * bfhi(nw);
                    const float y0 = silu_r(a0), y1 = silu_r(a1); y[4 * q + 2 * e] = y0; y[4 * q + 2 * e + 1] = y1; ss += y0 * y0 + y1 * y1; } }
            float sc = 1.0f;
            if (s < 2) { ss += __shfl_xor(ss, 1); ss += __shfl_xor(ss, 2); ss += __shfl_xor(ss, 4); sc = (1.0f / sqrtf(ss + EPS)) * (s == 0 ? 0.08838834764831845f : 1.0f); }
            LAS bf16* dst = (s == 0 ? QB : (s == 1 ? KB : VB)) + r * 136 + part * 16;
            v4u o0, o1;
            o0.x = pk2(y[0] * sc, y[1] * sc); o0.y = pk2(y[2] * sc, y[3] * sc); o0.z = pk2(y[4] * sc, y[5] * sc); o0.w = pk2(y[6] * sc, y[7] * sc);
            o1.x = pk2(y[8] * sc, y[9] * sc); o1.y = pk2(y[10] * sc, y[11] * sc); o1.z = pk2(y[12] * sc, y[13] * sc); o1.w = pk2(y[14] * sc, y[15] * sc);
            *(LAS v4u*)dst = o0; *(LAS v4u*)(dst + 8) = o1;
#pragma unroll
            for (int q = 0; q < 6; ++q) dc[q] = dn[q];
        }
#undef S1_LOAD
        if (wave < 2) { const int d = wave, i = lane, tl = d ? 63 - i : i; const float* abr = AB + (row_base + 64 * n + tl) * 16;
            const float a = abr[d * 4 + h], bb = abr[8 + d * 4 + h];
            const float xx = a + F.dt_bias[d * 4 + h]; const float sp = fmaxf(xx, 0.f) + log1pf(expf(-fabsf(xx)));
            float g = -expf(F.a_log[d * 4 + h]) * sp;
#pragma unroll
            for (int o = 1; o < 64; o <<= 1) { const float yv = __shfl_up(g, o); if (i >= o) g += yv; }
            GC[d * 64 + i] = g; BT[d * 64 + i] = 1.0f / (1.0f + expf(-bb)); const float gl = __shfl(g, 63); EG1[d * 64 + i] = __expf(g); EG2[d * 64 + i] = __expf(gl - g); }
    }
    __syncthreads();
    const PF pf = p3_prefetch(F, it + F.G);
    {
        const int mat = wave >> 2, tr = wave & 3;
#pragma unroll
        for (int tc = 0; tc < 4; ++tc) { f32x4 acc = {0.f, 0.f, 0.f, 0.f}; acc = mma_tile(mat ? QB : KB, 136, 16 * tr, KB, 136, 16 * tc, 128, acc, lane);
            LAS float* dst = (mat ? QK : KK) + (16 * tr + 4 * fq) * 65 + 16 * tc + fr;
#pragma unroll
            for (int j = 0; j < 4; ++j) dst[j * 65] = acc[j]; }
        bf16x8 id0, id1;
#pragma unroll
        for (int j = 0; j < 8; ++j) { id0[j] = (8 * fq + j == fr) ? (short)0x3F80 : (short)0; id1[j] = (8 * fq + j == fr + 16) ? (short)0x3F80 : (short)0; }
#pragma unroll 1
        for (int q = 0; q < 8; ++q) { const int job = wave * 8 + q, mt = job >> 5, tt = (job >> 3) & 3, ct = job & 7;
            const bf16x8 a = *(const LAS bf16x8*)((mt ? KB : VB) + (16 * tt + fr) * 136 + 32 * (ct >> 1) + 8 * fq);
            f32x4 acc = {0.f, 0.f, 0.f, 0.f}; acc = __builtin_amdgcn_mfma_f32_16x16x32_bf16(a, (ct & 1) ? id1 : id0, acc, 0, 0, 0);
            v2u o; o.x = pk2(acc[0], acc[1]); o.y = pk2(acc[2], acc[3]); *(LAS v2u*)((mt ? KT : VT) + (16 * ct + fr) * 72 + 16 * tt + 4 * fq) = o; }
    }
    __syncthreads();
    for (int idx = tid; idx < 8192; idx += 512) { const int d = idx >> 12, i = (idx >> 6) & 63, j = idx & 63; const int ti = d ? 63 - i : i, tj = d ? 63 - j : j;
        const float av = (i > j) ? BT[d * 64 + i] * KK[ti * 65 + tj] * __expf(GC[d * 64 + i] - GC[d * 64 + j]) : 0.f; AF[idx] = av;
        if (i >= 32 && j < 32) A10B[d * 1280 + (i - 32) * 40 + j] = (bf16)f2bf(av); }
    __syncthreads();
    unsigned char* gout = F.ws + WS_GDN + (size_t)slot * 2 * GDN_UNIT;
    if (wave < 2) {
        const int d = wave, blk = lane >> 5, jc = lane & 31; const LAS float* A = AF + d * 4096 + (blk * 32) * 64 + blk * 32; LAS bf16* TBd = TB + d * 4096;
        float Tc[32];
#pragma unroll
        for (int i = 0; i < 32; ++i) { float s0 = (i == jc) ? 1.f : 0.f, s1 = 0.f, s2 = 0.f, s3 = 0.f;
#pragma unroll
            for (int j = 0; j < i; ++j) { const float a = A[i * 64 + j]; if ((j & 3) == 0) s0 = fnma1(a, Tc[j], s0); else if ((j & 3) == 1) s1 = fnma1(a, Tc[j], s1); else if ((j & 3) == 2) s2 = fnma1(a, Tc[j], s2); else s3 = fnma1(a, Tc[j], s3); }
            Tc[i] = (s0 + s1) + (s2 + s3); TBd[(blk * 32 + i) * 64 + blk * 32 + jc] = (bf16)f2bf(Tc[i]);
            if (blk) TBd[i * 64 + 32 + jc] = (bf16)0;
            asm volatile("" ::: "memory"); }
        LAS bf16* DT0 = (LAS bf16*)(AF + d * 4096); LAS bf16* PT = DT0 + 1280;
        if (!blk) {
#pragma unroll
            for (int q = 0; q < 4; ++q) { v4u o; o.x = pk2(Tc[8 * q], Tc[8 * q + 1]); o.y = pk2(Tc[8 * q + 2], Tc[8 * q + 3]); o.z = pk2(Tc[8 * q + 4], Tc[8 * q + 5]); o.w = pk2(Tc[8 * q + 6], Tc[8 * q + 7]); *(LAS v4u*)(DT0 + jc * 40 + 8 * q) = o; } }
#pragma unroll
        for (int tl = 0; tl < 4; ++tl) { const int ti = tl >> 1, tj = tl & 1; f32x4 acc = {0.f, 0.f, 0.f, 0.f}; acc = mma_tile(A10B + d * 1280, 40, 16 * ti, DT0, 40, 16 * tj, 32, acc, lane);
            v2u o; o.x = pk2(acc[0], acc[1]); o.y = pk2(acc[2], acc[3]); *(LAS v2u*)(PT + (16 * tj + fr) * 40 + 16 * ti + 4 * fq) = o; }
#pragma unroll
        for (int tl = 0; tl < 4; ++tl) { const int ti = tl >> 1, tj = tl & 1; f32x4 acc = {0.f, 0.f, 0.f, 0.f}; acc = mma_tile(TBd + 32 * 64 + 32, 64, 16 * ti, PT, 40, 16 * tj, 32, acc, lane);
#pragma unroll
            for (int j = 0; j < 4; ++j) TBd[(32 + 16 * ti + 4 * fq + j) * 64 + 16 * tj + fr] = (bf16)f2bf(-acc[j]); }
    } else {
        const int t2 = tid - 128;
        for (int q = t2; q < 2048; q += 384) { const int d = q >> 10, i = (q >> 4) & 63, cg = q & 15, tok = d ? 63 - i : i; const float e = EG1[d * 64 + i];
            const v4u s = *(const LAS v4u*)(QB + tok * 136 + cg * 8); v4u o;
            o.x = pk2(bflo(s.x) * e, bfhi(s.x) * e); o.y = pk2(bflo(s.y) * e, bfhi(s.y) * e); o.z = pk2(bflo(s.z) * e, bfhi(s.z) * e); o.w = pk2(bflo(s.w) * e, bfhi(s.w) * e);
            *(v4u*)(gout + (size_t)d * GDN_UNIT + 16384 + (i * 128 + cg * 8) * 2) = o; }
        for (int q = t2; q < 2048; q += 384) { const int d = q >> 10, c = (q >> 3) & 127, ig = q & 7;
            float v[8];
            if (d == 0) { const v4u s = *(const LAS v4u*)(KT + c * 72 + ig * 8); v[0] = bflo(s.x); v[1] = bfhi(s.x); v[2] = bflo(s.y); v[3] = bfhi(s.y); v[4] = bflo(s.z); v[5] = bfhi(s.z); v[6] = bflo(s.w); v[7] = bfhi(s.w); }
            else { const v4u s = *(const LAS v4u*)(KT + c * 72 + 56 - ig * 8); v[7] = bflo(s.x); v[6] = bfhi(s.x); v[5] = bflo(s.y); v[4] = bfhi(s.y); v[3] = bflo(s.z); v[2] = bfhi(s.z); v[1] = bflo(s.w); v[0] = bfhi(s.w); }
            const LAS float* e2 = EG2 + d * 64 + ig * 8; v4u o;
            o.x = pk2(v[0] * e2[0], v[1] * e2[1]); o.y = pk2(v[2] * e2[2], v[3] * e2[3]); o.z = pk2(v[4] * e2[4], v[5] * e2[5]); o.w = pk2(v[6] * e2[6], v[7] * e2[7]);
            *(v4u*)(gout + (size_t)d * GDN_UNIT + 32768 + (c * 64 + ig * 8) * 2) = o; }
        for (int q = t2; q < 1024; q += 384) { const int d = q >> 9, i = (q >> 3) & 63, jg = q & 7, ti = d ? 63 - i : i; const float gi = GC[d * 64 + i]; float v[8];
#pragma unroll
            for (int jj = 0; jj < 8; ++jj) { const int j = jg * 8 + jj, tj = d ? 63 - j : j; v[jj] = (i >= j) ? QK[ti * 65 + tj] * __expf(gi - GC[d * 64 + j]) : 0.f; }
            v4u o; o.x = pk2(v[0], v[1]); o.y = pk2(v[2], v[3]); o.z = pk2(v[4], v[5]); o.w = pk2(v[6], v[7]);
            *(v4u*)(gout + (size_t)d * GDN_UNIT + 49152 + (i * 64 + jg * 8) * 2) = o; }
        if (t2 < 2) ((float*)(F.ws + WS_EGL))[slot * 2 + t2] = EG1[t2 * 64 + 63];
    }
    __syncthreads();
    for (int q = tid; q < 1024; q += 512) { const int d = q >> 9, i = (q >> 3) & 63, tg = q & 7;
        float v[8];
        if (d == 0) { const v4u s = *(const LAS v4u*)(TB + i * 64 + tg * 8); v[0] = bflo(s.x); v[1] = bfhi(s.x); v[2] = bflo(s.y); v[3] = bfhi(s.y); v[4] = bflo(s.z); v[5] = bfhi(s.z); v[6] = bflo(s.w); v[7] = bfhi(s.w); }
        else { const v4u s = *(const LAS v4u*)(TB + 4096 + i * 64 + 56 - tg * 8); v[7] = bflo(s.x); v[6] = bfhi(s.x); v[5] = bflo(s.y); v[4] = bfhi(s.y); v[3] = bflo(s.z); v[2] = bfhi(s.z); v[1] = bflo(s.w); v[0] = bfhi(s.w); }
        float t1[8], t2v[8];
#pragma unroll
        for (int e = 0; e < 8; ++e) { const int tok = tg * 8 + e, j = d ? 63 - tok : tok; t1[e] = v[e] * BT[d * 64 + j]; t2v[e] = t1[e] * EG1[d * 64 + j]; }
        v4u o; o.x = pk2(t1[0], t1[1]); o.y = pk2(t1[2], t1[3]); o.z = pk2(t1[4], t1[5]); o.w = pk2(t1[6], t1[7]); *(LAS v4u*)(T12 + (d * 2 + 0) * 4608 + i * 72 + tg * 8) = o;
        o.x = pk2(t2v[0], t2v[1]); o.y = pk2(t2v[2], t2v[3]); o.z = pk2(t2v[4], t2v[5]); o.w = pk2(t2v[6], t2v[7]); *(LAS v4u*)(T12 + (d * 2 + 1) * 4608 + i * 72 + tg * 8) = o; }
    __syncthreads();
#pragma unroll 1
    for (int q = 0; q < 16; ++q) { const int tile = wave * 16 + q, d = tile >> 6, kind = (tile >> 5) & 1, ti = (tile >> 3) & 3, tc = tile & 7; f32x4 acc = {0.f, 0.f, 0.f, 0.f};
        unsigned char* go = gout + (size_t)d * GDN_UNIT;
        if (kind == 0) { acc = mma_tile(T12 + (d * 2 + 0) * 4608, 72, 16 * ti, VT, 72, 16 * tc, 64, acc, lane);
            v2u o; o.x = pk2(acc[0], acc[1]); o.y = pk2(acc[2], acc[3]); *(v2u*)(go + 57344 + ((16 * tc + fr) * 64 + 16 * ti + 4 * fq) * 2) = o; }
        else { acc = mma_tile(KT, 72, 16 * tc, T12 + (d * 2 + 1) * 4608, 72, 16 * ti, 64, acc, lane);
            v2u o; o.x = pk2(acc[0], acc[1]); o.y = pk2(acc[2], acc[3]); *(v2u*)(go + ((16 * ti + fr) * 128 + 16 * tc + 4 * fq) * 2) = o; } }
    __syncthreads();
    pf_sink(F, pf);
}
__device__ __forceinline__ void gmlp_item(Frame& F, int it) {
    const int g = it & 3, nc = (it >> 2) & 63, b = it >> 8; const size_t r0 = (size_t)b * T + (size_t)nc * 128;
    const bf16* UV = (const bf16*)(F.ws + WS_UV); bf16* MIX = (bf16*)(F.ws + WS_MIX);
    LAS bf16* VNT = (LAS bf16*)(F.lds); LAS bf16* WSB = (LAS bf16*)(F.lds + 34816);
    const int tid = F.tid, lane = F.lane, wave = F.wave;
    {
        const int t = tid >> 2, part = tid & 3; const bf16* vp = UV + (r0 + t) * 1024 + 512 + 128 * g + part * 32;
        float v[32]; float ss = 0.f;
#pragma unroll
        for (int q = 0; q < 4; ++q) { const v4u xw = *(const v4u*)(vp + 8 * q);
#pragma unroll
            for (int e = 0; e < 4; ++e) { v[8 * q + 2 * e] = bflo(xw[e]); v[8 * q + 2 * e + 1] = bfhi(xw[e]); ss += v[8 * q + 2 * e] * v[8 * q + 2 * e] + v[8 * q + 2 * e + 1] * v[8 * q + 2 * e + 1]; } }
        ss += __shfl_xor(ss, 1); ss += __shfl_xor(ss, 2);
        const float rstd = 1.0f / sqrtf(ss * (1.0f / 128.0f) + EPS); const float* gn = F.gm_norm_g + 128 * g + part * 32;
#pragma unroll
        for (int cc = 0; cc < 32; ++cc) VNT[(part * 32 + cc) * 136 + t] = (bf16)f2bf(v[cc] * rstd * gn[cc]);
        const float* wp = F.gm_ws + ((size_t)g * 128 + t) * 128 + part * 32;
#pragma unroll
        for (int q = 0; q < 4; ++q) { const f32x4 w0 = *(const f32x4*)(wp + 8 * q), w1 = *(const f32x4*)(wp + 8 * q + 4); v4u o; o.x = pk2(w0.x, w0.y); o.y = pk2(w0.z, w0.w); o.z = pk2(w1.x, w1.y); o.w = pk2(w1.z, w1.w);
            *(LAS v4u*)(WSB + t * 136 + part * 32 + 8 * q) = o; }
    }
    __syncthreads();
    const PF pf = p3_prefetch(F, it + 1056 + F.G);
    {
        const int td = wave, fr = lane & 15, fq = lane >> 4;
#pragma unroll 1
        for (int tt = 0; tt < 8; ++tt) { f32x4 acc = {0.f, 0.f, 0.f, 0.f}; acc = mma_tile(VNT, 136, 16 * td, WSB, 136, 16 * tt, 128, acc, lane);
            const int tl = 16 * tt + fr; const size_t off = (r0 + tl) * 1024 + 128 * g + 16 * td + 4 * fq; const float bsv = F.gm_bs[g * 128 + tl];
            const v2u uw = *(const v2u*)(UV + off); v2u o;
            o.x = pk2(bflo(uw.x) * (acc[0] + bsv), bfhi(uw.x) * (acc[1] + bsv)); o.y = pk2(bflo(uw.y) * (acc[2] + bsv), bfhi(uw.y) * (acc[3] + bsv));
            *(v2u*)(MIX + off) = o; }
    }
    __syncthreads();
    pf_sink(F, pf);
}
__device__ __forceinline__ void p3_phase(Frame& F) {
    for (int it = F.vcu; it < 1056 + 512; it += F.G) { if (it < 1056) gdn_item(F, it); else gmlp_item(F, it - 1056); }
}
constexpr size_t WS_CB = 112 * MiB;
constexpr size_t WS_ZT = 136 * MiB;
constexpr size_t WS_XB = 140 * MiB;
__device__ __forceinline__ void p4_scan(Frame& F) {
    const int j14 = F.vcu & 31;
    if (j14 >= 28) return;
    const int chain = 2 * (F.vcu >> 5) + (j14 >= 14 ? 1 : 0), role = j14 % 14;
    const int g = role < 2 ? 0 : 1 + ((role - 2) >> 2), kindP = role < 2 ? 0 : ((role - 2) >> 1) & 1, ch = role < 2 ? role : (role - 2) & 1;
    const int b = chain >> 3, h = (chain >> 1) & 3, d = chain & 1, c0 = ch * 64;
    const int NS = g == 0 ? 36 : 32;
    constexpr int BUFB = 57344, ST_OFF = 2 * BUFB, VNT_OFF = ST_OFF + 64 * 288;
    const unsigned char* gdn = F.ws + WS_GDN; const float* EGL = (const float*)(F.ws + WS_EGL);
    const int lane = F.lane, wave = F.wave;
#define P4_SLOT(s) (g == 0 ? ((s) < 4 ? 1024 + (b * 4 + h) * 4 + (d ? 3 - (s) : (s)) : (b * 4 + h) * 128 + (d ? 127 - ((s) - 4) : ((s) - 4))) : (b * 4 + h) * 128 + (d ? 127 - (32 * g + (s)) : (32 * g + (s))))
#define P4_BAR() do { asm volatile("s_waitcnt lgkmcnt(0)" ::: "memory"); __builtin_amdgcn_s_barrier(); asm volatile("" ::: "memory"); } while (0)
    if (wave >= 4) {
        const int lw = wave - 4;
#define P4_ISSUE(s, bufi) do { const unsigned char* gb = gdn + (size_t)(P4_SLOT(s) * 2 + d) * GDN_UNIT; \
            _Pragma("unroll") for (int q = 0; q < 14; ++q) { const int k = lw + 4 * q; unsigned so; \
                if (k < 32) { const int qi = (k & 15) * 64 + lane, r = qi >> 4, sl = qi & 15; so = (unsigned)((k >> 4) * 16384 + r * 256 + ((sl ^ (r & 15)) << 4)); } \
                else { const int kk = k < 48 ? k - 32 : k - 48, qi = kk * 64 + lane, r = qi >> 3, sl = qi & 7; so = (unsigned)((k < 48 ? 32768 : 49152) + r * 128 + ((sl ^ ((r >> 1) & 7)) << 4)); } \
                __builtin_amdgcn_global_load_lds((const unsigned*)(gb + so), (LAS unsigned*)(F.lds + (bufi) * BUFB + k * 1024), 16, 0, 0); } } while (0)
        P4_ISSUE(0, 0);
        VM_WAIT(); P4_BAR();
#pragma unroll 1
        for (int s = 0; s < NS; ++s) {
            const int cur = s & 1;
            if (s + 1 < NS) P4_ISSUE(s + 1, cur ^ 1);
            P4_BAR();
            VM_WAIT();
            P4_BAR();
        }
#undef P4_ISSUE
    } else {
        const int m = wave, fr = lane & 15, fq = lane >> 4;
        for (int i = F.tid; i < 64 * 72; i += 256) { const int c = i / 72, w4 = i % 72;
            unsigned v = 0u; if (kindP) { const int dk = c0 + c; if ((dk >> 1) == w4) v = (dk & 1) ? 0x3F800000u : 0x00003F80u; }
            ((LAS unsigned*)(F.lds + ST_OFF))[i] = v; }
        f32x4 S[2][4];
#pragma unroll
        for (int t2 = 0; t2 < 2; ++t2)
#pragma unroll
            for (int n = 0; n < 4; ++n) {
#pragma unroll
                for (int jj = 0; jj < 4; ++jj) S[t2][n][jj] = (kindP && (32 * m + 16 * t2 + 4 * fq + jj == c0 + 16 * n + fr)) ? 1.0f : 0.0f; }
        bf16* OD = (bf16*)(F.ws + (d ? WS_OB : WS_OF)); bf16* CB = (bf16*)(F.ws + WS_CB);
        v2u un[4]; float egn;
        { const int sl = P4_SLOT(0); const unsigned char* gb = gdn + (size_t)(sl * 2 + d) * GDN_UNIT;
#pragma unroll
          for (int n = 0; n < 4; ++n) un[n] = kindP ? (v2u){0u, 0u} : *(const v2u*)(gb + 57344 + ((c0 + 16 * n + fr) * 64 + 16 * m + 4 * fq) * 2);
          egn = EGL[sl * 2 + d]; }
        P4_BAR();
#pragma unroll 1
        for (int s = 0; s < NS; ++s) {
            const int cur = s & 1; const LAS unsigned char* buf = F.lds + cur * BUFB; LAS unsigned char* ST = F.lds + ST_OFF; LAS unsigned char* VNT = F.lds + VNT_OFF;
            v2u uc[4];
#pragma unroll
            for (int n = 0; n < 4; ++n) uc[n] = un[n];
            const float eg = egn;
            if (s + 1 < NS) { const int sl = P4_SLOT(s + 1); const unsigned char* gb = gdn + (size_t)(sl * 2 + d) * GDN_UNIT;
                if (!kindP) {
#pragma unroll
                    for (int n = 0; n < 4; ++n) un[n] = *(const v2u*)(gb + 57344 + ((c0 + 16 * n + fr) * 64 + 16 * m + 4 * fq) * 2); }
                egn = EGL[sl * 2 + d]; }
            bf16x8 bS[4][4]; f32x4 acc[4];
#pragma unroll
            for (int n = 0; n < 4; ++n) acc[n] = (f32x4){0.f, 0.f, 0.f, 0.f};
            const int r = 16 * m + fr;
#pragma unroll
            for (int ks = 0; ks < 4; ++ks) { const bf16x8 a = *(const LAS bf16x8*)(buf + r * 256 + (((4 * ks + fq) ^ fr) << 4));
#pragma unroll
                for (int n = 0; n < 4; ++n) { bS[n][ks] = *(const LAS bf16x8*)(ST + (16 * n + fr) * 288 + (32 * ks + 8 * fq) * 2); acc[n] = __builtin_amdgcn_mfma_f32_16x16x32_bf16(a, bS[n][ks], acc[n], 0, 0, 0); } }
#pragma unroll
            for (int n = 0; n < 4; ++n) { const float v0 = bflo(uc[n].x) - acc[n][0], v1 = bfhi(uc[n].x) - acc[n][1], v2 = bflo(uc[n].y) - acc[n][2], v3 = bfhi(uc[n].y) - acc[n][3]; v2u o; o.x = pk2(v0, v1); o.y = pk2(v2, v3);
                *(LAS v2u*)(VNT + (16 * n + fr) * 160 + (16 * m + 4 * fq) * 2) = o; }
            P4_BAR();
            bf16x8 bV[4][2];
#pragma unroll
            for (int n = 0; n < 4; ++n)
#pragma unroll
                for (int ks = 0; ks < 2; ++ks) bV[n][ks] = *(const LAS bf16x8*)(VNT + (16 * n + fr) * 160 + (32 * ks + 8 * fq) * 2);
            if (g > 0 || s >= 4) {
                f32x4 o[4];
#pragma unroll
                for (int n = 0; n < 4; ++n) o[n] = (f32x4){0.f, 0.f, 0.f, 0.f};
#pragma unroll
                for (int ks = 0; ks < 4; ++ks) { const bf16x8 a = *(const LAS bf16x8*)(buf + 16384 + r * 256 + (((4 * ks + fq) ^ fr) << 4));
#pragma unroll
                    for (int n = 0; n < 4; ++n) o[n] = __builtin_amdgcn_mfma_f32_16x16x32_bf16(a, bS[n][ks], o[n], 0, 0, 0); }
#pragma unroll
                for (int ks = 0; ks < 2; ++ks) { const bf16x8 a = *(const LAS bf16x8*)(buf + 49152 + r * 128 + (((4 * ks + fq) ^ ((r >> 1) & 7)) << 4));
#pragma unroll
                    for (int n = 0; n < 4; ++n) o[n] = __builtin_amdgcn_mfma_f32_16x16x32_bf16(a, bV[n][ks], o[n], 0, 0, 0); }
                const int sp = g == 0 ? s - 4 : 32 * g + s;
                if (kindP) { bf16* cb = CB + ((size_t)(chain * 96 + (sp - 32)) * 64) * 128;
#pragma unroll
                    for (int n = 0; n < 4; ++n)
#pragma unroll
                        for (int jj = 0; jj < 4; ++jj) cb[(16 * m + 4 * fq + jj) * 128 + c0 + 16 * n + fr] = (bf16)f2bf(o[n][jj]); }
                else { const int nn = d ? 127 - sp : sp;
#pragma unroll
                    for (int n = 0; n < 4; ++n)
#pragma unroll
                        for (int jj = 0; jj < 4; ++jj) { const int i = 16 * m + 4 * fq + jj, tl = d ? 63 - i : i; OD[((size_t)b * T + 64 * nn + tl) * 512 + h * 128 + c0 + 16 * n + fr] = (bf16)f2bf(o[n][jj]); } }
            }
#pragma unroll
            for (int t2 = 0; t2 < 2; ++t2)
#pragma unroll
                for (int n = 0; n < 4; ++n) S[t2][n] *= eg;
#pragma unroll
            for (int ks = 0; ks < 2; ++ks)
#pragma unroll
                for (int t2 = 0; t2 < 2; ++t2) { const int rr = 32 * m + 16 * t2 + fr; const bf16x8 a = *(const LAS bf16x8*)(buf + 32768 + rr * 128 + (((4 * ks + fq) ^ ((rr >> 1) & 7)) << 4));
#pragma unroll
                    for (int n = 0; n < 4; ++n) S[t2][n] = __builtin_amdgcn_mfma_f32_16x16x32_bf16(a, bV[n][ks], S[t2][n], 0, 0, 0); }
#pragma unroll
            for (int t2 = 0; t2 < 2; ++t2)
#pragma unroll
                for (int n = 0; n < 4; ++n) { v2u o; o.x = pk2(S[t2][n][0], S[t2][n][1]); o.y = pk2(S[t2][n][2], S[t2][n][3]); *(LAS v2u*)(ST + (16 * n + fr) * 288 + (32 * m + 16 * t2 + 4 * fq) * 2) = o; }
            P4_BAR();
        }
        if (g < 3 && !kindP) { float* zt = (float*)(F.ws + WS_ZT) + (size_t)(chain * 4 + g) * 16384;
#pragma unroll
            for (int t2 = 0; t2 < 2; ++t2)
#pragma unroll
                for (int n = 0; n < 4; ++n) *(f32x4*)(zt + (c0 + 16 * n + fr) * 128 + 32 * m + 16 * t2 + 4 * fq) = S[t2][n]; }
        if (kindP && g < 3) { bf16* xb = (bf16*)(F.ws + WS_XB) + (size_t)(chain * 4 + g) * 16384;
#pragma unroll
            for (int t2 = 0; t2 < 2; ++t2)
#pragma unroll
                for (int n = 0; n < 4; ++n)
#pragma unroll
                    for (int jj = 0; jj < 4; ++jj) xb[(32 * m + 16 * t2 + 4 * fq + jj) * 128 + c0 + 16 * n + fr] = (bf16)f2bf(S[t2][n][jj]); }
    }
#undef P4_SLOT
#undef P4_BAR
}
__device__ __forceinline__ void p4b_correct(Frame& F) {
    if (F.vcu >= 192) return;
    const int chain = F.vcu / 12, g = 1 + (F.vcu % 12) / 4, qt = F.vcu & 3;
    const int b = chain >> 3, h = (chain >> 1) & 3, d = chain & 1;
    LAS bf16* Y = (LAS bf16*)F.lds;
    LAS bf16* Y2 = (LAS bf16*)(F.lds + 34816);
    LAS bf16* XL = (LAS bf16*)(F.lds + 69632);
    const float* ZT = (const float*)(F.ws + WS_ZT) + (size_t)chain * 4 * 16384; const bf16* XB = (const bf16*)(F.ws + WS_XB) + (size_t)chain * 4 * 16384;
    const int tid = F.tid, lane = F.lane, wave = F.wave, fr = lane & 15, fq = lane >> 4;
    for (int q = tid; q < 128 * 32; q += 512) { const int c = q >> 5, k4 = q & 31; const f32x4 z = *(const f32x4*)(ZT + c * 128 + 4 * k4); v2u o; o.x = pk2(z.x, z.y); o.y = pk2(z.z, z.w); *(LAS v2u*)(Y + c * 136 + 4 * k4) = o; }
    __syncthreads();
    LAS bf16* Yc = Y; LAS bf16* Yn = Y2;
#pragma unroll 1
    for (int gg = 1; gg < g; ++gg) {
        for (int q = tid; q < 128 * 16; q += 512) { const int rr = q >> 4, k8 = q & 15; *(LAS v4u*)(XL + rr * 136 + 8 * k8) = *(const v4u*)(XB + (size_t)gg * 16384 + rr * 128 + 8 * k8); }
        __syncthreads();
#pragma unroll 1
        for (int tn = 0; tn < 8; ++tn) { f32x4 acc = {0.f, 0.f, 0.f, 0.f}; acc = mma_tile(Yc, 136, 16 * wave, XL, 136, 16 * tn, 128, acc, lane);
#pragma unroll
            for (int jj = 0; jj < 4; ++jj) { const int col = 16 * wave + 4 * fq + jj, dk = 16 * tn + fr; Yn[col * 136 + dk] = (bf16)f2bf(acc[jj] + ZT[(size_t)gg * 16384 + col * 128 + dk]); } }
        __syncthreads();
        LAS bf16* t_ = Yc; Yc = Yn; Yn = t_;
    }
    bf16* OD = (bf16*)(F.ws + (d ? WS_OB : WS_OF)); const bf16* CB = (const bf16*)(F.ws + WS_CB);
#pragma unroll 1
    for (int cc = 0; cc < 8; ++cc) {
        const int sp = 32 * g + 8 * qt + cc, nn = d ? 127 - sp : sp; const bf16* cb = CB + ((size_t)(chain * 96 + (sp - 32)) * 64) * 128;
        for (int q = tid; q < 64 * 16; q += 512) { const int rr = q >> 4, k8 = q & 15; *(LAS v4u*)(XL + rr * 136 + 8 * k8) = *(const v4u*)(cb + rr * 128 + 8 * k8); }
        __syncthreads();
#pragma unroll 1
        for (int ti = 0; ti < 4; ++ti) { f32x4 acc = {0.f, 0.f, 0.f, 0.f}; acc = mma_tile(XL, 136, 16 * ti, Yc, 136, 16 * wave, 128, acc, lane);
#pragma unroll
            for (int jj = 0; jj < 4; ++jj) { const int i = 16 * ti + 4 * fq + jj, tl = d ? 63 - i : i; bf16* p = OD + ((size_t)b * T + 64 * nn + tl) * 512 + h * 128 + 16 * wave + fr; *p = (bf16)f2bf(bf1(*p) + acc[jj]); } }
        __syncthreads();
    }
}
__device__ __forceinline__ void p5a_combine(Frame& F) {
    const bf16* OFp = (const bf16*)(F.ws + WS_OF); const bf16* OBp = (const bf16*)(F.ws + WS_OB); const bf16* Z = (const bf16*)(F.ws + WS_Z); bf16* MIX = (bf16*)(F.ws + WS_MIX);
    const int gw = F.vcu * NWAVES + F.wave, NGW = F.G * NWAVES, lane = F.lane;
    float gn[8];
#pragma unroll
    for (int e = 0; e < 8; ++e) gn[e] = F.gdn_norm_g[(lane & 15) * 8 + e];
    for (int m = gw; m < M; m += NGW) {
        const v4u a = *(const v4u*)(OFp + (size_t)m * 512 + lane * 8), bq = *(const v4u*)(OBp + (size_t)m * 512 + lane * 8), zz = *(const v4u*)(Z + (size_t)m * 512 + lane * 8);
        float o[8]; float ss = 0.f;
#pragma unroll
        for (int e = 0; e < 4; ++e) { o[2 * e] = bflo(a[e]) + bflo(bq[e]); o[2 * e + 1] = bfhi(a[e]) + bfhi(bq[e]); ss += o[2 * e] * o[2 * e] + o[2 * e + 1] * o[2 * e + 1]; }
        ss += __shfl_xor(ss, 1); ss += __shfl_xor(ss, 2); ss += __shfl_xor(ss, 4); ss += __shfl_xor(ss, 8);
        const float rstd = 1.0f / sqrtf(ss * (1.0f / 128.0f) + EPS);
        float y[8];
#pragma unroll
        for (int e = 0; e < 4; ++e) { y[2 * e] = o[2 * e] * rstd * gn[2 * e] * silu1(bflo(zz[e])); y[2 * e + 1] = o[2 * e + 1] * rstd * gn[2 * e + 1] * silu1(bfhi(zz[e])); }
        v4u w; w.x = pk2(y[0], y[1]); w.y = pk2(y[2], y[3]); w.z = pk2(y[4], y[5]); w.w = pk2(y[6], y[7]);
        *(v4u*)(MIX + (size_t)m * 1024 + 512 + lane * 8) = w;
    }
}
__device__ __forceinline__ void p6_phase(Frame& F) {
    const float* MOD = (const float*)(F.ws + WS_MOD); const float* H1 = (const float*)(F.ws + WS_H1); bf16* FIN = (bf16*)(F.ws + WS_FIN);
    float* AFF = (float*)(F.ws + WS_AFF); int* SEL = (int*)(F.ws + WS_SEL);
    LAS float* WR = (LAS float*)F.lds;
    for (int i = F.tid; i < 1024 * 4; i += 512) { const int k = i >> 2, q = i & 3; *(LAS f32x4*)(WR + k * 20 + q * 4) = *(const f32x4*)(F.w_router + k * 16 + q * 4); }
    __syncthreads();
    const int gw = F.vcu * NWAVES + F.wave, NGW = F.G * NWAVES, lane = F.lane;
#pragma unroll 1
    for (int b = 0; b < 2; ++b) {
        const float* mv = MOD + b * 6144;
        float sc[16], sh[16];
#pragma unroll
        for (int j = 0; j < 16; ++j) { const int k = lane + 64 * j; sc[j] = F.norm2_g[k] * (1.0f + mv[4096 + k]); sh[j] = mv[3072 + k]; }
        for (int m = b * T + gw; m < (b + 1) * T; m += NGW) {
            const float* hr = H1 + (size_t)m * D; float v[16]; float ss = 0.f;
#pragma unroll
            for (int j = 0; j < 16; ++j) { v[j] = hr[lane + 64 * j]; ss += v[j] * v[j]; }
            const float rstd = 1.0f / sqrtf(wave_sum(ss) * (1.0f / D) + EPS);
            float lg[16];
#pragma unroll
            for (int e = 0; e < 16; ++e) lg[e] = 0.f;
            bf16* fr_ = FIN + (size_t)m * D;
#pragma unroll
            for (int j = 0; j < 16; ++j) { const float f = v[j] * rstd * sc[j] + sh[j]; fr_[lane + 64 * j] = (bf16)f2bf(f);
                const LAS float* wr = WR + (lane + 64 * j) * 20;
#pragma unroll
                for (int q = 0; q < 4; ++q) { const f32x4 w = *(const LAS f32x4*)(wr + 4 * q); lg[4 * q] += f * w.x; lg[4 * q + 1] += f * w.y; lg[4 * q + 2] += f * w.z; lg[4 * q + 3] += f * w.w; }
                asm volatile("" ::: "memory"); }
            float mx = -3.0e38f;
#pragma unroll
            for (int e = 0; e < 16; ++e) { lg[e] = wave_sum(lg[e]) + F.b_router[e]; mx = fmaxf(mx, lg[e]); }
            float den = 0.f;
#pragma unroll
            for (int e = 0; e < 16; ++e) { lg[e] = expf(lg[e] - mx); den += lg[e]; }
            float mine = 0.f;
#pragma unroll
            for (int e = 0; e < 16; ++e) mine = (lane == e) ? lg[e] : mine;
            if (lane < 16) { AFF[((size_t)b * 16 + lane) * T + (m - b * T)] = mine / den; SEL[(size_t)m * 16 + lane] = -1; }
        }
    }
}
__device__ __forceinline__ int block_excl_scan(int v, LAS int* tmp, int lane, int wave, int& total) {
    int inc = v;
#pragma unroll
    for (int o = 1; o < 64; o <<= 1) { const int y = __shfl_up(inc, o); if (lane >= o) inc += y; }
    if (lane == 63) tmp[wave] = inc;
    __syncthreads();
    int woff = 0, tot = 0;
#pragma unroll
    for (int w = 0; w < 8; ++w) { const int sv = tmp[w]; woff += (w < wave) ? sv : 0; tot += sv; }
    __syncthreads();
    total = tot; return woff + inc - v;
}
__device__ __forceinline__ void p7_topk(Frame& F) {
    const float* AFF = (const float*)(F.ws + WS_AFF); int* SEL = (int*)(F.ws + WS_SEL); int* IDX = (int*)(F.ws + WS_IDX); float* GATE = (float*)(F.ws + WS_GATE);
    LAS unsigned* vals = (LAS unsigned*)F.lds;
    LAS unsigned* hist = vals + 8192;
    LAS int* tmp = (LAS int*)(hist + 256);
    const int tid = F.tid, lane = F.lane, wave = F.wave;
    for (int u = F.vcu; u < 32; u += F.G) {
        const int b = u >> 4, e = u & 15; const float* ar = AFF + (size_t)u * T;
        for (int t = tid; t < T; t += 512) vals[t] = __builtin_bit_cast(unsigned, ar[t]);
        if (tid == 0) { tmp[8] = 0; tmp[9] = CAP; }
        __syncthreads();
#pragma unroll 1
        for (int pass = 0; pass < 4; ++pass) {
            const int shift = 24 - 8 * pass;
            if (tid < 256) hist[tid] = 0u;
            __syncthreads();
            const unsigned prefix = (unsigned)tmp[8], himask = pass == 0 ? 0u : (0xffffffffu << (shift + 8));
            for (int t = tid; t < T; t += 512) { const unsigned v = vals[t]; if ((v & himask) == prefix) __hip_atomic_fetch_add(hist + ((v >> shift) & 255u), 1u, __ATOMIC_RELAXED, __HIP_MEMORY_SCOPE_WORKGROUP); }
            __syncthreads();
            if (wave == 0) {
                const unsigned kth = (unsigned)tmp[9];
                const unsigned c0 = hist[255 - 4 * lane], c1 = hist[254 - 4 * lane], c2 = hist[253 - 4 * lane], c3 = hist[252 - 4 * lane], sm = c0 + c1 + c2 + c3;
                unsigned inc = sm;
#pragma unroll
                for (int o = 1; o < 64; o <<= 1) { const unsigned y = __shfl_up(inc, o); if (lane >= o) inc += y; }
                const unsigned exc = inc - sm;
                if (exc < kth && kth <= inc) { unsigned r = kth - exc; int bin;
                    if (r <= c0) bin = 255 - 4 * lane; else if (r <= c0 + c1) { bin = 254 - 4 * lane; r -= c0; } else if (r <= c0 + c1 + c2) { bin = 253 - 4 * lane; r -= c0 + c1; } else { bin = 252 - 4 * lane; r -= c0 + c1 + c2; }
                    tmp[8] = (int)(prefix | ((unsigned)bin << shift)); tmp[9] = (int)r; }
            }
            __syncthreads();
        }
        const unsigned thr = (unsigned)tmp[8]; const int kth = tmp[9];
        const int t0 = tid * 16; int cg = 0, ce = 0;
#pragma unroll
        for (int i = 0; i < 16; ++i) { const unsigned v = vals[t0 + i]; cg += (v > thr) ? 1 : 0; ce += (v == thr) ? 1 : 0; }
        int tot; const int eqb = block_excl_scan(ce, tmp, lane, wave, tot);
        int take = kth - eqb; take = take < 0 ? 0 : (take > ce ? ce : take);
        int pos = block_excl_scan(cg + take, tmp, lane, wave, tot); int eqseen = 0;
#pragma unroll 1
        for (int i = 0; i < 16; ++i) { const unsigned v = vals[t0 + i]; bool sel = v > thr; if (v == thr) { sel = eqseen < take; ++eqseen; }
            if (sel) { const int t = t0 + i; IDX[u * CAP + pos] = b * T + t; GATE[u * CAP + pos] = __builtin_bit_cast(float, v); SEL[((size_t)b * T + t) * 16 + e] = pos; ++pos; } }
        __syncthreads();
    }
}
__device__ __forceinline__ void p7b_gather(Frame& F) {
    const int* IDX = (const int*)(F.ws + WS_IDX); const bf16* FIN = (const bf16*)(F.ws + WS_FIN); bf16* XE = (bf16*)(F.ws + WS_XE);
    const int gw = F.vcu * NWAVES + F.wave, NGW = F.G * NWAVES, lane = F.lane;
    for (int r = gw; r < 32 * CAP; r += NGW) { const int src = IDX[r]; const v4u* sp = (const v4u*)(FIN + (size_t)src * D); v4u* dp = (v4u*)(XE + (size_t)r * D);
        const v4u a = sp[lane], c = sp[lane + 64]; dp[lane] = a; dp[lane + 64] = c; }
}
__device__ __forceinline__ void p10_final(Frame& F) {
    const float* MOD = (const float*)(F.ws + WS_MOD); const float* H1 = (const float*)(F.ws + WS_H1); const bf16* YE = (const bf16*)(F.ws + WS_YE); const int* SEL = (const int*)(F.ws + WS_SEL);
    const int gw = F.vcu * NWAVES + F.wave, NGW = F.G * NWAVES, lane = F.lane;
#pragma unroll 1
    for (int b = 0; b < 2; ++b) {
        f32x4 gt[4], fg[4];
#pragma unroll
        for (int j = 0; j < 4; ++j) { gt[j] = *(const f32x4*)(MOD + b * 6144 + 5120 + 4 * lane + 256 * j); fg[j] = *(const f32x4*)(F.final_norm_g + 4 * lane + 256 * j); }
        for (int m = b * T + gw; m < (b + 1) * T; m += NGW) {
            const int selv = lane < 16 ? SEL[(size_t)m * 16 + lane] : -1;
            f32x4 acc[4];
#pragma unroll
            for (int j = 0; j < 4; ++j) acc[j] = (f32x4){0.f, 0.f, 0.f, 0.f};
#pragma unroll 1
            for (int e = 0; e < 16; ++e) { const int cpos = __shfl(selv, e);
                if (cpos >= 0) { const bf16* yr = YE + ((size_t)(b * 16 + e) * CAP + cpos) * D + 4 * lane;
#pragma unroll
                    for (int j = 0; j < 4; ++j) { const v2u w = *(const v2u*)(yr + 256 * j); acc[j] += (f32x4){bflo(w.x), bfhi(w.x), bflo(w.y), bfhi(w.y)}; } } }
            f32x4 hv[4]; float ss = 0.f;
#pragma unroll
            for (int j = 0; j < 4; ++j) { hv[j] = *(const f32x4*)(H1 + (size_t)m * D + 4 * lane + 256 * j) + gt[j] * acc[j]; ss += (hv[j].x * hv[j].x + hv[j].y * hv[j].y) + (hv[j].z * hv[j].z + hv[j].w * hv[j].w); }
            const float rstd = 1.0f / sqrtf(wave_sum(ss) * (1.0f / D) + EPS);
#pragma unroll
            for (int j = 0; j < 4; ++j) *(f32x4*)(F.out + (size_t)m * D + 4 * lane + 256 * j) = hv[j] * rstd * fg[j];
        }
    }
}
struct Args { const float* in[23]; float* out; unsigned char* ws; int ph_lo, ph_hi; };
__global__ void __launch_bounds__(NWAVES * 64, 2) fwd_kernel(Args args) {
    extern __shared__ __attribute__((aligned(16))) unsigned char lds_raw[];
    Frame F;
    F.lds = (LAS unsigned char*)lds_raw;
    volatile LAS unsigned* MISC = (volatile LAS unsigned*)(F.lds + MISC_OFF);
    F.tid = threadIdx.x; F.lane = F.tid & 63; F.wave = __builtin_amdgcn_readfirstlane(F.tid >> 6);
    F.G = gridDim.x; { const int bx = blockIdx.x; F.vcu = (F.G % 8 == 0) ? (bx % 8) * (F.G / 8) + bx / 8 : bx; }
    F.ws = args.ws; F.out = args.out;
    F.x = args.in[0]; F.c = args.in[1]; F.ctx = args.in[2]; F.c_ctx = args.in[3]; F.w_mod = args.in[4]; F.b_mod = args.in[5]; F.norm1_g = args.in[6]; F.norm2_g = args.in[7];
    F.w_in = args.in[8]; F.conv_w = args.in[9]; F.a_log = args.in[10]; F.dt_bias = args.in[11]; F.gdn_norm_g = args.in[12]; F.gm_norm_g = args.in[13]; F.gm_ws = args.in[14]; F.gm_bs = args.in[15];
    F.w_out = args.in[16]; F.w_router = args.in[17]; F.b_router = args.in[18]; F.w_gate = args.in[19]; F.w_up = args.in[20]; F.w_down = args.in[21]; F.final_norm_g = args.in[22];
    for (int u = F.tid; u < 64; u += NWAVES * 64) MISC[u] = 0u;
    __syncthreads();
    XcdBarrier bar; bar.bar = (unsigned*)(F.ws + WS_CTL) + CW_BAR; bar.x = 0; bar.st = nullptr;
    if (!MK_PER_PHASE) bar = xcd_barrier_post((unsigned*)(F.ws + WS_CTL) + CW_BAR, MISC + 8);
    const int lo = args.ph_lo, hi = args.ph_hi;
#define IN(k) (lo <= (k) && (k) < hi)
#define SEAM(k) do { if (IN(k) && IN((k) + 1)) xcd_barrier(bar); } while (0)
    if (IN(0)) { p0_phase(F); } SEAM(0);
    if (IN(1)) { p1_phase(F); } SEAM(1);
    if (IN(2)) {
        pg8::Gemm g{(const bf16*)(F.ws + WS_AIN), (const bf16*)(F.ws + WS_WIN), MA, 3328, D, 0, 0, 0}; pg8::StaticOrder S; S.init(MA, 3328, F.G, (int)blockIdx.x);
        pg8::EpiInProj E{(bf16*)(F.ws + WS_QKV), (bf16*)(F.ws + WS_Z), (bf16*)(F.ws + WS_UV), (float*)(F.ws + WS_AB)};
        pg8::gemm_phase<pg8::EpiInProj, pg8::StaticOrder, PG8_ALIGN, PG8_SP2>(F.lds, g, S, E);
    } SEAM(2);
    if (IN(3)) { p3_phase(F); } SEAM(3);
    if (IN(4)) { p4_scan(F); } SEAM(4);
    if (IN(5)) { p4b_correct(F); } SEAM(5);
    if (IN(6)) { p5a_combine(F); wgu_convert(F); } SEAM(6);
    if (IN(7)) {
        pg8::Gemm g{(const bf16*)(F.ws + WS_MIX), (const bf16*)(F.ws + WS_WOUT), M, D, D, 0, 0, 0}; pg8::StaticOrder S; S.init(M, D, F.G, (int)blockIdx.x);
        pg8::EpiOutProj E{F.x, (const float*)(F.ws + WS_MOD), (float*)(F.ws + WS_H1)};
        pg8::gemm_phase<pg8::EpiOutProj, pg8::StaticOrder, PG8_ALIGN, PG8_SP2>(F.lds, g, S, E);
    } SEAM(7);
    if (IN(8)) { p6_phase(F); } SEAM(8);
    if (IN(9)) { p7_topk(F); } SEAM(9);
    if (IN(10)) { p7b_gather(F); } SEAM(10);
    if (IN(11)) {
        pg8::Gemm g{(const bf16*)(F.ws + WS_XE), (const bf16*)(F.ws + WS_WGU), 32 * CAP, 2 * FF, D, (size_t)2 * FF * D * 2, 2, 15}; pg8::StaticOrder S; S.init(32 * CAP, 2 * FF, F.G, (int)blockIdx.x);
        pg8::EpiSwiGLU E{(bf16*)(F.ws + WS_HID)};
        pg8::gemm_phase<pg8::EpiSwiGLU, pg8::StaticOrder, PG8_ALIGN, PG8_SP2>(F.lds, g, S, E);
    } SEAM(11);
    if (IN(12)) { wd_convert(F); } SEAM(12);
    if (IN(13)) {
        pg8::Gemm g{(const bf16*)(F.ws + WS_HID), (const bf16*)(F.ws + WS_WD), 32 * CAP, D, FF, (size_t)D * FF * 2, 2, 15}; pg8::StaticOrder S; S.init(32 * CAP, D, F.G, (int)blockIdx.x);
        pg8::EpiDown E{(bf16*)(F.ws + WS_YE), (const float*)(F.ws + WS_GATE)};
        pg8::gemm_phase<pg8::EpiDown, pg8::StaticOrder, PG8_ALIGN, PG8_SP2>(F.lds, g, S, E);
    } SEAM(13);
    if (IN(14)) { p10_final(F); }
#undef IN
#undef SEAM
}

extern "C" void kernel_launch(void* const* d_in, const int* in_sizes, int n_in, void* d_out, int out_size, void* d_ws, size_t ws_size, hipStream_t stream) {
    static int grid = 0;
    if (grid == 0) {
        if (n_in != 23 || out_size != M * D || ws_size < WS_END) { fprintf(stderr, "kernel_launch: unexpected problem (n_in %d, out %d, ws %zu)\n", n_in, out_size, ws_size); grid = -1; return; }
        int dev = 0, cus = 0;
        if (hipGetDevice(&dev) != hipSuccess || hipDeviceGetAttribute(&cus, hipDeviceAttributeMultiprocessorCount, dev) != hipSuccess) { grid = -1; return; }
        if (hipFuncSetAttribute((const void*)fwd_kernel, hipFuncAttributeMaxDynamicSharedMemorySize, LDS_BYTES) != hipSuccess) { fprintf(stderr, "kernel_launch: hipFuncSetAttribute failed\n"); grid = -1; return; }
        grid = cus;
    }
    if (grid < 0) return;
    if (hipMemsetAsync((char*)d_ws + WS_CTL, 0, CTL_ZERO_BYTES, stream) != hipSuccess) return;
    Args a{};
    for (int i = 0; i < 23; ++i) a.in[i] = (const float*)d_in[i];
    a.out = (float*)d_out; a.ws = (unsigned char*)d_ws;
#if MK_PER_PHASE
    for (int p = 0; p < NPHASE; ++p) { a.ph_lo = p; a.ph_hi = p + 1; hipLaunchKernelGGL(fwd_kernel, dim3(grid), dim3(NWAVES * 64), LDS_BYTES, stream, a); }
#else
    a.ph_lo = 0; a.ph_hi = NPHASE;
    hipLaunchKernelGGL(fwd_kernel, dim3(grid), dim3(NWAVES * 64), LDS_BYTES, stream, a);
#endif
}
```

```cpp
#include <hip/hip_runtime.h>
#include <cstdio>
#include <cstdint>
namespace pg8 {
#define PG8_LAS __attribute__((address_space(3)))
typedef unsigned short bf16_t;
typedef short bf16x8 __attribute__((ext_vector_type(8)));
typedef float f32x4 __attribute__((ext_vector_type(4)));
typedef unsigned u32x4 __attribute__((ext_vector_type(4)));
constexpr int BM = 256, BK = 64, HALF = 128, HTB = HALF * BK * 2  , STAGE_BYTES = 8 * HTB, NXCD = 8, WGM = 8;

__host__ __device__ __forceinline__ int lds_byte(int r, int c) { const int st = (r >> 4) * 2 + (c >> 5), rr = r & 15, cc = c & 31, ob = rr * 64 + cc * 2; return st * 1024 + (ob ^ (((ob >> 9) & 1) << 5)); }
__host__ __device__ __forceinline__ void stage_rc(int b, int& R, int& C) { const int st = b / 1024, sb = b % 1024, swz = sb ^ (((sb >> 9) & 1) << 5); R = (st >> 1) * 16 + swz / 64; C = (st & 1) * 32 + (swz % 64) / 2; }
__host__ __device__ __forceinline__ int perm32(int rho) { const int n = rho >> 4, i = rho & 15; return 8 * (i >> 2) + 4 * n + (i & 3); }

struct Unit { int pm, pn; };
struct Gemm { const bf16_t* A; const bf16_t* Bt; int M, N, K; size_t bgs; int gsh, gmask; };

struct StaticOrder {
    int nM, nN, nwg, G, c;
    __host__ __device__ void init(int M, int N, int G_, int c_) { nM = M / BM; nN = N / BM; nwg = nM * nN; G = G_; c = c_; }
    __host__ __device__ bool next(int i, Unit& u) const {
        const long L = (long)i * G + c; if (L >= nwg) return false;
        int wgid = (int)L; { const int q = nwg / NXCD, r = nwg % NXCD, xcd = wgid % NXCD, off = wgid / NXCD; wgid = (xcd < r ? xcd * (q + 1) : r * (q + 1) + (xcd - r) * q) + off; }
        const int nig = WGM * nN, gid = wgid / nig, fm = gid * WGM, gsz = (nM - fm) < WGM ? (nM - fm) : WGM;
        u.pm = fm + ((wgid % nig) % gsz); u.pn = (wgid % nig) / gsz; return true;
    }
    __device__ __forceinline__ void a_ready(const Unit&) const {}
    __device__ __forceinline__ void done(const Unit&) const {}
};

__device__ __forceinline__ unsigned cvt_pk_bf16(float lo, float hi) { unsigned r; asm volatile("v_cvt_pk_bf16_f32 %0, %1, %2" : "=v"(r) : "v"(lo), "v"(hi)); return r; }
typedef float f32x2 __attribute__((ext_vector_type(2)));
__device__ __forceinline__ f32x2 gelu_pk(f32x2 v) {
    const f32x2 av = __builtin_elementwise_abs(v), d = av * 0.2316418882f + 1.0f;
    f32x2 t; t.x = __builtin_amdgcn_rcpf(d.x); t.y = __builtin_amdgcn_rcpf(d.y);
    f32x2 q = t * 0.5307027145f + (-0.7265760135f); q = q * t + 0.7107068705f; q = q * t + (-0.142248368f); q = q * t + 0.127414796f; q = q * t;
    const f32x2 s = (v * v) * (-0.72134752044f);
    f32x2 e; e.x = __builtin_amdgcn_exp2f(s.x); e.y = __builtin_amdgcn_exp2f(s.y);
    const f32x2 m = v * (q * e), r = v - m;
    f32x2 o; o.x = v.x < 0.f ? m.x : r.x; o.y = v.y < 0.f ? m.y : r.y; return o;
}
__device__ __forceinline__ float silu_f(float x) { return x * __builtin_amdgcn_rcpf(1.0f + __expf(-x)); }
__device__ __forceinline__ void st8(bf16_t* p, const f32x4 v0, const f32x4 v1) { u32x4 w; w.x = cvt_pk_bf16(v0[0], v0[1]); w.y = cvt_pk_bf16(v0[2], v0[3]); w.z = cvt_pk_bf16(v1[0], v1[1]); w.w = cvt_pk_bf16(v1[2], v1[3]); *(u32x4*)p = w; }
struct EpiInProj {
    static constexpr bool PERM = true, AFTER_DRAIN = false;
    bf16_t* QKV; bf16_t* Z; bf16_t* UV; float* AB;
    __device__ __forceinline__ void operator()(const f32x4 (&acc)[2][2][4][2], const Unit& u, int wr, int wc, int fr, int fq) const {
        const int row0 = u.pm * BM + wr * 64 + fr, pn = u.pn;
        if (pn == 12) {
            if (wc == 0 && fq < 2) {
#pragma unroll
                for (int ai = 0; ai < 2; ++ai)
#pragma unroll
                    for (int m = 0; m < 4; ++m) { float* p = AB + (size_t)(row0 + ai * HALF + m * 16) * 16 + 8 * fq; *(f32x4*)p = acc[ai][0][m][0]; *(f32x4*)(p + 4) = acc[ai][0][m][1]; }
            }
            return;
        }
        bf16_t* base; int ldc, colt; bool act = false;
        if (pn < 6) { base = QKV; ldc = 1536; colt = pn * 256; }
        else { if (u.pm >= 64) return; if (pn < 8) { base = Z; ldc = 512; colt = (pn - 6) * 256; } else { base = UV; ldc = 1024; colt = (pn - 8) * 256; act = true; } }
        const int col0 = colt + wc * 32 + 8 * fq;
#pragma unroll
        for (int ai = 0; ai < 2; ++ai)
#pragma unroll
            for (int m = 0; m < 4; ++m) { bf16_t* rowp = base + (size_t)(row0 + ai * HALF + m * 16) * ldc + col0;
#pragma unroll
                for (int bj = 0; bj < 2; ++bj) { f32x4 v0 = acc[ai][bj][m][0], v1 = acc[ai][bj][m][1];
                    if (act) { f32x2 a = gelu_pk((f32x2){v0[0], v0[1]}), b = gelu_pk((f32x2){v0[2], v0[3]}), c = gelu_pk((f32x2){v1[0], v1[1]}), d = gelu_pk((f32x2){v1[2], v1[3]});
                        v0 = (f32x4){a.x, a.y, b.x, b.y}; v1 = (f32x4){c.x, c.y, d.x, d.y}; }
                    st8(rowp + bj * HALF, v0, v1); } }
    }
};
struct EpiOutProj {
    static constexpr bool PERM = false, AFTER_DRAIN = false;
    const float* x; const float* mod; float* H1;
    __device__ __forceinline__ void operator()(const f32x4 (&acc)[2][2][4][2], const Unit& u, int wr, int wc, int fr, int fq) const {
        const int row0 = u.pm * BM + wr * 64 + fr, col0 = u.pn * BM + wc * 32 + 4 * fq; const float* gt = mod + (u.pm >= 32 ? 6144 : 0) + 2048;
        f32x4 gv[2][2];
#pragma unroll
        for (int bj = 0; bj < 2; ++bj)
#pragma unroll
            for (int n = 0; n < 2; ++n) gv[bj][n] = *(const f32x4*)(gt + col0 + bj * HALF + n * 16);
#pragma unroll
        for (int ai = 0; ai < 2; ++ai)
#pragma unroll
            for (int m = 0; m < 4; ++m) { const size_t off = (size_t)(row0 + ai * HALF + m * 16) * 1024 + col0;
#pragma unroll
                for (int bj = 0; bj < 2; ++bj)
#pragma unroll
                    for (int n = 0; n < 2; ++n) { const f32x4 xv = *(const f32x4*)(x + off + bj * HALF + n * 16); *(f32x4*)(H1 + off + bj * HALF + n * 16) = xv + gv[bj][n] * acc[ai][bj][m][n]; } }
    }
};
struct EpiSwiGLU {
    static constexpr bool PERM = true, AFTER_DRAIN = false;
    bf16_t* HID;
    __device__ __forceinline__ void operator()(const f32x4 (&acc)[2][2][4][2], const Unit& u, int wr, int wc, int fr, int fq) const {
        const int row0 = u.pm * BM + wr * 64 + fr, col0 = u.pn * HALF + wc * 32 + 8 * fq;
#pragma unroll
        for (int ai = 0; ai < 2; ++ai)
#pragma unroll
            for (int m = 0; m < 4; ++m) { bf16_t* rowp = HID + (size_t)(row0 + ai * HALF + m * 16) * 1024 + col0; f32x4 h0, h1;
#pragma unroll
                for (int j = 0; j < 4; ++j) { h0[j] = silu_f(acc[ai][0][m][0][j]) * acc[ai][1][m][0][j]; h1[j] = silu_f(acc[ai][0][m][1][j]) * acc[ai][1][m][1][j]; }
                st8(rowp, h0, h1); }
    }
};
struct EpiDown {
    static constexpr bool PERM = true, AFTER_DRAIN = false;
    bf16_t* YE; const float* gate;
    __device__ __forceinline__ void operator()(const f32x4 (&acc)[2][2][4][2], const Unit& u, int wr, int wc, int fr, int fq) const {
        const int row0 = u.pm * BM + wr * 64 + fr, col0 = u.pn * BM + wc * 32 + 8 * fq;
#pragma unroll
        for (int ai = 0; ai < 2; ++ai)
#pragma unroll
            for (int m = 0; m < 4; ++m) { const int row = row0 + ai * HALF + m * 16; const float gv = gate[row]; bf16_t* rowp = YE + (size_t)row * 1024 + col0;
#pragma unroll
                for (int bj = 0; bj < 2; ++bj) st8(rowp + bj * HALF, acc[ai][bj][m][0] * gv, acc[ai][bj][m][1] * gv); }
    }
};
template <class Epi, class Sched, bool ALIGN_EPI = false, bool SP2 = false>
__device__ __forceinline__ void gemm_phase(PG8_LAS unsigned char* lds, const Gemm g, const Sched& S, const Epi& E) {
    const int tid = threadIdx.x, wid = __builtin_amdgcn_readfirstlane(tid >> 6), lane = tid & 63, wr = wid >> 2, wc = wid & 3, fr = lane & 15, fq = lane >> 4;
    const int K = g.K, nt = K / BK;
    unsigned voffA[2], voffB[2];
#pragma unroll
    for (int i = 0; i < 2; ++i) { int R, C; stage_rc(tid * 16 + i * 8192, R, C); const int Rb = Epi::PERM ? ((R & ~31) + perm32(R & 31)) : R;
        voffA[i] = (unsigned)(R * K + C) * 2u; voffB[i] = (unsigned)(Rb * K + C) * 2u; }
    const size_t kstep = (size_t)(BK * 2);
    const size_t hstep = (size_t)HALF * K * 2;
    const size_t tstep = 2 * hstep;
    const unsigned ldsw = (unsigned)wid * 1024u;
    const int aoff = lds_byte(wr * 64 + fr, fq * 8), boff = lds_byte(wc * 32 + fr, fq * 8);
#define PG8_SA(b, h) (((b) * 2 + (h)) * HTB)
#define PG8_SB(b, h) ((4 + (b) * 2 + (h)) * HTB)
#define PG8_STAGE(bufoff, gbase, voff) do { _Pragma("unroll") for (int _i = 0; _i < 2; ++_i) \
        __builtin_amdgcn_global_load_lds((const unsigned*)((const char*)(gbase) + (voff)[_i]), (PG8_LAS unsigned*)(lds + (bufoff) + ldsw + _i * 8192), 16, 0, 0); } while (0)
#define PG8_LDA(dst, b, h) do { _Pragma("unroll") for (int m = 0; m < 4; ++m) _Pragma("unroll") for (int k = 0; k < 2; ++k) dst[m][k] = *(const PG8_LAS bf16x8*)(lds + PG8_SA(b, h) + aoff + m * 2048 + k * 1024); } while (0)
#define PG8_LDB(dst, b, h) do { _Pragma("unroll") for (int n = 0; n < 2; ++n) _Pragma("unroll") for (int k = 0; k < 2; ++k) dst[n][k] = *(const PG8_LAS bf16x8*)(lds + PG8_SB(b, h) + boff + n * 2048 + k * 1024); } while (0)
#define PG8_MMA(ai, bj, At, Bt) do { __builtin_amdgcn_s_setprio(1); _Pragma("unroll") for (int m = 0; m < 4; ++m) _Pragma("unroll") for (int n = 0; n < 2; ++n) _Pragma("unroll") for (int k = 0; k < 2; ++k) \
        acc[ai][bj][m][n] = __builtin_amdgcn_mfma_f32_16x16x32_bf16(Bt[n][k], At[m][k], acc[ai][bj][m][n], 0, 0, 0); __builtin_amdgcn_s_setprio(0); } while (0)
#define PG8_WAIT_V(n) asm volatile("s_waitcnt vmcnt(" #n ")" ::: "memory")
#define PG8_WAIT_L(n) asm volatile("s_waitcnt lgkmcnt(" #n ")" ::: "memory")
#define PG8_BAR __builtin_amdgcn_s_barrier()
#define PG8_SCHED __builtin_amdgcn_sched_barrier(0)
    Unit cur, nxt; int ui = 0;
    if (!S.next(0, cur)) return;
    f32x4 acc[2][2][4][2];
#pragma unroll
    for (int a = 0; a < 2; ++a)
#pragma unroll
        for (int b = 0; b < 2; ++b)
#pragma unroll
            for (int m = 0; m < 4; ++m)
#pragma unroll
                for (int n = 0; n < 2; ++n) acc[a][b][m][n] = (f32x4){0.f, 0.f, 0.f, 0.f};
    bf16x8 At[4][2], B0[2][2], B1[2][2];
    const char* cA = (const char*)g.A + (size_t)cur.pm * tstep; const char* cB = (const char*)g.Bt + (size_t)((cur.pm >> g.gsh) & g.gmask) * g.bgs + (size_t)cur.pn * tstep;
    S.a_ready(cur);
    if constexpr (SP2) {
        PG8_STAGE(PG8_SB(0, 0), cB, voffB); PG8_STAGE(PG8_SB(0, 1), cB + hstep, voffB); PG8_STAGE(PG8_SA(0, 0), cA, voffA); PG8_STAGE(PG8_SA(0, 1), cA + hstep, voffA);
        if (wr == 1) PG8_BAR;
        PG8_WAIT_V(2); PG8_BAR;
        PG8_STAGE(PG8_SB(1, 0), cB + kstep, voffB); PG8_STAGE(PG8_SA(1, 0), cA + kstep, voffA); PG8_STAGE(PG8_SB(1, 1), cB + hstep + kstep, voffB);
        PG8_WAIT_V(6); PG8_BAR;
    } else {
        PG8_STAGE(PG8_SB(0, 0), cB, voffB); PG8_STAGE(PG8_SA(0, 0), cA, voffA); PG8_STAGE(PG8_SB(0, 1), cB + hstep, voffB); PG8_STAGE(PG8_SA(0, 1), cA + hstep, voffA);
        if (wr == 1) PG8_BAR;
        PG8_WAIT_V(4); PG8_BAR;
        PG8_STAGE(PG8_SB(1, 0), cB + kstep, voffB); PG8_STAGE(PG8_SA(1, 0), cA + kstep, voffA); PG8_STAGE(PG8_SB(1, 1), cB + hstep + kstep, voffB);
        PG8_WAIT_V(6); PG8_BAR;
    }
    for (;;) {
        const bool has_next = S.next(ui + 1, nxt);
        const char* nA = has_next ? (const char*)g.A + (size_t)nxt.pm * tstep : cA; const char* nB = has_next ? (const char*)g.Bt + (size_t)((nxt.pm >> g.gsh) & g.gmask) * g.bgs + (size_t)nxt.pn * tstep : cB;
        for (int t = 0; t < nt; t += 2) {
            const bool last = (t == nt - 2);
            const char* a1 = cA + (size_t)(t + 1) * kstep;
            const char* a2 = last ? nA : cA + (size_t)(t + 2) * kstep; const char* b2 = last ? nB : cB + (size_t)(t + 2) * kstep;
            const char* a3 = a2 + kstep; const char* b3 = b2 + kstep;
            if (last && has_next) S.a_ready(nxt);
            if constexpr (SP2) {
            PG8_LDB(B0, 0, 0); PG8_LDB(B1, 0, 1); PG8_SCHED; PG8_LDA(At, 0, 0); PG8_STAGE(PG8_SA(1, 1), a1 + hstep, voffA);
            PG8_WAIT_V(8); PG8_WAIT_L(0); PG8_BAR; PG8_MMA(0, 0, At, B0); PG8_MMA(0, 1, At, B1); PG8_BAR; PG8_SCHED;
            PG8_LDA(At, 0, 1); PG8_STAGE(PG8_SB(0, 0), b2, voffB); PG8_STAGE(PG8_SB(0, 1), b2 + hstep, voffB); PG8_STAGE(PG8_SA(0, 0), a2, voffA);
            PG8_WAIT_V(8); PG8_WAIT_L(0); PG8_BAR; PG8_MMA(1, 0, At, B0); PG8_MMA(1, 1, At, B1); PG8_BAR; PG8_SCHED;
            PG8_LDB(B0, 1, 0); PG8_LDB(B1, 1, 1); PG8_SCHED; PG8_LDA(At, 1, 0); PG8_STAGE(PG8_SA(0, 1), a2 + hstep, voffA);
            PG8_WAIT_V(8); PG8_WAIT_L(0); PG8_BAR; PG8_MMA(0, 0, At, B0); PG8_MMA(0, 1, At, B1); PG8_BAR; PG8_SCHED;
            PG8_LDA(At, 1, 1); PG8_STAGE(PG8_SB(1, 0), b3, voffB); PG8_STAGE(PG8_SB(1, 1), b3 + hstep, voffB); PG8_STAGE(PG8_SA(1, 0), a3, voffA);
            PG8_WAIT_V(8); PG8_WAIT_L(0); PG8_BAR; PG8_MMA(1, 0, At, B0); PG8_MMA(1, 1, At, B1); PG8_BAR; PG8_SCHED;
            } else {
            PG8_LDB(B0, 0, 0); PG8_SCHED; PG8_LDA(At, 0, 0); PG8_STAGE(PG8_SA(1, 1), a1 + hstep, voffA);
            PG8_WAIT_L(8); PG8_BAR; PG8_WAIT_L(0); PG8_MMA(0, 0, At, B0); PG8_BAR; PG8_SCHED;
            PG8_LDB(B1, 0, 1); PG8_STAGE(PG8_SB(0, 0), b2, voffB);
            PG8_BAR; PG8_WAIT_L(0); PG8_MMA(0, 1, At, B1); PG8_BAR;
            PG8_LDA(At, 0, 1); PG8_STAGE(PG8_SA(0, 0), a2, voffA);
            PG8_BAR; PG8_WAIT_L(0); PG8_MMA(1, 0, At, B0); PG8_BAR; PG8_SCHED;
            PG8_STAGE(PG8_SB(0, 1), b2 + hstep, voffB);
            PG8_WAIT_V(6); PG8_BAR; PG8_MMA(1, 1, At, B1); PG8_BAR;
            PG8_LDB(B0, 1, 0); PG8_SCHED; PG8_LDA(At, 1, 0); PG8_STAGE(PG8_SA(0, 1), a2 + hstep, voffA);
            PG8_WAIT_L(8); PG8_BAR; PG8_WAIT_L(0); PG8_MMA(0, 0, At, B0); PG8_BAR; PG8_SCHED;
            PG8_LDB(B1, 1, 1); PG8_STAGE(PG8_SB(1, 0), b3, voffB);
            PG8_BAR; PG8_WAIT_L(0); PG8_MMA(0, 1, At, B1); PG8_BAR;
            PG8_LDA(At, 1, 1); PG8_STAGE(PG8_SA(1, 0), a3, voffA);
            PG8_BAR; PG8_WAIT_L(0); PG8_MMA(1, 0, At, B0); PG8_BAR; PG8_SCHED;
            PG8_STAGE(PG8_SB(1, 1), b3 + hstep, voffB);
            PG8_WAIT_V(6); PG8_BAR; PG8_MMA(1, 1, At, B1); PG8_BAR;
            }
        }
        if constexpr (ALIGN_EPI) { if (wr == 0) PG8_BAR; }
        if constexpr (!Epi::AFTER_DRAIN) { E(acc, cur, wr, wc, fr, fq); S.done(cur); }
        if (!has_next) break;
#pragma unroll
        for (int a = 0; a < 2; ++a)
#pragma unroll
            for (int b = 0; b < 2; ++b)
#pragma unroll
                for (int m = 0; m < 4; ++m)
#pragma unroll
                    for (int n = 0; n < 2; ++n) acc[a][b][m][n] = (f32x4){0.f, 0.f, 0.f, 0.f};
        cur = nxt; cA = nA; cB = nB; ++ui;
        if constexpr (ALIGN_EPI) { if (wr == 1) PG8_BAR; }
    }
    PG8_WAIT_V(0);
    if constexpr (!ALIGN_EPI) { if (wr == 0) PG8_BAR; }
    PG8_BAR;
    if constexpr (Epi::AFTER_DRAIN) { E.fused(acc, cur, wr, wc, fr, fq, lds, wid, lane); S.done(cur); }
#undef PG8_SA
#undef PG8_SB
#undef PG8_STAGE
#undef PG8_LDA
#undef PG8_LDB
#undef PG8_MMA
#undef PG8_WAIT_V
#undef PG8_WAIT_L
#undef PG8_BAR
#undef PG8_SCHED
}
}
#ifndef PG8_SP2
#define PG8_SP2 true
#endif
#ifndef PG8_ALIGN
#define PG8_ALIGN true
#endif
constexpr int NWAVES = 8;
#ifndef MK_PER_PHASE
#define MK_PER_PHASE 0
#endif
constexpr int NPHASE = 15;
constexpr int BATCH = 2, T = 8192, D = 1024, TC = 256, M = BATCH * T, MC = BATCH * TC, MA = M + MC;
constexpr int NEXP = 16, CAP = 1024, FF = 1024;
constexpr float EPS = 1e-6f;
constexpr size_t MiB = 1u << 20;
constexpr size_t WS_CTL = 0, CTL_ZERO_BYTES = 1 * MiB;
constexpr size_t WS_MOD = 1 * MiB;
constexpr size_t WS_EGL = 1 * MiB + 128 * 1024;
constexpr size_t WS_IDX = 1 * MiB + 512 * 1024;
constexpr size_t WS_GATE = WS_IDX + 128 * 1024;
constexpr size_t WS_AFF = 2 * MiB;
constexpr size_t WS_SEL = 3 * MiB;
constexpr size_t WS_WIN = 4 * MiB;
constexpr size_t WS_WOUT = 11 * MiB;
constexpr size_t WS_AIN = 13 * MiB;
constexpr size_t WS_MIX = 13 * MiB;
constexpr size_t WS_FIN = 13 * MiB;
constexpr size_t WS_QKV = 46 * MiB;
constexpr size_t WS_OF = 46 * MiB, WS_OB = 62 * MiB;
constexpr size_t WS_Z = 96 * MiB;
constexpr size_t WS_UV = 112 * MiB;
constexpr size_t WS_AB = 144 * MiB;
constexpr size_t WS_GDN = 146 * MiB;
constexpr size_t GDN_UNIT = 73728;
constexpr size_t WS_WGU = 132 * MiB;
constexpr size_t WS_H1 = 232 * MiB;
constexpr size_t WS_XE = 68 * MiB;
constexpr size_t WS_HID = 4 * MiB;
constexpr size_t WS_WD = 68 * MiB;
constexpr size_t WS_YE = 132 * MiB;
constexpr size_t WS_END = 296 * MiB;
static_assert(WS_GDN + 2112 * GDN_UNIT <= WS_END && WS_AB + (size_t)MA * 64 <= WS_GDN && WS_QKV + (size_t)MA * 3072 <= WS_Z, "ws map");
constexpr int CW_BAR = 4096;
constexpr int LDS_BYTES = 163840;
constexpr int MISC_OFF = LDS_BYTES - 256;
#define LAS __attribute__((address_space(3)))
#define GAS __attribute__((address_space(1)))
typedef unsigned short bf16;
typedef unsigned v4u __attribute__((ext_vector_type(4)));
typedef unsigned v2u __attribute__((ext_vector_type(2)));
typedef float f32x4 __attribute__((ext_vector_type(4)));
typedef short bf16x8 __attribute__((ext_vector_type(8)));
#define LDS_WAIT() asm volatile("s_waitcnt lgkmcnt(0)" ::: "memory")
#define VM_WAIT() asm volatile("s_waitcnt vmcnt(0)" ::: "memory")
__device__ __forceinline__ unsigned f2bf(float f) { unsigned u = __builtin_bit_cast(unsigned, f); return (u + 0x7fffu + ((u >> 16) & 1u)) >> 16; }
__device__ __forceinline__ unsigned pk2(float lo, float hi) { return f2bf(lo) | (f2bf(hi) << 16); }
__device__ __forceinline__ float bflo(unsigned w) { return __builtin_bit_cast(float, w << 16); }
__device__ __forceinline__ float bfhi(unsigned w) { return __builtin_bit_cast(float, w & 0xffff0000u); }
__device__ __forceinline__ float bf1(bf16 h) { return __builtin_bit_cast(float, (unsigned)h << 16); }
__device__ __forceinline__ float wave_sum(float v) {
#pragma unroll
    for (int o = 1; o < 64; o <<= 1) v += __shfl_xor(v, o);
    return v;
}
__device__ __forceinline__ float fnma1(float a, float b, float c) { float r; asm("v_fma_f32 %0, -%1, %2, %3" : "=v"(r) : "v"(a), "v"(b), "v"(c)); return r; }
__device__ __forceinline__ float silu_r(float x) { return x * __builtin_amdgcn_rcpf(1.0f + __expf(-x)); }
__device__ __forceinline__ float silu1(float x) { return x / (1.0f + __expf(-x)); }

#define XB_TMO      128
#define XB_XCNT(j)  (256  + 64 * (j))
#define XB_XSUB(j)  (1280 + 64 * (j))
#define XB_XGEN(j)  (2304 + 64 * (j))
#define XB_TOP      3328
#define XB_TOPGEN   3392
#define XCD_BAR_WORDS 3456
#define XB_SPIN_CAP (1u << 18)
__device__ __forceinline__ unsigned xb_ld(unsigned* p)              { return __hip_atomic_load(p, __ATOMIC_RELAXED, __HIP_MEMORY_SCOPE_AGENT); }
__device__ __forceinline__ unsigned xb_add(unsigned* p, unsigned v) { return __hip_atomic_fetch_add(p, v, __ATOMIC_RELAXED, __HIP_MEMORY_SCOPE_AGENT); }
__device__ __forceinline__ unsigned xb_xcc_id() { return (unsigned)__builtin_amdgcn_s_getreg((3 << 11) | 20) & 0xFu; }
#define XB_SPIN(cond, bar) do { unsigned _sp = 0; while (cond) { __builtin_amdgcn_s_sleep(1); \
    if ((++_sp & 255u) == 0u) { if (xb_ld(&(bar)[XB_TMO])) break; if (_sp > XB_SPIN_CAP) { atomicAdd(&(bar)[XB_TMO], 1u); break; } } } } while (0)
struct XcdBarrier { unsigned* bar; unsigned x; volatile LAS unsigned* st; };
__device__ __forceinline__ XcdBarrier xcd_barrier_post(unsigned* bar, volatile LAS unsigned* st) {
    XcdBarrier b; b.bar = bar; b.x = xb_xcc_id(); b.st = st;
    if (threadIdx.x == 0) (void)xb_add(&bar[XB_XCNT(b.x)], 1u);
    return b;
}
__device__ __forceinline__ void xcd_barrier_complete(unsigned* bar, unsigned x, unsigned& nloc, unsigned& nx) {
    const unsigned G = gridDim.x * gridDim.y * gridDim.z;
    unsigned sum, cnt, mine, sp = 0u;
    for (;;) {
        sum = 0u; cnt = 0u; mine = 0u;
#pragma unroll
        for (unsigned j = 0; j < 16; ++j) { const unsigned c = xb_ld(&bar[XB_XCNT(j)]); sum += c; cnt += (c > 0u) ? 1u : 0u; mine = (j == x) ? c : mine; }
        if (sum == G) break;
        __builtin_amdgcn_s_sleep(1);
        if ((++sp & 255u) == 0u) { if (xb_ld(&bar[XB_TMO])) break; if (sp > XB_SPIN_CAP) { atomicAdd(&bar[XB_TMO], 1u); break; } }
    }
    nloc = mine > 0u ? mine : 1u; nx = cnt > 0u ? cnt : 1u;
}
__device__ __forceinline__ void xcd_barrier(const XcdBarrier& b) {
    asm volatile("s_waitcnt vmcnt(0)" ::: "memory");
    __syncthreads();
    if (threadIdx.x == 0) {
        unsigned* bar = b.bar;
        __builtin_amdgcn_s_waitcnt(0);
        unsigned nloc = b.st[0], nx = b.st[1];
        if (nloc == 0u) { xcd_barrier_complete(bar, b.x, nloc, nx); b.st[0] = nloc; b.st[1] = nx; }
        const unsigned old = xb_add(&bar[XB_XSUB(b.x)], 1u);
        const unsigned gen = old / nloc;
        if (old + 1u == (gen + 1u) * nloc) {
            __builtin_amdgcn_fence(__ATOMIC_RELEASE, "agent");
            asm volatile("s_waitcnt vmcnt(0)" ::: "memory");
            const unsigned og = xb_add(&bar[XB_TOP], 1u);
            const unsigned tg = og / nx;
            if (og + 1u == (tg + 1u) * nx) xb_add(&bar[XB_TOPGEN], 1u);
            else XB_SPIN(xb_ld(&bar[XB_TOPGEN]) == tg, bar);
            __builtin_amdgcn_fence(__ATOMIC_ACQUIRE, "agent");
            xb_add(&bar[XB_XGEN(b.x)], 1u);
            asm volatile("s_waitcnt vmcnt(0)" ::: "memory");
        } else {
            XB_SPIN(xb_ld(&bar[XB_XGEN(b.x)]) == gen, bar);
            __builtin_amdgcn_fence(__ATOMIC_ACQUIRE, "agent");
            asm volatile("s_waitcnt vmcnt(0)" ::: "memory");
        }
    }
    __syncthreads();
}

struct Frame {
    LAS unsigned char* lds;
    int tid, lane, wave, vcu, G;
    unsigned char* ws;
    const float *x, *c, *ctx, *c_ctx, *w_mod, *b_mod, *norm1_g, *norm2_g, *w_in, *conv_w, *a_log, *dt_bias, *gdn_norm_g, *gm_norm_g, *gm_ws, *gm_bs, *w_out, *w_router, *b_router, *w_gate, *w_up, *w_down, *final_norm_g;
    float* out;
};
__device__ __forceinline__ f32x4 mma_tile(const LAS bf16* A, int lda, int r0, const LAS bf16* Bt, int ldb, int c0, int K, f32x4 acc, int lane) {
    const int fr = lane & 15, fq = lane >> 4;
    const LAS bf16* ap = A + (r0 + fr) * lda + 8 * fq; const LAS bf16* bp = Bt + (c0 + fr) * ldb + 8 * fq;
#pragma unroll 4
    for (int k0 = 0; k0 < K; k0 += 32) { const bf16x8 a = *(const LAS bf16x8*)(ap + k0), b = *(const LAS bf16x8*)(bp + k0); acc = __builtin_amdgcn_mfma_f32_16x16x32_bf16(a, b, acc, 0, 0, 0); }
    return acc;
}
__device__ __forceinline__ void transpose_item(const float* W, int ldw, int src_col0, int k0, bf16* WT, int Kp, int dst_row0, LAS float* scr, int lane) {
#pragma unroll 8
    for (int i = 0; i < 32; ++i) { const int kk = 2 * i + (lane >> 5); scr[kk * 33 + (lane & 31)] = W[(size_t)(k0 + kk) * ldw + src_col0 + (lane & 31)]; }
    LDS_WAIT(); asm volatile("" ::: "memory");
    const int c = lane & 7;
#pragma unroll
    for (int j = 0; j < 4; ++j) { const int n = (lane >> 3) + 8 * j; const LAS float* s = scr + (8 * c) * 33 + n;
        v4u o; o.x = pk2(s[0 * 33], s[1 * 33]); o.y = pk2(s[2 * 33], s[3 * 33]); o.z = pk2(s[4 * 33], s[5 * 33]); o.w = pk2(s[6 * 33], s[7 * 33]);
        *(v4u*)(WT + (size_t)(dst_row0 + n) * Kp + k0 + 8 * c) = o; }
    LDS_WAIT(); asm volatile("" ::: "memory");
}
__device__ __forceinline__ void p0_phase(Frame& F) {
    float* MOD = (float*)(F.ws + WS_MOD);
    if (F.vcu < 96) {
        LAS float* sv = (LAS float*)F.lds;
        LAS float* red = sv + 3072;
        for (int i = F.tid; i < 3072; i += 512) { const int v = i >> 10, k = i & 1023; const float s = v < 2 ? F.c[v * 1024 + k] : F.c_ctx[k]; sv[i] = silu1(s); }
        __syncthreads();
        for (int item = F.vcu; item < 96; item += F.G) {
            const int kq = F.tid >> 4, cq = F.tid & 15, col = item * 64 + cq * 4;
            f32x4 a0 = {0.f, 0.f, 0.f, 0.f}, a1 = a0, a2 = a0;
#pragma unroll 8
            for (int kk = 0; kk < 32; ++kk) { const int k = kq * 32 + kk; const f32x4 w = *(const f32x4*)(F.w_mod + (size_t)k * 6144 + col); a0 += sv[k] * w; a1 += sv[1024 + k] * w; a2 += sv[2048 + k] * w; }
            *(LAS f32x4*)(red + (kq * 3 + 0) * 64 + cq * 4) = a0; *(LAS f32x4*)(red + (kq * 3 + 1) * 64 + cq * 4) = a1; *(LAS f32x4*)(red + (kq * 3 + 2) * 64 + cq * 4) = a2;
            __syncthreads();
            if (F.tid < 192) { const int v = F.tid >> 6, cc = F.tid & 63; float s = F.b_mod[item * 64 + cc];
                for (int q = 0; q < 32; ++q) s += red[(q * 3 + v) * 64 + cc];
                MOD[v * 6144 + item * 64 + cc] = s; }
            __syncthreads();
        }
    }
    __syncthreads();
    LAS float* scr = (LAS float*)(F.lds + F.wave * 16384);
    const int gw = F.vcu * NWAVES + F.wave, NGW = F.G * NWAVES;
    bf16* WIN = (bf16*)(F.ws + WS_WIN); bf16* WOUT = (bf16*)(F.ws + WS_WOUT);
    constexpr int I_IN = 97 * 16, I_OUT = 32 * 16;
    for (int it = gw; it < I_IN + I_OUT; it += NGW) {
        if (it < I_IN) { const int blk = it >> 4, kb = it & 15;
            const int src = blk < 48 ? 32 * blk : (blk < 64 ? 1552 + 32 * (blk - 48) : (blk < 96 ? 2064 + 32 * (blk - 64) : 1536));
            transpose_item(F.w_in, 3088, src, kb * 64, WIN, 1024, blk * 32, scr, F.lane); }
        else { const int r = it - I_IN, blk = r >> 4, kb = r & 15; transpose_item(F.w_out, 1024, blk * 32, kb * 64, WOUT, 1024, blk * 32, scr, F.lane); }
    }
}
__device__ __forceinline__ void wgu_convert(Frame& F) {
    LAS float* scr = (LAS float*)(F.lds + F.wave * 16384);
    const int gw = F.vcu * NWAVES + F.wave, NGW = F.G * NWAVES;
    bf16* WGU = (bf16*)(F.ws + WS_WGU);
    for (int it = gw; it < 16 * 2 * 512; it += NGW) {
        const int kb = it & 15, fb = (it >> 4) & 31, mat = (it >> 9) & 1, e = it >> 10;
        const float* W = (mat ? F.w_up : F.w_gate) + (size_t)e * 1024 * 1024;
        const int f0 = fb * 32, pn = f0 >> 7, dst = 256 * pn + (mat ? 128 : 0) + (f0 & 127);
        transpose_item(W, 1024, f0, kb * 64, WGU + (size_t)e * 2048 * 1024, 1024, dst, scr, F.lane);
    }
}
__device__ __forceinline__ void wd_convert(Frame& F) {
    LAS float* scr = (LAS float*)(F.lds + F.wave * 16384);
    const int gw = F.vcu * NWAVES + F.wave, NGW = F.G * NWAVES;
    bf16* WD = (bf16*)(F.ws + WS_WD);
    for (int it = gw; it < 16 * 512; it += NGW) { const int kb = it & 15, nb = (it >> 4) & 31, e = it >> 9;
        transpose_item(F.w_down + (size_t)e * 1024 * 1024, 1024, nb * 32, kb * 64, WD + (size_t)e * 1024 * 1024, 1024, nb * 32, scr, F.lane); }
}
__device__ __forceinline__ void p1_phase(Frame& F) {
    const float* MOD = (const float*)(F.ws + WS_MOD); bf16* AIN = (bf16*)(F.ws + WS_AIN);
    const int gw = F.vcu * NWAVES + F.wave, NGW = F.G * NWAVES;
#pragma unroll 1
    for (int seg = 0; seg < 3; ++seg) {
        const int r_lo = seg < 2 ? seg * T : M, r_hi = seg < 2 ? (seg + 1) * T : MA;
        const float* mv = MOD + seg * 6144;
        f32x4 sc[4], sh[4];
#pragma unroll
        for (int j = 0; j < 4; ++j) { const int k = 4 * F.lane + 256 * j; const f32x4 g = *(const f32x4*)(F.norm1_g + k), s1 = *(const f32x4*)(mv + 1024 + k); sc[j] = g * (1.0f + s1); sh[j] = *(const f32x4*)(mv + k); }
        for (int m = r_lo + gw; m < r_hi; m += NGW) {
            const float* xr = seg < 2 ? F.x + (size_t)m * D : F.ctx + (size_t)(m - M) * D;
            f32x4 v[4]; float ss = 0.f;
#pragma unroll
            for (int j = 0; j < 4; ++j) { v[j] = *(const f32x4*)(xr + 4 * F.lane + 256 * j); ss += (v[j].x * v[j].x + v[j].y * v[j].y) + (v[j].z * v[j].z + v[j].w * v[j].w); }
            const float rstd = 1.0f / sqrtf(wave_sum(ss) * (1.0f / D) + EPS);
            bf16* orow = AIN + (size_t)m * D;
#pragma unroll
            for (int j = 0; j < 4; ++j) { const f32x4 a = v[j] * rstd * sc[j] + sh[j]; v2u o; o.x = pk2(a.x, a.y); o.y = pk2(a.z, a.w); *(v2u*)(orow + 4 * F.lane + 256 * j) = o; }
        }
    }
}
struct PF { unsigned a, b, c, d; };
__device__ __forceinline__ unsigned touch(const void* p) { return *(const GAS unsigned*)p; }
__device__ __forceinline__ PF p3_prefetch(Frame& F, int it) {
    PF r; r.a = r.b = r.c = r.d = 0u;
    if (it >= 1056 + 512) return r;
    const int tid = F.tid;
    if (it < 1056) {
        int b, n, h, L; size_t row_base;
        if (it < 1024) { b = it >> 9; n = (it >> 2) & 127; h = it & 3; L = T; row_base = (size_t)b * T; }
        else { const int j = it - 1024; b = j >> 4; n = (j >> 2) & 3; h = j & 3; L = TC; row_base = (size_t)M + (size_t)b * TC; }
        const bf16* QKV = (const bf16*)(F.ws + WS_QKV);
        { const int p = tid, rr = p / 12, q = p % 12, s = q >> 2, piece = q & 3; int t = 64 * n - 1 + rr; t = t < 0 ? 0 : (t >= L ? L - 1 : t); r.a = touch(QKV + (row_base + t) * 1536 + s * 512 + h * 128 + piece * 32); }
        if (tid < 280) { const int p = tid + 512, rr = p / 12, q = p % 12, s = q >> 2, piece = q & 3; int t = 64 * n - 1 + rr; t = t < 0 ? 0 : (t >= L ? L - 1 : t); r.b = touch(QKV + (row_base + t) * 1536 + s * 512 + h * 128 + piece * 32); }
        if (tid < 64) r.c = touch((const float*)(F.ws + WS_AB) + (row_base + 64 * n + tid) * 16);
    } else {
        const int i2 = it - 1056, g = i2 & 3, nc = (i2 >> 2) & 63, b = i2 >> 8; const size_t r0 = (size_t)b * T + (size_t)nc * 128;
        const bf16* UV = (const bf16*)(F.ws + WS_UV);
        const int t = tid >> 2, piece = tid & 3; r.a = touch(UV + (r0 + t) * 1024 + 512 + 128 * g + piece * 32); r.b = touch(UV + (r0 + t) * 1024 + 128 * g + piece * 32);
        r.c = touch(F.gm_ws + (size_t)g * 16384 + tid * 16); r.d = touch(F.gm_ws + (size_t)g * 16384 + (tid + 512) * 16);
    }
    return r;
}
__device__ __forceinline__ void pf_sink(Frame& F, const PF& r) { asm volatile("" :: "v"(r.a), "v"(r.b), "v"(r.c), "v"(r.d)); }
__device__ __forceinline__ void gdn_item(Frame& F, int it) {
    int b, n, h, L, slot; size_t row_base;
    if (it < 1024) { b = it >> 9; n = (it >> 2) & 127; h = it & 3; L = T; row_base = (size_t)b * T; slot = (b * 4 + h) * 128 + n; }
    else { const int j = it - 1024; b = j >> 4; n = (j >> 2) & 3; h = j & 3; L = TC; row_base = (size_t)M + (size_t)b * TC; slot = 1024 + (b * 4 + h) * 4 + n; }
    const bf16* QKV = (const bf16*)(F.ws + WS_QKV); const float* AB = (const float*)(F.ws + WS_AB);
    LAS bf16* QB = (LAS bf16*)(F.lds); LAS bf16* KB = (LAS bf16*)(F.lds + 17408); LAS bf16* VB = (LAS bf16*)(F.lds + 34816); LAS bf16* TB = (LAS bf16*)(F.lds + 34816);
    LAS bf16* KT = (LAS bf16*)(F.lds + 52224); LAS bf16* VT = (LAS bf16*)(F.lds + 70656);
    LAS float* KK = (LAS float*)(F.lds + 89088); LAS float* QK = (LAS float*)(F.lds + 105728);
    LAS bf16* T12 = (LAS bf16*)(F.lds + 89088);
    LAS float* AF = (LAS float*)(F.lds + 122368);
    LAS float* GC = (LAS float*)(F.lds + 155136); LAS float* BT = (LAS float*)(F.lds + 155648); LAS float* EG1 = (LAS float*)(F.lds + 156160); LAS float* EG2 = (LAS float*)(F.lds + 156672);
    LAS bf16* A10B = (LAS bf16*)(F.lds + 157184);
    const int tid = F.tid, lane = F.lane, wave = F.wave, fr = lane & 15, fq = lane >> 4;
    for (int q = tid; q < 1152; q += 512) { const int tap = q / 384, rem = q % 384, s = rem >> 7, c = rem & 127; ((LAS float*)(F.lds + 89088))[q] = F.conv_w[tap * 1536 + s * 512 + h * 128 + c]; }
    __syncthreads();
    {
        const int r = tid >> 3, part = tid & 7, t = 64 * n + r; const bool hasp = t > 0, hasn = t + 1 < L;
        const bf16* prow = QKV + (row_base + t) * 1536;
        const LAS float* cwl = (const LAS float*)(F.lds + 89088) + part * 16;
        const int offp = hasp ? 1536 : 0, offn = hasn ? 1536 : 0; const unsigned mp = hasp ? 0xffffffffu : 0u, mn = hasn ? 0xffffffffu : 0u;
        v4u dc[6], dn[6];
#define S1_LOAD(dst, s_) do { const bf16* pc_ = prow + (s_) * 512 + h * 128 + part * 16; const bf16* pp_ = pc_ - offp; const bf16* pn_ = pc_ + offn; \
            dst[0] = *(const v4u*)pc_; dst[1] = *(const v4u*)(pc_ + 8); dst[2] = *(const v4u*)pp_; dst[3] = *(const v4u*)(pp_ + 8); dst[4] = *(const v4u*)pn_; dst[5] = *(const v4u*)(pn_ + 8); } while (0)
        S1_LOAD(dc, 0);
#pragma unroll 1
        for (int s = 0; s < 3; ++s) {
            if (s < 2) S1_LOAD(dn, s + 1);
            float y[16]; float ss = 0.f;
#pragma unroll
            for (int q = 0; q < 4; ++q) { const f32x4 w0 = *(const LAS f32x4*)(cwl + (0 * 3 + s) * 128 + 4 * q), w1 = *(const LAS f32x4*)(cwl + (1 * 3 + s) * 128 + 4 * q), w2 = *(const LAS f32x4*)(cwl + (2 * 3 + s) * 128 + 4 * q);
#pragma unroll
                for (int e = 0; e < 2; ++e) { const unsigned cw = dc[q >> 1][(q & 1) * 2 + e], pw = dc[2 + (q >> 1)][(q & 1) * 2 + e] & mp, nw = dc[4 + (q >> 1)][(q & 1) * 2 + e] & mn;
                    const float a0 = w0[2 * e] * bflo(pw) + w1[2 * e] * bflo(cw) + w2[2 * e] * bflo(nw), a1 = w0[2 * e + 1] * bfhi(pw) + w1[2 * e + 1] * bfhi(cw) + w2[2 * e + 1] * bfhi(nw);
                    const float y0 = silu_r(a0), y1 = silu_r(a1); y[4 * q + 2 * e] = y0; y[4 * q + 2 * e + 1] = y1; ss += y0 * y0 + y1 * y1; } }
            float sc = 1.0f;
            if (s < 2) { ss += __shfl_xor(ss, 1); ss += __shfl_xor(ss, 2); ss += __shfl_xor(ss, 4); sc = (1.0f / sqrtf(ss + EPS)) * (s == 0 ? 0.08838834764831845f : 1.0f); }
            LAS bf16* dst = (s == 0 ? QB : (s == 1 ? KB : VB)) + r * 136 + part * 16;
            v4u o0, o1;
            o0.x = pk2(y[0] * sc, y[1] * sc); o0.y = pk2(y[2] * sc, y[3] * sc); o0.z = pk2(y[4] * sc, y[5] * sc); o0.w = pk2(y[6] * sc, y[7] * sc);
            o1.x = pk2(y[8] * sc, y[9] * sc); o1.y = pk2(y[10] * sc, y[11] * sc); o1.z = pk2(y[12] * sc, y[13] * sc); o1.w = pk2(y[14] * sc, y[15] * sc);
            *(LAS v4u*)dst = o0; *(LAS v4u*)(dst + 8) = o1;
#pragma unroll
            for (int q = 0; q < 6; ++q) dc[q] = dn[q];
        }
#undef S1_LOAD
        if (wave < 2) { const int d = wave, i = lane, tl = d ? 63 - i : i; const float* abr = AB + (row_base + 64 * n + tl) * 16;
            const float a = abr[d * 4 + h], bb = abr[8 + d * 4 + h];
            const float xx = a + F.dt_bias[d * 4 + h]; const float sp = fmaxf(xx, 0.f) + log1pf(expf(-fabsf(xx)));
            float g = -expf(F.a_log[d * 4 + h]) * sp;
#pragma unroll
            for (int o = 1; o < 64; o <<= 1) { const float yv = __shfl_up(g, o); if (i >= o) g += yv; }
            GC[d * 64 + i] = g; BT[d * 64 + i] = 1.0f / (1.0f + expf(-bb)); const float gl = __shfl(g, 63); EG1[d * 64 + i] = __expf(g); EG2[d * 64 + i] = __expf(gl - g); }
    }
    __syncthreads();
    const PF pf = p3_prefetch(F, it + F.G);
    {
        const int mat = wave >> 2, tr = wave & 3;
#pragma unroll
        for (int tc = 0; tc < 4; ++tc) { f32x4 acc = {0.f, 0.f, 0.f, 0.f}; acc = mma_tile(mat ? QB : KB, 136, 16 * tr, KB, 136, 16 * tc, 128, acc, lane);
            LAS float* dst = (mat ? QK : KK) + (16 * tr + 4 * fq) * 65 + 16 * tc + fr;
#pragma unroll
            for (int j = 0; j < 4; ++j) dst[j * 65] = acc[j]; }
        bf16x8 id0, id1;
#pragma unroll
        for (int j = 0; j < 8; ++j) { id0[j] = (8 * fq + j == fr) ? (short)0x3F80 : (short)0; id1[j] = (8 * fq + j == fr + 16) ? (short)0x3F80 : (short)0; }
#pragma unroll 1
        for (int q = 0; q < 8; ++q) { const int job = wave * 8 + q, mt = job >> 5, tt = (job >> 3) & 3, ct = job & 7;
            const bf16x8 a = *(const LAS bf16x8*)((mt ? KB : VB) + (16 * tt + fr) * 136 + 32 * (ct >> 1) + 8 * fq);
            f32x4 acc = {0.f, 0.f, 0.f, 0.f}; acc = __builtin_amdgcn_mfma_f32_16x16x32_bf16(a, (ct & 1) ? id1 : id0, acc, 0, 0, 0);
            v2u o; o.x = pk2(acc[0], acc[1]); o.y = pk2(acc[2], acc[3]); *(LAS v2u*)((mt ? KT : VT) + (16 * ct + fr) * 72 + 16 * tt + 4 * fq) = o; }
    }
    __syncthreads();
    for (int idx = tid; idx < 8192; idx += 512) { const int d = idx >> 12, i = (idx >> 6) & 63, j = idx & 63; const int ti = d ? 63 - i : i, tj = d ? 63 - j : j;
        const float av = (i > j) ? BT[d * 64 + i] * KK[ti * 65 + tj] * __expf(GC[d * 64 + i] - GC[d * 64 + j]) : 0.f; AF[idx] = av;
        if (i >= 32 && j < 32) A10B[d * 1280 + (i - 32) * 40 + j] = (bf16)f2bf(av); }
    __syncthreads();
    unsigned char* gout = F.ws + WS_GDN + (size_t)slot * 2 * GDN_UNIT;
    if (wave < 2) {
        const int d = wave, blk = lane >> 5, jc = lane & 31; const LAS float* A = AF + d * 4096 + (blk * 32) * 64 + blk * 32; LAS bf16* TBd = TB + d * 4096;
        float Tc[32];
#pragma unroll
        for (int i = 0; i < 32; ++i) { float s0 = (i == jc) ? 1.f : 0.f, s1 = 0.f, s2 = 0.f, s3 = 0.f;
#pragma unroll
            for (int j = 0; j < i; ++j) { const float a = A[i * 64 + j]; if ((j & 3) == 0) s0 = fnma1(a, Tc[j], s0); else if ((j & 3) == 1) s1 = fnma1(a, Tc[j], s1); else if ((j & 3) == 2) s2 = fnma1(a, Tc[j], s2); else s3 = fnma1(a, Tc[j], s3); }
            Tc[i] = (s0 + s1) + (s2 + s3); TBd[(blk * 32 + i) * 64 + blk * 32 + jc] = (bf16)f2bf(Tc[i]);
            if (blk) TBd[i * 64 + 32 + jc] = (bf16)0;
            asm volatile("" ::: "memory"); }
        LAS bf16* DT0 = (LAS bf16*)(AF + d * 4096); LAS bf16* PT = DT0 + 1280;
        if (!blk) {
#pragma unroll
            for (int q = 0; q < 4; ++q) { v4u o; o.x = pk2(Tc[8 * q], Tc[8 * q + 1]); o.y = pk2(Tc[8 * q + 2], Tc[8 * q + 3]); o.z = pk2(Tc[8 * q + 4], Tc[8 * q + 5]); o.w = pk2(Tc[8 * q + 6], Tc[8 * q + 7]); *(LAS v4u*)(DT0 + jc * 40 + 8 * q) = o; } }
#pragma unroll
        for (int tl = 0; tl < 4; ++tl) { const int ti = tl >> 1, tj = tl & 1; f32x4 acc = {0.f, 0.f, 0.f, 0.f}; acc = mma_tile(A10B + d * 1280, 40, 16 * ti, DT0, 40, 16 * tj, 32, acc, lane);
            v2u o; o.x = pk2(acc[0], acc[1]); o.y = pk2(acc[2], acc[3]); *(LAS v2u*)(PT + (16 * tj + fr) * 40 + 16 * ti + 4 * fq) = o; }
#pragma unroll
        for (int tl = 0; tl < 4; ++tl) { const int ti = tl >> 1, tj = tl & 1; f32x4 acc = {0.f, 0.f, 0.f, 0.f}; acc = mma_tile(TBd + 32 * 64 + 32, 64, 16 * ti, PT, 40, 16 * tj, 32, acc, lane);
#pragma unroll
            for (int j = 0; j < 4; ++j) TBd[(32 + 16 * ti + 4 * fq + j) * 64 + 16 * tj + fr] = (bf16)f2bf(-acc[j]); }
    } else {
        const int t2 = tid - 128;
        for (int q = t2; q < 2048; q += 384) { const int d = q >> 10, i = (q >> 4) & 63, cg = q & 15, tok = d ? 63 - i : i; const float e = EG1[d * 64 + i];
            const v4u s = *(const LAS v4u*)(QB + tok * 136 + cg * 8); v4u o;
            o.x = pk2(bflo(s.x) * e, bfhi(s.x) * e); o.y = pk2(bflo(s.y) * e, bfhi(s.y) * e); o.z = pk2(bflo(s.z) * e, bfhi(s.z) * e); o.w = pk2(bflo(s.w) * e, bfhi(s.w) * e);
            *(v4u*)(gout + (size_t)d * GDN_UNIT + 16384 + (i * 128 + cg * 8) * 2) = o; }
        for (int q = t2; q < 2048; q += 384) { const int d = q >> 10, c = (q >> 3) & 127, ig = q & 7;
            float v[8];
            if (d == 0) { const v4u s = *(const LAS v4u*)(KT + c * 72 + ig * 8); v[0] = bflo(s.x); v[1] = bfhi(s.x); v[2] = bflo(s.y); v[3] = bfhi(s.y); v[4] = bflo(s.z); v[5] = bfhi(s.z); v[6] = bflo(s.w); v[7] = bfhi(s.w); }
            else { const v4u s = *(const LAS v4u*)(KT + c * 72 + 56 - ig * 8); v[7] = bflo(s.x); v[6] = bfhi(s.x); v[5] = bflo(s.y); v[4] = bfhi(s.y); v[3] = bflo(s.z); v[2] = bfhi(s.z); v[1] = bflo(s.w); v[0] = bfhi(s.w); }
            const LAS float* e2 = EG2 + d * 64 + ig * 8; v4u o;
            o.x = pk2(v[0] * e2[0], v[1] * e2[1]); o.y = pk2(v[2] * e2[2], v[3] * e2[3]); o.z = pk2(v[4] * e2[4], v[5] * e2[5]); o.w = pk2(v[6] * e2[6], v[7] * e2[7]);
            *(v4u*)(gout + (size_t)d * GDN_UNIT + 32768 + (c * 64 + ig * 8) * 2) = o; }
        for (int q = t2; q < 1024; q += 384) { const int d = q >> 9, i = (q >> 3) & 63, jg = q & 7, ti = d ? 63 - i : i; const float gi = GC[d * 64 + i]; float v[8];
#pragma unroll
            for (int jj = 0; jj < 8; ++jj) { const int j = jg * 8 + jj, tj = d ? 63 - j : j; v[jj] = (i >= j) ? QK[ti * 65 + tj] * __expf(gi - GC[d * 64 + j]) : 0.f; }
            v4u o; o.x = pk2(v[0], v[1]); o.y = pk2(v[2], v[3]); o.z = pk2(v[4], v[5]); o.w = pk2(v[6], v[7]);
            *(v4u*)(gout + (size_t)d * GDN_UNIT + 49152 + (i * 64 + jg * 8) * 2) = o; }
        if (t2 < 2) ((float*)(F.ws + WS_EGL))[slot * 2 + t2] = EG1[t2 * 64 + 63];
    }
    __syncthreads();
    for (int q = tid; q < 1024; q += 512) { const int d = q >> 9, i = (q >> 3) & 63, tg = q & 7;
        float v[8];
        if (d == 0) { const v4u s = *(const LAS v4u*)(TB + i * 64 + tg * 8); v[0] = bflo(s.x); v[1] = bfhi(s.x); v[2] = bflo(s.y); v[3] = bfhi(s.y); v[4] = bflo(s.z); v[5] = bfhi(s.z); v[6] = bflo(s.w); v[7] = bfhi(s.w); }
        else { const v4u s = *(const LAS v4u*)(TB + 4096 + i * 64 + 56 - tg * 8); v[7] = bflo(s.x); v[6] = bfhi(s.x); v[5] = bflo(s.y); v[4] = bfhi(s.y); v[3] = bflo(s.z); v[2] = bfhi(s.z); v[1] = bflo(s.w); v[0] = bfhi(s.w); }
        float t1[8], t2v[8];
#pragma unroll
        for (int e = 0; e < 8; ++e) { const int tok = tg * 8 + e, j = d ? 63 - tok : tok; t1[e] = v[e] * BT[d * 64 + j]; t2v[e] = t1[e] * EG1[d * 64 + j]; }
        v4u o; o.x = pk2(t1[0], t1[1]); o.y = pk2(t1[2], t1[3]); o.z = pk2(t1[4], t1[5]); o.w = pk2(t1[6], t1[7]); *(LAS v4u*)(T12 + (d * 2 + 0) * 4608 + i * 72 + tg * 8) = o;
        o.x = pk2(t2v[0], t2v[1]); o.y = pk2(t2v[2], t2v[3]); o.z = pk2(t2v[4], t2v[5]); o.w = pk2(t2v[6], t2v[7]); *(LAS v4u*)(T12 + (d * 2 + 1) * 4608 + i * 72 + tg * 8) = o; }
    __syncthreads();
#pragma unroll 1
    for (int q = 0; q < 16; ++q) { const int tile = wave * 16 + q, d = tile >> 6, kind = (tile >> 5) & 1, ti = (tile >> 3) & 3, tc = tile & 7; f32x4 acc = {0.f, 0.f, 0.f, 0.f};
        unsigned char* go = gout + (size_t)d * GDN_UNIT;
        if (kind == 0) { acc = mma_tile(T12 + (d * 2 + 0) * 4608, 72, 16 * ti, VT, 72, 16 * tc, 64, acc, lane);
            v2u o; o.x = pk2(acc[0], acc[1]); o.y = pk2(acc[2], acc[3]); *(v2u*)(go + 57344 + ((16 * tc + fr) * 64 + 16 * ti + 4 * fq) * 2) = o; }
        else { acc = mma_tile(KT, 72, 16 * tc, T12 + (d * 2 + 1) * 4608, 72, 16 * ti, 64, acc, lane);
            v2u o; o.x = pk2(acc[0], acc[1]); o.y = pk2(acc[2], acc[3]); *(v2u*)(go + ((16 * ti + fr) * 128 + 16 * tc + 4 * fq) * 2) = o; } }
    __syncthreads();
    pf_sink(F, pf);
}
__device__ __forceinline__ void gmlp_item(Frame& F, int it) {
    const int g = it & 3, nc = (it >> 2) & 63, b = it >> 8; const size_t r0 = (size_t)b * T + (size_t)nc * 128;
    const bf16* UV = (const bf16*)(F.ws + WS_UV); bf16* MIX = (bf16*)(F.ws + WS_MIX);
    LAS bf16* VNT = (LAS bf16*)(F.lds); LAS bf16* WSB = (LAS bf16*)(F.lds + 34816);
    const int tid = F.tid, lane = F.lane, wave = F.wave;
    {
        const int t = tid >> 2, part = tid & 3; const bf16* vp = UV + (r0 + t) * 1024 + 512 + 128 * g + part * 32;
        float v[32]; float ss = 0.f;
#pragma unroll
        for (int q = 0; q < 4; ++q) { const v4u xw = *(const v4u*)(vp + 8 * q);
#pragma unroll
            for (int e = 0; e < 4; ++e) { v[8 * q + 2 * e] = bflo(xw[e]); v[8 * q + 2 * e + 1] = bfhi(xw[e]); ss += v[8 * q + 2 * e] * v[8 * q + 2 * e] + v[8 * q + 2 * e + 1] * v[8 * q + 2 * e + 1]; } }
        ss += __shfl_xor(ss, 1); ss += __shfl_xor(ss, 2);
        const float rstd = 1.0f / sqrtf(ss * (1.0f / 128.0f) + EPS); const float* gn = F.gm_norm_g + 128 * g + part * 32;
#pragma unroll
        for (int cc = 0; cc < 32; ++cc) VNT[(part * 32 + cc) * 136 + t] = (bf16)f2bf(v[cc] * rstd * gn[cc]);
        const float* wp = F.gm_ws + ((size_t)g * 128 + t) * 128 + part * 32;
#pragma unroll
        for (int q = 0; q < 4; ++q) { const f32x4 w0 = *(const f32x4*)(wp + 8 * q), w1 = *(const f32x4*)(wp + 8 * q + 4); v4u o; o.x = pk2(w0.x, w0.y); o.y = pk2(w0.z, w0.w); o.z = pk2(w1.x, w1.y); o.w = pk2(w1.z, w1.w);
            *(LAS v4u*)(WSB + t * 136 + part * 32 + 8 * q) = o; }
    }
    __syncthreads();
    const PF pf = p3_prefetch(F, it + 1056 + F.G);
    {
        const int td = wave, fr = lane & 15, fq = lane >> 4;
#pragma unroll 1
        for (int tt = 0; tt < 8; ++tt) { f32x4 acc = {0.f, 0.f, 0.f, 0.f}; acc = mma_tile(VNT, 136, 16 * td, WSB, 136, 16 * tt, 128, acc, lane);
            const int tl = 16 * tt + fr; const size_t off = (r0 + tl) * 1024 + 128 * g + 16 * td + 4 * fq; const float bsv = F.gm_bs[g * 128 + tl];
            const v2u uw = *(const v2u*)(UV + off); v2u o;
            o.x = pk2(bflo(uw.x) * (acc[0] + bsv), bfhi(uw.x) * (acc[1] + bsv)); o.y = pk2(bflo(uw.y) * (acc[2] + bsv), bfhi(uw.y) * (acc[3] + bsv));
            *(v2u*)(MIX + off) = o; }
    }
    __syncthreads();
    pf_sink(F, pf);
}
__device__ __forceinline__ void p3_phase(Frame& F) {
    for (int it = F.vcu; it < 1056 + 512; it += F.G) { if (it < 1056) gdn_item(F, it); else gmlp_item(F, it - 1056); }
}
constexpr size_t WS_CB = 112 * MiB;
constexpr size_t WS_ZT = 136 * MiB;
constexpr size_t WS_XB = 140 * MiB;
constexpr size_t WS_CORRF = 200 * MiB, WS_CORRB = 216 * MiB;
__device__ __forceinline__ void p4_scan(Frame& F) {
    const int j14 = F.vcu & 31;
    if (j14 >= 28) return;
    const int chain = 2 * (F.vcu >> 5) + (j14 >= 14 ? 1 : 0), role = j14 % 14;
    const int g = role < 2 ? 0 : 1 + ((role - 2) >> 2), kindP = role < 2 ? 0 : ((role - 2) >> 1) & 1, ch = role < 2 ? role : (role - 2) & 1;
    const int b = chain >> 3, h = (chain >> 1) & 3, d = chain & 1, c0 = ch * 64;
    const int NS = g == 0 ? 36 : 32;
    constexpr int BUFB = 65536, ST_OFF = 2 * BUFB, VNT_OFF = ST_OFF + 64 * 288, EGS_OFF = VNT_OFF + 64 * 160;
    const unsigned char* gdn = F.ws + WS_GDN; const float* EGL = (const float*)(F.ws + WS_EGL);
    const int lane = F.lane, wave = F.wave;
#define P4_SLOT(s) (g == 0 ? ((s) < 4 ? 1024 + (b * 4 + h) * 4 + (d ? 3 - (s) : (s)) : (b * 4 + h) * 128 + (d ? 127 - ((s) - 4) : ((s) - 4))) : (b * 4 + h) * 128 + (d ? 127 - (32 * g + (s)) : (32 * g + (s))))
#define P4_BAR() do { asm volatile("s_waitcnt lgkmcnt(0)" ::: "memory"); __builtin_amdgcn_s_barrier(); asm volatile("" ::: "memory"); } while (0)
    if (wave >= 4) {
        const int lw = wave - 4;
#define P4_ISSUE(s, bufi) do { const unsigned char* gb = gdn + (size_t)(P4_SLOT(s) * 2 + d) * GDN_UNIT; \
            _Pragma("unroll") for (int q = 0; q < 14; ++q) { const int k = lw + 4 * q; unsigned so; \
                if (k < 32) { const int qi = (k & 15) * 64 + lane, r = qi >> 4, sl = qi & 15; so = (unsigned)((k >> 4) * 16384 + r * 256 + ((sl ^ (r & 15)) << 4)); } \
                else { const int kk = k < 48 ? k - 32 : k - 48, qi = kk * 64 + lane, r = qi >> 3, sl = qi & 7; so = (unsigned)((k < 48 ? 32768 : 49152) + r * 128 + ((sl ^ ((r >> 1) & 7)) << 4)); } \
                __builtin_amdgcn_global_load_lds((const unsigned*)(gb + so), (LAS unsigned*)(F.lds + (bufi) * BUFB + k * 1024), 16, 0, 0); } \
            if (!kindP) { _Pragma("unroll") for (int q = 0; q < 2; ++q) { const int k = lw + 4 * q;       \
                __builtin_amdgcn_global_load_lds((const unsigned*)(gb + 57344 + (size_t)c0 * 128 + k * 1024 + lane * 16), (LAS unsigned*)(F.lds + (bufi) * BUFB + 57344 + k * 1024), 16, 0, 0); } } } while (0)
#define P4_TOUCH(s, ta, tb) do { const unsigned char* gb = gdn + (size_t)(P4_SLOT(s) * 2 + d) * GDN_UNIT; const int li = lw * 64 + lane, l2 = li < 192 ? li + 256 : 448 + c0 + (li - 192);   \
            ta = *(const GAS unsigned*)(gb + (size_t)li * 128); tb = *(const GAS unsigned*)(gb + (size_t)l2 * 128); } while (0)
#define P4_LSTEP(s, tnew0, tnew1, told0, told1) do { const int cur_ = (s) & 1; \
            asm volatile("" :: "v"(told0), "v"(told1)); \
            if ((s) + 1 < NS) P4_ISSUE((s) + 1, cur_ ^ 1); \
            if ((s) + 3 < NS) { P4_TOUCH((s) + 3, tnew0, tnew1); P4_BAR(); asm volatile("s_waitcnt vmcnt(2)" ::: "memory"); } \
            else { P4_BAR(); asm volatile("s_waitcnt vmcnt(0)" ::: "memory"); } \
            P4_BAR(); } while (0)
        unsigned ta = 0u, tb = 0u, tc = 0u, td = 0u;
        P4_ISSUE(0, 0);
        P4_TOUCH(1, ta, tb);
        P4_TOUCH(2, tc, td);
        VM_WAIT(); P4_BAR();
        asm volatile("" :: "v"(ta), "v"(tb));
#pragma unroll 1
        for (int s = 0; s < NS; s += 2) {
            P4_LSTEP(s, ta, tb, tc, td);
            P4_LSTEP(s + 1, tc, td, ta, tb);
        }
        asm volatile("" :: "v"(ta), "v"(tb), "v"(tc), "v"(td));
#undef P4_LSTEP
#undef P4_TOUCH
#undef P4_ISSUE
    } else {
        const int m = wave, fr = lane & 15, fq = lane >> 4;
        for (int i = F.tid; i < 64 * 72; i += 256) { const int c = i / 72, w4 = i % 72;
            unsigned v = 0u; if (kindP) { const int dk = c0 + c; if ((dk >> 1) == w4) v = (dk & 1) ? 0x3F800000u : 0x00003F80u; }
            ((LAS unsigned*)(F.lds + ST_OFF))[i] = v; }
        f32x4 S[2][4];
#pragma unroll
        for (int t2 = 0; t2 < 2; ++t2)
#pragma unroll
            for (int n = 0; n < 4; ++n) {
#pragma unroll
                for (int jj = 0; jj < 4; ++jj) S[t2][n][jj] = (kindP && (32 * m + 16 * t2 + 4 * fq + jj == c0 + 16 * n + fr)) ? 1.0f : 0.0f; }
        bf16* OD = (bf16*)(F.ws + (d ? WS_OB : WS_OF)); bf16* CB = (bf16*)(F.ws + WS_CB);
        for (int i = F.tid; i < NS; i += 256) ((LAS float*)(F.lds + EGS_OFF))[i] = EGL[P4_SLOT(i) * 2 + d];
        P4_BAR();
#pragma unroll 1
        for (int s = 0; s < NS; ++s) {
            const int cur = s & 1; const LAS unsigned char* buf = F.lds + cur * BUFB; LAS unsigned char* ST = F.lds + ST_OFF; LAS unsigned char* VNT = F.lds + VNT_OFF;
            const float eg = ((const LAS float*)(F.lds + EGS_OFF))[s];
            bf16x8 bS[4][4]; f32x4 acc[4];
#pragma unroll
            for (int n = 0; n < 4; ++n) acc[n] = (f32x4){0.f, 0.f, 0.f, 0.f};
            const int r = 16 * m + fr;
#pragma unroll
            for (int ks = 0; ks < 4; ++ks) { const bf16x8 a = *(const LAS bf16x8*)(buf + r * 256 + (((4 * ks + fq) ^ fr) << 4));
#pragma unroll
                for (int n = 0; n < 4; ++n) { bS[n][ks] = *(const LAS bf16x8*)(ST + (16 * n + fr) * 288 + (32 * ks + 8 * fq) * 2); acc[n] = __builtin_amdgcn_mfma_f32_16x16x32_bf16(a, bS[n][ks], acc[n], 0, 0, 0); } }
#pragma unroll
            for (int n = 0; n < 4; ++n) { v2u ucn = {0u, 0u}; if (!kindP) ucn = *(const LAS v2u*)(buf + 57344 + (16 * n + fr) * 128 + (16 * m + 4 * fq) * 2);
                const float v0 = bflo(ucn.x) - acc[n][0], v1 = bfhi(ucn.x) - acc[n][1], v2 = bflo(ucn.y) - acc[n][2], v3 = bfhi(ucn.y) - acc[n][3]; v2u o; o.x = pk2(v0, v1); o.y = pk2(v2, v3);
                *(LAS v2u*)(VNT + (16 * n + fr) * 160 + (16 * m + 4 * fq) * 2) = o; }
            P4_BAR();
            bf16x8 bV[4][2];
#pragma unroll
            for (int n = 0; n < 4; ++n)
#pragma unroll
                for (int ks = 0; ks < 2; ++ks) bV[n][ks] = *(const LAS bf16x8*)(VNT + (16 * n + fr) * 160 + (32 * ks + 8 * fq) * 2);
            if (g > 0 || s >= 4) {
                f32x4 o[4];
#pragma unroll
                for (int n = 0; n < 4; ++n) o[n] = (f32x4){0.f, 0.f, 0.f, 0.f};
#pragma unroll
                for (int ks = 0; ks < 4; ++ks) { const bf16x8 a = *(const LAS bf16x8*)(buf + 16384 + r * 256 + (((4 * ks + fq) ^ fr) << 4));
#pragma unroll
                    for (int n = 0; n < 4; ++n) o[n] = __builtin_amdgcn_mfma_f32_16x16x32_bf16(bS[n][ks], a, o[n], 0, 0, 0); }
#pragma unroll
                for (int ks = 0; ks < 2; ++ks) { const bf16x8 a = *(const LAS bf16x8*)(buf + 49152 + r * 128 + (((4 * ks + fq) ^ ((r >> 1) & 7)) << 4));
#pragma unroll
                    for (int n = 0; n < 4; ++n) o[n] = __builtin_amdgcn_mfma_f32_16x16x32_bf16(bV[n][ks], a, o[n], 0, 0, 0); }
                const int sp = g == 0 ? s - 4 : 32 * g + s;
                const int i = 16 * m + fr;
                if (kindP) { bf16* cb = CB + ((size_t)(chain * 96 + (sp - 32)) * 64 + i) * 128 + c0 + 4 * fq;
#pragma unroll
                    for (int n = 0; n < 4; ++n) { v2u w; w.x = pk2(o[n][0], o[n][1]); w.y = pk2(o[n][2], o[n][3]); *(v2u*)(cb + 16 * n) = w; } }
                else { const int nn = d ? 127 - sp : sp, tl = d ? 63 - i : i; bf16* op = OD + ((size_t)b * T + 64 * nn + tl) * 512 + h * 128 + c0 + 4 * fq;
#pragma unroll
                    for (int n = 0; n < 4; ++n) { v2u w; w.x = pk2(o[n][0], o[n][1]); w.y = pk2(o[n][2], o[n][3]); *(v2u*)(op + 16 * n) = w; } }
            }
#pragma unroll
            for (int t2 = 0; t2 < 2; ++t2)
#pragma unroll
                for (int n = 0; n < 4; ++n) S[t2][n] *= eg;
#pragma unroll
            for (int ks = 0; ks < 2; ++ks)
#pragma unroll
                for (int t2 = 0; t2 < 2; ++t2) { const int rr = 32 * m + 16 * t2 + fr; const bf16x8 a = *(const LAS bf16x8*)(buf + 32768 + rr * 128 + (((4 * ks + fq) ^ ((rr >> 1) & 7)) << 4));
#pragma unroll
                    for (int n = 0; n < 4; ++n) S[t2][n] = __builtin_amdgcn_mfma_f32_16x16x32_bf16(a, bV[n][ks], S[t2][n], 0, 0, 0); }
#pragma unroll
            for (int t2 = 0; t2 < 2; ++t2)
#pragma unroll
                for (int n = 0; n < 4; ++n) { v2u o; o.x = pk2(S[t2][n][0], S[t2][n][1]); o.y = pk2(S[t2][n][2], S[t2][n][3]); *(LAS v2u*)(ST + (16 * n + fr) * 288 + (32 * m + 16 * t2 + 4 * fq) * 2) = o; }
            P4_BAR();
        }
        if (g < 3 && !kindP) { float* zt = (float*)(F.ws + WS_ZT) + (size_t)(chain * 4 + g) * 16384;
#pragma unroll
            for (int t2 = 0; t2 < 2; ++t2)
#pragma unroll
                for (int n = 0; n < 4; ++n) *(f32x4*)(zt + (c0 + 16 * n + fr) * 128 + 32 * m + 16 * t2 + 4 * fq) = S[t2][n]; }
        if (kindP && g < 3) { bf16* xb = (bf16*)(F.ws + WS_XB) + (size_t)(chain * 4 + g) * 16384;
#pragma unroll
            for (int t2 = 0; t2 < 2; ++t2)
#pragma unroll
                for (int n = 0; n < 4; ++n)
#pragma unroll
                    for (int jj = 0; jj < 4; ++jj) xb[(32 * m + 16 * t2 + 4 * fq + jj) * 128 + c0 + 16 * n + fr] = (bf16)f2bf(S[t2][n][jj]); }
    }
#undef P4_SLOT
#undef P4_BAR
}
__device__ __forceinline__ void p4b_correct(Frame& F) {
    if (F.vcu >= 192) return;
    const int chain = F.vcu / 12, g = 1 + (F.vcu % 12) / 4, qt = F.vcu & 3;
    const int b = chain >> 3, h = (chain >> 1) & 3, d = chain & 1;
    LAS bf16* Y = (LAS bf16*)F.lds;
    LAS bf16* Y2 = (LAS bf16*)(F.lds + 34816);
    LAS bf16* XL = (LAS bf16*)(F.lds + 69632);
    const float* ZT = (const float*)(F.ws + WS_ZT) + (size_t)chain * 4 * 16384; const bf16* XB = (const bf16*)(F.ws + WS_XB) + (size_t)chain * 4 * 16384;
    const int tid = F.tid, lane = F.lane, wave = F.wave, fr = lane & 15, fq = lane >> 4;
    for (int q = tid; q < 128 * 32; q += 512) { const int c = q >> 5, k4 = q & 31; const f32x4 z = *(const f32x4*)(ZT + c * 128 + 4 * k4); v2u o; o.x = pk2(z.x, z.y); o.y = pk2(z.z, z.w); *(LAS v2u*)(Y + c * 136 + 4 * k4) = o; }
    __syncthreads();
    LAS bf16* Yc = Y; LAS bf16* Yn = Y2;
#pragma unroll 1
    for (int gg = 1; gg < g; ++gg) {
        for (int q = tid; q < 128 * 16; q += 512) { const int rr = q >> 4, k8 = q & 15; *(LAS v4u*)(XL + rr * 136 + 8 * k8) = *(const v4u*)(XB + (size_t)gg * 16384 + rr * 128 + 8 * k8); }
        __syncthreads();
#pragma unroll 1
        for (int tn = 0; tn < 8; ++tn) { f32x4 acc = {0.f, 0.f, 0.f, 0.f}; acc = mma_tile(Yc, 136, 16 * wave, XL, 136, 16 * tn, 128, acc, lane);
#pragma unroll
            for (int jj = 0; jj < 4; ++jj) { const int col = 16 * wave + 4 * fq + jj, dk = 16 * tn + fr; Yn[col * 136 + dk] = (bf16)f2bf(acc[jj] + ZT[(size_t)gg * 16384 + col * 128 + dk]); } }
        __syncthreads();
        LAS bf16* t_ = Yc; Yc = Yn; Yn = t_;
    }
    bf16* OD = (bf16*)(F.ws + (d ? WS_CORRB : WS_CORRF)); const bf16* CB = (const bf16*)(F.ws + WS_CB);
#pragma unroll 1
    for (int cc = 0; cc < 8; ++cc) {
        const int sp = 32 * g + 8 * qt + cc, nn = d ? 127 - sp : sp; const bf16* cb = CB + ((size_t)(chain * 96 + (sp - 32)) * 64) * 128;
        for (int q = tid; q < 64 * 16; q += 512) { const int rr = q >> 4, k8 = q & 15; *(LAS v4u*)(XL + rr * 136 + 8 * k8) = *(const v4u*)(cb + rr * 128 + 8 * k8); }
        __syncthreads();
#pragma unroll 1
        for (int ti = 0; ti < 4; ++ti) { f32x4 acc = {0.f, 0.f, 0.f, 0.f}; acc = mma_tile(Yc, 136, 16 * wave, XL, 136, 16 * ti, 128, acc, lane);
            const int i = 16 * ti + fr, tl = d ? 63 - i : i; v2u w; w.x = pk2(acc[0], acc[1]); w.y = pk2(acc[2], acc[3]);
            *(v2u*)(OD + ((size_t)b * T + 64 * nn + tl) * 512 + h * 128 + 16 * wave + 4 * fq) = w; }
        __syncthreads();
    }
}
__device__ __forceinline__ void p5a_combine(Frame& F) {
    const bf16* OFp = (const bf16*)(F.ws + WS_OF); const bf16* OBp = (const bf16*)(F.ws + WS_OB); const bf16* Z = (const bf16*)(F.ws + WS_Z); bf16* MIX = (bf16*)(F.ws + WS_MIX);
    const int gw = F.vcu * NWAVES + F.wave, NGW = F.G * NWAVES, lane = F.lane;
    float gn[8];
#pragma unroll
    for (int e = 0; e < 8; ++e) gn[e] = F.gdn_norm_g[(lane & 15) * 8 + e];
    for (int m = gw; m < M; m += NGW) {
        const v4u a = *(const v4u*)(OFp + (size_t)m * 512 + lane * 8), bq = *(const v4u*)(OBp + (size_t)m * 512 + lane * 8), zz = *(const v4u*)(Z + (size_t)m * 512 + lane * 8);
        const int tt = m & (T - 1); v4u cf = {0u, 0u, 0u, 0u}, cbk = cf;
        if (tt >= 2048) cf = *(const v4u*)((const bf16*)(F.ws + WS_CORRF) + (size_t)m * 512 + lane * 8);
        if (tt < 6144) cbk = *(const v4u*)((const bf16*)(F.ws + WS_CORRB) + (size_t)m * 512 + lane * 8);
        float o[8]; float ss = 0.f;
#pragma unroll
        for (int e = 0; e < 4; ++e) { o[2 * e] = (bflo(a[e]) + bflo(bq[e])) + (bflo(cf[e]) + bflo(cbk[e])); o[2 * e + 1] = (bfhi(a[e]) + bfhi(bq[e])) + (bfhi(cf[e]) + bfhi(cbk[e])); ss += o[2 * e] * o[2 * e] + o[2 * e + 1] * o[2 * e + 1]; }
        ss += __shfl_xor(ss, 1); ss += __shfl_xor(ss, 2); ss += __shfl_xor(ss, 4); ss += __shfl_xor(ss, 8);
        const float rstd = 1.0f / sqrtf(ss * (1.0f / 128.0f) + EPS);
        float y[8];
#pragma unroll
        for (int e = 0; e < 4; ++e) { y[2 * e] = o[2 * e] * rstd * gn[2 * e] * silu1(bflo(zz[e])); y[2 * e + 1] = o[2 * e + 1] * rstd * gn[2 * e + 1] * silu1(bfhi(zz[e])); }
        v4u w; w.x = pk2(y[0], y[1]); w.y = pk2(y[2], y[3]); w.z = pk2(y[4], y[5]); w.w = pk2(y[6], y[7]);
        *(v4u*)(MIX + (size_t)m * 1024 + 512 + lane * 8) = w;
    }
}
__device__ __forceinline__ void p6_phase(Frame& F) {
    const float* MOD = (const float*)(F.ws + WS_MOD); const float* H1 = (const float*)(F.ws + WS_H1); bf16* FIN = (bf16*)(F.ws + WS_FIN);
    float* AFF = (float*)(F.ws + WS_AFF); int* SEL = (int*)(F.ws + WS_SEL);
    LAS float* WR = (LAS float*)F.lds;
    for (int i = F.tid; i < 1024 * 4; i += 512) { const int k = i >> 2, q = i & 3; *(LAS f32x4*)(WR + k * 20 + q * 4) = *(const f32x4*)(F.w_router + k * 16 + q * 4); }
    __syncthreads();
    const int gw = F.vcu * NWAVES + F.wave, NGW = F.G * NWAVES, lane = F.lane;
#pragma unroll 1
    for (int b = 0; b < 2; ++b) {
        const float* mv = MOD + b * 6144;
        float sc[16], sh[16];
#pragma unroll
        for (int j = 0; j < 16; ++j) { const int k = lane + 64 * j; sc[j] = F.norm2_g[k] * (1.0f + mv[4096 + k]); sh[j] = mv[3072 + k]; }
        for (int m = b * T + gw; m < (b + 1) * T; m += NGW) {
            const float* hr = H1 + (size_t)m * D; float v[16]; float ss = 0.f;
#pragma unroll
            for (int j = 0; j < 16; ++j) { v[j] = hr[lane + 64 * j]; ss += v[j] * v[j]; }
            const float rstd = 1.0f / sqrtf(wave_sum(ss) * (1.0f / D) + EPS);
            float lg[16];
#pragma unroll
            for (int e = 0; e < 16; ++e) lg[e] = 0.f;
            bf16* fr_ = FIN + (size_t)m * D;
#pragma unroll
            for (int j = 0; j < 16; ++j) { const float f = v[j] * rstd * sc[j] + sh[j]; fr_[lane + 64 * j] = (bf16)f2bf(f);
                const LAS float* wr = WR + (lane + 64 * j) * 20;
#pragma unroll
                for (int q = 0; q < 4; ++q) { const f32x4 w = *(const LAS f32x4*)(wr + 4 * q); lg[4 * q] += f * w.x; lg[4 * q + 1] += f * w.y; lg[4 * q + 2] += f * w.z; lg[4 * q + 3] += f * w.w; }
                asm volatile("" ::: "memory"); }
            float mx = -3.0e38f;
#pragma unroll
            for (int e = 0; e < 16; ++e) { lg[e] = wave_sum(lg[e]) + F.b_router[e]; mx = fmaxf(mx, lg[e]); }
            float den = 0.f;
#pragma unroll
            for (int e = 0; e < 16; ++e) { lg[e] = expf(lg[e] - mx); den += lg[e]; }
            float mine = 0.f;
#pragma unroll
            for (int e = 0; e < 16; ++e) mine = (lane == e) ? lg[e] : mine;
            if (lane < 16) { AFF[((size_t)b * 16 + lane) * T + (m - b * T)] = mine / den; SEL[(size_t)m * 16 + lane] = -1; }
        }
    }
}
__device__ __forceinline__ int block_excl_scan(int v, LAS int* tmp, int lane, int wave, int& total) {
    int inc = v;
#pragma unroll
    for (int o = 1; o < 64; o <<= 1) { const int y = __shfl_up(inc, o); if (lane >= o) inc += y; }
    if (lane == 63) tmp[wave] = inc;
    __syncthreads();
    int woff = 0, tot = 0;
#pragma unroll
    for (int w = 0; w < 8; ++w) { const int sv = tmp[w]; woff += (w < wave) ? sv : 0; tot += sv; }
    __syncthreads();
    total = tot; return woff + inc - v;
}
__device__ __forceinline__ void p7_topk(Frame& F) {
    const float* AFF = (const float*)(F.ws + WS_AFF); int* SEL = (int*)(F.ws + WS_SEL); int* IDX = (int*)(F.ws + WS_IDX); float* GATE = (float*)(F.ws + WS_GATE);
    LAS unsigned* vals = (LAS unsigned*)F.lds;
    LAS unsigned* hist = vals + 8192;
    LAS int* tmp = (LAS int*)(hist + 256);
    const int tid = F.tid, lane = F.lane, wave = F.wave;
    for (int u = F.vcu; u < 32; u += F.G) {
        const int b = u >> 4, e = u & 15; const float* ar = AFF + (size_t)u * T;
        for (int t = tid; t < T; t += 512) vals[t] = __builtin_bit_cast(unsigned, ar[t]);
        if (tid == 0) { tmp[8] = 0; tmp[9] = CAP; }
        __syncthreads();
#pragma unroll 1
        for (int pass = 0; pass < 4; ++pass) {
            const int shift = 24 - 8 * pass;
            if (tid < 256) hist[tid] = 0u;
            __syncthreads();
            const unsigned prefix = (unsigned)tmp[8], himask = pass == 0 ? 0u : (0xffffffffu << (shift + 8));
            for (int t = tid; t < T; t += 512) { const unsigned v = vals[t]; if ((v & himask) == prefix) __hip_atomic_fetch_add(hist + ((v >> shift) & 255u), 1u, __ATOMIC_RELAXED, __HIP_MEMORY_SCOPE_WORKGROUP); }
            __syncthreads();
            if (wave == 0) {
                const unsigned kth = (unsigned)tmp[9];
                const unsigned c0 = hist[255 - 4 * lane], c1 = hist[254 - 4 * lane], c2 = hist[253 - 4 * lane], c3 = hist[252 - 4 * lane], sm = c0 + c1 + c2 + c3;
                unsigned inc = sm;
#pragma unroll
                for (int o = 1; o < 64; o <<= 1) { const unsigned y = __shfl_up(inc, o); if (lane >= o) inc += y; }
                const unsigned exc = inc - sm;
                if (exc < kth && kth <= inc) { unsigned r = kth - exc; int bin;
                    if (r <= c0) bin = 255 - 4 * lane; else if (r <= c0 + c1) { bin = 254 - 4 * lane; r -= c0; } else if (r <= c0 + c1 + c2) { bin = 253 - 4 * lane; r -= c0 + c1; } else { bin = 252 - 4 * lane; r -= c0 + c1 + c2; }
                    tmp[8] = (int)(prefix | ((unsigned)bin << shift)); tmp[9] = (int)r; }
            }
            __syncthreads();
        }
        const unsigned thr = (unsigned)tmp[8]; const int kth = tmp[9];
        const int t0 = tid * 16; int cg = 0, ce = 0;
#pragma unroll
        for (int i = 0; i < 16; ++i) { const unsigned v = vals[t0 + i]; cg += (v > thr) ? 1 : 0; ce += (v == thr) ? 1 : 0; }
        int tot; const int eqb = block_excl_scan(ce, tmp, lane, wave, tot);
        int take = kth - eqb; take = take < 0 ? 0 : (take > ce ? ce : take);
        int pos = block_excl_scan(cg + take, tmp, lane, wave, tot); int eqseen = 0;
#pragma unroll 1
        for (int i = 0; i < 16; ++i) { const unsigned v = vals[t0 + i]; bool sel = v > thr; if (v == thr) { sel = eqseen < take; ++eqseen; }
            if (sel) { const int t = t0 + i; IDX[u * CAP + pos] = b * T + t; GATE[u * CAP + pos] = __builtin_bit_cast(float, v); SEL[((size_t)b * T + t) * 16 + e] = pos; ++pos; } }
        __syncthreads();
    }
}
__device__ __forceinline__ void p7b_gather(Frame& F) {
    const int* IDX = (const int*)(F.ws + WS_IDX); const bf16* FIN = (const bf16*)(F.ws + WS_FIN); bf16* XE = (bf16*)(F.ws + WS_XE);
    const int gw = F.vcu * NWAVES + F.wave, NGW = F.G * NWAVES, lane = F.lane;
    for (int r = gw; r < 32 * CAP; r += NGW) { const int src = IDX[r]; const v4u* sp = (const v4u*)(FIN + (size_t)src * D); v4u* dp = (v4u*)(XE + (size_t)r * D);
        const v4u a = sp[lane], c = sp[lane + 64]; dp[lane] = a; dp[lane + 64] = c; }
}
__device__ __forceinline__ void p10_final(Frame& F) {
    const float* MOD = (const float*)(F.ws + WS_MOD); const float* H1 = (const float*)(F.ws + WS_H1); const bf16* YE = (const bf16*)(F.ws + WS_YE); const int* SEL = (const int*)(F.ws + WS_SEL);
    const int gw = F.vcu * NWAVES + F.wave, NGW = F.G * NWAVES, lane = F.lane;
#pragma unroll 1
    for (int b = 0; b < 2; ++b) {
        f32x4 gt[4], fg[4];
#pragma unroll
        for (int j = 0; j < 4; ++j) { gt[j] = *(const f32x4*)(MOD + b * 6144 + 5120 + 4 * lane + 256 * j); fg[j] = *(const f32x4*)(F.final_norm_g + 4 * lane + 256 * j); }
        for (int m = b * T + gw; m < (b + 1) * T; m += NGW) {
            const int selv = lane < 16 ? SEL[(size_t)m * 16 + lane] : -1;
            f32x4 acc[4];
#pragma unroll
            for (int j = 0; j < 4; ++j) acc[j] = (f32x4){0.f, 0.f, 0.f, 0.f};
#pragma unroll 1
            for (int e = 0; e < 16; ++e) { const int cpos = __shfl(selv, e);
                if (cpos >= 0) { const bf16* yr = YE + ((size_t)(b * 16 + e) * CAP + cpos) * D + 4 * lane;
#pragma unroll
                    for (int j = 0; j < 4; ++j) { const v2u w = *(const v2u*)(yr + 256 * j); acc[j] += (f32x4){bflo(w.x), bfhi(w.x), bflo(w.y), bfhi(w.y)}; } } }
            f32x4 hv[4]; float ss = 0.f;
#pragma unroll
            for (int j = 0; j < 4; ++j) { hv[j] = *(const f32x4*)(H1 + (size_t)m * D + 4 * lane + 256 * j) + gt[j] * acc[j]; ss += (hv[j].x * hv[j].x + hv[j].y * hv[j].y) + (hv[j].z * hv[j].z + hv[j].w * hv[j].w); }
            const float rstd = 1.0f / sqrtf(wave_sum(ss) * (1.0f / D) + EPS);
#pragma unroll
            for (int j = 0; j < 4; ++j) *(f32x4*)(F.out + (size_t)m * D + 4 * lane + 256 * j) = hv[j] * rstd * fg[j];
        }
    }
}
struct Args { const float* in[23]; float* out; unsigned char* ws; int ph_lo, ph_hi; };
__global__ void __launch_bounds__(NWAVES * 64, 2) fwd_kernel(Args args) {
    extern __shared__ __attribute__((aligned(16))) unsigned char lds_raw[];
    Frame F;
    F.lds = (LAS unsigned char*)lds_raw;
    volatile LAS unsigned* MISC = (volatile LAS unsigned*)(F.lds + MISC_OFF);
    F.tid = threadIdx.x; F.lane = F.tid & 63; F.wave = __builtin_amdgcn_readfirstlane(F.tid >> 6);
    F.G = gridDim.x; { const int bx = blockIdx.x; F.vcu = (F.G % 8 == 0) ? (bx % 8) * (F.G / 8) + bx / 8 : bx; }
    F.ws = args.ws; F.out = args.out;
    F.x = args.in[0]; F.c = args.in[1]; F.ctx = args.in[2]; F.c_ctx = args.in[3]; F.w_mod = args.in[4]; F.b_mod = args.in[5]; F.norm1_g = args.in[6]; F.norm2_g = args.in[7];
    F.w_in = args.in[8]; F.conv_w = args.in[9]; F.a_log = args.in[10]; F.dt_bias = args.in[11]; F.gdn_norm_g = args.in[12]; F.gm_norm_g = args.in[13]; F.gm_ws = args.in[14]; F.gm_bs = args.in[15];
    F.w_out = args.in[16]; F.w_router = args.in[17]; F.b_router = args.in[18]; F.w_gate = args.in[19]; F.w_up = args.in[20]; F.w_down = args.in[21]; F.final_norm_g = args.in[22];
    for (int u = F.tid; u < 64; u += NWAVES * 64) MISC[u] = 0u;
    __syncthreads();
    XcdBarrier bar; bar.bar = (unsigned*)(F.ws + WS_CTL) + CW_BAR; bar.x = 0; bar.st = nullptr;
    if (!MK_PER_PHASE) bar = xcd_barrier_post((unsigned*)(F.ws + WS_CTL) + CW_BAR, MISC + 8);
    const int lo = args.ph_lo, hi = args.ph_hi;
#define IN(k) (lo <= (k) && (k) < hi)
#define SEAM(k) do { if (IN(k) && IN((k) + 1)) xcd_barrier(bar); } while (0)
    if (IN(0)) { p0_phase(F); } SEAM(0);
    if (IN(1)) { p1_phase(F); } SEAM(1);
    if (IN(2)) {
        pg8::Gemm g{(const bf16*)(F.ws + WS_AIN), (const bf16*)(F.ws + WS_WIN), MA, 3328, D, 0, 0, 0}; pg8::StaticOrder S; S.init(MA, 3328, F.G, (int)blockIdx.x);
        pg8::EpiInProj E{(bf16*)(F.ws + WS_QKV), (bf16*)(F.ws + WS_Z), (bf16*)(F.ws + WS_UV), (float*)(F.ws + WS_AB)};
        pg8::gemm_phase<pg8::EpiInProj, pg8::StaticOrder, PG8_ALIGN, PG8_SP2>(F.lds, g, S, E);
    } SEAM(2);
    if (IN(3)) { p3_phase(F); } SEAM(3);
    if (IN(4)) { p4_scan(F); } SEAM(4);
    if (IN(5)) { p4b_correct(F); } SEAM(5);
    if (IN(6)) { p5a_combine(F); wgu_convert(F); } SEAM(6);
    if (IN(7)) {
        pg8::Gemm g{(const bf16*)(F.ws + WS_MIX), (const bf16*)(F.ws + WS_WOUT), M, D, D, 0, 0, 0}; pg8::StaticOrder S; S.init(M, D, F.G, (int)blockIdx.x);
        pg8::EpiOutProj E{F.x, (const float*)(F.ws + WS_MOD), (float*)(F.ws + WS_H1)};
        pg8::gemm_phase<pg8::EpiOutProj, pg8::StaticOrder, PG8_ALIGN, PG8_SP2>(F.lds, g, S, E);
    } SEAM(7);
    if (IN(8)) { p6_phase(F); } SEAM(8);
    if (IN(9)) { p7_topk(F); } SEAM(9);
    if (IN(10)) { p7b_gather(F); } SEAM(10);
    if (IN(11)) {
        pg8::Gemm g{(const bf16*)(F.ws + WS_XE), (const bf16*)(F.ws + WS_WGU), 32 * CAP, 2 * FF, D, (size_t)2 * FF * D * 2, 2, 15}; pg8::StaticOrder S; S.init(32 * CAP, 2 * FF, F.G, (int)blockIdx.x);
        pg8::EpiSwiGLU E{(bf16*)(F.ws + WS_HID)};
        pg8::gemm_phase<pg8::EpiSwiGLU, pg8::StaticOrder, PG8_ALIGN, PG8_SP2>(F.lds, g, S, E);
    } SEAM(11);
    if (IN(12)) { wd_convert(F); } SEAM(12);
    if (IN(13)) {
        pg8::Gemm g{(const bf16*)(F.ws + WS_HID), (const bf16*)(F.ws + WS_WD), 32 * CAP, D, FF, (size_t)D * FF * 2, 2, 15}; pg8::StaticOrder S; S.init(32 * CAP, D, F.G, (int)blockIdx.x);
        pg8::EpiDown E{(bf16*)(F.ws + WS_YE), (const float*)(F.ws + WS_GATE)};
        pg8::gemm_phase<pg8::EpiDown, pg8::StaticOrder, PG8_ALIGN, PG8_SP2>(F.lds, g, S, E);
    } SEAM(13);
    if (IN(14)) { p10_final(F); }
#undef IN
#undef SEAM
}

extern "C" void kernel_launch(void* const* d_in, const int* in_sizes, int n_in, void* d_out, int out_size, void* d_ws, size_t ws_size, hipStream_t stream) {
    static int grid = 0;
    if (grid == 0) {
        if (n_in != 23 || out_size != M * D || ws_size < WS_END) { fprintf(stderr, "kernel_launch: unexpected problem (n_in %d, out %d, ws %zu)\n", n_in, out_size, ws_size); grid = -1; return; }
        int dev = 0, cus = 0;
        if (hipGetDevice(&dev) != hipSuccess || hipDeviceGetAttribute(&cus, hipDeviceAttributeMultiprocessorCount, dev) != hipSuccess) { grid = -1; return; }
        if (hipFuncSetAttribute((const void*)fwd_kernel, hipFuncAttributeMaxDynamicSharedMemorySize, LDS_BYTES) != hipSuccess) { fprintf(stderr, "kernel_launch: hipFuncSetAttribute failed\n"); grid = -1; return; }
        grid = cus;
    }
    if (grid < 0) return;
    if (hipMemsetAsync((char*)d_ws + WS_CTL, 0, CTL_ZERO_BYTES, stream) != hipSuccess) return;
    Args a{};
    for (int i = 0; i < 23; ++i) a.in[i] = (const float*)d_in[i];
    a.out = (float*)d_out; a.ws = (unsigned char*)d_ws;
#if MK_PER_PHASE
    for (int p = 0; p < NPHASE; ++p) { a.ph_lo = p; a.ph_hi = p + 1; hipLaunchKernelGGL(fwd_kernel, dim3(grid), dim3(NWAVES * 64), LDS_BYTES, stream, a); }
#else
    a.ph_lo = 0; a.ph_hi = NPHASE;
    hipLaunchKernelGGL(fwd_kernel, dim3(grid), dim3(NWAVES * 64), LDS_BYTES, stream, a);
#endif
}
```

```cpp
#include <hip/hip_runtime.h>
#include <cstdio>
#include <cstdint>
namespace pg8 {
#define PG8_LAS __attribute__((address_space(3)))
typedef unsigned short bf16_t;
typedef short bf16x8 __attribute__((ext_vector_type(8)));
typedef float f32x4 __attribute__((ext_vector_type(4)));
typedef unsigned u32x4 __attribute__((ext_vector_type(4)));
constexpr int BM = 256, BK = 64, HALF = 128, HTB = HALF * BK * 2  , STAGE_BYTES = 8 * HTB, NXCD = 8, WGM = 8;

__host__ __device__ __forceinline__ int lds_byte(int r, int c) { const int st = (r >> 4) * 2 + (c >> 5), rr = r & 15, cc = c & 31, ob = rr * 64 + cc * 2; return st * 1024 + (ob ^ (((ob >> 9) & 1) << 5)); }
__host__ __device__ __forceinline__ void stage_rc(int b, int& R, int& C) { const int st = b / 1024, sb = b % 1024, swz = sb ^ (((sb >> 9) & 1) << 5); R = (st >> 1) * 16 + swz / 64; C = (st & 1) * 32 + (swz % 64) / 2; }
__host__ __device__ __forceinline__ int perm32(int rho) { const int n = rho >> 4, i = rho & 15; return 8 * (i >> 2) + 4 * n + (i & 3); }

struct Unit { int pm, pn; };
struct Gemm { const bf16_t* A; const bf16_t* Bt; int M, N, K; size_t bgs; int gsh, gmask; const int* gidx; };

struct StaticOrder {
    int nM, nN, nwg, G, c;
    __host__ __device__ void init(int M, int N, int G_, int c_) { nM = M / BM; nN = N / BM; nwg = nM * nN; G = G_; c = c_; }
    __host__ __device__ bool next(int i, Unit& u) const {
        const long L = (long)i * G + c; if (L >= nwg) return false;
        int wgid = (int)L; { const int q = nwg / NXCD, r = nwg % NXCD, xcd = wgid % NXCD, off = wgid / NXCD; wgid = (xcd < r ? xcd * (q + 1) : r * (q + 1) + (xcd - r) * q) + off; }
        const int nig = WGM * nN, gid = wgid / nig, fm = gid * WGM, gsz = (nM - fm) < WGM ? (nM - fm) : WGM;
        u.pm = fm + ((wgid % nig) % gsz); u.pn = (wgid % nig) / gsz; return true;
    }
    __device__ __forceinline__ void a_ready(const Unit&) const {}
    __device__ __forceinline__ void done(const Unit&) const {}
};

__device__ __forceinline__ unsigned cvt_pk_bf16(float lo, float hi) { unsigned r; asm volatile("v_cvt_pk_bf16_f32 %0, %1, %2" : "=v"(r) : "v"(lo), "v"(hi)); return r; }
typedef float f32x2 __attribute__((ext_vector_type(2)));
__device__ __forceinline__ f32x2 gelu_pk(f32x2 v) {
    const f32x2 av = __builtin_elementwise_abs(v), d = av * 0.2316418882f + 1.0f;
    f32x2 t; t.x = __builtin_amdgcn_rcpf(d.x); t.y = __builtin_amdgcn_rcpf(d.y);
    f32x2 q = t * 0.5307027145f + (-0.7265760135f); q = q * t + 0.7107068705f; q = q * t + (-0.142248368f); q = q * t + 0.127414796f; q = q * t;
    const f32x2 s = (v * v) * (-0.72134752044f);
    f32x2 e; e.x = __builtin_amdgcn_exp2f(s.x); e.y = __builtin_amdgcn_exp2f(s.y);
    const f32x2 m = v * (q * e), r = v - m;
    f32x2 o; o.x = v.x < 0.f ? m.x : r.x; o.y = v.y < 0.f ? m.y : r.y; return o;
}
__device__ __forceinline__ float silu_f(float x) { return x * __builtin_amdgcn_rcpf(1.0f + __expf(-x)); }
__device__ __forceinline__ void st8(bf16_t* p, const f32x4 v0, const f32x4 v1) { u32x4 w; w.x = cvt_pk_bf16(v0[0], v0[1]); w.y = cvt_pk_bf16(v0[2], v0[3]); w.z = cvt_pk_bf16(v1[0], v1[1]); w.w = cvt_pk_bf16(v1[2], v1[3]); *(u32x4*)p = w; }
struct EpiInProj {
    static constexpr bool PERM = true, AFTER_DRAIN = false;
    bf16_t* QKV; bf16_t* Z; bf16_t* UV; float* AB;
    __device__ __forceinline__ void operator()(const f32x4 (&acc)[2][2][4][2], const Unit& u, int wr, int wc, int fr, int fq) const {
        const int row0 = u.pm * BM + wr * 64 + fr, pn = u.pn;
        if (pn == 12) {
            if (wc == 0 && fq < 2) {
#pragma unroll
                for (int ai = 0; ai < 2; ++ai)
#pragma unroll
                    for (int m = 0; m < 4; ++m) { float* p = AB + (size_t)(row0 + ai * HALF + m * 16) * 16 + 8 * fq; *(f32x4*)p = acc[ai][0][m][0]; *(f32x4*)(p + 4) = acc[ai][0][m][1]; }
            }
            return;
        }
        bf16_t* base; int ldc, colt; bool act = false;
        if (pn < 6) { base = QKV; ldc = 1536; colt = pn * 256; }
        else { if (u.pm >= 64) return; if (pn < 8) { base = Z; ldc = 512; colt = (pn - 6) * 256; } else { base = UV; ldc = 1024; colt = (pn - 8) * 256; act = true; } }
        const int col0 = colt + wc * 32 + 8 * fq;
#pragma unroll
        for (int ai = 0; ai < 2; ++ai)
#pragma unroll
            for (int m = 0; m < 4; ++m) { bf16_t* rowp = base + (size_t)(row0 + ai * HALF + m * 16) * ldc + col0;
#pragma unroll
                for (int bj = 0; bj < 2; ++bj) { f32x4 v0 = acc[ai][bj][m][0], v1 = acc[ai][bj][m][1];
                    if (act) { f32x2 a = gelu_pk((f32x2){v0[0], v0[1]}), b = gelu_pk((f32x2){v0[2], v0[3]}), c = gelu_pk((f32x2){v1[0], v1[1]}), d = gelu_pk((f32x2){v1[2], v1[3]});
                        v0 = (f32x4){a.x, a.y, b.x, b.y}; v1 = (f32x4){c.x, c.y, d.x, d.y}; }
                    st8(rowp + bj * HALF, v0, v1); } }
    }
};
struct EpiOutProj {
    static constexpr bool PERM = false, AFTER_DRAIN = false;
    const float* x; const float* mod; float* H1;
    __device__ __forceinline__ void operator()(const f32x4 (&acc)[2][2][4][2], const Unit& u, int wr, int wc, int fr, int fq) const {
        const int row0 = u.pm * BM + wr * 64 + fr, col0 = u.pn * BM + wc * 32 + 4 * fq; const float* gt = mod + (u.pm >= 32 ? 6144 : 0) + 2048;
        f32x4 gv[2][2];
#pragma unroll
        for (int bj = 0; bj < 2; ++bj)
#pragma unroll
            for (int n = 0; n < 2; ++n) gv[bj][n] = *(const f32x4*)(gt + col0 + bj * HALF + n * 16);
#pragma unroll
        for (int ai = 0; ai < 2; ++ai)
#pragma unroll
            for (int m = 0; m < 4; ++m) { const size_t off = (size_t)(row0 + ai * HALF + m * 16) * 1024 + col0;
#pragma unroll
                for (int bj = 0; bj < 2; ++bj)
#pragma unroll
                    for (int n = 0; n < 2; ++n) { const f32x4 xv = *(const f32x4*)(x + off + bj * HALF + n * 16); *(f32x4*)(H1 + off + bj * HALF + n * 16) = xv + gv[bj][n] * acc[ai][bj][m][n]; } }
    }
};
struct EpiSwiGLU {
    static constexpr bool PERM = true, AFTER_DRAIN = false;
    bf16_t* HID;
    __device__ __forceinline__ void operator()(const f32x4 (&acc)[2][2][4][2], const Unit& u, int wr, int wc, int fr, int fq) const {
        const int row0 = u.pm * BM + wr * 64 + fr, col0 = u.pn * HALF + wc * 32 + 8 * fq;
#pragma unroll
        for (int ai = 0; ai < 2; ++ai)
#pragma unroll
            for (int m = 0; m < 4; ++m) { bf16_t* rowp = HID + (size_t)(row0 + ai * HALF + m * 16) * 1024 + col0; f32x4 h0, h1;
#pragma unroll
                for (int j = 0; j < 4; ++j) { h0[j] = silu_f(acc[ai][0][m][0][j]) * acc[ai][1][m][0][j]; h1[j] = silu_f(acc[ai][0][m][1][j]) * acc[ai][1][m][1][j]; }
                st8(rowp, h0, h1); }
    }
};
struct EpiDown {
    static constexpr bool PERM = true, AFTER_DRAIN = false;
    bf16_t* YE; const float* gate;
    __device__ __forceinline__ void operator()(const f32x4 (&acc)[2][2][4][2], const Unit& u, int wr, int wc, int fr, int fq) const {
        const int row0 = u.pm * BM + wr * 64 + fr, col0 = u.pn * BM + wc * 32 + 8 * fq;
#pragma unroll
        for (int ai = 0; ai < 2; ++ai)
#pragma unroll
            for (int m = 0; m < 4; ++m) { const int row = row0 + ai * HALF + m * 16; const float gv = gate[row]; bf16_t* rowp = YE + (size_t)row * 1024 + col0;
#pragma unroll
                for (int bj = 0; bj < 2; ++bj) st8(rowp + bj * HALF, acc[ai][bj][m][0] * gv, acc[ai][bj][m][1] * gv); }
    }
};
template <class Epi, class Sched, bool ALIGN_EPI = false, bool SP2 = false, bool GATHER = false>
__device__ __forceinline__ void gemm_phase(PG8_LAS unsigned char* lds, const Gemm g, const Sched& S, const Epi& E, PG8_LAS unsigned char* idx_lds = nullptr) {
    static_assert(!GATHER || SP2, "the gathered-A form exists only for the SP2 loop");
    const int tid = threadIdx.x, wid = __builtin_amdgcn_readfirstlane(tid >> 6), lane = tid & 63, wr = wid >> 2, wc = wid & 3, fr = lane & 15, fq = lane >> 4;
    const int K = g.K, nt = K / BK;
    unsigned voffA[2], voffB[2], colA2[2]; int rowA[2];
#pragma unroll
    for (int i = 0; i < 2; ++i) { int R, C; stage_rc(tid * 16 + i * 8192, R, C); const int Rb = Epi::PERM ? ((R & ~31) + perm32(R & 31)) : R;
        voffA[i] = (unsigned)(R * K + C) * 2u; voffB[i] = (unsigned)(Rb * K + C) * 2u; rowA[i] = R; colA2[i] = (unsigned)C * 2u; }
    unsigned gc[2][2] = {{0u, 0u}, {0u, 0u}}, gn[2][2] = {{0u, 0u}, {0u, 0u}};
    const size_t kstep = (size_t)(BK * 2);
    const size_t hstep = (size_t)HALF * K * 2;
    const size_t tstep = 2 * hstep;
    const unsigned ldsw = (unsigned)wid * 1024u;
    const int aoff = lds_byte(wr * 64 + fr, fq * 8), boff = lds_byte(wc * 32 + fr, fq * 8);
#define PG8_SA(b, h) (((b) * 2 + (h)) * HTB)
#define PG8_SB(b, h) ((4 + (b) * 2 + (h)) * HTB)
#define PG8_STAGE(bufoff, gbase, voff) do { _Pragma("unroll") for (int _i = 0; _i < 2; ++_i) \
        __builtin_amdgcn_global_load_lds((const unsigned*)((const char*)(gbase) + (voff)[_i]), (PG8_LAS unsigned*)(lds + (bufoff) + ldsw + _i * 8192), 16, 0, 0); } while (0)
#define PG8_STAGE_A(bufoff, ptr, hh, offs) do { if constexpr (GATHER) { PG8_STAGE(bufoff, ptr, offs[hh]); } else { PG8_STAGE(bufoff, (ptr) + (hh) * hstep, voffA); } } while (0)
#define PG8_GOFFS(dst, bufi) do { _Pragma("unroll") for (int h_ = 0; h_ < 2; ++h_) _Pragma("unroll") for (int i_ = 0; i_ < 2; ++i_) \
        dst[h_][i_] = (unsigned)(((const PG8_LAS int*)(idx_lds + (bufi) * 1024))[h_ * HALF + rowA[i_]]) * (unsigned)(K * 2) + colA2[i_]; } while (0)
#define PG8_IDX_ISSUE(unit, bufi) do { if (wid == 0) __builtin_amdgcn_global_load_lds((const unsigned*)(g.gidx + (size_t)(unit).pm * BM + lane * 4), (PG8_LAS unsigned*)(idx_lds + (bufi) * 1024), 16, 0, 0); } while (0)
#define PG8_LDA(dst, b, h) do { _Pragma("unroll") for (int m = 0; m < 4; ++m) _Pragma("unroll") for (int k = 0; k < 2; ++k) dst[m][k] = *(const PG8_LAS bf16x8*)(lds + PG8_SA(b, h) + aoff + m * 2048 + k * 1024); } while (0)
#define PG8_LDB(dst, b, h) do { _Pragma("unroll") for (int n = 0; n < 2; ++n) _Pragma("unroll") for (int k = 0; k < 2; ++k) dst[n][k] = *(const PG8_LAS bf16x8*)(lds + PG8_SB(b, h) + boff + n * 2048 + k * 1024); } while (0)
#define PG8_MMA(ai, bj, At, Bt) do { __builtin_amdgcn_s_setprio(1); _Pragma("unroll") for (int m = 0; m < 4; ++m) _Pragma("unroll") for (int n = 0; n < 2; ++n) _Pragma("unroll") for (int k = 0; k < 2; ++k) \
        acc[ai][bj][m][n] = __builtin_amdgcn_mfma_f32_16x16x32_bf16(Bt[n][k], At[m][k], acc[ai][bj][m][n], 0, 0, 0); __builtin_amdgcn_s_setprio(0); } while (0)
#define PG8_WAIT_V(n) asm volatile("s_waitcnt vmcnt(" #n ")" ::: "memory")
#define PG8_WAIT_L(n) asm volatile("s_waitcnt lgkmcnt(" #n ")" ::: "memory")
#define PG8_BAR __builtin_amdgcn_s_barrier()
#define PG8_SCHED __builtin_amdgcn_sched_barrier(0)
    Unit cur, nxt; int ui = 0;
    if (!S.next(0, cur)) return;
    f32x4 acc[2][2][4][2];
#pragma unroll
    for (int a = 0; a < 2; ++a)
#pragma unroll
        for (int b = 0; b < 2; ++b)
#pragma unroll
            for (int m = 0; m < 4; ++m)
#pragma unroll
                for (int n = 0; n < 2; ++n) acc[a][b][m][n] = (f32x4){0.f, 0.f, 0.f, 0.f};
    bf16x8 At[4][2], B0[2][2], B1[2][2];
    const char* cA = (const char*)g.A + (size_t)cur.pm * tstep; const char* cB = (const char*)g.Bt + (size_t)((cur.pm >> g.gsh) & g.gmask) * g.bgs + (size_t)cur.pn * tstep;
    if constexpr (GATHER) { cA = (const char*)g.A;
        PG8_IDX_ISSUE(cur, 0); asm volatile("s_waitcnt vmcnt(0)" ::: "memory"); PG8_BAR; PG8_GOFFS(gc, 0); asm volatile("s_waitcnt lgkmcnt(0)" ::: "memory"); }
    S.a_ready(cur);
    if constexpr (SP2) {
        PG8_STAGE(PG8_SB(0, 0), cB, voffB); PG8_STAGE(PG8_SB(0, 1), cB + hstep, voffB); PG8_STAGE_A(PG8_SA(0, 0), cA, 0, gc); PG8_STAGE_A(PG8_SA(0, 1), cA, 1, gc);
        if (wr == 1) PG8_BAR;
        PG8_WAIT_V(2); PG8_BAR;
        PG8_STAGE(PG8_SB(1, 0), cB + kstep, voffB); PG8_STAGE_A(PG8_SA(1, 0), cA + kstep, 0, gc); PG8_STAGE(PG8_SB(1, 1), cB + hstep + kstep, voffB);
        PG8_WAIT_V(6); PG8_BAR;
    } else {
        PG8_STAGE(PG8_SB(0, 0), cB, voffB); PG8_STAGE(PG8_SA(0, 0), cA, voffA); PG8_STAGE(PG8_SB(0, 1), cB + hstep, voffB); PG8_STAGE(PG8_SA(0, 1), cA + hstep, voffA);
        if (wr == 1) PG8_BAR;
        PG8_WAIT_V(4); PG8_BAR;
        PG8_STAGE(PG8_SB(1, 0), cB + kstep, voffB); PG8_STAGE(PG8_SA(1, 0), cA + kstep, voffA); PG8_STAGE(PG8_SB(1, 1), cB + hstep + kstep, voffB);
        PG8_WAIT_V(6); PG8_BAR;
    }
    for (;;) {
        const bool has_next = S.next(ui + 1, nxt);
        const char* nA = GATHER ? (const char*)g.A : (has_next ? (const char*)g.A + (size_t)nxt.pm * tstep : cA);
        if constexpr (GATHER) { if (has_next) PG8_IDX_ISSUE(nxt, (ui + 1) & 1); }
        const char* nB = has_next ? (const char*)g.Bt + (size_t)((nxt.pm >> g.gsh) & g.gmask) * g.bgs + (size_t)nxt.pn * tstep : cB;
        for (int t = 0; t < nt; t += 2) {
            const bool last = (t == nt - 2);
            const char* a1 = cA + (size_t)(t + 1) * kstep;
            const char* a2 = last ? nA : cA + (size_t)(t + 2) * kstep; const char* b2 = last ? nB : cB + (size_t)(t + 2) * kstep;
            const char* a3 = a2 + kstep; const char* b3 = b2 + kstep;
            if (last && has_next) S.a_ready(nxt);
            unsigned g2[2][2] = {{gc[0][0], gc[0][1]}, {gc[1][0], gc[1][1]}};
            if constexpr (GATHER) { if (last && has_next) { PG8_GOFFS(gn, (ui + 1) & 1); g2[0][0] = gn[0][0]; g2[0][1] = gn[0][1]; g2[1][0] = gn[1][0]; g2[1][1] = gn[1][1]; } }
            if constexpr (SP2) {
            PG8_LDB(B0, 0, 0); PG8_LDB(B1, 0, 1); PG8_SCHED; PG8_LDA(At, 0, 0); PG8_STAGE_A(PG8_SA(1, 1), a1, 1, gc);
            PG8_WAIT_V(8); PG8_WAIT_L(0); PG8_BAR; PG8_MMA(0, 0, At, B0); PG8_MMA(0, 1, At, B1); PG8_BAR; PG8_SCHED;
            PG8_LDA(At, 0, 1); PG8_STAGE(PG8_SB(0, 0), b2, voffB); PG8_STAGE(PG8_SB(0, 1), b2 + hstep, voffB); PG8_STAGE_A(PG8_SA(0, 0), a2, 0, g2);
            PG8_WAIT_V(8); PG8_WAIT_L(0); PG8_BAR; PG8_MMA(1, 0, At, B0); PG8_MMA(1, 1, At, B1); PG8_BAR; PG8_SCHED;
            PG8_LDB(B0, 1, 0); PG8_LDB(B1, 1, 1); PG8_SCHED; PG8_LDA(At, 1, 0); PG8_STAGE_A(PG8_SA(0, 1), a2, 1, g2);
            PG8_WAIT_V(8); PG8_WAIT_L(0); PG8_BAR; PG8_MMA(0, 0, At, B0); PG8_MMA(0, 1, At, B1); PG8_BAR; PG8_SCHED;
            PG8_LDA(At, 1, 1); PG8_STAGE(PG8_SB(1, 0), b3, voffB); PG8_STAGE(PG8_SB(1, 1), b3 + hstep, voffB); PG8_STAGE_A(PG8_SA(1, 0), a3, 0, g2);
            PG8_WAIT_V(8); PG8_WAIT_L(0); PG8_BAR; PG8_MMA(1, 0, At, B0); PG8_MMA(1, 1, At, B1); PG8_BAR; PG8_SCHED;
            } else {
            PG8_LDB(B0, 0, 0); PG8_SCHED; PG8_LDA(At, 0, 0); PG8_STAGE(PG8_SA(1, 1), a1 + hstep, voffA);
            PG8_WAIT_L(8); PG8_BAR; PG8_WAIT_L(0); PG8_MMA(0, 0, At, B0); PG8_BAR; PG8_SCHED;
            PG8_LDB(B1, 0, 1); PG8_STAGE(PG8_SB(0, 0), b2, voffB);
            PG8_BAR; PG8_WAIT_L(0); PG8_MMA(0, 1, At, B1); PG8_BAR;
            PG8_LDA(At, 0, 1); PG8_STAGE(PG8_SA(0, 0), a2, voffA);
            PG8_BAR; PG8_WAIT_L(0); PG8_MMA(1, 0, At, B0); PG8_BAR; PG8_SCHED;
            PG8_STAGE(PG8_SB(0, 1), b2 + hstep, voffB);
            PG8_WAIT_V(6); PG8_BAR; PG8_MMA(1, 1, At, B1); PG8_BAR;
            PG8_LDB(B0, 1, 0); PG8_SCHED; PG8_LDA(At, 1, 0); PG8_STAGE(PG8_SA(0, 1), a2 + hstep, voffA);
            PG8_WAIT_L(8); PG8_BAR; PG8_WAIT_L(0); PG8_MMA(0, 0, At, B0); PG8_BAR; PG8_SCHED;
            PG8_LDB(B1, 1, 1); PG8_STAGE(PG8_SB(1, 0), b3, voffB);
            PG8_BAR; PG8_WAIT_L(0); PG8_MMA(0, 1, At, B1); PG8_BAR;
            PG8_LDA(At, 1, 1); PG8_STAGE(PG8_SA(1, 0), a3, voffA);
            PG8_BAR; PG8_WAIT_L(0); PG8_MMA(1, 0, At, B0); PG8_BAR; PG8_SCHED;
            PG8_STAGE(PG8_SB(1, 1), b3 + hstep, voffB);
            PG8_WAIT_V(6); PG8_BAR; PG8_MMA(1, 1, At, B1); PG8_BAR;
            }
        }
        if constexpr (ALIGN_EPI) { if (wr == 0) PG8_BAR; }
        if constexpr (!Epi::AFTER_DRAIN) { E(acc, cur, wr, wc, fr, fq); S.done(cur); }
        if (!has_next) break;
#pragma unroll
        for (int a = 0; a < 2; ++a)
#pragma unroll
            for (int b = 0; b < 2; ++b)
#pragma unroll
                for (int m = 0; m < 4; ++m)
#pragma unroll
                    for (int n = 0; n < 2; ++n) acc[a][b][m][n] = (f32x4){0.f, 0.f, 0.f, 0.f};
        cur = nxt; cA = nA; cB = nB; ++ui;
        if constexpr (GATHER) { gc[0][0] = gn[0][0]; gc[0][1] = gn[0][1]; gc[1][0] = gn[1][0]; gc[1][1] = gn[1][1]; }
        if constexpr (ALIGN_EPI) { if (wr == 1) PG8_BAR; }
    }
    PG8_WAIT_V(0);
    if constexpr (!ALIGN_EPI) { if (wr == 0) PG8_BAR; }
    PG8_BAR;
    if constexpr (Epi::AFTER_DRAIN) { E.fused(acc, cur, wr, wc, fr, fq, lds, wid, lane); S.done(cur); }
#undef PG8_SA
#undef PG8_SB
#undef PG8_STAGE
#undef PG8_LDA
#undef PG8_STAGE_A
#undef PG8_GOFFS
#undef PG8_IDX_ISSUE
#undef PG8_LDB
#undef PG8_MMA
#undef PG8_WAIT_V
#undef PG8_WAIT_L
#undef PG8_BAR
#undef PG8_SCHED
}
}
#ifndef PG8_SP2
#define PG8_SP2 true
#endif
#ifndef PG8_ALIGN
#define PG8_ALIGN true
#endif
constexpr int NWAVES = 8;
#ifndef MK_PER_PHASE
#define MK_PER_PHASE 0
#endif
constexpr int NPHASE = 13;
constexpr int BATCH = 2, T = 8192, D = 1024, TC = 256, M = BATCH * T, MC = BATCH * TC, MA = M + MC;
constexpr int NEXP = 16, CAP = 1024, FF = 1024;
constexpr float EPS = 1e-6f;
constexpr size_t MiB = 1u << 20;
constexpr size_t WS_CTL = 0, CTL_ZERO_BYTES = 1 * MiB;
constexpr size_t WS_MOD = 1 * MiB;
constexpr size_t WS_EGL = 1 * MiB + 128 * 1024;
constexpr size_t WS_IDX = 1 * MiB + 512 * 1024;
constexpr size_t WS_GATE = WS_IDX + 128 * 1024;
constexpr size_t WS_AFF = 2 * MiB;
constexpr size_t WS_SEL = 3 * MiB;
constexpr size_t WS_WIN = 4 * MiB;
constexpr size_t WS_WOUT = 11 * MiB;
constexpr size_t WS_AIN = 13 * MiB;
constexpr size_t WS_MIX = 13 * MiB;
constexpr size_t WS_FIN = 13 * MiB;
constexpr size_t WS_QKV = 46 * MiB;
constexpr size_t WS_OF = 46 * MiB, WS_OB = 62 * MiB;
constexpr size_t WS_Z = 96 * MiB;
constexpr size_t WS_UV = 112 * MiB;
constexpr size_t WS_AB = 144 * MiB;
constexpr size_t WS_GDN = 146 * MiB;
constexpr size_t GDN_UNIT = 73728;
constexpr size_t WS_WGU = 132 * MiB;
constexpr size_t WS_H1 = 232 * MiB;
constexpr size_t WS_XE = 68 * MiB;
constexpr size_t WS_HID = 46 * MiB;
constexpr size_t WS_WD = 196 * MiB;
constexpr size_t WS_YE = 132 * MiB;
constexpr size_t WS_END = 296 * MiB;
static_assert(WS_GDN + 2112 * GDN_UNIT <= WS_END && WS_AB + (size_t)MA * 64 <= WS_GDN && WS_QKV + (size_t)MA * 3072 <= WS_Z, "ws map");
constexpr int CW_BAR = 4096;
constexpr int LDS_BYTES = 163840;
constexpr int MISC_OFF = LDS_BYTES - 256;
#define LAS __attribute__((address_space(3)))
#define GAS __attribute__((address_space(1)))
typedef unsigned short bf16;
typedef unsigned v4u __attribute__((ext_vector_type(4)));
typedef unsigned v2u __attribute__((ext_vector_type(2)));
typedef float f32x4 __attribute__((ext_vector_type(4)));
typedef short bf16x8 __attribute__((ext_vector_type(8)));
#define LDS_WAIT() asm volatile("s_waitcnt lgkmcnt(0)" ::: "memory")
#define VM_WAIT() asm volatile("s_waitcnt vmcnt(0)" ::: "memory")
__device__ __forceinline__ unsigned f2bf(float f) { unsigned u = __builtin_bit_cast(unsigned, f); return (u + 0x7fffu + ((u >> 16) & 1u)) >> 16; }
__device__ __forceinline__ unsigned pk2(float lo, float hi) { return f2bf(lo) | (f2bf(hi) << 16); }
__device__ __forceinline__ float bflo(unsigned w) { return __builtin_bit_cast(float, w << 16); }
__device__ __forceinline__ float bfhi(unsigned w) { return __builtin_bit_cast(float, w & 0xffff0000u); }
__device__ __forceinline__ float bf1(bf16 h) { return __builtin_bit_cast(float, (unsigned)h << 16); }
__device__ __forceinline__ float wave_sum(float v) {
#pragma unroll
    for (int o = 1; o < 64; o <<= 1) v += __shfl_xor(v, o);
    return v;
}
__device__ __forceinline__ float fnma1(float a, float b, float c) { float r; asm("v_fma_f32 %0, -%1, %2, %3" : "=v"(r) : "v"(a), "v"(b), "v"(c)); return r; }
__device__ __forceinline__ float silu_r(float x) { return x * __builtin_amdgcn_rcpf(1.0f + __expf(-x)); }
__device__ __forceinline__ float silu1(float x) { return x / (1.0f + __expf(-x)); }

#define XB_TMO      128
#define XB_XCNT(j)  (256  + 64 * (j))
#define XB_XSUB(j)  (1280 + 64 * (j))
#define XB_XGEN(j)  (2304 + 64 * (j))
#define XB_TOP      3328
#define XB_TOPGEN   3392
#define XCD_BAR_WORDS 3456
#define XB_SPIN_CAP (1u << 18)
__device__ __forceinline__ unsigned xb_ld(unsigned* p)              { return __hip_atomic_load(p, __ATOMIC_RELAXED, __HIP_MEMORY_SCOPE_AGENT); }
__device__ __forceinline__ unsigned xb_add(unsigned* p, unsigned v) { return __hip_atomic_fetch_add(p, v, __ATOMIC_RELAXED, __HIP_MEMORY_SCOPE_AGENT); }
__device__ __forceinline__ unsigned xb_xcc_id() { return (unsigned)__builtin_amdgcn_s_getreg((3 << 11) | 20) & 0xFu; }
#define XB_SPIN(cond, bar) do { unsigned _sp = 0; while (cond) { __builtin_amdgcn_s_sleep(1); \
    if ((++_sp & 255u) == 0u) { if (xb_ld(&(bar)[XB_TMO])) break; if (_sp > XB_SPIN_CAP) { atomicAdd(&(bar)[XB_TMO], 1u); break; } } } } while (0)
struct XcdBarrier { unsigned* bar; unsigned x; volatile LAS unsigned* st; };
__device__ __forceinline__ XcdBarrier xcd_barrier_post(unsigned* bar, volatile LAS unsigned* st) {
    XcdBarrier b; b.bar = bar; b.x = xb_xcc_id(); b.st = st;
    if (threadIdx.x == 0) (void)xb_add(&bar[XB_XCNT(b.x)], 1u);
    return b;
}
__device__ __forceinline__ void xcd_barrier_complete(unsigned* bar, unsigned x, unsigned& nloc, unsigned& nx) {
    const unsigned G = gridDim.x * gridDim.y * gridDim.z;
    unsigned sum, cnt, mine, sp = 0u;
    for (;;) {
        sum = 0u; cnt = 0u; mine = 0u;
#pragma unroll
        for (unsigned j = 0; j < 16; ++j) { const unsigned c = xb_ld(&bar[XB_XCNT(j)]); sum += c; cnt += (c > 0u) ? 1u : 0u; mine = (j == x) ? c : mine; }
        if (sum == G) break;
        __builtin_amdgcn_s_sleep(1);
        if ((++sp & 255u) == 0u) { if (xb_ld(&bar[XB_TMO])) break; if (sp > XB_SPIN_CAP) { atomicAdd(&bar[XB_TMO], 1u); break; } }
    }
    nloc = mine > 0u ? mine : 1u; nx = cnt > 0u ? cnt : 1u;
}
__device__ __forceinline__ void xcd_barrier(const XcdBarrier& b) {
    asm volatile("s_waitcnt vmcnt(0)" ::: "memory");
    __syncthreads();
    if (threadIdx.x == 0) {
        unsigned* bar = b.bar;
        __builtin_amdgcn_s_waitcnt(0);
        unsigned nloc = b.st[0], nx = b.st[1];
        if (nloc == 0u) { xcd_barrier_complete(bar, b.x, nloc, nx); b.st[0] = nloc; b.st[1] = nx; }
        const unsigned old = xb_add(&bar[XB_XSUB(b.x)], 1u);
        const unsigned gen = old / nloc;
        if (old + 1u == (gen + 1u) * nloc) {
            __builtin_amdgcn_fence(__ATOMIC_RELEASE, "agent");
            asm volatile("s_waitcnt vmcnt(0)" ::: "memory");
            const unsigned og = xb_add(&bar[XB_TOP], 1u);
            const unsigned tg = og / nx;
            if (og + 1u == (tg + 1u) * nx) xb_add(&bar[XB_TOPGEN], 1u);
            else XB_SPIN(xb_ld(&bar[XB_TOPGEN]) == tg, bar);
            __builtin_amdgcn_fence(__ATOMIC_ACQUIRE, "agent");
            xb_add(&bar[XB_XGEN(b.x)], 1u);
            asm volatile("s_waitcnt vmcnt(0)" ::: "memory");
        } else {
            XB_SPIN(xb_ld(&bar[XB_XGEN(b.x)]) == gen, bar);
            __builtin_amdgcn_fence(__ATOMIC_ACQUIRE, "agent");
            asm volatile("s_waitcnt vmcnt(0)" ::: "memory");
        }
    }
    __syncthreads();
}

struct Frame {
    LAS unsigned char* lds;
    int tid, lane, wave, vcu, G;
    unsigned char* ws;
    const float *x, *c, *ctx, *c_ctx, *w_mod, *b_mod, *norm1_g, *norm2_g, *w_in, *conv_w, *a_log, *dt_bias, *gdn_norm_g, *gm_norm_g, *gm_ws, *gm_bs, *w_out, *w_router, *b_router, *w_gate, *w_up, *w_down, *final_norm_g;
    float* out;
};
__device__ __forceinline__ f32x4 mma_tile(const LAS bf16* A, int lda, int r0, const LAS bf16* Bt, int ldb, int c0, int K, f32x4 acc, int lane) {
    const int fr = lane & 15, fq = lane >> 4;
    const LAS bf16* ap = A + (r0 + fr) * lda + 8 * fq; const LAS bf16* bp = Bt + (c0 + fr) * ldb + 8 * fq;
#pragma unroll 4
    for (int k0 = 0; k0 < K; k0 += 32) { const bf16x8 a = *(const LAS bf16x8*)(ap + k0), b = *(const LAS bf16x8*)(bp + k0); acc = __builtin_amdgcn_mfma_f32_16x16x32_bf16(a, b, acc, 0, 0, 0); }
    return acc;
}
__device__ __forceinline__ void transpose_item(const float* W, int ldw, int src_col0, int k0, bf16* WT, int Kp, int dst_row0, LAS float* scr, int lane) {
#pragma unroll 8
    for (int i = 0; i < 32; ++i) { const int kk = 2 * i + (lane >> 5); scr[kk * 33 + (lane & 31)] = W[(size_t)(k0 + kk) * ldw + src_col0 + (lane & 31)]; }
    LDS_WAIT(); asm volatile("" ::: "memory");
    const int c = lane & 7;
#pragma unroll
    for (int j = 0; j < 4; ++j) { const int n = (lane >> 3) + 8 * j; const LAS float* s = scr + (8 * c) * 33 + n;
        v4u o; o.x = pk2(s[0 * 33], s[1 * 33]); o.y = pk2(s[2 * 33], s[3 * 33]); o.z = pk2(s[4 * 33], s[5 * 33]); o.w = pk2(s[6 * 33], s[7 * 33]);
        *(v4u*)(WT + (size_t)(dst_row0 + n) * Kp + k0 + 8 * c) = o; }
    LDS_WAIT(); asm volatile("" ::: "memory");
}
__device__ __forceinline__ void p0_phase(Frame& F) {
    float* MOD = (float*)(F.ws + WS_MOD);
    if (F.vcu < 96) {
        LAS float* sv = (LAS float*)F.lds;
        LAS float* red = sv + 3072;
        for (int i = F.tid; i < 3072; i += 512) { const int v = i >> 10, k = i & 1023; const float s = v < 2 ? F.c[v * 1024 + k] : F.c_ctx[k]; sv[i] = silu1(s); }
        __syncthreads();
        for (int item = F.vcu; item < 96; item += F.G) {
            const int kq = F.tid >> 4, cq = F.tid & 15, col = item * 64 + cq * 4;
            f32x4 a0 = {0.f, 0.f, 0.f, 0.f}, a1 = a0, a2 = a0;
#pragma unroll 8
            for (int kk = 0; kk < 32; ++kk) { const int k = kq * 32 + kk; const f32x4 w = *(const f32x4*)(F.w_mod + (size_t)k * 6144 + col); a0 += sv[k] * w; a1 += sv[1024 + k] * w; a2 += sv[2048 + k] * w; }
            *(LAS f32x4*)(red + (kq * 3 + 0) * 64 + cq * 4) = a0; *(LAS f32x4*)(red + (kq * 3 + 1) * 64 + cq * 4) = a1; *(LAS f32x4*)(red + (kq * 3 + 2) * 64 + cq * 4) = a2;
            __syncthreads();
            if (F.tid < 192) { const int v = F.tid >> 6, cc = F.tid & 63; float s = F.b_mod[item * 64 + cc];
                for (int q = 0; q < 32; ++q) s += red[(q * 3 + v) * 64 + cc];
                MOD[v * 6144 + item * 64 + cc] = s; }
            __syncthreads();
        }
    }
    __syncthreads();
    LAS float* scr = (LAS float*)(F.lds + F.wave * 16384);
    const int gw = F.vcu * NWAVES + F.wave, NGW = F.G * NWAVES;
    bf16* WIN = (bf16*)(F.ws + WS_WIN); bf16* WOUT = (bf16*)(F.ws + WS_WOUT);
    constexpr int I_IN = 97 * 16, I_OUT = 32 * 16;
    for (int it = gw; it < I_IN + I_OUT; it += NGW) {
        if (it < I_IN) { const int blk = it >> 4, kb = it & 15;
            const int src = blk < 48 ? 32 * blk : (blk < 64 ? 1552 + 32 * (blk - 48) : (blk < 96 ? 2064 + 32 * (blk - 64) : 1536));
            transpose_item(F.w_in, 3088, src, kb * 64, WIN, 1024, blk * 32, scr, F.lane); }
        else { const int r = it - I_IN, blk = r >> 4, kb = r & 15; transpose_item(F.w_out, 1024, blk * 32, kb * 64, WOUT, 1024, blk * 32, scr, F.lane); }
    }
}
__device__ __forceinline__ void wgu_convert(Frame& F) {
    LAS float* scr = (LAS float*)(F.lds + F.wave * 16384);
    const int gw = F.vcu * NWAVES + F.wave, NGW = F.G * NWAVES;
    bf16* WGU = (bf16*)(F.ws + WS_WGU);
    for (int it = gw; it < 16 * 2 * 512; it += NGW) {
        const int kb = it & 15, fb = (it >> 4) & 31, mat = (it >> 9) & 1, e = it >> 10;
        const float* W = (mat ? F.w_up : F.w_gate) + (size_t)e * 1024 * 1024;
        const int f0 = fb * 32, pn = f0 >> 7, dst = 256 * pn + (mat ? 128 : 0) + (f0 & 127);
        transpose_item(W, 1024, f0, kb * 64, WGU + (size_t)e * 2048 * 1024, 1024, dst, scr, F.lane);
    }
}
__device__ __forceinline__ void wd_convert(Frame& F) {
    LAS float* scr = (LAS float*)(F.lds + F.wave * 16384);
    if (F.vcu < 32) return;
    const int gw = (F.vcu - 32) * NWAVES + F.wave, NGW = (F.G - 32) * NWAVES;
    bf16* WD = (bf16*)(F.ws + WS_WD);
    for (int it = gw; it < 16 * 512; it += NGW) { const int kb = it & 15, nb = (it >> 4) & 31, e = it >> 9;
        transpose_item(F.w_down + (size_t)e * 1024 * 1024, 1024, nb * 32, kb * 64, WD + (size_t)e * 1024 * 1024, 1024, nb * 32, scr, F.lane); }
}
__device__ __forceinline__ void p1_phase(Frame& F) {
    const float* MOD = (const float*)(F.ws + WS_MOD); bf16* AIN = (bf16*)(F.ws + WS_AIN);
    const int gw = F.vcu * NWAVES + F.wave, NGW = F.G * NWAVES;
#pragma unroll 1
    for (int seg = 0; seg < 3; ++seg) {
        const int r_lo = seg < 2 ? seg * T : M, r_hi = seg < 2 ? (seg + 1) * T : MA;
        const float* mv = MOD + seg * 6144;
        f32x4 sc[4], sh[4];
#pragma unroll
        for (int j = 0; j < 4; ++j) { const int k = 4 * F.lane + 256 * j; const f32x4 g = *(const f32x4*)(F.norm1_g + k), s1 = *(const f32x4*)(mv + 1024 + k); sc[j] = g * (1.0f + s1); sh[j] = *(const f32x4*)(mv + k); }
        for (int m0 = r_lo + gw; m0 < r_hi; m0 += 2 * NGW) {
            const int m1 = m0 + NGW; const bool has1 = m1 < r_hi; const int m1c = has1 ? m1 : m0;
            const float* xr0 = seg < 2 ? F.x + (size_t)m0 * D : F.ctx + (size_t)(m0 - M) * D; const float* xr1 = seg < 2 ? F.x + (size_t)m1c * D : F.ctx + (size_t)(m1c - M) * D;
            f32x4 v0[4], v1[4]; float s0 = 0.f, s1 = 0.f;
#pragma unroll
            for (int j = 0; j < 4; ++j) { v0[j] = *(const f32x4*)(xr0 + 4 * F.lane + 256 * j); v1[j] = *(const f32x4*)(xr1 + 4 * F.lane + 256 * j); }
#pragma unroll
            for (int j = 0; j < 4; ++j) { s0 += (v0[j].x * v0[j].x + v0[j].y * v0[j].y) + (v0[j].z * v0[j].z + v0[j].w * v0[j].w); s1 += (v1[j].x * v1[j].x + v1[j].y * v1[j].y) + (v1[j].z * v1[j].z + v1[j].w * v1[j].w); }
            const float r0 = 1.0f / sqrtf(wave_sum(s0) * (1.0f / D) + EPS), r1 = 1.0f / sqrtf(wave_sum(s1) * (1.0f / D) + EPS);
            bf16* o0 = AIN + (size_t)m0 * D; bf16* o1 = AIN + (size_t)m1c * D;
#pragma unroll
            for (int j = 0; j < 4; ++j) { const f32x4 a = v0[j] * r0 * sc[j] + sh[j]; v2u o; o.x = pk2(a.x, a.y); o.y = pk2(a.z, a.w); *(v2u*)(o0 + 4 * F.lane + 256 * j) = o; }
            if (has1) {
#pragma unroll
                for (int j = 0; j < 4; ++j) { const f32x4 a = v1[j] * r1 * sc[j] + sh[j]; v2u o; o.x = pk2(a.x, a.y); o.y = pk2(a.z, a.w); *(v2u*)(o1 + 4 * F.lane + 256 * j) = o; } }
        }
    }
}
struct PF { unsigned a, b, c, d; };
__device__ __forceinline__ unsigned touch(const void* p) { return *(const GAS unsigned*)p; }
__device__ __forceinline__ PF p3_prefetch(Frame& F, int it) {
    PF r; r.a = r.b = r.c = r.d = 0u;
    if (it >= 1056 + 512) return r;
    const int tid = F.tid;
    if (it < 1056) {
        int b, n, h, L; size_t row_base;
        if (it < 1024) { b = it >> 9; n = (it >> 2) & 127; h = it & 3; L = T; row_base = (size_t)b * T; }
        else { const int j = it - 1024; b = j >> 4; n = (j >> 2) & 3; h = j & 3; L = TC; row_base = (size_t)M + (size_t)b * TC; }
        const bf16* QKV = (const bf16*)(F.ws + WS_QKV);
        { const int p = tid, rr = p / 12, q = p % 12, s = q >> 2, piece = q & 3; int t = 64 * n - 1 + rr; t = t < 0 ? 0 : (t >= L ? L - 1 : t); r.a = touch(QKV + (row_base + t) * 1536 + s * 512 + h * 128 + piece * 32); }
        if (tid < 280) { const int p = tid + 512, rr = p / 12, q = p % 12, s = q >> 2, piece = q & 3; int t = 64 * n - 1 + rr; t = t < 0 ? 0 : (t >= L ? L - 1 : t); r.b = touch(QKV + (row_base + t) * 1536 + s * 512 + h * 128 + piece * 32); }
        if (tid < 64) r.c = touch((const float*)(F.ws + WS_AB) + (row_base + 64 * n + tid) * 16);
    } else {
        const int i2 = it - 1056, g = i2 & 3, nc = (i2 >> 2) & 63, b = i2 >> 8; const size_t r0 = (size_t)b * T + (size_t)nc * 128;
        const bf16* UV = (const bf16*)(F.ws + WS_UV);
        const int t = tid >> 2, piece = tid & 3; r.a = touch(UV + (r0 + t) * 1024 + 512 + 128 * g + piece * 32); r.b = touch(UV + (r0 + t) * 1024 + 128 * g + piece * 32);
        r.c = touch(F.gm_ws + (size_t)g * 16384 + tid * 16); r.d = touch(F.gm_ws + (size_t)g * 16384 + (tid + 512) * 16);
    }
    return r;
}
__device__ __forceinline__ void pf_sink(Frame& F, const PF& r) { asm volatile("" :: "v"(r.a), "v"(r.b), "v"(r.c), "v"(r.d)); }
__device__ __forceinline__ void gdn_item(Frame& F, int it) {
    int b, n, h, L, slot; size_t row_base;
    if (it < 1024) { b = it >> 9; n = (it >> 2) & 127; h = it & 3; L = T; row_base = (size_t)b * T; slot = (b * 4 + h) * 128 + n; }
    else { const int j = it - 1024; b = j >> 4; n = (j >> 2) & 3; h = j & 3; L = TC; row_base = (size_t)M + (size_t)b * TC; slot = 1024 + (b * 4 + h) * 4 + n; }
    const bf16* QKV = (const bf16*)(F.ws + WS_QKV); const float* AB = (const float*)(F.ws + WS_AB);
    LAS bf16* QB = (LAS bf16*)(F.lds); LAS bf16* KB = (LAS bf16*)(F.lds + 17408); LAS bf16* VB = (LAS bf16*)(F.lds + 34816); LAS bf16* TB = (LAS bf16*)(F.lds + 34816);
    LAS bf16* KT = (LAS bf16*)(F.lds + 52224); LAS bf16* VT = (LAS bf16*)(F.lds + 70656);
    LAS float* KK = (LAS float*)(F.lds + 89088); LAS float* QK = (LAS float*)(F.lds + 105728);
    LAS bf16* T12 = (LAS bf16*)(F.lds + 89088);
    LAS float* AF = (LAS float*)(F.lds + 122368);
    LAS float* GC = (LAS float*)(F.lds + 155136); LAS float* BT = (LAS float*)(F.lds + 155648); LAS float* EG1 = (LAS float*)(F.lds + 156160); LAS float* EG2 = (LAS float*)(F.lds + 156672);
    LAS bf16* A10B = (LAS bf16*)(F.lds + 157184);
    const int tid = F.tid, lane = F.lane, wave = F.wave, fr = lane & 15, fq = lane >> 4;
    for (int q = tid; q < 1152; q += 512) { const int tap = q / 384, rem = q % 384, s = rem >> 7, c = rem & 127; ((LAS float*)(F.lds + 89088))[q] = F.conv_w[tap * 1536 + s * 512 + h * 128 + c]; }
    __syncthreads();
    {
        const int r = tid >> 3, part = tid & 7, t = 64 * n + r; const bool hasp = t > 0, hasn = t + 1 < L;
        const bf16* prow = QKV + (row_base + t) * 1536;
        const LAS float* cwl = (const LAS float*)(F.lds + 89088) + part * 16;
        const int offp = hasp ? 1536 : 0, offn = hasn ? 1536 : 0; const unsigned mp = hasp ? 0xffffffffu : 0u, mn = hasn ? 0xffffffffu : 0u;
        v4u dc[6], dn[6];
#define S1_LOAD(dst, s_) do { const bf16* pc_ = prow + (s_) * 512 + h * 128 + part * 16; const bf16* pp_ = pc_ - offp; const bf16* pn_ = pc_ + offn; \
            dst[0] = *(const v4u*)pc_; dst[1] = *(const v4u*)(pc_ + 8); dst[2] = *(const v4u*)pp_; dst[3] = *(const v4u*)(pp_ + 8); dst[4] = *(const v4u*)pn_; dst[5] = *(const v4u*)(pn_ + 8); } while (0)
        S1_LOAD(dc, 0);
#pragma unroll 1
        for (int s = 0; s < 3; ++s) {
            if (s < 2) S1_LOAD(dn, s + 1);
            float y[16]; float ss = 0.f;
#pragma unroll
            for (int q = 0; q < 4; ++q) { const f32x4 w0 = *(const LAS f32x4*)(cwl + (0 * 3 + s) * 128 + 4 * q), w1 = *(const LAS f32x4*)(cwl + (1 * 3 + s) * 128 + 4 * q), w2 = *(const LAS f32x4*)(cwl + (2 * 3 + s) * 128 + 4 * q);
#pragma unroll
                for (int e = 0; e < 2; ++e) { const unsigned cw = dc[q >> 1][(q & 1) * 2 + e], pw = dc[2 + (q >> 1)][(q & 1) * 2 + e] & mp, nw = dc[4 + (q >> 1)][(q & 1) * 2 + e] & mn;
                    const float a0 = w0[2 * e] * bflo(pw) + w1[2 * e] * bflo(cw) + w2[2 * e] * bflo(nw), a1 = w0[2 * e + 1] * bfhi(pw) + w1[2 * e + 1] * bfhi(cw) + w2[2 * e + 1] * bfhi(nw);
                    const float y0 = silu_r(a0), y1 = silu_r(a1); y[4 * q + 2 * e] = y0; y[4 * q + 2 * e + 1] = y1; ss += y0 * y0 + y1 * y1; } }
            float sc = 1.0f;
            if (s < 2) { ss += __shfl_xor(ss, 1); ss += __shfl_xor(ss, 2); ss += __shfl_xor(ss, 4); sc = (1.0f / sqrtf(ss + EPS)) * (s == 0 ? 0.08838834764831845f : 1.0f); }
            LAS bf16* dst = (s == 0 ? QB : (s == 1 ? KB : VB)) + r * 136 + part * 16;
            v4u o0, o1;
            o0.x = pk2(y[0] * sc, y[1] * sc); o0.y = pk2(y[2] * sc, y[3] * sc); o0.z = pk2(y[4] * sc, y[5] * sc); o0.w = pk2(y[6] * sc, y[7] * sc);
            o1.x = pk2(y[8] * sc, y[9] * sc); o1.y = pk2(y[10] * sc, y[11] * sc); o1.z = pk2(y[12] * sc, y[13] * sc); o1.w = pk2(y[14] * sc, y[15] * sc);
            *(LAS v4u*)dst = o0; *(LAS v4u*)(dst + 8) = o1;
#pragma unroll
            for (int q = 0; q < 6; ++q) dc[q] = dn[q];
        }
#undef S1_LOAD
        if (wave < 2) { const int d = wave, i = lane, tl = d ? 63 - i : i; const float* abr = AB + (row_base + 64 * n + tl) * 16;
            const float a = abr[d * 4 + h], bb = abr[8 + d * 4 + h];
            const float xx = a + F.dt_bias[d * 4 + h]; const float sp = fmaxf(xx, 0.f) + log1pf(expf(-fabsf(xx)));
            float g = -expf(F.a_log[d * 4 + h]) * sp;
#pragma unroll
            for (int o = 1; o < 64; o <<= 1) { const float yv = __shfl_up(g, o); if (i >= o) g += yv; }
            GC[d * 64 + i] = g; BT[d * 64 + i] = 1.0f / (1.0f + expf(-bb)); const float gl = __shfl(g, 63); EG1[d * 64 + i] = __expf(g); EG2[d * 64 + i] = __expf(gl - g); }
    }
    __syncthreads();
    const PF pf = p3_prefetch(F, it + F.G);
    {
        const int mat = wave >> 2, tr = wave & 3;
#pragma unroll
        for (int tc = 0; tc < 4; ++tc) { f32x4 acc = {0.f, 0.f, 0.f, 0.f}; acc = mma_tile(mat ? QB : KB, 136, 16 * tr, KB, 136, 16 * tc, 128, acc, lane);
            LAS float* dst = (mat ? QK : KK) + (16 * tr + 4 * fq) * 65 + 16 * tc + fr;
#pragma unroll
            for (int j = 0; j < 4; ++j) dst[j * 65] = acc[j]; }
        bf16x8 id0, id1;
#pragma unroll
        for (int j = 0; j < 8; ++j) { id0[j] = (8 * fq + j == fr) ? (short)0x3F80 : (short)0; id1[j] = (8 * fq + j == fr + 16) ? (short)0x3F80 : (short)0; }
#pragma unroll 1
        for (int q = 0; q < 8; ++q) { const int job = wave * 8 + q, mt = job >> 5, tt = (job >> 3) & 3, ct = job & 7;
            const bf16x8 a = *(const LAS bf16x8*)((mt ? KB : VB) + (16 * tt + fr) * 136 + 32 * (ct >> 1) + 8 * fq);
            f32x4 acc = {0.f, 0.f, 0.f, 0.f}; acc = __builtin_amdgcn_mfma_f32_16x16x32_bf16(a, (ct & 1) ? id1 : id0, acc, 0, 0, 0);
            v2u o; o.x = pk2(acc[0], acc[1]); o.y = pk2(acc[2], acc[3]); *(LAS v2u*)((mt ? KT : VT) + (16 * ct + fr) * 72 + 16 * tt + 4 * fq) = o; }
    }
    __syncthreads();
    for (int idx = tid; idx < 8192; idx += 512) { const int d = idx >> 12, i = (idx >> 6) & 63, j = idx & 63; const int ti = d ? 63 - i : i, tj = d ? 63 - j : j;
        const float av = (i > j) ? BT[d * 64 + i] * KK[ti * 65 + tj] * __expf(GC[d * 64 + i] - GC[d * 64 + j]) : 0.f; AF[idx] = av;
        if (i >= 32 && j < 32) A10B[d * 1280 + (i - 32) * 40 + j] = (bf16)f2bf(av); }
    __syncthreads();
    unsigned char* gout = F.ws + WS_GDN + (size_t)slot * 2 * GDN_UNIT;
    if (wave < 2) {
        const int d = wave, blk = lane >> 5, jc = lane & 31; const LAS float* A = AF + d * 4096 + (blk * 32) * 64 + blk * 32; LAS bf16* TBd = TB + d * 4096;
        float Tc[32];
#pragma unroll
        for (int i = 0; i < 32; ++i) { float s0 = (i == jc) ? 1.f : 0.f, s1 = 0.f, s2 = 0.f, s3 = 0.f;
#pragma unroll
            for (int j = 0; j < i; ++j) { const float a = A[i * 64 + j]; if ((j & 3) == 0) s0 = fnma1(a, Tc[j], s0); else if ((j & 3) == 1) s1 = fnma1(a, Tc[j], s1); else if ((j & 3) == 2) s2 = fnma1(a, Tc[j], s2); else s3 = fnma1(a, Tc[j], s3); }
            Tc[i] = (s0 + s1) + (s2 + s3); TBd[(blk * 32 + i) * 64 + blk * 32 + jc] = (bf16)f2bf(Tc[i]);
            if (blk) TBd[i * 64 + 32 + jc] = (bf16)0;
            asm volatile("" ::: "memory"); }
        LAS bf16* DT0 = (LAS bf16*)(AF + d * 4096); LAS bf16* PT = DT0 + 1280;
        if (!blk) {
#pragma unroll
            for (int q = 0; q < 4; ++q) { v4u o; o.x = pk2(Tc[8 * q], Tc[8 * q + 1]); o.y = pk2(Tc[8 * q + 2], Tc[8 * q + 3]); o.z = pk2(Tc[8 * q + 4], Tc[8 * q + 5]); o.w = pk2(Tc[8 * q + 6], Tc[8 * q + 7]); *(LAS v4u*)(DT0 + jc * 40 + 8 * q) = o; } }
#pragma unroll
        for (int tl = 0; tl < 4; ++tl) { const int ti = tl >> 1, tj = tl & 1; f32x4 acc = {0.f, 0.f, 0.f, 0.f}; acc = mma_tile(A10B + d * 1280, 40, 16 * ti, DT0, 40, 16 * tj, 32, acc, lane);
            v2u o; o.x = pk2(acc[0], acc[1]); o.y = pk2(acc[2], acc[3]); *(LAS v2u*)(PT + (16 * tj + fr) * 40 + 16 * ti + 4 * fq) = o; }
#pragma unroll
        for (int tl = 0; tl < 4; ++tl) { const int ti = tl >> 1, tj = tl & 1; f32x4 acc = {0.f, 0.f, 0.f, 0.f}; acc = mma_tile(TBd + 32 * 64 + 32, 64, 16 * ti, PT, 40, 16 * tj, 32, acc, lane);
#pragma unroll
            for (int j = 0; j < 4; ++j) TBd[(32 + 16 * ti + 4 * fq + j) * 64 + 16 * tj + fr] = (bf16)f2bf(-acc[j]); }
    } else {
        const int t2 = tid - 128;
        for (int q = t2; q < 2048; q += 384) { const int d = q >> 10, i = (q >> 4) & 63, cg = q & 15, tok = d ? 63 - i : i; const float e = EG1[d * 64 + i];
            const v4u s = *(const LAS v4u*)(QB + tok * 136 + cg * 8); v4u o;
            o.x = pk2(bflo(s.x) * e, bfhi(s.x) * e); o.y = pk2(bflo(s.y) * e, bfhi(s.y) * e); o.z = pk2(bflo(s.z) * e, bfhi(s.z) * e); o.w = pk2(bflo(s.w) * e, bfhi(s.w) * e);
            *(v4u*)(gout + (size_t)d * GDN_UNIT + 16384 + (i * 128 + cg * 8) * 2) = o; }
        for (int q = t2; q < 2048; q += 384) { const int d = q >> 10, c = (q >> 3) & 127, ig = q & 7;
            float v[8];
            if (d == 0) { const v4u s = *(const LAS v4u*)(KT + c * 72 + ig * 8); v[0] = bflo(s.x); v[1] = bfhi(s.x); v[2] = bflo(s.y); v[3] = bfhi(s.y); v[4] = bflo(s.z); v[5] = bfhi(s.z); v[6] = bflo(s.w); v[7] = bfhi(s.w); }
            else { const v4u s = *(const LAS v4u*)(KT + c * 72 + 56 - ig * 8); v[7] = bflo(s.x); v[6] = bfhi(s.x); v[5] = bflo(s.y); v[4] = bfhi(s.y); v[3] = bflo(s.z); v[2] = bfhi(s.z); v[1] = bflo(s.w); v[0] = bfhi(s.w); }
            const LAS float* e2 = EG2 + d * 64 + ig * 8; v4u o;
            o.x = pk2(v[0] * e2[0], v[1] * e2[1]); o.y = pk2(v[2] * e2[2], v[3] * e2[3]); o.z = pk2(v[4] * e2[4], v[5] * e2[5]); o.w = pk2(v[6] * e2[6], v[7] * e2[7]);
            *(v4u*)(gout + (size_t)d * GDN_UNIT + 32768 + (c * 64 + ig * 8) * 2) = o; }
        for (int q = t2; q < 1024; q += 384) { const int d = q >> 9, i = (q >> 3) & 63, jg = q & 7, ti = d ? 63 - i : i; const float gi = GC[d * 64 + i]; float v[8];
#pragma unroll
            for (int jj = 0; jj < 8; ++jj) { const int j = jg * 8 + jj, tj = d ? 63 - j : j; v[jj] = (i >= j) ? QK[ti * 65 + tj] * __expf(gi - GC[d * 64 + j]) : 0.f; }
            v4u o; o.x = pk2(v[0], v[1]); o.y = pk2(v[2], v[3]); o.z = pk2(v[4], v[5]); o.w = pk2(v[6], v[7]);
            *(v4u*)(gout + (size_t)d * GDN_UNIT + 49152 + (i * 64 + jg * 8) * 2) = o; }
        if (t2 < 2) ((float*)(F.ws + WS_EGL))[slot * 2 + t2] = EG1[t2 * 64 + 63];
    }
    __syncthreads();
    for (int q = tid; q < 1024; q += 512) { const int d = q >> 9, i = (q >> 3) & 63, tg = q & 7;
        float v[8];
        if (d == 0) { const v4u s = *(const LAS v4u*)(TB + i * 64 + tg * 8); v[0] = bflo(s.x); v[1] = bfhi(s.x); v[2] = bflo(s.y); v[3] = bfhi(s.y); v[4] = bflo(s.z); v[5] = bfhi(s.z); v[6] = bflo(s.w); v[7] = bfhi(s.w); }
        else { const v4u s = *(const LAS v4u*)(TB + 4096 + i * 64 + 56 - tg * 8); v[7] = bflo(s.x); v[6] = bfhi(s.x); v[5] = bflo(s.y); v[4] = bfhi(s.y); v[3] = bflo(s.z); v[2] = bfhi(s.z); v[1] = bflo(s.w); v[0] = bfhi(s.w); }
        float t1[8], t2v[8];
#pragma unroll
        for (int e = 0; e < 8; ++e) { const int tok = tg * 8 + e, j = d ? 63 - tok : tok; t1[e] = v[e] * BT[d * 64 + j]; t2v[e] = t1[e] * EG1[d * 64 + j]; }
        v4u o; o.x = pk2(t1[0], t1[1]); o.y = pk2(t1[2], t1[3]); o.z = pk2(t1[4], t1[5]); o.w = pk2(t1[6], t1[7]); *(LAS v4u*)(T12 + (d * 2 + 0) * 4608 + i * 72 + tg * 8) = o;
        o.x = pk2(t2v[0], t2v[1]); o.y = pk2(t2v[2], t2v[3]); o.z = pk2(t2v[4], t2v[5]); o.w = pk2(t2v[6], t2v[7]); *(LAS v4u*)(T12 + (d * 2 + 1) * 4608 + i * 72 + tg * 8) = o; }
    __syncthreads();
#pragma unroll 1
    for (int q = 0; q < 16; ++q) { const int tile = wave * 16 + q, d = tile >> 6, kind = (tile >> 5) & 1, ti = (tile >> 3) & 3, tc = tile & 7; f32x4 acc = {0.f, 0.f, 0.f, 0.f};
        unsigned char* go = gout + (size_t)d * GDN_UNIT;
        if (kind == 0) { acc = mma_tile(T12 + (d * 2 + 0) * 4608, 72, 16 * ti, VT, 72, 16 * tc, 64, acc, lane);
            v2u o; o.x = pk2(acc[0], acc[1]); o.y = pk2(acc[2], acc[3]); *(v2u*)(go + 57344 + ((16 * tc + fr) * 64 + 16 * ti + 4 * fq) * 2) = o; }
        else { acc = mma_tile(KT, 72, 16 * tc, T12 + (d * 2 + 1) * 4608, 72, 16 * ti, 64, acc, lane);
            v2u o; o.x = pk2(acc[0], acc[1]); o.y = pk2(acc[2], acc[3]); *(v2u*)(go + ((16 * ti + fr) * 128 + 16 * tc + 4 * fq) * 2) = o; } }
    __syncthreads();
    pf_sink(F, pf);
}
__device__ __forceinline__ void gmlp_item(Frame& F, int it) {
    const int g = it & 3, nc = (it >> 2) & 63, b = it >> 8; const size_t r0 = (size_t)b * T + (size_t)nc * 128;
    const bf16* UV = (const bf16*)(F.ws + WS_UV); bf16* MIX = (bf16*)(F.ws + WS_MIX);
    LAS bf16* VNT = (LAS bf16*)(F.lds); LAS bf16* WSB = (LAS bf16*)(F.lds + 34816);
    const int tid = F.tid, lane = F.lane, wave = F.wave;
    {
        const int t = tid >> 2, part = tid & 3; const bf16* vp = UV + (r0 + t) * 1024 + 512 + 128 * g + part * 32;
        float v[32]; float ss = 0.f;
#pragma unroll
        for (int q = 0; q < 4; ++q) { const v4u xw = *(const v4u*)(vp + 8 * q);
#pragma unroll
            for (int e = 0; e < 4; ++e) { v[8 * q + 2 * e] = bflo(xw[e]); v[8 * q + 2 * e + 1] = bfhi(xw[e]); ss += v[8 * q + 2 * e] * v[8 * q + 2 * e] + v[8 * q + 2 * e + 1] * v[8 * q + 2 * e + 1]; } }
        ss += __shfl_xor(ss, 1); ss += __shfl_xor(ss, 2);
        const float rstd = 1.0f / sqrtf(ss * (1.0f / 128.0f) + EPS); const float* gn = F.gm_norm_g + 128 * g + part * 32;
#pragma unroll
        for (int cc = 0; cc < 32; ++cc) VNT[(part * 32 + cc) * 136 + t] = (bf16)f2bf(v[cc] * rstd * gn[cc]);
        const float* wp = F.gm_ws + ((size_t)g * 128 + t) * 128 + part * 32;
#pragma unroll
        for (int q = 0; q < 4; ++q) { const f32x4 w0 = *(const f32x4*)(wp + 8 * q), w1 = *(const f32x4*)(wp + 8 * q + 4); v4u o; o.x = pk2(w0.x, w0.y); o.y = pk2(w0.z, w0.w); o.z = pk2(w1.x, w1.y); o.w = pk2(w1.z, w1.w);
            *(LAS v4u*)(WSB + t * 136 + part * 32 + 8 * q) = o; }
    }
    __syncthreads();
    const PF pf = p3_prefetch(F, it + 1056 + F.G);
    {
        const int td = wave, fr = lane & 15, fq = lane >> 4;
        v2u uws[8]; float bss[8];
#pragma unroll
        for (int tt = 0; tt < 8; ++tt) { const int tl = 16 * tt + fr; uws[tt] = *(const v2u*)(UV + (r0 + tl) * 1024 + 128 * g + 16 * td + 4 * fq); bss[tt] = F.gm_bs[g * 128 + tl]; }
#pragma unroll
        for (int tt = 0; tt < 8; ++tt) { f32x4 acc = {0.f, 0.f, 0.f, 0.f}; acc = mma_tile(VNT, 136, 16 * td, WSB, 136, 16 * tt, 128, acc, lane);
            const int tl = 16 * tt + fr; const size_t off = (r0 + tl) * 1024 + 128 * g + 16 * td + 4 * fq; const float bsv = bss[tt];
            const v2u uw = uws[tt]; v2u o;
            o.x = pk2(bflo(uw.x) * (acc[0] + bsv), bfhi(uw.x) * (acc[1] + bsv)); o.y = pk2(bflo(uw.y) * (acc[2] + bsv), bfhi(uw.y) * (acc[3] + bsv));
            *(v2u*)(MIX + off) = o; }
    }
    __syncthreads();
    pf_sink(F, pf);
}
__device__ __forceinline__ void p3_phase(Frame& F) {
    for (int it = F.vcu; it < 1056 + 512; it += F.G) { if (it < 1056) gdn_item(F, it); else gmlp_item(F, it - 1056); }
}
constexpr size_t WS_CB = 112 * MiB;
constexpr size_t WS_ZT = 136 * MiB;
constexpr size_t WS_XB = 140 * MiB;
constexpr size_t WS_CORRF = 200 * MiB, WS_CORRB = 216 * MiB;
__device__ __forceinline__ void p4_scan(Frame& F) {
    const int j14 = F.vcu & 31;
    if (j14 >= 28) return;
    const int chain = 2 * (F.vcu >> 5) + (j14 >= 14 ? 1 : 0), role = j14 % 14;
    const int g = role < 2 ? 0 : 1 + ((role - 2) >> 2), kindP = role < 2 ? 0 : ((role - 2) >> 1) & 1, ch = role < 2 ? role : (role - 2) & 1;
    const int b = chain >> 3, h = (chain >> 1) & 3, d = chain & 1, c0 = ch * 64;
    const int NS = g == 0 ? 36 : 32;
    constexpr int BUFB = 65536, ST_OFF = 2 * BUFB, VNT_OFF = ST_OFF + 64 * 288, EGS_OFF = VNT_OFF + 64 * 160;
    const unsigned char* gdn = F.ws + WS_GDN; const float* EGL = (const float*)(F.ws + WS_EGL);
    const int lane = F.lane, wave = F.wave;
#define P4_SLOT(s) (g == 0 ? ((s) < 4 ? 1024 + (b * 4 + h) * 4 + (d ? 3 - (s) : (s)) : (b * 4 + h) * 128 + (d ? 127 - ((s) - 4) : ((s) - 4))) : (b * 4 + h) * 128 + (d ? 127 - (32 * g + (s)) : (32 * g + (s))))
#define P4_BAR() do { asm volatile("s_waitcnt lgkmcnt(0)" ::: "memory"); __builtin_amdgcn_s_barrier(); asm volatile("" ::: "memory"); } while (0)
    if (wave >= 4) {
        const int lw = wave - 4;
#define P4_ISSUE(s, bufi) do { const unsigned char* gb = gdn + (size_t)(P4_SLOT(s) * 2 + d) * GDN_UNIT; \
            _Pragma("unroll") for (int q = 0; q < 14; ++q) { const int k = lw + 4 * q; unsigned so; \
                if (k < 32) { const int qi = (k & 15) * 64 + lane, r = qi >> 4, sl = qi & 15; so = (unsigned)((k >> 4) * 16384 + r * 256 + ((sl ^ (r & 15)) << 4)); } \
                else { const int kk = k < 48 ? k - 32 : k - 48, qi = kk * 64 + lane, r = qi >> 3, sl = qi & 7; so = (unsigned)((k < 48 ? 32768 : 49152) + r * 128 + ((sl ^ ((r >> 1) & 7)) << 4)); } \
                __builtin_amdgcn_global_load_lds((const unsigned*)(gb + so), (LAS unsigned*)(F.lds + (bufi) * BUFB + k * 1024), 16, 0, 0); } \
            if (!kindP) { _Pragma("unroll") for (int q = 0; q < 2; ++q) { const int k = lw + 4 * q;       \
                __builtin_amdgcn_global_load_lds((const unsigned*)(gb + 57344 + (size_t)c0 * 128 + k * 1024 + lane * 16), (LAS unsigned*)(F.lds + (bufi) * BUFB + 57344 + k * 1024), 16, 0, 0); } } } while (0)
#define P4_TOUCH(s, ta, tb) do { const unsigned char* gb = gdn + (size_t)(P4_SLOT(s) * 2 + d) * GDN_UNIT; const int li = lw * 64 + lane, l2 = li < 192 ? li + 256 : 448 + c0 + (li - 192);   \
            ta = *(const GAS unsigned*)(gb + (size_t)li * 128); tb = *(const GAS unsigned*)(gb + (size_t)l2 * 128); } while (0)
#define P4_LSTEP(s, tnew0, tnew1, told0, told1) do { const int cur_ = (s) & 1; \
            asm volatile("" :: "v"(told0), "v"(told1)); \
            if ((s) + 1 < NS) P4_ISSUE((s) + 1, cur_ ^ 1); \
            if ((s) + 3 < NS) { P4_TOUCH((s) + 3, tnew0, tnew1); P4_BAR(); asm volatile("s_waitcnt vmcnt(2)" ::: "memory"); } \
            else { P4_BAR(); asm volatile("s_waitcnt vmcnt(0)" ::: "memory"); } \
            P4_BAR(); } while (0)
        unsigned ta = 0u, tb = 0u, tc = 0u, td = 0u;
        P4_ISSUE(0, 0);
        P4_TOUCH(1, ta, tb);
        P4_TOUCH(2, tc, td);
        VM_WAIT(); P4_BAR();
        asm volatile("" :: "v"(ta), "v"(tb));
#pragma unroll 1
        for (int s = 0; s < NS; s += 2) {
            P4_LSTEP(s, ta, tb, tc, td);
            P4_LSTEP(s + 1, tc, td, ta, tb);
        }
        asm volatile("" :: "v"(ta), "v"(tb), "v"(tc), "v"(td));
#undef P4_LSTEP
#undef P4_TOUCH
#undef P4_ISSUE
    } else {
        const int m = wave, fr = lane & 15, fq = lane >> 4;
        for (int i = F.tid; i < 64 * 72; i += 256) { const int c = i / 72, w4 = i % 72;
            unsigned v = 0u; if (kindP) { const int dk = c0 + c; if ((dk >> 1) == w4) v = (dk & 1) ? 0x3F800000u : 0x00003F80u; }
            ((LAS unsigned*)(F.lds + ST_OFF))[i] = v; }
        f32x4 S[2][4];
#pragma unroll
        for (int t2 = 0; t2 < 2; ++t2)
#pragma unroll
            for (int n = 0; n < 4; ++n) {
#pragma unroll
                for (int jj = 0; jj < 4; ++jj) S[t2][n][jj] = (kindP && (32 * m + 16 * t2 + 4 * fq + jj == c0 + 16 * n + fr)) ? 1.0f : 0.0f; }
        bf16* OD = (bf16*)(F.ws + (d ? WS_OB : WS_OF)); bf16* CB = (bf16*)(F.ws + WS_CB);
        for (int i = F.tid; i < NS; i += 256) ((LAS float*)(F.lds + EGS_OFF))[i] = EGL[P4_SLOT(i) * 2 + d];
        P4_BAR();
#pragma unroll 1
        for (int s = 0; s < NS; ++s) {
            const int cur = s & 1; const LAS unsigned char* buf = F.lds + cur * BUFB; LAS unsigned char* ST = F.lds + ST_OFF; LAS unsigned char* VNT = F.lds + VNT_OFF;
            const float eg = ((const LAS float*)(F.lds + EGS_OFF))[s];
            bf16x8 bS[4][4]; f32x4 acc[4];
#pragma unroll
            for (int n = 0; n < 4; ++n) acc[n] = (f32x4){0.f, 0.f, 0.f, 0.f};
            const int r = 16 * m + fr;
#pragma unroll
            for (int ks = 0; ks < 4; ++ks) { const bf16x8 a = *(const LAS bf16x8*)(buf + r * 256 + (((4 * ks + fq) ^ fr) << 4));
#pragma unroll
                for (int n = 0; n < 4; ++n) { bS[n][ks] = *(const LAS bf16x8*)(ST + (16 * n + fr) * 288 + (32 * ks + 8 * fq) * 2); acc[n] = __builtin_amdgcn_mfma_f32_16x16x32_bf16(a, bS[n][ks], acc[n], 0, 0, 0); } }
#pragma unroll
            for (int n = 0; n < 4; ++n) { v2u ucn = {0u, 0u}; if (!kindP) ucn = *(const LAS v2u*)(buf + 57344 + (16 * n + fr) * 128 + (16 * m + 4 * fq) * 2);
                const float v0 = bflo(ucn.x) - acc[n][0], v1 = bfhi(ucn.x) - acc[n][1], v2 = bflo(ucn.y) - acc[n][2], v3 = bfhi(ucn.y) - acc[n][3]; v2u o; o.x = pk2(v0, v1); o.y = pk2(v2, v3);
                *(LAS v2u*)(VNT + (16 * n + fr) * 160 + (16 * m + 4 * fq) * 2) = o; }
            P4_BAR();
            bf16x8 bV[4][2];
#pragma unroll
            for (int n = 0; n < 4; ++n)
#pragma unroll
                for (int ks = 0; ks < 2; ++ks) bV[n][ks] = *(const LAS bf16x8*)(VNT + (16 * n + fr) * 160 + (32 * ks + 8 * fq) * 2);
            if (g > 0 || s >= 4) {
                f32x4 o[4];
#pragma unroll
                for (int n = 0; n < 4; ++n) o[n] = (f32x4){0.f, 0.f, 0.f, 0.f};
#pragma unroll
                for (int ks = 0; ks < 4; ++ks) { const bf16x8 a = *(const LAS bf16x8*)(buf + 16384 + r * 256 + (((4 * ks + fq) ^ fr) << 4));
#pragma unroll
                    for (int n = 0; n < 4; ++n) o[n] = __builtin_amdgcn_mfma_f32_16x16x32_bf16(bS[n][ks], a, o[n], 0, 0, 0); }
#pragma unroll
                for (int ks = 0; ks < 2; ++ks) { const bf16x8 a = *(const LAS bf16x8*)(buf + 49152 + r * 128 + (((4 * ks + fq) ^ ((r >> 1) & 7)) << 4));
#pragma unroll
                    for (int n = 0; n < 4; ++n) o[n] = __builtin_amdgcn_mfma_f32_16x16x32_bf16(bV[n][ks], a, o[n], 0, 0, 0); }
                const int sp = g == 0 ? s - 4 : 32 * g + s;
                const int i = 16 * m + fr;
                if (kindP) { bf16* cb = CB + ((size_t)(chain * 96 + (sp - 32)) * 64 + i) * 128 + c0 + 4 * fq;
#pragma unroll
                    for (int n = 0; n < 4; ++n) { v2u w; w.x = pk2(o[n][0], o[n][1]); w.y = pk2(o[n][2], o[n][3]); *(v2u*)(cb + 16 * n) = w; } }
                else { const int nn = d ? 127 - sp : sp, tl = d ? 63 - i : i; bf16* op = OD + ((size_t)b * T + 64 * nn + tl) * 512 + h * 128 + c0 + 4 * fq;
#pragma unroll
                    for (int n = 0; n < 4; ++n) { v2u w; w.x = pk2(o[n][0], o[n][1]); w.y = pk2(o[n][2], o[n][3]); *(v2u*)(op + 16 * n) = w; } }
            }
#pragma unroll
            for (int t2 = 0; t2 < 2; ++t2)
#pragma unroll
                for (int n = 0; n < 4; ++n) S[t2][n] *= eg;
#pragma unroll
            for (int ks = 0; ks < 2; ++ks)
#pragma unroll
                for (int t2 = 0; t2 < 2; ++t2) { const int rr = 32 * m + 16 * t2 + fr; const bf16x8 a = *(const LAS bf16x8*)(buf + 32768 + rr * 128 + (((4 * ks + fq) ^ ((rr >> 1) & 7)) << 4));
#pragma unroll
                    for (int n = 0; n < 4; ++n) S[t2][n] = __builtin_amdgcn_mfma_f32_16x16x32_bf16(a, bV[n][ks], S[t2][n], 0, 0, 0); }
#pragma unroll
            for (int t2 = 0; t2 < 2; ++t2)
#pragma unroll
                for (int n = 0; n < 4; ++n) { v2u o; o.x = pk2(S[t2][n][0], S[t2][n][1]); o.y = pk2(S[t2][n][2], S[t2][n][3]); *(LAS v2u*)(ST + (16 * n + fr) * 288 + (32 * m + 16 * t2 + 4 * fq) * 2) = o; }
            P4_BAR();
        }
        if (g < 3 && !kindP) { float* zt = (float*)(F.ws + WS_ZT) + (size_t)(chain * 4 + g) * 16384;
#pragma unroll
            for (int t2 = 0; t2 < 2; ++t2)
#pragma unroll
                for (int n = 0; n < 4; ++n) *(f32x4*)(zt + (c0 + 16 * n + fr) * 128 + 32 * m + 16 * t2 + 4 * fq) = S[t2][n]; }
        if (kindP && g < 3) { bf16* xb = (bf16*)(F.ws + WS_XB) + (size_t)(chain * 4 + g) * 16384;
#pragma unroll
            for (int t2 = 0; t2 < 2; ++t2)
#pragma unroll
                for (int n = 0; n < 4; ++n)
#pragma unroll
                    for (int jj = 0; jj < 4; ++jj) xb[(32 * m + 16 * t2 + 4 * fq + jj) * 128 + c0 + 16 * n + fr] = (bf16)f2bf(S[t2][n][jj]); }
    }
#undef P4_SLOT
#undef P4_BAR
}
__device__ __forceinline__ void p4b_correct(Frame& F) {
    if (F.vcu >= 192) return;
    const int chain = F.vcu / 12, g = 1 + (F.vcu % 12) / 4, qt = F.vcu & 3;
    const int b = chain >> 3, h = (chain >> 1) & 3, d = chain & 1;
    LAS bf16* Y = (LAS bf16*)F.lds;
    LAS bf16* Y2 = (LAS bf16*)(F.lds + 34816);
    LAS bf16* XL = (LAS bf16*)(F.lds + 69632);
    const float* ZT = (const float*)(F.ws + WS_ZT) + (size_t)chain * 4 * 16384; const bf16* XB = (const bf16*)(F.ws + WS_XB) + (size_t)chain * 4 * 16384;
    const int tid = F.tid, lane = F.lane, wave = F.wave, fr = lane & 15, fq = lane >> 4;
    for (int q = tid; q < 128 * 32; q += 512) { const int c = q >> 5, k4 = q & 31; const f32x4 z = *(const f32x4*)(ZT + c * 128 + 4 * k4); v2u o; o.x = pk2(z.x, z.y); o.y = pk2(z.z, z.w); *(LAS v2u*)(Y + c * 136 + 4 * k4) = o; }
    __syncthreads();
    LAS bf16* Yc = Y; LAS bf16* Yn = Y2;
#pragma unroll 1
    for (int gg = 1; gg < g; ++gg) {
        for (int q = tid; q < 128 * 16; q += 512) { const int rr = q >> 4, k8 = q & 15; *(LAS v4u*)(XL + rr * 136 + 8 * k8) = *(const v4u*)(XB + (size_t)gg * 16384 + rr * 128 + 8 * k8); }
        __syncthreads();
#pragma unroll 1
        for (int tn = 0; tn < 8; ++tn) { f32x4 acc = {0.f, 0.f, 0.f, 0.f}; acc = mma_tile(Yc, 136, 16 * wave, XL, 136, 16 * tn, 128, acc, lane);
#pragma unroll
            for (int jj = 0; jj < 4; ++jj) { const int col = 16 * wave + 4 * fq + jj, dk = 16 * tn + fr; Yn[col * 136 + dk] = (bf16)f2bf(acc[jj] + ZT[(size_t)gg * 16384 + col * 128 + dk]); } }
        __syncthreads();
        LAS bf16* t_ = Yc; Yc = Yn; Yn = t_;
    }
    bf16* OD = (bf16*)(F.ws + (d ? WS_CORRB : WS_CORRF)); const bf16* CB = (const bf16*)(F.ws + WS_CB);
#pragma unroll 1
    for (int cc = 0; cc < 8; ++cc) {
        const int sp = 32 * g + 8 * qt + cc, nn = d ? 127 - sp : sp; const bf16* cb = CB + ((size_t)(chain * 96 + (sp - 32)) * 64) * 128;
        for (int q = tid; q < 64 * 16; q += 512) { const int rr = q >> 4, k8 = q & 15; *(LAS v4u*)(XL + rr * 136 + 8 * k8) = *(const v4u*)(cb + rr * 128 + 8 * k8); }
        __syncthreads();
#pragma unroll 1
        for (int ti = 0; ti < 4; ++ti) { f32x4 acc = {0.f, 0.f, 0.f, 0.f}; acc = mma_tile(Yc, 136, 16 * wave, XL, 136, 16 * ti, 128, acc, lane);
            const int i = 16 * ti + fr, tl = d ? 63 - i : i; v2u w; w.x = pk2(acc[0], acc[1]); w.y = pk2(acc[2], acc[3]);
            *(v2u*)(OD + ((size_t)b * T + 64 * nn + tl) * 512 + h * 128 + 16 * wave + 4 * fq) = w; }
        __syncthreads();
    }
}
__device__ __forceinline__ void p5a_combine(Frame& F) {
    const bf16* OFp = (const bf16*)(F.ws + WS_OF); const bf16* OBp = (const bf16*)(F.ws + WS_OB); const bf16* Z = (const bf16*)(F.ws + WS_Z); bf16* MIX = (bf16*)(F.ws + WS_MIX);
    const int gw = F.vcu * NWAVES + F.wave, NGW = F.G * NWAVES, lane = F.lane;
    float gn[8];
#pragma unroll
    for (int e = 0; e < 8; ++e) gn[e] = F.gdn_norm_g[(lane & 15) * 8 + e];
    for (int mb = gw; mb < M; mb += 2 * NGW) {
        v4u a[2], bq[2], zz[2], cf[2], cbk[2];
#pragma unroll
        for (int u = 0; u < 2; ++u) { const int m = mb + u * NGW, tt = m & (T - 1);
            a[u] = *(const v4u*)(OFp + (size_t)m * 512 + lane * 8); bq[u] = *(const v4u*)(OBp + (size_t)m * 512 + lane * 8); zz[u] = *(const v4u*)(Z + (size_t)m * 512 + lane * 8);
            cf[u] = cbk[u] = (v4u){0u, 0u, 0u, 0u};
            if (tt >= 2048) cf[u] = *(const v4u*)((const bf16*)(F.ws + WS_CORRF) + (size_t)m * 512 + lane * 8);
            if (tt < 6144) cbk[u] = *(const v4u*)((const bf16*)(F.ws + WS_CORRB) + (size_t)m * 512 + lane * 8); }
#pragma unroll
        for (int u = 0; u < 2; ++u) { const int m = mb + u * NGW;
            float o[8]; float ss = 0.f;
#pragma unroll
            for (int e = 0; e < 4; ++e) { o[2 * e] = (bflo(a[u][e]) + bflo(bq[u][e])) + (bflo(cf[u][e]) + bflo(cbk[u][e])); o[2 * e + 1] = (bfhi(a[u][e]) + bfhi(bq[u][e])) + (bfhi(cf[u][e]) + bfhi(cbk[u][e])); ss += o[2 * e] * o[2 * e] + o[2 * e + 1] * o[2 * e + 1]; }
            ss += __shfl_xor(ss, 1); ss += __shfl_xor(ss, 2); ss += __shfl_xor(ss, 4); ss += __shfl_xor(ss, 8);
            const float rstd = 1.0f / sqrtf(ss * (1.0f / 128.0f) + EPS);
            float y[8];
#pragma unroll
            for (int e = 0; e < 4; ++e) { y[2 * e] = o[2 * e] * rstd * gn[2 * e] * silu_r(bflo(zz[u][e])); y[2 * e + 1] = o[2 * e + 1] * rstd * gn[2 * e + 1] * silu_r(bfhi(zz[u][e])); }
            v4u w; w.x = pk2(y[0], y[1]); w.y = pk2(y[2], y[3]); w.z = pk2(y[4], y[5]); w.w = pk2(y[6], y[7]);
            *(v4u*)(MIX + (size_t)m * 1024 + 512 + lane * 8) = w; }
    }
}
__device__ __forceinline__ void p6_phase(Frame& F) {
    const float* MOD = (const float*)(F.ws + WS_MOD); const float* H1 = (const float*)(F.ws + WS_H1); bf16* FIN = (bf16*)(F.ws + WS_FIN);
    float* AFF = (float*)(F.ws + WS_AFF); int* SEL = (int*)(F.ws + WS_SEL);
    LAS float* WR = (LAS float*)F.lds;
    for (int i = F.tid; i < 1024 * 4; i += 512) { const int k = i >> 2, q = i & 3; *(LAS f32x4*)(WR + k * 20 + q * 4) = *(const f32x4*)(F.w_router + k * 16 + q * 4); }
    __syncthreads();
    const int gw = F.vcu * NWAVES + F.wave, NGW = F.G * NWAVES, lane = F.lane;
#pragma unroll 1
    for (int b = 0; b < 2; ++b) {
        const float* mv = MOD + b * 6144;
        float sc[16], sh[16];
#pragma unroll
        for (int j = 0; j < 16; ++j) { const int k = lane + 64 * j; sc[j] = F.norm2_g[k] * (1.0f + mv[4096 + k]); sh[j] = mv[3072 + k]; }
        float vn[16];
        { const float* hr = H1 + (size_t)(b * T + gw) * D;
#pragma unroll
          for (int j = 0; j < 16; ++j) vn[j] = hr[lane + 64 * j]; }
        for (int m = b * T + gw; m < (b + 1) * T; m += NGW) {
            float v[16]; float ss = 0.f;
#pragma unroll
            for (int j = 0; j < 16; ++j) { v[j] = vn[j]; ss += v[j] * v[j]; }
            { const int mn = (m + NGW < (b + 1) * T) ? m + NGW : m; const float* hr = H1 + (size_t)mn * D;
#pragma unroll
              for (int j = 0; j < 16; ++j) vn[j] = hr[lane + 64 * j]; }
            const float rstd = 1.0f / sqrtf(wave_sum(ss) * (1.0f / D) + EPS);
            float lg[16];
#pragma unroll
            for (int e = 0; e < 16; ++e) lg[e] = 0.f;
            bf16* fr_ = FIN + (size_t)m * D;
#pragma unroll
            for (int j = 0; j < 16; ++j) { const float f = v[j] * rstd * sc[j] + sh[j]; fr_[lane + 64 * j] = (bf16)f2bf(f);
                const LAS float* wr = WR + (lane + 64 * j) * 20;
#pragma unroll
                for (int q = 0; q < 4; ++q) { const f32x4 w = *(const LAS f32x4*)(wr + 4 * q); lg[4 * q] += f * w.x; lg[4 * q + 1] += f * w.y; lg[4 * q + 2] += f * w.z; lg[4 * q + 3] += f * w.w; }
                asm volatile("" ::: "memory"); }
            float r8[8], r4[4], r2[2], r1;
#pragma unroll
            for (int e = 0; e < 8; ++e) { const bool hi = lane & 32; const float keep = hi ? lg[e + 8] : lg[e], give = hi ? lg[e] : lg[e + 8]; r8[e] = keep + __shfl_xor(give, 32); }
#pragma unroll
            for (int e = 0; e < 4; ++e) { const bool hi = lane & 16; const float keep = hi ? r8[e + 4] : r8[e], give = hi ? r8[e] : r8[e + 4]; r4[e] = keep + __shfl_xor(give, 16); }
#pragma unroll
            for (int e = 0; e < 2; ++e) { const bool hi = lane & 8; const float keep = hi ? r4[e + 2] : r4[e], give = hi ? r4[e] : r4[e + 2]; r2[e] = keep + __shfl_xor(give, 8); }
            { const bool hi = lane & 4; const float keep = hi ? r2[1] : r2[0], give = hi ? r2[0] : r2[1]; r1 = keep + __shfl_xor(give, 4); }
            r1 += __shfl_xor(r1, 2); r1 += __shfl_xor(r1, 1);
            const int eL = ((lane >> 5) & 1) * 8 + ((lane >> 4) & 1) * 4 + ((lane >> 3) & 1) * 2 + ((lane >> 2) & 1);
            const float lgt = r1 + F.b_router[eL];
            float mx = lgt; mx = fmaxf(mx, __shfl_xor(mx, 4)); mx = fmaxf(mx, __shfl_xor(mx, 8)); mx = fmaxf(mx, __shfl_xor(mx, 16)); mx = fmaxf(mx, __shfl_xor(mx, 32));
            const float ex = expf(lgt - mx); float den = ex; den += __shfl_xor(den, 4); den += __shfl_xor(den, 8); den += __shfl_xor(den, 16); den += __shfl_xor(den, 32);
            if ((lane & 3) == 0) AFF[((size_t)b * 16 + eL) * T + (m - b * T)] = ex / den;
            if (lane < 16) SEL[(size_t)m * 16 + lane] = -1;
        }
    }
}
__device__ __forceinline__ int block_excl_scan(int v, LAS int* tmp, int lane, int wave, int& total) {
    int inc = v;
#pragma unroll
    for (int o = 1; o < 64; o <<= 1) { const int y = __shfl_up(inc, o); if (lane >= o) inc += y; }
    if (lane == 63) tmp[wave] = inc;
    __syncthreads();
    int woff = 0, tot = 0;
#pragma unroll
    for (int w = 0; w < 8; ++w) { const int sv = tmp[w]; woff += (w < wave) ? sv : 0; tot += sv; }
    __syncthreads();
    total = tot; return woff + inc - v;
}
__device__ __forceinline__ void p7_topk(Frame& F) {
    const float* AFF = (const float*)(F.ws + WS_AFF); int* SEL = (int*)(F.ws + WS_SEL); int* IDX = (int*)(F.ws + WS_IDX); float* GATE = (float*)(F.ws + WS_GATE);
    LAS unsigned* vals = (LAS unsigned*)F.lds;
    LAS unsigned* hist = vals + 8192;
    LAS int* tmp = (LAS int*)(hist + 256);
    const int tid = F.tid, lane = F.lane, wave = F.wave;
    for (int u = F.vcu; u < 32; u += F.G) {
        const int b = u >> 4, e = u & 15; const float* ar = AFF + (size_t)u * T;
        for (int t = tid; t < T; t += 512) vals[t] = __builtin_bit_cast(unsigned, ar[t]);
        if (tid == 0) { tmp[8] = 0; tmp[9] = CAP; }
        __syncthreads();
#pragma unroll 1
        for (int pass = 0; pass < 4; ++pass) {
            const int shift = 24 - 8 * pass;
            if (tid < 256) hist[tid] = 0u;
            __syncthreads();
            const unsigned prefix = (unsigned)tmp[8], himask = pass == 0 ? 0u : (0xffffffffu << (shift + 8));
            for (int t = tid; t < T; t += 512) { const unsigned v = vals[t]; if ((v & himask) == prefix) __hip_atomic_fetch_add(hist + ((v >> shift) & 255u), 1u, __ATOMIC_RELAXED, __HIP_MEMORY_SCOPE_WORKGROUP); }
            __syncthreads();
            if (wave == 0) {
                const unsigned kth = (unsigned)tmp[9];
                const unsigned c0 = hist[255 - 4 * lane], c1 = hist[254 - 4 * lane], c2 = hist[253 - 4 * lane], c3 = hist[252 - 4 * lane], sm = c0 + c1 + c2 + c3;
                unsigned inc = sm;
#pragma unroll
                for (int o = 1; o < 64; o <<= 1) { const unsigned y = __shfl_up(inc, o); if (lane >= o) inc += y; }
                const unsigned exc = inc - sm;
                if (exc < kth && kth <= inc) { unsigned r = kth - exc; int bin;
                    if (r <= c0) bin = 255 - 4 * lane; else if (r <= c0 + c1) { bin = 254 - 4 * lane; r -= c0; } else if (r <= c0 + c1 + c2) { bin = 253 - 4 * lane; r -= c0 + c1; } else { bin = 252 - 4 * lane; r -= c0 + c1 + c2; }
                    tmp[8] = (int)(prefix | ((unsigned)bin << shift)); tmp[9] = (int)r; }
            }
            __syncthreads();
        }
        const unsigned thr = (unsigned)tmp[8]; const int kth = tmp[9];
        const int t0 = tid * 16; int cg = 0, ce = 0;
#pragma unroll
        for (int i = 0; i < 16; ++i) { const unsigned v = vals[t0 + i]; cg += (v > thr) ? 1 : 0; ce += (v == thr) ? 1 : 0; }
        int tot; const int eqb = block_excl_scan(ce, tmp, lane, wave, tot);
        int take = kth - eqb; take = take < 0 ? 0 : (take > ce ? ce : take);
        int pos = block_excl_scan(cg + take, tmp, lane, wave, tot); int eqseen = 0;
#pragma unroll 1
        for (int i = 0; i < 16; ++i) { const unsigned v = vals[t0 + i]; bool sel = v > thr; if (v == thr) { sel = eqseen < take; ++eqseen; }
            if (sel) { const int t = t0 + i; IDX[u * CAP + pos] = b * T + t; GATE[u * CAP + pos] = __builtin_bit_cast(float, v); SEL[((size_t)b * T + t) * 16 + e] = pos; ++pos; } }
        __syncthreads();
    }
}
__device__ __forceinline__ void p7b_gather(Frame& F) {
    const int* IDX = (const int*)(F.ws + WS_IDX); const bf16* FIN = (const bf16*)(F.ws + WS_FIN); bf16* XE = (bf16*)(F.ws + WS_XE);
    const int gw = F.vcu * NWAVES + F.wave, NGW = F.G * NWAVES, lane = F.lane;
    for (int r = gw; r < 32 * CAP; r += 2 * NGW) { const int r1 = r + NGW; const int src0 = IDX[r], src1 = IDX[r1];
        const v4u* sp0 = (const v4u*)(FIN + (size_t)src0 * D); const v4u* sp1 = (const v4u*)(FIN + (size_t)src1 * D); v4u* dp0 = (v4u*)(XE + (size_t)r * D); v4u* dp1 = (v4u*)(XE + (size_t)r1 * D);
        const v4u a = sp0[lane], c = sp0[lane + 64], e = sp1[lane], f = sp1[lane + 64]; dp0[lane] = a; dp0[lane + 64] = c; dp1[lane] = e; dp1[lane + 64] = f; }
}
__device__ __forceinline__ void p10_final(Frame& F) {
    const float* MOD = (const float*)(F.ws + WS_MOD); const float* H1 = (const float*)(F.ws + WS_H1); const bf16* YE = (const bf16*)(F.ws + WS_YE); const int* SEL = (const int*)(F.ws + WS_SEL);
    const int gw = F.vcu * NWAVES + F.wave, NGW = F.G * NWAVES, lane = F.lane;
#pragma unroll 1
    for (int b = 0; b < 2; ++b) {
        f32x4 gt[4], fg[4];
#pragma unroll
        for (int j = 0; j < 4; ++j) { gt[j] = *(const f32x4*)(MOD + b * 6144 + 5120 + 4 * lane + 256 * j); fg[j] = *(const f32x4*)(F.final_norm_g + 4 * lane + 256 * j); }
        for (int m0 = b * T + gw; m0 < (b + 1) * T; m0 += 2 * NGW) {
            const int m1 = m0 + NGW;
            const int sel0 = lane < 16 ? SEL[(size_t)m0 * 16 + lane] : -1, sel1 = lane < 16 ? SEL[(size_t)m1 * 16 + lane] : -1;
            f32x4 h0[4], h1v[4], a0[4], a1[4];
#pragma unroll
            for (int j = 0; j < 4; ++j) { h0[j] = *(const f32x4*)(H1 + (size_t)m0 * D + 4 * lane + 256 * j); h1v[j] = *(const f32x4*)(H1 + (size_t)m1 * D + 4 * lane + 256 * j); a0[j] = a1[j] = (f32x4){0.f, 0.f, 0.f, 0.f}; }
#pragma unroll 1
            for (int e = 0; e < 16; ++e) { const int c0_ = __shfl(sel0, e), c1_ = __shfl(sel1, e);
                if (c0_ >= 0 || c1_ >= 0) {
                    const bf16* y0 = YE + ((size_t)(b * 16 + e) * CAP + (c0_ >= 0 ? c0_ : 0)) * D + 4 * lane; const bf16* y1 = YE + ((size_t)(b * 16 + e) * CAP + (c1_ >= 0 ? c1_ : 0)) * D + 4 * lane;
                    v2u w0[4], w1[4];
#pragma unroll
                    for (int j = 0; j < 4; ++j) { w0[j] = *(const v2u*)(y0 + 256 * j); w1[j] = *(const v2u*)(y1 + 256 * j); }
                    const float k0 = c0_ >= 0 ? 1.f : 0.f, k1 = c1_ >= 0 ? 1.f : 0.f;
#pragma unroll
                    for (int j = 0; j < 4; ++j) { a0[j] += k0 * (f32x4){bflo(w0[j].x), bfhi(w0[j].x), bflo(w0[j].y), bfhi(w0[j].y)}; a1[j] += k1 * (f32x4){bflo(w1[j].x), bfhi(w1[j].x), bflo(w1[j].y), bfhi(w1[j].y)}; } } }
            float s0 = 0.f, s1 = 0.f;
#pragma unroll
            for (int j = 0; j < 4; ++j) { h0[j] += gt[j] * a0[j]; h1v[j] += gt[j] * a1[j];
                s0 += (h0[j].x * h0[j].x + h0[j].y * h0[j].y) + (h0[j].z * h0[j].z + h0[j].w * h0[j].w); s1 += (h1v[j].x * h1v[j].x + h1v[j].y * h1v[j].y) + (h1v[j].z * h1v[j].z + h1v[j].w * h1v[j].w); }
            const float r0 = 1.0f / sqrtf(wave_sum(s0) * (1.0f / D) + EPS), r1 = 1.0f / sqrtf(wave_sum(s1) * (1.0f / D) + EPS);
#pragma unroll
            for (int j = 0; j < 4; ++j) { *(f32x4*)(F.out + (size_t)m0 * D + 4 * lane + 256 * j) = h0[j] * r0 * fg[j]; *(f32x4*)(F.out + (size_t)m1 * D + 4 * lane + 256 * j) = h1v[j] * r1 * fg[j]; }
        }
    }
}
struct Args { const float* in[23]; float* out; unsigned char* ws; int ph_lo, ph_hi; };
__global__ void __launch_bounds__(NWAVES * 64, 2) fwd_kernel(Args args) {
    extern __shared__ __attribute__((aligned(16))) unsigned char lds_raw[];
    Frame F;
    F.lds = (LAS unsigned char*)lds_raw;
    volatile LAS unsigned* MISC = (volatile LAS unsigned*)(F.lds + MISC_OFF);
    F.tid = threadIdx.x; F.lane = F.tid & 63; F.wave = __builtin_amdgcn_readfirstlane(F.tid >> 6);
    F.G = gridDim.x; { const int bx = blockIdx.x; F.vcu = (F.G % 8 == 0) ? (bx % 8) * (F.G / 8) + bx / 8 : bx; }
    F.ws = args.ws; F.out = args.out;
    F.x = args.in[0]; F.c = args.in[1]; F.ctx = args.in[2]; F.c_ctx = args.in[3]; F.w_mod = args.in[4]; F.b_mod = args.in[5]; F.norm1_g = args.in[6]; F.norm2_g = args.in[7];
    F.w_in = args.in[8]; F.conv_w = args.in[9]; F.a_log = args.in[10]; F.dt_bias = args.in[11]; F.gdn_norm_g = args.in[12]; F.gm_norm_g = args.in[13]; F.gm_ws = args.in[14]; F.gm_bs = args.in[15];
    F.w_out = args.in[16]; F.w_router = args.in[17]; F.b_router = args.in[18]; F.w_gate = args.in[19]; F.w_up = args.in[20]; F.w_down = args.in[21]; F.final_norm_g = args.in[22];
    for (int u = F.tid; u < 64; u += NWAVES * 64) MISC[u] = 0u;
    __syncthreads();
    XcdBarrier bar; bar.bar = (unsigned*)(F.ws + WS_CTL) + CW_BAR; bar.x = 0; bar.st = nullptr;
    if (!MK_PER_PHASE) bar = xcd_barrier_post((unsigned*)(F.ws + WS_CTL) + CW_BAR, MISC + 8);
    const int lo = args.ph_lo, hi = args.ph_hi;
#define IN(k) (lo <= (k) && (k) < hi)
#define SEAM(k) do { if (IN(k) && IN((k) + 1)) xcd_barrier(bar); } while (0)
    if (IN(0)) { p0_phase(F); } SEAM(0);
    if (IN(1)) { p1_phase(F); } SEAM(1);
    if (IN(2)) {
        pg8::Gemm g{(const bf16*)(F.ws + WS_AIN), (const bf16*)(F.ws + WS_WIN), MA, 3328, D, 0, 0, 0, nullptr}; pg8::StaticOrder S; S.init(MA, 3328, F.G, (int)blockIdx.x);
        pg8::EpiInProj E{(bf16*)(F.ws + WS_QKV), (bf16*)(F.ws + WS_Z), (bf16*)(F.ws + WS_UV), (float*)(F.ws + WS_AB)};
        pg8::gemm_phase<pg8::EpiInProj, pg8::StaticOrder, PG8_ALIGN, PG8_SP2>(F.lds, g, S, E);
    } SEAM(2);
    if (IN(3)) { p3_phase(F); } SEAM(3);
    if (IN(4)) { p4_scan(F); } SEAM(4);
    if (IN(5)) { p4b_correct(F); } SEAM(5);
    if (IN(6)) { p5a_combine(F); wgu_convert(F); } SEAM(6);
    if (IN(7)) {
        pg8::Gemm g{(const bf16*)(F.ws + WS_MIX), (const bf16*)(F.ws + WS_WOUT), M, D, D, 0, 0, 0, nullptr}; pg8::StaticOrder S; S.init(M, D, F.G, (int)blockIdx.x);
        pg8::EpiOutProj E{F.x, (const float*)(F.ws + WS_MOD), (float*)(F.ws + WS_H1)};
        pg8::gemm_phase<pg8::EpiOutProj, pg8::StaticOrder, PG8_ALIGN, PG8_SP2>(F.lds, g, S, E);
    } SEAM(7);
    if (IN(8)) { p6_phase(F); } SEAM(8);
    if (IN(9)) { p7_topk(F); wd_convert(F); } SEAM(9);
    if (IN(10)) {
        pg8::Gemm g{(const bf16*)(F.ws + WS_FIN), (const bf16*)(F.ws + WS_WGU), 32 * CAP, 2 * FF, D, (size_t)2 * FF * D * 2, 2, 15, (const int*)(F.ws + WS_IDX)};     pg8::StaticOrder S; S.init(32 * CAP, 2 * FF, F.G, (int)blockIdx.x);
        pg8::EpiSwiGLU E{(bf16*)(F.ws + WS_HID)};
        pg8::gemm_phase<pg8::EpiSwiGLU, pg8::StaticOrder, PG8_ALIGN, PG8_SP2, true>(F.lds, g, S, E, F.lds + 131072);
    } SEAM(10);
    if (IN(11)) {
        pg8::Gemm g{(const bf16*)(F.ws + WS_HID), (const bf16*)(F.ws + WS_WD), 32 * CAP, D, FF, (size_t)D * FF * 2, 2, 15, nullptr}; pg8::StaticOrder S; S.init(32 * CAP, D, F.G, (int)blockIdx.x);
        pg8::EpiDown E{(bf16*)(F.ws + WS_YE), (const float*)(F.ws + WS_GATE)};
        pg8::gemm_phase<pg8::EpiDown, pg8::StaticOrder, PG8_ALIGN, PG8_SP2>(F.lds, g, S, E);
    } SEAM(11);
    if (IN(12)) { p10_final(F); }
#undef IN
#undef SEAM
}

extern "C" void kernel_launch(void* const* d_in, const int* in_sizes, int n_in, void* d_out, int out_size, void* d_ws, size_t ws_size, hipStream_t stream) {
    static int grid = 0;
    if (grid == 0) {
        if (n_in != 23 || out_size != M * D || ws_size < WS_END) { fprintf(stderr, "kernel_launch: unexpected problem (n_in %d, out %d, ws %zu)\n", n_in, out_size, ws_size); grid = -1; return; }
        int dev = 0, cus = 0;
        if (hipGetDevice(&dev) != hipSuccess || hipDeviceGetAttribute(&cus, hipDeviceAttributeMultiprocessorCount, dev) != hipSuccess) { grid = -1; return; }
        if (hipFuncSetAttribute((const void*)fwd_kernel, hipFuncAttributeMaxDynamicSharedMemorySize, LDS_BYTES) != hipSuccess) { fprintf(stderr, "kernel_launch: hipFuncSetAttribute failed\n"); grid = -1; return; }
        grid = cus;
    }
    if (grid < 0) return;
    if (hipMemsetAsync((char*)d_ws + WS_CTL, 0, CTL_ZERO_BYTES, stream) != hipSuccess) return;
    Args a{};
    for (int i = 0; i < 23; ++i) a.in[i] = (const float*)d_in[i];
    a.out = (float*)d_out; a.ws = (unsigned char*)d_ws;
#if MK_PER_PHASE
    for (int p = 0; p < NPHASE; ++p) { a.ph_lo = p; a.ph_hi = p + 1; hipLaunchKernelGGL(fwd_kernel, dim3(grid), dim3(NWAVES * 64), LDS_BYTES, stream, a); }
#else
    a.ph_lo = 0; a.ph_hi = NPHASE;
    hipLaunchKernelGGL(fwd_kernel, dim3(grid), dim3(NWAVES * 64), LDS_BYTES, stream, a);
#endif
}
```

```cpp
#include <hip/hip_runtime.h>
#include <cstdio>
#include <cstdint>
namespace pg8 {
#define PG8_LAS __attribute__((address_space(3)))
typedef unsigned short bf16_t;
typedef short bf16x8 __attribute__((ext_vector_type(8)));
typedef float f32x4 __attribute__((ext_vector_type(4)));
typedef unsigned u32x4 __attribute__((ext_vector_type(4)));
constexpr int BM = 256, BK = 64, HALF = 128, HTB = HALF * BK * 2  , STAGE_BYTES = 8 * HTB, NXCD = 8, WGM = 8;

__host__ __device__ __forceinline__ int lds_byte(int r, int c) { const int st = (r >> 4) * 2 + (c >> 5), rr = r & 15, cc = c & 31, ob = rr * 64 + cc * 2; return st * 1024 + (ob ^ (((ob >> 9) & 1) << 5)); }
__host__ __device__ __forceinline__ void stage_rc(int b, int& R, int& C) { const int st = b / 1024, sb = b % 1024, swz = sb ^ (((sb >> 9) & 1) << 5); R = (st >> 1) * 16 + swz / 64; C = (st & 1) * 32 + (swz % 64) / 2; }
__host__ __device__ __forceinline__ int perm32(int rho) { const int n = rho >> 4, i = rho & 15; return 8 * (i >> 2) + 4 * n + (i & 3); }

struct Unit { int pm, pn; };
struct Gemm { const bf16_t* A; const bf16_t* Bt; int M, N, K; size_t bgs; int gsh, gmask; const int* gidx; };

struct StaticOrder {
    int nM, nN, nwg, G, c;
    __host__ __device__ void init(int M, int N, int G_, int c_) { nM = M / BM; nN = N / BM; nwg = nM * nN; G = G_; c = c_; }
    __host__ __device__ bool next(int i, Unit& u) const {
        const long L = (long)i * G + c; if (L >= nwg) return false;
        int wgid = (int)L; { const int q = nwg / NXCD, r = nwg % NXCD, xcd = wgid % NXCD, off = wgid / NXCD; wgid = (xcd < r ? xcd * (q + 1) : r * (q + 1) + (xcd - r) * q) + off; }
        const int nig = WGM * nN, gid = wgid / nig, fm = gid * WGM, gsz = (nM - fm) < WGM ? (nM - fm) : WGM;
        u.pm = fm + ((wgid % nig) % gsz); u.pn = (wgid % nig) / gsz; return true;
    }
    __device__ __forceinline__ void a_ready(const Unit&) const {}
    __device__ __forceinline__ void done(const Unit&) const {}
};

__device__ __forceinline__ unsigned cvt_pk_bf16(float lo, float hi) { unsigned r; asm volatile("v_cvt_pk_bf16_f32 %0, %1, %2" : "=v"(r) : "v"(lo), "v"(hi)); return r; }
typedef float f32x2 __attribute__((ext_vector_type(2)));
__device__ __forceinline__ f32x2 gelu_pk(f32x2 v) {
    const f32x2 av = __builtin_elementwise_abs(v), d = av * 0.2316418882f + 1.0f;
    f32x2 t; t.x = __builtin_amdgcn_rcpf(d.x); t.y = __builtin_amdgcn_rcpf(d.y);
    f32x2 q = t * 0.5307027145f + (-0.7265760135f); q = q * t + 0.7107068705f; q = q * t + (-0.142248368f); q = q * t + 0.127414796f; q = q * t;
    const f32x2 s = (v * v) * (-0.72134752044f);
    f32x2 e; e.x = __builtin_amdgcn_exp2f(s.x); e.y = __builtin_amdgcn_exp2f(s.y);
    const f32x2 m = v * (q * e), r = v - m;
    f32x2 o; o.x = v.x < 0.f ? m.x : r.x; o.y = v.y < 0.f ? m.y : r.y; return o;
}
__device__ __forceinline__ float silu_f(float x) { return x * __builtin_amdgcn_rcpf(1.0f + __expf(-x)); }
__device__ __forceinline__ void st8(bf16_t* p, const f32x4 v0, const f32x4 v1) { u32x4 w; w.x = cvt_pk_bf16(v0[0], v0[1]); w.y = cvt_pk_bf16(v0[2], v0[3]); w.z = cvt_pk_bf16(v1[0], v1[1]); w.w = cvt_pk_bf16(v1[2], v1[3]); *(u32x4*)p = w; }
struct EpiInProj {
    static constexpr bool PERM = true, AFTER_DRAIN = false;
    bf16_t* QKV; bf16_t* Z; bf16_t* UV; float* AB;
    __device__ __forceinline__ void operator()(const f32x4 (&acc)[2][2][4][2], const Unit& u, int wr, int wc, int fr, int fq) const {
        const int row0 = u.pm * BM + wr * 64 + fr, pn = u.pn;
        if (pn == 12) {
            if (wc == 0 && fq < 2) {
#pragma unroll
                for (int ai = 0; ai < 2; ++ai)
#pragma unroll
                    for (int m = 0; m < 4; ++m) { float* p = AB + (size_t)(row0 + ai * HALF + m * 16) * 16 + 8 * fq; *(f32x4*)p = acc[ai][0][m][0]; *(f32x4*)(p + 4) = acc[ai][0][m][1]; }
            }
            return;
        }
        bf16_t* base; int ldc, colt; bool act = false;
        if (pn < 6) { base = QKV; ldc = 1536; colt = pn * 256; }
        else { if (u.pm >= 64) return; if (pn < 8) { base = Z; ldc = 512; colt = (pn - 6) * 256; } else { base = UV; ldc = 1024; colt = (pn - 8) * 256; act = true; } }
        const int col0 = colt + wc * 32 + 8 * fq;
#pragma unroll
        for (int ai = 0; ai < 2; ++ai)
#pragma unroll
            for (int m = 0; m < 4; ++m) { bf16_t* rowp = base + (size_t)(row0 + ai * HALF + m * 16) * ldc + col0;
#pragma unroll
                for (int bj = 0; bj < 2; ++bj) { f32x4 v0 = acc[ai][bj][m][0], v1 = acc[ai][bj][m][1];
                    if (act) { f32x2 a = gelu_pk((f32x2){v0[0], v0[1]}), b = gelu_pk((f32x2){v0[2], v0[3]}), c = gelu_pk((f32x2){v1[0], v1[1]}), d = gelu_pk((f32x2){v1[2], v1[3]});
                        v0 = (f32x4){a.x, a.y, b.x, b.y}; v1 = (f32x4){c.x, c.y, d.x, d.y}; }
                    st8(rowp + bj * HALF, v0, v1); } }
    }
};
struct EpiOutProj {
    static constexpr bool PERM = false, AFTER_DRAIN = false;
    const float* x; const float* mod; float* H1;
    __device__ __forceinline__ void operator()(const f32x4 (&acc)[2][2][4][2], const Unit& u, int wr, int wc, int fr, int fq) const {
        const int row0 = u.pm * BM + wr * 64 + fr, col0 = u.pn * BM + wc * 32 + 4 * fq; const float* gt = mod + (u.pm >= 32 ? 6144 : 0) + 2048;
        f32x4 gv[2][2];
#pragma unroll
        for (int bj = 0; bj < 2; ++bj)
#pragma unroll
            for (int n = 0; n < 2; ++n) gv[bj][n] = *(const f32x4*)(gt + col0 + bj * HALF + n * 16);
#pragma unroll
        for (int ai = 0; ai < 2; ++ai)
#pragma unroll
            for (int m = 0; m < 4; ++m) { const size_t off = (size_t)(row0 + ai * HALF + m * 16) * 1024 + col0;
#pragma unroll
                for (int bj = 0; bj < 2; ++bj)
#pragma unroll
                    for (int n = 0; n < 2; ++n) { const f32x4 xv = *(const f32x4*)(x + off + bj * HALF + n * 16); *(f32x4*)(H1 + off + bj * HALF + n * 16) = xv + gv[bj][n] * acc[ai][bj][m][n]; } }
    }
};
struct EpiSwiGLU {
    static constexpr bool PERM = true, AFTER_DRAIN = false;
    bf16_t* HID;
    __device__ __forceinline__ void operator()(const f32x4 (&acc)[2][2][4][2], const Unit& u, int wr, int wc, int fr, int fq) const {
        const int row0 = u.pm * BM + wr * 64 + fr, col0 = u.pn * HALF + wc * 32 + 8 * fq;
#pragma unroll
        for (int ai = 0; ai < 2; ++ai)
#pragma unroll
            for (int m = 0; m < 4; ++m) { bf16_t* rowp = HID + (size_t)(row0 + ai * HALF + m * 16) * 1024 + col0; f32x4 h0, h1;
#pragma unroll
                for (int j = 0; j < 4; ++j) { h0[j] = silu_f(acc[ai][0][m][0][j]) * acc[ai][1][m][0][j]; h1[j] = silu_f(acc[ai][0][m][1][j]) * acc[ai][1][m][1][j]; }
                st8(rowp, h0, h1); }
    }
};
struct EpiDown {
    static constexpr bool PERM = true, AFTER_DRAIN = false;
    bf16_t* YE; const float* gate;
    __device__ __forceinline__ void operator()(const f32x4 (&acc)[2][2][4][2], const Unit& u, int wr, int wc, int fr, int fq) const {
        const int row0 = u.pm * BM + wr * 64 + fr, col0 = u.pn * BM + wc * 32 + 8 * fq;
#pragma unroll
        for (int ai = 0; ai < 2; ++ai)
#pragma unroll
            for (int m = 0; m < 4; ++m) { const int row = row0 + ai * HALF + m * 16; const float gv = gate[row]; bf16_t* rowp = YE + (size_t)row * 1024 + col0;
#pragma unroll
                for (int bj = 0; bj < 2; ++bj) st8(rowp + bj * HALF, acc[ai][bj][m][0] * gv, acc[ai][bj][m][1] * gv); }
    }
};
template <class Epi, class Sched, bool ALIGN_EPI = false, bool SP2 = false, bool GATHER = false>
__device__ __forceinline__ void gemm_phase(PG8_LAS unsigned char* lds, const Gemm g, const Sched& S, const Epi& E, PG8_LAS unsigned char* idx_lds = nullptr) {
    static_assert(!GATHER || SP2, "the gathered-A form exists only for the SP2 loop");
    const int tid = threadIdx.x, wid = __builtin_amdgcn_readfirstlane(tid >> 6), lane = tid & 63, wr = wid >> 2, wc = wid & 3, fr = lane & 15, fq = lane >> 4;
    const int K = g.K, nt = K / BK;
    unsigned voffA[2], voffB[2], colA2[2]; int rowA[2];
#pragma unroll
    for (int i = 0; i < 2; ++i) { int R, C; stage_rc(tid * 16 + i * 8192, R, C); const int Rb = Epi::PERM ? ((R & ~31) + perm32(R & 31)) : R;
        voffA[i] = (unsigned)(R * K + C) * 2u; voffB[i] = (unsigned)(Rb * K + C) * 2u; rowA[i] = R; colA2[i] = (unsigned)C * 2u; }
    unsigned gc[2][2] = {{0u, 0u}, {0u, 0u}}, gn[2][2] = {{0u, 0u}, {0u, 0u}};
    const size_t kstep = (size_t)(BK * 2);
    const size_t hstep = (size_t)HALF * K * 2;
    const size_t tstep = 2 * hstep;
    const unsigned ldsw = (unsigned)wid * 1024u;
    const int aoff = lds_byte(wr * 64 + fr, fq * 8), boff = lds_byte(wc * 32 + fr, fq * 8);
#define PG8_SA(b, h) (((b) * 2 + (h)) * HTB)
#define PG8_SB(b, h) ((4 + (b) * 2 + (h)) * HTB)
#define PG8_STAGE(bufoff, gbase, voff) do { _Pragma("unroll") for (int _i = 0; _i < 2; ++_i) \
        __builtin_amdgcn_global_load_lds((const unsigned*)((const char*)(gbase) + (voff)[_i]), (PG8_LAS unsigned*)(lds + (bufoff) + ldsw + _i * 8192), 16, 0, 0); } while (0)
#define PG8_STAGE_A(bufoff, ptr, hh, offs) do { if constexpr (GATHER) { PG8_STAGE(bufoff, ptr, offs[hh]); } else { PG8_STAGE(bufoff, (ptr) + (hh) * hstep, voffA); } } while (0)
#define PG8_GOFFS(dst, bufi) do { _Pragma("unroll") for (int h_ = 0; h_ < 2; ++h_) _Pragma("unroll") for (int i_ = 0; i_ < 2; ++i_) \
        dst[h_][i_] = (unsigned)(((const PG8_LAS int*)(idx_lds + (bufi) * 1024))[h_ * HALF + rowA[i_]]) * (unsigned)(K * 2) + colA2[i_]; } while (0)
#define PG8_IDX_ISSUE(unit, bufi) do { if (wid == 0) __builtin_amdgcn_global_load_lds((const unsigned*)(g.gidx + (size_t)(unit).pm * BM + lane * 4), (PG8_LAS unsigned*)(idx_lds + (bufi) * 1024), 16, 0, 0); } while (0)
#define PG8_LDA(dst, b, h) do { _Pragma("unroll") for (int m = 0; m < 4; ++m) _Pragma("unroll") for (int k = 0; k < 2; ++k) dst[m][k] = *(const PG8_LAS bf16x8*)(lds + PG8_SA(b, h) + aoff + m * 2048 + k * 1024); } while (0)
#define PG8_LDB(dst, b, h) do { _Pragma("unroll") for (int n = 0; n < 2; ++n) _Pragma("unroll") for (int k = 0; k < 2; ++k) dst[n][k] = *(const PG8_LAS bf16x8*)(lds + PG8_SB(b, h) + boff + n * 2048 + k * 1024); } while (0)
#define PG8_MMA(ai, bj, At, Bt) do { __builtin_amdgcn_s_setprio(1); _Pragma("unroll") for (int m = 0; m < 4; ++m) _Pragma("unroll") for (int n = 0; n < 2; ++n) _Pragma("unroll") for (int k = 0; k < 2; ++k) \
        acc[ai][bj][m][n] = __builtin_amdgcn_mfma_f32_16x16x32_bf16(Bt[n][k], At[m][k], acc[ai][bj][m][n], 0, 0, 0); __builtin_amdgcn_s_setprio(0); } while (0)
#define PG8_WAIT_V(n) asm volatile("s_waitcnt vmcnt(" #n ")" ::: "memory")
#define PG8_WAIT_L(n) asm volatile("s_waitcnt lgkmcnt(" #n ")" ::: "memory")
#define PG8_BAR __builtin_amdgcn_s_barrier()
#define PG8_SCHED __builtin_amdgcn_sched_barrier(0)
    Unit cur, nxt; int ui = 0;
    if (!S.next(0, cur)) return;
    f32x4 acc[2][2][4][2];
#pragma unroll
    for (int a = 0; a < 2; ++a)
#pragma unroll
        for (int b = 0; b < 2; ++b)
#pragma unroll
            for (int m = 0; m < 4; ++m)
#pragma unroll
                for (int n = 0; n < 2; ++n) acc[a][b][m][n] = (f32x4){0.f, 0.f, 0.f, 0.f};
    bf16x8 At[4][2], B0[2][2], B1[2][2];
    const char* cA = (const char*)g.A + (size_t)cur.pm * tstep; const char* cB = (const char*)g.Bt + (size_t)((cur.pm >> g.gsh) & g.gmask) * g.bgs + (size_t)cur.pn * tstep;
    if constexpr (GATHER) { cA = (const char*)g.A;
        PG8_IDX_ISSUE(cur, 0); asm volatile("s_waitcnt vmcnt(0)" ::: "memory"); PG8_BAR; PG8_GOFFS(gc, 0); asm volatile("s_waitcnt lgkmcnt(0)" ::: "memory"); }
    S.a_ready(cur);
    if constexpr (SP2) {
        PG8_STAGE(PG8_SB(0, 0), cB, voffB); PG8_STAGE(PG8_SB(0, 1), cB + hstep, voffB); PG8_STAGE_A(PG8_SA(0, 0), cA, 0, gc); PG8_STAGE_A(PG8_SA(0, 1), cA, 1, gc);
        if (wr == 1) PG8_BAR;
        PG8_WAIT_V(2); PG8_BAR;
        PG8_STAGE(PG8_SB(1, 0), cB + kstep, voffB); PG8_STAGE_A(PG8_SA(1, 0), cA + kstep, 0, gc); PG8_STAGE(PG8_SB(1, 1), cB + hstep + kstep, voffB);
        PG8_WAIT_V(6); PG8_BAR;
    } else {
        PG8_STAGE(PG8_SB(0, 0), cB, voffB); PG8_STAGE(PG8_SA(0, 0), cA, voffA); PG8_STAGE(PG8_SB(0, 1), cB + hstep, voffB); PG8_STAGE(PG8_SA(0, 1), cA + hstep, voffA);
        if (wr == 1) PG8_BAR;
        PG8_WAIT_V(4); PG8_BAR;
        PG8_STAGE(PG8_SB(1, 0), cB + kstep, voffB); PG8_STAGE(PG8_SA(1, 0), cA + kstep, voffA); PG8_STAGE(PG8_SB(1, 1), cB + hstep + kstep, voffB);
        PG8_WAIT_V(6); PG8_BAR;
    }
    for (;;) {
        const bool has_next = S.next(ui + 1, nxt);
        const char* nA = GATHER ? (const char*)g.A : (has_next ? (const char*)g.A + (size_t)nxt.pm * tstep : cA);
        if constexpr (GATHER) { if (has_next) PG8_IDX_ISSUE(nxt, (ui + 1) & 1); }
        const char* nB = has_next ? (const char*)g.Bt + (size_t)((nxt.pm >> g.gsh) & g.gmask) * g.bgs + (size_t)nxt.pn * tstep : cB;
        for (int t = 0; t < nt; t += 2) {
            const bool last = (t == nt - 2);
            const char* a1 = cA + (size_t)(t + 1) * kstep;
            const char* a2 = last ? nA : cA + (size_t)(t + 2) * kstep; const char* b2 = last ? nB : cB + (size_t)(t + 2) * kstep;
            const char* a3 = a2 + kstep; const char* b3 = b2 + kstep;
            if (last && has_next) S.a_ready(nxt);
            unsigned g2[2][2] = {{gc[0][0], gc[0][1]}, {gc[1][0], gc[1][1]}};
            if constexpr (GATHER) { if (last && has_next) { PG8_GOFFS(gn, (ui + 1) & 1); g2[0][0] = gn[0][0]; g2[0][1] = gn[0][1]; g2[1][0] = gn[1][0]; g2[1][1] = gn[1][1]; } }
            if constexpr (SP2) {
            PG8_LDB(B0, 0, 0); PG8_LDB(B1, 0, 1); PG8_SCHED; PG8_LDA(At, 0, 0); PG8_STAGE_A(PG8_SA(1, 1), a1, 1, gc);
            PG8_WAIT_V(8); PG8_WAIT_L(0); PG8_BAR; PG8_MMA(0, 0, At, B0); PG8_MMA(0, 1, At, B1); PG8_BAR; PG8_SCHED;
            PG8_LDA(At, 0, 1); PG8_STAGE(PG8_SB(0, 0), b2, voffB); PG8_STAGE(PG8_SB(0, 1), b2 + hstep, voffB); PG8_STAGE_A(PG8_SA(0, 0), a2, 0, g2);
            PG8_WAIT_V(8); PG8_WAIT_L(0); PG8_BAR; PG8_MMA(1, 0, At, B0); PG8_MMA(1, 1, At, B1); PG8_BAR; PG8_SCHED;
            PG8_LDB(B0, 1, 0); PG8_LDB(B1, 1, 1); PG8_SCHED; PG8_LDA(At, 1, 0); PG8_STAGE_A(PG8_SA(0, 1), a2, 1, g2);
            PG8_WAIT_V(8); PG8_WAIT_L(0); PG8_BAR; PG8_MMA(0, 0, At, B0); PG8_MMA(0, 1, At, B1); PG8_BAR; PG8_SCHED;
            PG8_LDA(At, 1, 1); PG8_STAGE(PG8_SB(1, 0), b3, voffB); PG8_STAGE(PG8_SB(1, 1), b3 + hstep, voffB); PG8_STAGE_A(PG8_SA(1, 0), a3, 0, g2);
            PG8_WAIT_V(8); PG8_WAIT_L(0); PG8_BAR; PG8_MMA(1, 0, At, B0); PG8_MMA(1, 1, At, B1); PG8_BAR; PG8_SCHED;
            } else {
            PG8_LDB(B0, 0, 0); PG8_SCHED; PG8_LDA(At, 0, 0); PG8_STAGE(PG8_SA(1, 1), a1 + hstep, voffA);
            PG8_WAIT_L(8); PG8_BAR; PG8_WAIT_L(0); PG8_MMA(0, 0, At, B0); PG8_BAR; PG8_SCHED;
            PG8_LDB(B1, 0, 1); PG8_STAGE(PG8_SB(0, 0), b2, voffB);
            PG8_BAR; PG8_WAIT_L(0); PG8_MMA(0, 1, At, B1); PG8_BAR;
            PG8_LDA(At, 0, 1); PG8_STAGE(PG8_SA(0, 0), a2, voffA);
            PG8_BAR; PG8_WAIT_L(0); PG8_MMA(1, 0, At, B0); PG8_BAR; PG8_SCHED;
            PG8_STAGE(PG8_SB(0, 1), b2 + hstep, voffB);
            PG8_WAIT_V(6); PG8_BAR; PG8_MMA(1, 1, At, B1); PG8_BAR;
            PG8_LDB(B0, 1, 0); PG8_SCHED; PG8_LDA(At, 1, 0); PG8_STAGE(PG8_SA(0, 1), a2 + hstep, voffA);
            PG8_WAIT_L(8); PG8_BAR; PG8_WAIT_L(0); PG8_MMA(0, 0, At, B0); PG8_BAR; PG8_SCHED;
            PG8_LDB(B1, 1, 1); PG8_STAGE(PG8_SB(1, 0), b3, voffB);
            PG8_BAR; PG8_WAIT_L(0); PG8_MMA(0, 1, At, B1); PG8_BAR;
            PG8_LDA(At, 1, 1); PG8_STAGE(PG8_SA(1, 0), a3, voffA);
            PG8_BAR; PG8_WAIT_L(0); PG8_MMA(1, 0, At, B0); PG8_BAR; PG8_SCHED;
            PG8_STAGE(PG8_SB(1, 1), b3 + hstep, voffB);
            PG8_WAIT_V(6); PG8_BAR; PG8_MMA(1, 1, At, B1); PG8_BAR;
            }
        }
        if constexpr (ALIGN_EPI) { if (wr == 0) PG8_BAR; }
        if constexpr (!Epi::AFTER_DRAIN) { E(acc, cur, wr, wc, fr, fq); S.done(cur); }
        if (!has_next) break;
#pragma unroll
        for (int a = 0; a < 2; ++a)
#pragma unroll
            for (int b = 0; b < 2; ++b)
#pragma unroll
                for (int m = 0; m < 4; ++m)
#pragma unroll
                    for (int n = 0; n < 2; ++n) acc[a][b][m][n] = (f32x4){0.f, 0.f, 0.f, 0.f};
        cur = nxt; cA = nA; cB = nB; ++ui;
        if constexpr (GATHER) { gc[0][0] = gn[0][0]; gc[0][1] = gn[0][1]; gc[1][0] = gn[1][0]; gc[1][1] = gn[1][1]; }
        if constexpr (ALIGN_EPI) { if (wr == 1) PG8_BAR; }
    }
    PG8_WAIT_V(0);
    if constexpr (!ALIGN_EPI) { if (wr == 0) PG8_BAR; }
    PG8_BAR;
    if constexpr (Epi::AFTER_DRAIN) { E.fused(acc, cur, wr, wc, fr, fq, lds, wid, lane); S.done(cur); }
#undef PG8_SA
#undef PG8_SB
#undef PG8_STAGE
#undef PG8_LDA
#undef PG8_STAGE_A
#undef PG8_GOFFS
#undef PG8_IDX_ISSUE
#undef PG8_LDB
#undef PG8_MMA
#undef PG8_WAIT_V
#undef PG8_WAIT_L
#undef PG8_BAR
#undef PG8_SCHED
}
}
#ifndef PG8_SP2
#define PG8_SP2 true
#endif
#ifndef PG8_ALIGN
#define PG8_ALIGN true
#endif
constexpr int NWAVES = 8;
#ifndef MK_PER_PHASE
#define MK_PER_PHASE 0
#endif
constexpr int NPHASE = 13;
constexpr int BATCH = 2, T = 8192, D = 1024, TC = 256, M = BATCH * T, MC = BATCH * TC, MA = M + MC;
constexpr int NEXP = 16, CAP = 1024, FF = 1024;
constexpr float EPS = 1e-6f;
constexpr size_t MiB = 1u << 20;
constexpr size_t WS_CTL = 0, CTL_ZERO_BYTES = 1 * MiB;
constexpr size_t WS_MOD = 1 * MiB;
constexpr size_t WS_EGL = 1 * MiB + 128 * 1024;
constexpr size_t WS_IDX = 1 * MiB + 512 * 1024;
constexpr size_t WS_GATE = WS_IDX + 128 * 1024;
constexpr size_t WS_AFF = 2 * MiB;
constexpr size_t WS_SEL = 3 * MiB;
constexpr size_t WS_WIN = 4 * MiB;
constexpr size_t WS_WOUT = 11 * MiB;
constexpr size_t WS_AIN = 13 * MiB;
constexpr size_t WS_MIX = 13 * MiB;
constexpr size_t WS_FIN = 13 * MiB;
constexpr size_t WS_QKV = 46 * MiB;
constexpr size_t WS_OF = 46 * MiB, WS_OB = 62 * MiB;
constexpr size_t WS_Z = 96 * MiB;
constexpr size_t WS_UV = 112 * MiB;
constexpr size_t WS_AB = 144 * MiB;
constexpr size_t WS_GDN = 146 * MiB;
constexpr size_t GDN_UNIT = 73728;
constexpr size_t WS_WGU = 132 * MiB;
constexpr size_t WS_H1 = 232 * MiB;
constexpr size_t WS_XE = 68 * MiB;
constexpr size_t WS_HID = 46 * MiB;
constexpr size_t WS_WD = 196 * MiB;
constexpr size_t WS_YE = 132 * MiB;
constexpr size_t WS_END = 296 * MiB;
static_assert(WS_GDN + 2112 * GDN_UNIT <= WS_END && WS_AB + (size_t)MA * 64 <= WS_GDN && WS_QKV + (size_t)MA * 3072 <= WS_Z, "ws map");
constexpr int CW_BAR = 4096;
constexpr int LDS_BYTES = 163840;
constexpr int MISC_OFF = LDS_BYTES - 256;
#define LAS __attribute__((address_space(3)))
#define GAS __attribute__((address_space(1)))
typedef unsigned short bf16;
typedef unsigned v4u __attribute__((ext_vector_type(4)));
typedef unsigned v2u __attribute__((ext_vector_type(2)));
typedef float f32x4 __attribute__((ext_vector_type(4)));
typedef short bf16x8 __attribute__((ext_vector_type(8)));
#define LDS_WAIT() asm volatile("s_waitcnt lgkmcnt(0)" ::: "memory")
#define VM_WAIT() asm volatile("s_waitcnt vmcnt(0)" ::: "memory")
__device__ __forceinline__ unsigned f2bf(float f) { unsigned u = __builtin_bit_cast(unsigned, f); return (u + 0x7fffu + ((u >> 16) & 1u)) >> 16; }
__device__ __forceinline__ unsigned pk2(float lo, float hi) { return f2bf(lo) | (f2bf(hi) << 16); }
__device__ __forceinline__ float bflo(unsigned w) { return __builtin_bit_cast(float, w << 16); }
__device__ __forceinline__ float bfhi(unsigned w) { return __builtin_bit_cast(float, w & 0xffff0000u); }
__device__ __forceinline__ float bf1(bf16 h) { return __builtin_bit_cast(float, (unsigned)h << 16); }
__device__ __forceinline__ float wave_sum(float v) {
#pragma unroll
    for (int o = 1; o < 64; o <<= 1) v += __shfl_xor(v, o);
    return v;
}
__device__ __forceinline__ float fnma1(float a, float b, float c) { float r; asm("v_fma_f32 %0, -%1, %2, %3" : "=v"(r) : "v"(a), "v"(b), "v"(c)); return r; }
__device__ __forceinline__ float silu_r(float x) { return x * __builtin_amdgcn_rcpf(1.0f + __expf(-x)); }
__device__ __forceinline__ float silu1(float x) { return x / (1.0f + __expf(-x)); }

#define XB_TMO      128
#define XB_XCNT(j)  (256  + 64 * (j))
#define XB_XSUB(j)  (1280 + 64 * (j))
#define XB_XGEN(j)  (2304 + 64 * (j))
#define XB_TOP      3328
#define XB_TOPGEN   3392
#define XCD_BAR_WORDS 3456
#define XB_SPIN_CAP (1u << 18)
__device__ __forceinline__ unsigned xb_ld(unsigned* p)              { return __hip_atomic_load(p, __ATOMIC_RELAXED, __HIP_MEMORY_SCOPE_AGENT); }
__device__ __forceinline__ unsigned xb_add(unsigned* p, unsigned v) { return __hip_atomic_fetch_add(p, v, __ATOMIC_RELAXED, __HIP_MEMORY_SCOPE_AGENT); }
__device__ __forceinline__ unsigned xb_xcc_id() { return (unsigned)__builtin_amdgcn_s_getreg((3 << 11) | 20) & 0xFu; }
#define XB_SPIN(cond, bar) do { unsigned _sp = 0; while (cond) { __builtin_amdgcn_s_sleep(1); \
    if ((++_sp & 255u) == 0u) { if (xb_ld(&(bar)[XB_TMO])) break; if (_sp > XB_SPIN_CAP) { atomicAdd(&(bar)[XB_TMO], 1u); break; } } } } while (0)
struct XcdBarrier { unsigned* bar; unsigned x; volatile LAS unsigned* st; };
__device__ __forceinline__ XcdBarrier xcd_barrier_post(unsigned* bar, volatile LAS unsigned* st) {
    XcdBarrier b; b.bar = bar; b.x = xb_xcc_id(); b.st = st;
    if (threadIdx.x == 0) (void)xb_add(&bar[XB_XCNT(b.x)], 1u);
    return b;
}
__device__ __forceinline__ void xcd_barrier_complete(unsigned* bar, unsigned x, unsigned& nloc, unsigned& nx) {
    const unsigned G = gridDim.x * gridDim.y * gridDim.z;
    unsigned sum, cnt, mine, sp = 0u;
    for (;;) {
        sum = 0u; cnt = 0u; mine = 0u;
#pragma unroll
        for (unsigned j = 0; j < 16; ++j) { const unsigned c = xb_ld(&bar[XB_XCNT(j)]); sum += c; cnt += (c > 0u) ? 1u : 0u; mine = (j == x) ? c : mine; }
        if (sum == G) break;
        __builtin_amdgcn_s_sleep(1);
        if ((++sp & 255u) == 0u) { if (xb_ld(&bar[XB_TMO])) break; if (sp > XB_SPIN_CAP) { atomicAdd(&bar[XB_TMO], 1u); break; } }
    }
    nloc = mine > 0u ? mine : 1u; nx = cnt > 0u ? cnt : 1u;
}
__device__ __forceinline__ void xcd_barrier(const XcdBarrier& b) {
    asm volatile("s_waitcnt vmcnt(0)" ::: "memory");
    __syncthreads();
    if (threadIdx.x == 0) {
        unsigned* bar = b.bar;
        __builtin_amdgcn_s_waitcnt(0);
        unsigned nloc = b.st[0], nx = b.st[1];
        if (nloc == 0u) { xcd_barrier_complete(bar, b.x, nloc, nx); b.st[0] = nloc; b.st[1] = nx; }
        const unsigned old = xb_add(&bar[XB_XSUB(b.x)], 1u);
        const unsigned gen = old / nloc;
        if (old + 1u == (gen + 1u) * nloc) {
            __builtin_amdgcn_fence(__ATOMIC_RELEASE, "agent");
            asm volatile("s_waitcnt vmcnt(0)" ::: "memory");
            const unsigned og = xb_add(&bar[XB_TOP], 1u);
            const unsigned tg = og / nx;
            if (og + 1u == (tg + 1u) * nx) xb_add(&bar[XB_TOPGEN], 1u);
            else XB_SPIN(xb_ld(&bar[XB_TOPGEN]) == tg, bar);
            __builtin_amdgcn_fence(__ATOMIC_ACQUIRE, "agent");
            xb_add(&bar[XB_XGEN(b.x)], 1u);
            asm volatile("s_waitcnt vmcnt(0)" ::: "memory");
        } else {
            XB_SPIN(xb_ld(&bar[XB_XGEN(b.x)]) == gen, bar);
            __builtin_amdgcn_fence(__ATOMIC_ACQUIRE, "agent");
            asm volatile("s_waitcnt vmcnt(0)" ::: "memory");
        }
    }
    __syncthreads();
}

struct Frame {
    LAS unsigned char* lds;
    int tid, lane, wave, vcu, G;
    unsigned char* ws;
    const float *x, *c, *ctx, *c_ctx, *w_mod, *b_mod, *norm1_g, *norm2_g, *w_in, *conv_w, *a_log, *dt_bias, *gdn_norm_g, *gm_norm_g, *gm_ws, *gm_bs, *w_out, *w_router, *b_router, *w_gate, *w_up, *w_down, *final_norm_g;
    float* out;
};
__device__ __forceinline__ f32x4 mma_tile(const LAS bf16* A, int lda, int r0, const LAS bf16* Bt, int ldb, int c0, int K, f32x4 acc, int lane) {
    const int fr = lane & 15, fq = lane >> 4;
    const LAS bf16* ap = A + (r0 + fr) * lda + 8 * fq; const LAS bf16* bp = Bt + (c0 + fr) * ldb + 8 * fq;
#pragma unroll 4
    for (int k0 = 0; k0 < K; k0 += 32) { const bf16x8 a = *(const LAS bf16x8*)(ap + k0), b = *(const LAS bf16x8*)(bp + k0); acc = __builtin_amdgcn_mfma_f32_16x16x32_bf16(a, b, acc, 0, 0, 0); }
    return acc;
}
__device__ __forceinline__ void transpose_item(const float* W, int ldw, int src_col0, int k0, bf16* WT, int Kp, int dst_row0, LAS float* scr, int lane) {
#pragma unroll 8
    for (int i = 0; i < 32; ++i) { const int kk = 2 * i + (lane >> 5); scr[kk * 33 + (lane & 31)] = W[(size_t)(k0 + kk) * ldw + src_col0 + (lane & 31)]; }
    LDS_WAIT(); asm volatile("" ::: "memory");
    const int c = lane & 7;
#pragma unroll
    for (int j = 0; j < 4; ++j) { const int n = (lane >> 3) + 8 * j; const LAS float* s = scr + (8 * c) * 33 + n;
        v4u o; o.x = pk2(s[0 * 33], s[1 * 33]); o.y = pk2(s[2 * 33], s[3 * 33]); o.z = pk2(s[4 * 33], s[5 * 33]); o.w = pk2(s[6 * 33], s[7 * 33]);
        *(v4u*)(WT + (size_t)(dst_row0 + n) * Kp + k0 + 8 * c) = o; }
    LDS_WAIT(); asm volatile("" ::: "memory");
}
__device__ __forceinline__ void p0_phase(Frame& F) {
    float* MOD = (float*)(F.ws + WS_MOD);
    if (F.vcu < 96) {
        LAS float* sv = (LAS float*)F.lds;
        LAS float* red = sv + 3072;
        for (int i = F.tid; i < 3072; i += 512) { const int v = i >> 10, k = i & 1023; const float s = v < 2 ? F.c[v * 1024 + k] : F.c_ctx[k]; sv[i] = silu1(s); }
        __syncthreads();
        for (int item = F.vcu; item < 96; item += F.G) {
            const int kq = F.tid >> 4, cq = F.tid & 15, col = item * 64 + cq * 4;
            f32x4 a0 = {0.f, 0.f, 0.f, 0.f}, a1 = a0, a2 = a0;
#pragma unroll 8
            for (int kk = 0; kk < 32; ++kk) { const int k = kq * 32 + kk; const f32x4 w = *(const f32x4*)(F.w_mod + (size_t)k * 6144 + col); a0 += sv[k] * w; a1 += sv[1024 + k] * w; a2 += sv[2048 + k] * w; }
            *(LAS f32x4*)(red + (kq * 3 + 0) * 64 + cq * 4) = a0; *(LAS f32x4*)(red + (kq * 3 + 1) * 64 + cq * 4) = a1; *(LAS f32x4*)(red + (kq * 3 + 2) * 64 + cq * 4) = a2;
            __syncthreads();
            if (F.tid < 192) { const int v = F.tid >> 6, cc = F.tid & 63; float s = F.b_mod[item * 64 + cc];
                for (int q = 0; q < 32; ++q) s += red[(q * 3 + v) * 64 + cc];
                MOD[v * 6144 + item * 64 + cc] = s; }
            __syncthreads();
        }
    }
    __syncthreads();
    LAS float* scr = (LAS float*)(F.lds + F.wave * 16384);
    const int gw = F.vcu * NWAVES + F.wave, NGW = F.G * NWAVES;
    bf16* WIN = (bf16*)(F.ws + WS_WIN); bf16* WOUT = (bf16*)(F.ws + WS_WOUT);
    constexpr int I_IN = 97 * 16, I_OUT = 32 * 16;
    for (int it = gw; it < I_IN + I_OUT; it += NGW) {
        if (it < I_IN) { const int blk = it >> 4, kb = it & 15;
            const int src = blk < 48 ? 32 * blk : (blk < 64 ? 1552 + 32 * (blk - 48) : (blk < 96 ? 2064 + 32 * (blk - 64) : 1536));
            transpose_item(F.w_in, 3088, src, kb * 64, WIN, 1024, blk * 32, scr, F.lane); }
        else { const int r = it - I_IN, blk = r >> 4, kb = r & 15; transpose_item(F.w_out, 1024, blk * 32, kb * 64, WOUT, 1024, blk * 32, scr, F.lane); }
    }
}
__device__ __forceinline__ void wgu_convert(Frame& F) {
    LAS float* scr = (LAS float*)(F.lds + F.wave * 16384);
    const int gw = F.vcu * NWAVES + F.wave, NGW = F.G * NWAVES;
    bf16* WGU = (bf16*)(F.ws + WS_WGU);
    for (int it = gw; it < 16 * 2 * 512; it += NGW) {
        const int kb = it & 15, fb = (it >> 4) & 31, mat = (it >> 9) & 1, e = it >> 10;
        const float* W = (mat ? F.w_up : F.w_gate) + (size_t)e * 1024 * 1024;
        const int f0 = fb * 32, pn = f0 >> 7, dst = 256 * pn + (mat ? 128 : 0) + (f0 & 127);
        transpose_item(W, 1024, f0, kb * 64, WGU + (size_t)e * 2048 * 1024, 1024, dst, scr, F.lane);
    }
}
__device__ __forceinline__ void wd_convert(Frame& F) {
    LAS float* scr = (LAS float*)(F.lds + F.wave * 16384);
    if (F.vcu < 32) return;
    const int gw = (F.vcu - 32) * NWAVES + F.wave, NGW = (F.G - 32) * NWAVES;
    bf16* WD = (bf16*)(F.ws + WS_WD);
    for (int it = gw; it < 16 * 512; it += NGW) { const int kb = it & 15, nb = (it >> 4) & 31, e = it >> 9;
        transpose_item(F.w_down + (size_t)e * 1024 * 1024, 1024, nb * 32, kb * 64, WD + (size_t)e * 1024 * 1024, 1024, nb * 32, scr, F.lane); }
}
__device__ __forceinline__ void p1_rows4(Frame& F, const float* const (&src)[4], bf16* const (&dst)[4], const bool (&ok)[4], const float* mv) {
    f32x4 v[4][4];
#pragma unroll
    for (int r = 0; r < 4; ++r)
#pragma unroll
        for (int j = 0; j < 4; ++j) v[r][j] = *(const f32x4*)(src[r] + 4 * F.lane + 256 * j);
    f32x4 sc[4], sh[4];
#pragma unroll
    for (int j = 0; j < 4; ++j) { const int k = 4 * F.lane + 256 * j; const f32x4 g = *(const f32x4*)(F.norm1_g + k), s1 = *(const f32x4*)(mv + 1024 + k); sc[j] = g * (1.0f + s1); sh[j] = *(const f32x4*)(mv + k); }
#pragma unroll
    for (int r = 0; r < 4; ++r) { float ss = 0.f;
#pragma unroll
        for (int j = 0; j < 4; ++j) ss += (v[r][j].x * v[r][j].x + v[r][j].y * v[r][j].y) + (v[r][j].z * v[r][j].z + v[r][j].w * v[r][j].w);
        const float rstd = 1.0f / sqrtf(wave_sum(ss) * (1.0f / D) + EPS);
        if (ok[r]) {
#pragma unroll
            for (int j = 0; j < 4; ++j) { const f32x4 a = v[r][j] * rstd * sc[j] + sh[j]; v2u o; o.x = pk2(a.x, a.y); o.y = pk2(a.z, a.w); *(v2u*)(dst[r] + 4 * F.lane + 256 * j) = o; } } }
}
__device__ __forceinline__ void p1_phase(Frame& F) {
    const float* MOD = (const float*)(F.ws + WS_MOD); bf16* AIN = (bf16*)(F.ws + WS_AIN);
    const int gw = F.vcu * NWAVES + F.wave, NGW = F.G * NWAVES;
#pragma unroll 1
    for (int seg = 0; seg < 2; ++seg) {
        const float* src[4]; bf16* dst[4]; bool ok[4];
#pragma unroll
        for (int r = 0; r < 4; ++r) { const int m = seg * T + gw + r * NGW; ok[r] = (gw + r * NGW) < T; const int mc = ok[r] ? m : seg * T; src[r] = F.x + (size_t)mc * D; dst[r] = AIN + (size_t)mc * D; }
        p1_rows4(F, src, dst, ok, MOD + seg * 6144);
    }
    if (gw < MC) {
        const float* src[4]; bf16* dst[4]; bool ok[4];
#pragma unroll
        for (int r = 0; r < 4; ++r) { ok[r] = (r == 0); src[r] = F.ctx + (size_t)gw * D; dst[r] = AIN + (size_t)(M + gw) * D; }
        p1_rows4(F, src, dst, ok, MOD + 2 * 6144);
    }
}
struct PF { unsigned a, b, c, d; };
__device__ __forceinline__ unsigned touch(const void* p) { return *(const GAS unsigned*)p; }
__device__ __forceinline__ PF p3_prefetch(Frame& F, int it) {
    PF r; r.a = r.b = r.c = r.d = 0u;
    if (it >= 1056 + 512) return r;
    const int tid = F.tid;
    if (it < 1056) {
        int b, n, h, L; size_t row_base;
        if (it < 1024) { b = it >> 9; n = (it >> 2) & 127; h = it & 3; L = T; row_base = (size_t)b * T; }
        else { const int j = it - 1024; b = j >> 4; n = (j >> 2) & 3; h = j & 3; L = TC; row_base = (size_t)M + (size_t)b * TC; }
        const bf16* QKV = (const bf16*)(F.ws + WS_QKV);
        { const int p = tid, rr = p / 12, q = p % 12, s = q >> 2, piece = q & 3; int t = 64 * n - 1 + rr; t = t < 0 ? 0 : (t >= L ? L - 1 : t); r.a = touch(QKV + (row_base + t) * 1536 + s * 512 + h * 128 + piece * 32); }
        if (tid < 280) { const int p = tid + 512, rr = p / 12, q = p % 12, s = q >> 2, piece = q & 3; int t = 64 * n - 1 + rr; t = t < 0 ? 0 : (t >= L ? L - 1 : t); r.b = touch(QKV + (row_base + t) * 1536 + s * 512 + h * 128 + piece * 32); }
        if (tid < 64) r.c = touch((const float*)(F.ws + WS_AB) + (row_base + 64 * n + tid) * 16);
    } else {
        const int i2 = it - 1056, g = i2 & 3, nc = (i2 >> 2) & 63, b = i2 >> 8; const size_t r0 = (size_t)b * T + (size_t)nc * 128;
        const bf16* UV = (const bf16*)(F.ws + WS_UV);
        const int t = tid >> 2, piece = tid & 3; r.a = touch(UV + (r0 + t) * 1024 + 512 + 128 * g + piece * 32); r.b = touch(UV + (r0 + t) * 1024 + 128 * g + piece * 32);
        r.c = touch(F.gm_ws + (size_t)g * 16384 + tid * 16); r.d = touch(F.gm_ws + (size_t)g * 16384 + (tid + 512) * 16);
    }
    return r;
}
__device__ __forceinline__ void pf_sink(Frame& F, const PF& r) { asm volatile("" :: "v"(r.a), "v"(r.b), "v"(r.c), "v"(r.d)); }
__device__ __forceinline__ void gdn_item(Frame& F, int it) {
    int b, n, h, L, slot; size_t row_base;
    if (it < 1024) { b = it >> 9; n = (it >> 2) & 127; h = it & 3; L = T; row_base = (size_t)b * T; slot = (b * 4 + h) * 128 + n; }
    else { const int j = it - 1024; b = j >> 4; n = (j >> 2) & 3; h = j & 3; L = TC; row_base = (size_t)M + (size_t)b * TC; slot = 1024 + (b * 4 + h) * 4 + n; }
    const bf16* QKV = (const bf16*)(F.ws + WS_QKV); const float* AB = (const float*)(F.ws + WS_AB);
    LAS bf16* QB = (LAS bf16*)(F.lds); LAS bf16* KB = (LAS bf16*)(F.lds + 17408); LAS bf16* VB = (LAS bf16*)(F.lds + 34816); LAS bf16* TB = (LAS bf16*)(F.lds + 34816);
    LAS bf16* KT = (LAS bf16*)(F.lds + 52224); LAS bf16* VT = (LAS bf16*)(F.lds + 70656);
    LAS float* KK = (LAS float*)(F.lds + 89088); LAS float* QK = (LAS float*)(F.lds + 105728);
    LAS bf16* T12 = (LAS bf16*)(F.lds + 89088);
    LAS float* AF = (LAS float*)(F.lds + 122368);
    LAS float* GC = (LAS float*)(F.lds + 155136); LAS float* BT = (LAS float*)(F.lds + 155648); LAS float* EG1 = (LAS float*)(F.lds + 156160); LAS float* EG2 = (LAS float*)(F.lds + 156672);
    LAS bf16* A10B = (LAS bf16*)(F.lds + 157184);
    const int tid = F.tid, lane = F.lane, wave = F.wave, fr = lane & 15, fq = lane >> 4;
    for (int q = tid; q < 1152; q += 512) { const int tap = q / 384, rem = q % 384, s = rem >> 7, c = rem & 127; ((LAS float*)(F.lds + 89088))[q] = F.conv_w[tap * 1536 + s * 512 + h * 128 + c]; }
    __syncthreads();
    {
        const int r = tid >> 3, part = tid & 7, t = 64 * n + r; const bool hasp = t > 0, hasn = t + 1 < L;
        const bf16* prow = QKV + (row_base + t) * 1536;
        const LAS float* cwl = (const LAS float*)(F.lds + 89088) + part * 16;
        const int offp = hasp ? 1536 : 0, offn = hasn ? 1536 : 0; const unsigned mp = hasp ? 0xffffffffu : 0u, mn = hasn ? 0xffffffffu : 0u;
        v4u dc[6], dn[6];
#define S1_LOAD(dst, s_) do { const bf16* pc_ = prow + (s_) * 512 + h * 128 + part * 16; const bf16* pp_ = pc_ - offp; const bf16* pn_ = pc_ + offn; \
            dst[0] = *(const v4u*)pc_; dst[1] = *(const v4u*)(pc_ + 8); dst[2] = *(const v4u*)pp_; dst[3] = *(const v4u*)(pp_ + 8); dst[4] = *(const v4u*)pn_; dst[5] = *(const v4u*)(pn_ + 8); } while (0)
        S1_LOAD(dc, 0);
#pragma unroll 1
        for (int s = 0; s < 3; ++s) {
            if (s < 2) S1_LOAD(dn, s + 1);
            float y[16]; float ss = 0.f;
#pragma unroll
            for (int q = 0; q < 4; ++q) { const f32x4 w0 = *(const LAS f32x4*)(cwl + (0 * 3 + s) * 128 + 4 * q), w1 = *(const LAS f32x4*)(cwl + (1 * 3 + s) * 128 + 4 * q), w2 = *(const LAS f32x4*)(cwl + (2 * 3 + s) * 128 + 4 * q);
#pragma unroll
                for (int e = 0; e < 2; ++e) { const unsigned cw = dc[q >> 1][(q & 1) * 2 + e], pw = dc[2 + (q >> 1)][(q & 1) * 2 + e] & mp, nw = dc[4 + (q >> 1)][(q & 1) * 2 + e] & mn;
                    const float a0 = w0[2 * e] * bflo(pw) + w1[2 * e] * bflo(cw) + w2[2 * e] * bflo(nw), a1 = w0[2 * e + 1] * bfhi(pw) + w1[2 * e + 1] * bfhi(cw) + w2[2 * e + 1] * bfhi(nw);
                    const float y0 = silu_r(a0), y1 = silu_r(a1); y[4 * q + 2 * e] = y0; y[4 * q + 2 * e + 1] = y1; ss += y0 * y0 + y1 * y1; } }
            float sc = 1.0f;
            if (s < 2) { ss += __shfl_xor(ss, 1); ss += __shfl_xor(ss, 2); ss += __shfl_xor(ss, 4); sc = (1.0f / sqrtf(ss + EPS)) * (s == 0 ? 0.08838834764831845f : 1.0f); }
            LAS bf16* dst = (s == 0 ? QB : (s == 1 ? KB : VB)) + r * 136 + part * 16;
            v4u o0, o1;
            o0.x = pk2(y[0] * sc, y[1] * sc); o0.y = pk2(y[2] * sc, y[3] * sc); o0.z = pk2(y[4] * sc, y[5] * sc); o0.w = pk2(y[6] * sc, y[7] * sc);
            o1.x = pk2(y[8] * sc, y[9] * sc); o1.y = pk2(y[10] * sc, y[11] * sc); o1.z = pk2(y[12] * sc, y[13] * sc); o1.w = pk2(y[14] * sc, y[15] * sc);
            *(LAS v4u*)dst = o0; *(LAS v4u*)(dst + 8) = o1;
#pragma unroll
            for (int q = 0; q < 6; ++q) dc[q] = dn[q];
        }
#undef S1_LOAD
        if (wave < 2) { const int d = wave, i = lane, tl = d ? 63 - i : i; const float* abr = AB + (row_base + 64 * n + tl) * 16;
            const float a = abr[d * 4 + h], bb = abr[8 + d * 4 + h];
            const float xx = a + F.dt_bias[d * 4 + h]; const float sp = fmaxf(xx, 0.f) + log1pf(expf(-fabsf(xx)));
            float g = -expf(F.a_log[d * 4 + h]) * sp;
#pragma unroll
            for (int o = 1; o < 64; o <<= 1) { const float yv = __shfl_up(g, o); if (i >= o) g += yv; }
            GC[d * 64 + i] = g; BT[d * 64 + i] = 1.0f / (1.0f + expf(-bb)); const float gl = __shfl(g, 63); EG1[d * 64 + i] = __expf(g); EG2[d * 64 + i] = __expf(gl - g); }
    }
    __syncthreads();
    const PF pf = p3_prefetch(F, it + F.G);
    {
        const int mat = wave >> 2, tr = wave & 3;
#pragma unroll
        for (int tc = 0; tc < 4; ++tc) { f32x4 acc = {0.f, 0.f, 0.f, 0.f}; acc = mma_tile(mat ? QB : KB, 136, 16 * tr, KB, 136, 16 * tc, 128, acc, lane);
            LAS float* dst = (mat ? QK : KK) + (16 * tr + 4 * fq) * 65 + 16 * tc + fr;
#pragma unroll
            for (int j = 0; j < 4; ++j) dst[j * 65] = acc[j]; }
        bf16x8 id0, id1;
#pragma unroll
        for (int j = 0; j < 8; ++j) { id0[j] = (8 * fq + j == fr) ? (short)0x3F80 : (short)0; id1[j] = (8 * fq + j == fr + 16) ? (short)0x3F80 : (short)0; }
#pragma unroll 1
        for (int q = 0; q < 8; ++q) { const int job = wave * 8 + q, mt = job >> 5, tt = (job >> 3) & 3, ct = job & 7;
            const bf16x8 a = *(const LAS bf16x8*)((mt ? KB : VB) + (16 * tt + fr) * 136 + 32 * (ct >> 1) + 8 * fq);
            f32x4 acc = {0.f, 0.f, 0.f, 0.f}; acc = __builtin_amdgcn_mfma_f32_16x16x32_bf16(a, (ct & 1) ? id1 : id0, acc, 0, 0, 0);
            v2u o; o.x = pk2(acc[0], acc[1]); o.y = pk2(acc[2], acc[3]); *(LAS v2u*)((mt ? KT : VT) + (16 * ct + fr) * 72 + 16 * tt + 4 * fq) = o; }
    }
    __syncthreads();
    for (int idx = tid; idx < 8192; idx += 512) { const int d = idx >> 12, i = (idx >> 6) & 63, j = idx & 63; const int ti = d ? 63 - i : i, tj = d ? 63 - j : j;
        const float av = (i > j) ? BT[d * 64 + i] * KK[ti * 65 + tj] * __expf(GC[d * 64 + i] - GC[d * 64 + j]) : 0.f; AF[idx] = av;
        if (i >= 32 && j < 32) A10B[d * 1280 + (i - 32) * 40 + j] = (bf16)f2bf(av); }
    __syncthreads();
    unsigned char* gout = F.ws + WS_GDN + (size_t)slot * 2 * GDN_UNIT;
    if (wave < 2) {
        const int d = wave, blk = lane >> 5, jc = lane & 31; const LAS float* A = AF + d * 4096 + (blk * 32) * 64 + blk * 32; LAS bf16* TBd = TB + d * 4096;
        float Tc[32];
#pragma unroll
        for (int i = 0; i < 32; ++i) { float s0 = (i == jc) ? 1.f : 0.f, s1 = 0.f, s2 = 0.f, s3 = 0.f;
#pragma unroll
            for (int j = 0; j < i; ++j) { const float a = A[i * 64 + j]; if ((j & 3) == 0) s0 = fnma1(a, Tc[j], s0); else if ((j & 3) == 1) s1 = fnma1(a, Tc[j], s1); else if ((j & 3) == 2) s2 = fnma1(a, Tc[j], s2); else s3 = fnma1(a, Tc[j], s3); }
            Tc[i] = (s0 + s1) + (s2 + s3); TBd[(blk * 32 + i) * 64 + blk * 32 + jc] = (bf16)f2bf(Tc[i]);
            if (blk) TBd[i * 64 + 32 + jc] = (bf16)0;
            asm volatile("" ::: "memory"); }
        LAS bf16* DT0 = (LAS bf16*)(AF + d * 4096); LAS bf16* PT = DT0 + 1280;
        if (!blk) {
#pragma unroll
            for (int q = 0; q < 4; ++q) { v4u o; o.x = pk2(Tc[8 * q], Tc[8 * q + 1]); o.y = pk2(Tc[8 * q + 2], Tc[8 * q + 3]); o.z = pk2(Tc[8 * q + 4], Tc[8 * q + 5]); o.w = pk2(Tc[8 * q + 6], Tc[8 * q + 7]); *(LAS v4u*)(DT0 + jc * 40 + 8 * q) = o; } }
#pragma unroll
        for (int tl = 0; tl < 4; ++tl) { const int ti = tl >> 1, tj = tl & 1; f32x4 acc = {0.f, 0.f, 0.f, 0.f}; acc = mma_tile(A10B + d * 1280, 40, 16 * ti, DT0, 40, 16 * tj, 32, acc, lane);
            v2u o; o.x = pk2(acc[0], acc[1]); o.y = pk2(acc[2], acc[3]); *(LAS v2u*)(PT + (16 * tj + fr) * 40 + 16 * ti + 4 * fq) = o; }
#pragma unroll
        for (int tl = 0; tl < 4; ++tl) { const int ti = tl >> 1, tj = tl & 1; f32x4 acc = {0.f, 0.f, 0.f, 0.f}; acc = mma_tile(TBd + 32 * 64 + 32, 64, 16 * ti, PT, 40, 16 * tj, 32, acc, lane);
#pragma unroll
            for (int j = 0; j < 4; ++j) TBd[(32 + 16 * ti + 4 * fq + j) * 64 + 16 * tj + fr] = (bf16)f2bf(-acc[j]); }
    } else {
        const int t2 = tid - 128;
        for (int q = t2; q < 2048; q += 384) { const int d = q >> 10, i = (q >> 4) & 63, cg = q & 15, tok = d ? 63 - i : i; const float e = EG1[d * 64 + i];
            const v4u s = *(const LAS v4u*)(QB + tok * 136 + cg * 8); v4u o;
            o.x = pk2(bflo(s.x) * e, bfhi(s.x) * e); o.y = pk2(bflo(s.y) * e, bfhi(s.y) * e); o.z = pk2(bflo(s.z) * e, bfhi(s.z) * e); o.w = pk2(bflo(s.w) * e, bfhi(s.w) * e);
            *(v4u*)(gout + (size_t)d * GDN_UNIT + 16384 + (i * 128 + cg * 8) * 2) = o; }
        for (int q = t2; q < 2048; q += 384) { const int d = q >> 10, c = (q >> 3) & 127, ig = q & 7;
            float v[8];
            if (d == 0) { const v4u s = *(const LAS v4u*)(KT + c * 72 + ig * 8); v[0] = bflo(s.x); v[1] = bfhi(s.x); v[2] = bflo(s.y); v[3] = bfhi(s.y); v[4] = bflo(s.z); v[5] = bfhi(s.z); v[6] = bflo(s.w); v[7] = bfhi(s.w); }
            else { const v4u s = *(const LAS v4u*)(KT + c * 72 + 56 - ig * 8); v[7] = bflo(s.x); v[6] = bfhi(s.x); v[5] = bflo(s.y); v[4] = bfhi(s.y); v[3] = bflo(s.z); v[2] = bfhi(s.z); v[1] = bflo(s.w); v[0] = bfhi(s.w); }
            const LAS float* e2 = EG2 + d * 64 + ig * 8; v4u o;
            o.x = pk2(v[0] * e2[0], v[1] * e2[1]); o.y = pk2(v[2] * e2[2], v[3] * e2[3]); o.z = pk2(v[4] * e2[4], v[5] * e2[5]); o.w = pk2(v[6] * e2[6], v[7] * e2[7]);
            *(v4u*)(gout + (size_t)d * GDN_UNIT + 32768 + (c * 64 + ig * 8) * 2) = o; }
        for (int q = t2; q < 1024; q += 384) { const int d = q >> 9, i = (q >> 3) & 63, jg = q & 7, ti = d ? 63 - i : i; const float gi = GC[d * 64 + i]; float v[8];
#pragma unroll
            for (int jj = 0; jj < 8; ++jj) { const int j = jg * 8 + jj, tj = d ? 63 - j : j; v[jj] = (i >= j) ? QK[ti * 65 + tj] * __expf(gi - GC[d * 64 + j]) : 0.f; }
            v4u o; o.x = pk2(v[0], v[1]); o.y = pk2(v[2], v[3]); o.z = pk2(v[4], v[5]); o.w = pk2(v[6], v[7]);
            *(v4u*)(gout + (size_t)d * GDN_UNIT + 49152 + (i * 64 + jg * 8) * 2) = o; }
        if (t2 < 2) ((float*)(F.ws + WS_EGL))[slot * 2 + t2] = EG1[t2 * 64 + 63];
    }
    __syncthreads();
    for (int q = tid; q < 1024; q += 512) { const int d = q >> 9, i = (q >> 3) & 63, tg = q & 7;
        float v[8];
        if (d == 0) { const v4u s = *(const LAS v4u*)(TB + i * 64 + tg * 8); v[0] = bflo(s.x); v[1] = bfhi(s.x); v[2] = bflo(s.y); v[3] = bfhi(s.y); v[4] = bflo(s.z); v[5] = bfhi(s.z); v[6] = bflo(s.w); v[7] = bfhi(s.w); }
        else { const v4u s = *(const LAS v4u*)(TB + 4096 + i * 64 + 56 - tg * 8); v[7] = bflo(s.x); v[6] = bfhi(s.x); v[5] = bflo(s.y); v[4] = bfhi(s.y); v[3] = bflo(s.z); v[2] = bfhi(s.z); v[1] = bflo(s.w); v[0] = bfhi(s.w); }
        float t1[8], t2v[8];
#pragma unroll
        for (int e = 0; e < 8; ++e) { const int tok = tg * 8 + e, j = d ? 63 - tok : tok; t1[e] = v[e] * BT[d * 64 + j]; t2v[e] = t1[e] * EG1[d * 64 + j]; }
        v4u o; o.x = pk2(t1[0], t1[1]); o.y = pk2(t1[2], t1[3]); o.z = pk2(t1[4], t1[5]); o.w = pk2(t1[6], t1[7]); *(LAS v4u*)(T12 + (d * 2 + 0) * 4608 + i * 72 + tg * 8) = o;
        o.x = pk2(t2v[0], t2v[1]); o.y = pk2(t2v[2], t2v[3]); o.z = pk2(t2v[4], t2v[5]); o.w = pk2(t2v[6], t2v[7]); *(LAS v4u*)(T12 + (d * 2 + 1) * 4608 + i * 72 + tg * 8) = o; }
    __syncthreads();
#pragma unroll 1
    for (int q = 0; q < 16; ++q) { const int tile = wave * 16 + q, d = tile >> 6, kind = (tile >> 5) & 1, ti = (tile >> 3) & 3, tc = tile & 7; f32x4 acc = {0.f, 0.f, 0.f, 0.f};
        unsigned char* go = gout + (size_t)d * GDN_UNIT;
        if (kind == 0) { acc = mma_tile(T12 + (d * 2 + 0) * 4608, 72, 16 * ti, VT, 72, 16 * tc, 64, acc, lane);
            v2u o; o.x = pk2(acc[0], acc[1]); o.y = pk2(acc[2], acc[3]); *(v2u*)(go + 57344 + ((16 * tc + fr) * 64 + 16 * ti + 4 * fq) * 2) = o; }
        else { acc = mma_tile(KT, 72, 16 * tc, T12 + (d * 2 + 1) * 4608, 72, 16 * ti, 64, acc, lane);
            v2u o; o.x = pk2(acc[0], acc[1]); o.y = pk2(acc[2], acc[3]); *(v2u*)(go + ((16 * ti + fr) * 128 + 16 * tc + 4 * fq) * 2) = o; } }
    __syncthreads();
    pf_sink(F, pf);
}
__device__ __forceinline__ void gmlp_item(Frame& F, int it) {
    const int g = it & 3, nc = (it >> 2) & 63, b = it >> 8; const size_t r0 = (size_t)b * T + (size_t)nc * 128;
    const bf16* UV = (const bf16*)(F.ws + WS_UV); bf16* MIX = (bf16*)(F.ws + WS_MIX);
    LAS bf16* VNT = (LAS bf16*)(F.lds); LAS bf16* WSB = (LAS bf16*)(F.lds + 34816);
    const int tid = F.tid, lane = F.lane, wave = F.wave;
    {
        const int t = tid >> 2, part = tid & 3; const bf16* vp = UV + (r0 + t) * 1024 + 512 + 128 * g + part * 32;
        float v[32]; float ss = 0.f;
#pragma unroll
        for (int q = 0; q < 4; ++q) { const v4u xw = *(const v4u*)(vp + 8 * q);
#pragma unroll
            for (int e = 0; e < 4; ++e) { v[8 * q + 2 * e] = bflo(xw[e]); v[8 * q + 2 * e + 1] = bfhi(xw[e]); ss += v[8 * q + 2 * e] * v[8 * q + 2 * e] + v[8 * q + 2 * e + 1] * v[8 * q + 2 * e + 1]; } }
        ss += __shfl_xor(ss, 1); ss += __shfl_xor(ss, 2);
        const float rstd = 1.0f / sqrtf(ss * (1.0f / 128.0f) + EPS); const float* gn = F.gm_norm_g + 128 * g + part * 32;
#pragma unroll
        for (int cc = 0; cc < 32; ++cc) VNT[(part * 32 + cc) * 136 + t] = (bf16)f2bf(v[cc] * rstd * gn[cc]);
        const float* wp = F.gm_ws + ((size_t)g * 128 + t) * 128 + part * 32;
#pragma unroll
        for (int q = 0; q < 4; ++q) { const f32x4 w0 = *(const f32x4*)(wp + 8 * q), w1 = *(const f32x4*)(wp + 8 * q + 4); v4u o; o.x = pk2(w0.x, w0.y); o.y = pk2(w0.z, w0.w); o.z = pk2(w1.x, w1.y); o.w = pk2(w1.z, w1.w);
            *(LAS v4u*)(WSB + t * 136 + part * 32 + 8 * q) = o; }
    }
    __syncthreads();
    const PF pf = p3_prefetch(F, it + 1056 + F.G);
    {
        const int td = wave, fr = lane & 15, fq = lane >> 4;
        v2u uws[8]; float bss[8];
#pragma unroll
        for (int tt = 0; tt < 8; ++tt) { const int tl = 16 * tt + fr; uws[tt] = *(const v2u*)(UV + (r0 + tl) * 1024 + 128 * g + 16 * td + 4 * fq); bss[tt] = F.gm_bs[g * 128 + tl]; }
#pragma unroll
        for (int tt = 0; tt < 8; ++tt) { f32x4 acc = {0.f, 0.f, 0.f, 0.f}; acc = mma_tile(VNT, 136, 16 * td, WSB, 136, 16 * tt, 128, acc, lane);
            const int tl = 16 * tt + fr; const size_t off = (r0 + tl) * 1024 + 128 * g + 16 * td + 4 * fq; const float bsv = bss[tt];
            const v2u uw = uws[tt]; v2u o;
            o.x = pk2(bflo(uw.x) * (acc[0] + bsv), bfhi(uw.x) * (acc[1] + bsv)); o.y = pk2(bflo(uw.y) * (acc[2] + bsv), bfhi(uw.y) * (acc[3] + bsv));
            *(v2u*)(MIX + off) = o; }
    }
    __syncthreads();
    pf_sink(F, pf);
}
__device__ __forceinline__ void p3_phase(Frame& F) {
    for (int it = F.vcu; it < 1056 + 512; it += F.G) { if (it < 1056) gdn_item(F, it); else gmlp_item(F, it - 1056); }
}
constexpr size_t WS_CB = 112 * MiB;
constexpr size_t WS_ZT = 136 * MiB;
constexpr size_t WS_XB = 140 * MiB;
constexpr size_t WS_CORRF = 200 * MiB, WS_CORRB = 216 * MiB;
#ifndef P4_TOUCHES
#define P4_TOUCHES 0
#endif
__device__ __forceinline__ void p4_scan(Frame& F) {
    const int j14 = F.vcu & 31;
    if (j14 >= 28) return;
    const int chain = 2 * (F.vcu >> 5) + (j14 >= 14 ? 1 : 0), role = j14 % 14;
    const int g = role < 2 ? 0 : 1 + ((role - 2) >> 2), kindP = role < 2 ? 0 : ((role - 2) >> 1) & 1, ch = role < 2 ? role : (role - 2) & 1;
    const int b = chain >> 3, h = (chain >> 1) & 3, d = chain & 1, c0 = ch * 64;
    const int NS = g == 0 ? 36 : 32;
    constexpr int BUFB = 65536, ST_OFF = 2 * BUFB, VNT_OFF = ST_OFF + 64 * 288, EGS_OFF = VNT_OFF + 64 * 160, JUNK_OFF = EGS_OFF + 256;
    const unsigned char* gdn = F.ws + WS_GDN; const float* EGL = (const float*)(F.ws + WS_EGL);
    const int lane = F.lane, wave = F.wave;
#define P4_SLOT(s) (g == 0 ? ((s) < 4 ? 1024 + (b * 4 + h) * 4 + (d ? 3 - (s) : (s)) : (b * 4 + h) * 128 + (d ? 127 - ((s) - 4) : ((s) - 4))) : (b * 4 + h) * 128 + (d ? 127 - (32 * g + (s)) : (32 * g + (s))))
#define P4_BAR() do { asm volatile("s_waitcnt lgkmcnt(0)" ::: "memory"); __builtin_amdgcn_s_barrier(); asm volatile("" ::: "memory"); } while (0)
#define P4_ISSUE(s, bufi) do { const unsigned char* gb = gdn + (size_t)(P4_SLOT(s) * 2 + d) * GDN_UNIT; \
            _Pragma("unroll") for (int q = 0; q < 7; ++q) { const int k = wave + 8 * q; unsigned so; \
                if (k < 32) { const int qi = (k & 15) * 64 + lane, r = qi >> 4, sl = qi & 15; so = (unsigned)((k >> 4) * 16384 + r * 256 + ((sl ^ (r & 15)) << 4)); } \
                else { const int kk = k < 48 ? k - 32 : k - 48, qi = kk * 64 + lane, r = qi >> 3, sl = qi & 7; so = (unsigned)((k < 48 ? 32768 : 49152) + r * 128 + ((sl ^ ((r >> 1) & 7)) << 4)); } \
                __builtin_amdgcn_global_load_lds((const unsigned*)(gb + so), (LAS unsigned*)(F.lds + (bufi) * BUFB + k * 1024), 16, 0, 0); } \
            if (!kindP) __builtin_amdgcn_global_load_lds((const unsigned*)(gb + 57344 + (size_t)c0 * 128 + wave * 1024 + lane * 16), (LAS unsigned*)(F.lds + (bufi) * BUFB + 57344 + wave * 1024), 16, 0, 0); } while (0)
#define P4_TOUCH(s) do { const unsigned char* gb = gdn + (size_t)(P4_SLOT(s) * 2 + d) * GDN_UNIT; const int li = wave * 64 + lane, ln = li < 448 ? li : 448 + c0 + (li - 448); \
            __builtin_amdgcn_global_load_lds((const unsigned*)(gb + (size_t)ln * 128), (LAS unsigned*)(F.lds + JUNK_OFF + wave * 256), 4, 0, 0); } while (0)
    const int m = wave & 3, nh = wave >> 2, fr = lane & 15, fq = lane >> 4;
    for (int i = F.tid; i < 64 * 72; i += 512) { const int c = i / 72, w4 = i % 72;
        unsigned v = 0u; if (kindP) { const int dk = c0 + c; if ((dk >> 1) == w4) v = (dk & 1) ? 0x3F800000u : 0x00003F80u; }
        ((LAS unsigned*)(F.lds + ST_OFF))[i] = v; }
    for (int i = F.tid; i < NS; i += 512) ((LAS float*)(F.lds + EGS_OFF))[i] = EGL[P4_SLOT(i) * 2 + d];
    f32x4 S[2][2];
#pragma unroll
    for (int t2 = 0; t2 < 2; ++t2)
#pragma unroll
        for (int n2 = 0; n2 < 2; ++n2) {
#pragma unroll
            for (int jj = 0; jj < 4; ++jj) S[t2][n2][jj] = (kindP && (32 * m + 16 * t2 + 4 * fq + jj == c0 + 32 * nh + 16 * n2 + fr)) ? 1.0f : 0.0f; }
    bf16* OD = (bf16*)(F.ws + (d ? WS_OB : WS_OF)); bf16* CB = (bf16*)(F.ws + WS_CB);
    P4_ISSUE(0, 0);
    VM_WAIT(); P4_BAR();
    if (P4_TOUCHES) { P4_TOUCH(1); P4_TOUCH(2); }
#pragma unroll 1
    for (int s = 0; s < NS; ++s) {
        const int cur = s & 1; const LAS unsigned char* buf = F.lds + cur * BUFB; LAS unsigned char* ST = F.lds + ST_OFF; LAS unsigned char* VNT = F.lds + VNT_OFF;
        if (s + 1 < NS) P4_ISSUE(s + 1, cur ^ 1);
        const float eg = ((const LAS float*)(F.lds + EGS_OFF))[s];
        bf16x8 bS[2][4]; f32x4 acc[2];
#pragma unroll
        for (int n2 = 0; n2 < 2; ++n2) acc[n2] = (f32x4){0.f, 0.f, 0.f, 0.f};
        const int r = 16 * m + fr;
#pragma unroll
        for (int ks = 0; ks < 4; ++ks) { const bf16x8 a = *(const LAS bf16x8*)(buf + r * 256 + (((4 * ks + fq) ^ fr) << 4));
#pragma unroll
            for (int n2 = 0; n2 < 2; ++n2) { bS[n2][ks] = *(const LAS bf16x8*)(ST + (32 * nh + 16 * n2 + fr) * 288 + (32 * ks + 8 * fq) * 2); acc[n2] = __builtin_amdgcn_mfma_f32_16x16x32_bf16(a, bS[n2][ks], acc[n2], 0, 0, 0); } }
#pragma unroll
        for (int n2 = 0; n2 < 2; ++n2) { const int cl = 32 * nh + 16 * n2 + fr; v2u ucn = {0u, 0u}; if (!kindP) ucn = *(const LAS v2u*)(buf + 57344 + cl * 128 + (16 * m + 4 * fq) * 2);
            const float v0 = bflo(ucn.x) - acc[n2][0], v1 = bfhi(ucn.x) - acc[n2][1], v2 = bflo(ucn.y) - acc[n2][2], v3 = bfhi(ucn.y) - acc[n2][3]; v2u o; o.x = pk2(v0, v1); o.y = pk2(v2, v3);
            *(LAS v2u*)(VNT + cl * 160 + (16 * m + 4 * fq) * 2) = o; }
        P4_BAR();
        bf16x8 bV[2][2];
#pragma unroll
        for (int n2 = 0; n2 < 2; ++n2)
#pragma unroll
            for (int ks = 0; ks < 2; ++ks) bV[n2][ks] = *(const LAS bf16x8*)(VNT + (32 * nh + 16 * n2 + fr) * 160 + (32 * ks + 8 * fq) * 2);
        const bool outp = (g > 0 || s >= 4);
        if (outp) {
            f32x4 o[2];
#pragma unroll
            for (int n2 = 0; n2 < 2; ++n2) o[n2] = (f32x4){0.f, 0.f, 0.f, 0.f};
#pragma unroll
            for (int ks = 0; ks < 4; ++ks) { const bf16x8 a = *(const LAS bf16x8*)(buf + 16384 + r * 256 + (((4 * ks + fq) ^ fr) << 4));
#pragma unroll
                for (int n2 = 0; n2 < 2; ++n2) o[n2] = __builtin_amdgcn_mfma_f32_16x16x32_bf16(bS[n2][ks], a, o[n2], 0, 0, 0); }
#pragma unroll
            for (int ks = 0; ks < 2; ++ks) { const bf16x8 a = *(const LAS bf16x8*)(buf + 49152 + r * 128 + (((4 * ks + fq) ^ ((r >> 1) & 7)) << 4));
#pragma unroll
                for (int n2 = 0; n2 < 2; ++n2) o[n2] = __builtin_amdgcn_mfma_f32_16x16x32_bf16(bV[n2][ks], a, o[n2], 0, 0, 0); }
            const int sp = g == 0 ? s - 4 : 32 * g + s;
            const int i = 16 * m + fr;
            if (kindP) { bf16* cb = CB + ((size_t)(chain * 96 + (sp - 32)) * 64 + i) * 128 + c0 + 32 * nh + 4 * fq;
#pragma unroll
                for (int n2 = 0; n2 < 2; ++n2) { v2u w; w.x = pk2(o[n2][0], o[n2][1]); w.y = pk2(o[n2][2], o[n2][3]); *(v2u*)(cb + 16 * n2) = w; } }
            else { const int nn = d ? 127 - sp : sp, tl = d ? 63 - i : i; bf16* op = OD + ((size_t)b * T + 64 * nn + tl) * 512 + h * 128 + c0 + 32 * nh + 4 * fq;
#pragma unroll
                for (int n2 = 0; n2 < 2; ++n2) { v2u w; w.x = pk2(o[n2][0], o[n2][1]); w.y = pk2(o[n2][2], o[n2][3]); *(v2u*)(op + 16 * n2) = w; } }
        }
#pragma unroll
        for (int t2 = 0; t2 < 2; ++t2)
#pragma unroll
            for (int n2 = 0; n2 < 2; ++n2) S[t2][n2] *= eg;
#pragma unroll
        for (int ks = 0; ks < 2; ++ks)
#pragma unroll
            for (int t2 = 0; t2 < 2; ++t2) { const int rr = 32 * m + 16 * t2 + fr; const bf16x8 a = *(const LAS bf16x8*)(buf + 32768 + rr * 128 + (((4 * ks + fq) ^ ((rr >> 1) & 7)) << 4));
#pragma unroll
                for (int n2 = 0; n2 < 2; ++n2) S[t2][n2] = __builtin_amdgcn_mfma_f32_16x16x32_bf16(a, bV[n2][ks], S[t2][n2], 0, 0, 0); }
#pragma unroll
        for (int t2 = 0; t2 < 2; ++t2)
#pragma unroll
            for (int n2 = 0; n2 < 2; ++n2) { v2u o; o.x = pk2(S[t2][n2][0], S[t2][n2][1]); o.y = pk2(S[t2][n2][2], S[t2][n2][3]); *(LAS v2u*)(ST + (32 * nh + 16 * n2 + fr) * 288 + (32 * m + 16 * t2 + 4 * fq) * 2) = o; }
        if (P4_TOUCHES && s + 3 < NS) { P4_TOUCH(s + 3); if (outp) asm volatile("s_waitcnt vmcnt(3)" ::: "memory"); else asm volatile("s_waitcnt vmcnt(1)" ::: "memory"); }
        else { if (outp) asm volatile("s_waitcnt vmcnt(2)" ::: "memory"); else asm volatile("s_waitcnt vmcnt(0)" ::: "memory"); }
        P4_BAR();
    }
    if (g < 3 && !kindP) { float* zt = (float*)(F.ws + WS_ZT) + (size_t)(chain * 4 + g) * 16384;
#pragma unroll
        for (int t2 = 0; t2 < 2; ++t2)
#pragma unroll
            for (int n2 = 0; n2 < 2; ++n2) *(f32x4*)(zt + (c0 + 32 * nh + 16 * n2 + fr) * 128 + 32 * m + 16 * t2 + 4 * fq) = S[t2][n2]; }
    if (kindP && g < 3) { bf16* xb = (bf16*)(F.ws + WS_XB) + (size_t)(chain * 4 + g) * 16384;
#pragma unroll
        for (int t2 = 0; t2 < 2; ++t2)
#pragma unroll
            for (int n2 = 0; n2 < 2; ++n2)
#pragma unroll
                for (int jj = 0; jj < 4; ++jj) xb[(32 * m + 16 * t2 + 4 * fq + jj) * 128 + c0 + 32 * nh + 16 * n2 + fr] = (bf16)f2bf(S[t2][n2][jj]); }
    VM_WAIT();
#undef P4_TOUCH
#undef P4_ISSUE
#undef P4_SLOT
#undef P4_BAR
}
__device__ __forceinline__ void p4b_correct(Frame& F) {
    if (F.vcu >= 192) return;
    const int chain = F.vcu / 12, g = 1 + (F.vcu % 12) / 4, qt = F.vcu & 3;
    const int b = chain >> 3, h = (chain >> 1) & 3, d = chain & 1;
    LAS bf16* Y = (LAS bf16*)F.lds;
    LAS bf16* Y2 = (LAS bf16*)(F.lds + 34816);
    LAS bf16* XL = (LAS bf16*)(F.lds + 69632);
    const float* ZT = (const float*)(F.ws + WS_ZT) + (size_t)chain * 4 * 16384; const bf16* XB = (const bf16*)(F.ws + WS_XB) + (size_t)chain * 4 * 16384;
    const int tid = F.tid, lane = F.lane, wave = F.wave, fr = lane & 15, fq = lane >> 4;
    for (int q = tid; q < 128 * 32; q += 512) { const int c = q >> 5, k4 = q & 31; const f32x4 z = *(const f32x4*)(ZT + c * 128 + 4 * k4); v2u o; o.x = pk2(z.x, z.y); o.y = pk2(z.z, z.w); *(LAS v2u*)(Y + c * 136 + 4 * k4) = o; }
    __syncthreads();
    LAS bf16* Yc = Y; LAS bf16* Yn = Y2;
#pragma unroll 1
    for (int gg = 1; gg < g; ++gg) {
        for (int q = tid; q < 128 * 16; q += 512) { const int rr = q >> 4, k8 = q & 15; *(LAS v4u*)(XL + rr * 136 + 8 * k8) = *(const v4u*)(XB + (size_t)gg * 16384 + rr * 128 + 8 * k8); }
        __syncthreads();
#pragma unroll 1
        for (int tn = 0; tn < 8; ++tn) { f32x4 acc = {0.f, 0.f, 0.f, 0.f}; acc = mma_tile(Yc, 136, 16 * wave, XL, 136, 16 * tn, 128, acc, lane);
#pragma unroll
            for (int jj = 0; jj < 4; ++jj) { const int col = 16 * wave + 4 * fq + jj, dk = 16 * tn + fr; Yn[col * 136 + dk] = (bf16)f2bf(acc[jj] + ZT[(size_t)gg * 16384 + col * 128 + dk]); } }
        __syncthreads();
        LAS bf16* t_ = Yc; Yc = Yn; Yn = t_;
    }
    bf16* OD = (bf16*)(F.ws + (d ? WS_CORRB : WS_CORRF)); const bf16* CB = (const bf16*)(F.ws + WS_CB);
#pragma unroll 1
    for (int cc = 0; cc < 8; ++cc) {
        const int sp = 32 * g + 8 * qt + cc, nn = d ? 127 - sp : sp; const bf16* cb = CB + ((size_t)(chain * 96 + (sp - 32)) * 64) * 128;
        for (int q = tid; q < 64 * 16; q += 512) { const int rr = q >> 4, k8 = q & 15; *(LAS v4u*)(XL + rr * 136 + 8 * k8) = *(const v4u*)(cb + rr * 128 + 8 * k8); }
        __syncthreads();
#pragma unroll 1
        for (int ti = 0; ti < 4; ++ti) { f32x4 acc = {0.f, 0.f, 0.f, 0.f}; acc = mma_tile(Yc, 136, 16 * wave, XL, 136, 16 * ti, 128, acc, lane);
            const int i = 16 * ti + fr, tl = d ? 63 - i : i; v2u w; w.x = pk2(acc[0], acc[1]); w.y = pk2(acc[2], acc[3]);
            *(v2u*)(OD + ((size_t)b * T + 64 * nn + tl) * 512 + h * 128 + 16 * wave + 4 * fq) = w; }
        __syncthreads();
    }
}
__device__ __forceinline__ void p5a_combine(Frame& F) {
    const bf16* OFp = (const bf16*)(F.ws + WS_OF); const bf16* OBp = (const bf16*)(F.ws + WS_OB); const bf16* Z = (const bf16*)(F.ws + WS_Z); bf16* MIX = (bf16*)(F.ws + WS_MIX);
    const int gw = F.vcu * NWAVES + F.wave, NGW = F.G * NWAVES, lane = F.lane;
    float gn[8];
#pragma unroll
    for (int e = 0; e < 8; ++e) gn[e] = F.gdn_norm_g[(lane & 15) * 8 + e];
    for (int mb = gw; mb < M; mb += 2 * NGW) {
        v4u a[2], bq[2], zz[2], cf[2], cbk[2];
#pragma unroll
        for (int u = 0; u < 2; ++u) { const int m = mb + u * NGW, tt = m & (T - 1);
            a[u] = *(const v4u*)(OFp + (size_t)m * 512 + lane * 8); bq[u] = *(const v4u*)(OBp + (size_t)m * 512 + lane * 8); zz[u] = *(const v4u*)(Z + (size_t)m * 512 + lane * 8);
            cf[u] = cbk[u] = (v4u){0u, 0u, 0u, 0u};
            if (tt >= 2048) cf[u] = *(const v4u*)((const bf16*)(F.ws + WS_CORRF) + (size_t)m * 512 + lane * 8);
            if (tt < 6144) cbk[u] = *(const v4u*)((const bf16*)(F.ws + WS_CORRB) + (size_t)m * 512 + lane * 8); }
#pragma unroll
        for (int u = 0; u < 2; ++u) { const int m = mb + u * NGW;
            float o[8]; float ss = 0.f;
#pragma unroll
            for (int e = 0; e < 4; ++e) { o[2 * e] = (bflo(a[u][e]) + bflo(bq[u][e])) + (bflo(cf[u][e]) + bflo(cbk[u][e])); o[2 * e + 1] = (bfhi(a[u][e]) + bfhi(bq[u][e])) + (bfhi(cf[u][e]) + bfhi(cbk[u][e])); ss += o[2 * e] * o[2 * e] + o[2 * e + 1] * o[2 * e + 1]; }
            ss += __shfl_xor(ss, 1); ss += __shfl_xor(ss, 2); ss += __shfl_xor(ss, 4); ss += __shfl_xor(ss, 8);
            const float rstd = 1.0f / sqrtf(ss * (1.0f / 128.0f) + EPS);
            float y[8];
#pragma unroll
            for (int e = 0; e < 4; ++e) { y[2 * e] = o[2 * e] * rstd * gn[2 * e] * silu_r(bflo(zz[u][e])); y[2 * e + 1] = o[2 * e + 1] * rstd * gn[2 * e + 1] * silu_r(bfhi(zz[u][e])); }
            v4u w; w.x = pk2(y[0], y[1]); w.y = pk2(y[2], y[3]); w.z = pk2(y[4], y[5]); w.w = pk2(y[6], y[7]);
            *(v4u*)(MIX + (size_t)m * 1024 + 512 + lane * 8) = w; }
    }
}
__device__ __forceinline__ void p6_phase(Frame& F) {
    const float* MOD = (const float*)(F.ws + WS_MOD); const float* H1 = (const float*)(F.ws + WS_H1); bf16* FIN = (bf16*)(F.ws + WS_FIN);
    float* AFF = (float*)(F.ws + WS_AFF); int* SEL = (int*)(F.ws + WS_SEL);
    LAS float* WR = (LAS float*)F.lds;
    for (int i = F.tid; i < 1024 * 4; i += 512) { const int k = i >> 2, q = i & 3; *(LAS f32x4*)(WR + k * 20 + q * 4) = *(const f32x4*)(F.w_router + k * 16 + q * 4); }
    __syncthreads();
    const int gw = F.vcu * NWAVES + F.wave, NGW = F.G * NWAVES, lane = F.lane;
#pragma unroll 1
    for (int b = 0; b < 2; ++b) {
        const float* mv = MOD + b * 6144;
        float sc[16], sh[16];
#pragma unroll
        for (int j = 0; j < 16; ++j) { const int k = lane + 64 * j; sc[j] = F.norm2_g[k] * (1.0f + mv[4096 + k]); sh[j] = mv[3072 + k]; }
        float vn[16];
        { const float* hr = H1 + (size_t)(b * T + gw) * D;
#pragma unroll
          for (int j = 0; j < 16; ++j) vn[j] = hr[lane + 64 * j]; }
        for (int m = b * T + gw; m < (b + 1) * T; m += NGW) {
            float v[16]; float ss = 0.f;
#pragma unroll
            for (int j = 0; j < 16; ++j) { v[j] = vn[j]; ss += v[j] * v[j]; }
            { const int mn = (m + NGW < (b + 1) * T) ? m + NGW : m; const float* hr = H1 + (size_t)mn * D;
#pragma unroll
              for (int j = 0; j < 16; ++j) vn[j] = hr[lane + 64 * j]; }
            const float rstd = 1.0f / sqrtf(wave_sum(ss) * (1.0f / D) + EPS);
            float lg[16];
#pragma unroll
            for (int e = 0; e < 16; ++e) lg[e] = 0.f;
            bf16* fr_ = FIN + (size_t)m * D;
#pragma unroll
            for (int j = 0; j < 16; ++j) { const float f = v[j] * rstd * sc[j] + sh[j]; fr_[lane + 64 * j] = (bf16)f2bf(f);
                const LAS float* wr = WR + (lane + 64 * j) * 20;
#pragma unroll
                for (int q = 0; q < 4; ++q) { const f32x4 w = *(const LAS f32x4*)(wr + 4 * q); lg[4 * q] += f * w.x; lg[4 * q + 1] += f * w.y; lg[4 * q + 2] += f * w.z; lg[4 * q + 3] += f * w.w; }
                asm volatile("" ::: "memory"); }
            float r8[8], r4[4], r2[2], r1;
#pragma unroll
            for (int e = 0; e < 8; ++e) { const bool hi = lane & 32; const float keep = hi ? lg[e + 8] : lg[e], give = hi ? lg[e] : lg[e + 8]; r8[e] = keep + __shfl_xor(give, 32); }
#pragma unroll
            for (int e = 0; e < 4; ++e) { const bool hi = lane & 16; const float keep = hi ? r8[e + 4] : r8[e], give = hi ? r8[e] : r8[e + 4]; r4[e] = keep + __shfl_xor(give, 16); }
#pragma unroll
            for (int e = 0; e < 2; ++e) { const bool hi = lane & 8; const float keep = hi ? r4[e + 2] : r4[e], give = hi ? r4[e] : r4[e + 2]; r2[e] = keep + __shfl_xor(give, 8); }
            { const bool hi = lane & 4; const float keep = hi ? r2[1] : r2[0], give = hi ? r2[0] : r2[1]; r1 = keep + __shfl_xor(give, 4); }
            r1 += __shfl_xor(r1, 2); r1 += __shfl_xor(r1, 1);
            const int eL = ((lane >> 5) & 1) * 8 + ((lane >> 4) & 1) * 4 + ((lane >> 3) & 1) * 2 + ((lane >> 2) & 1);
            const float lgt = r1 + F.b_router[eL];
            float mx = lgt; mx = fmaxf(mx, __shfl_xor(mx, 4)); mx = fmaxf(mx, __shfl_xor(mx, 8)); mx = fmaxf(mx, __shfl_xor(mx, 16)); mx = fmaxf(mx, __shfl_xor(mx, 32));
            const float ex = expf(lgt - mx); float den = ex; den += __shfl_xor(den, 4); den += __shfl_xor(den, 8); den += __shfl_xor(den, 16); den += __shfl_xor(den, 32);
            if ((lane & 3) == 0) AFF[((size_t)b * 16 + eL) * T + (m - b * T)] = ex / den;
            if (lane < 16) SEL[(size_t)m * 16 + lane] = -1;
        }
    }
}
__device__ __forceinline__ int block_excl_scan(int v, LAS int* tmp, int lane, int wave, int& total) {
    int inc = v;
#pragma unroll
    for (int o = 1; o < 64; o <<= 1) { const int y = __shfl_up(inc, o); if (lane >= o) inc += y; }
    if (lane == 63) tmp[wave] = inc;
    __syncthreads();
    int woff = 0, tot = 0;
#pragma unroll
    for (int w = 0; w < 8; ++w) { const int sv = tmp[w]; woff += (w < wave) ? sv : 0; tot += sv; }
    __syncthreads();
    total = tot; return woff + inc - v;
}
__device__ __forceinline__ void p7_topk(Frame& F) {
    const float* AFF = (const float*)(F.ws + WS_AFF); int* SEL = (int*)(F.ws + WS_SEL); int* IDX = (int*)(F.ws + WS_IDX); float* GATE = (float*)(F.ws + WS_GATE);
    LAS unsigned* vals = (LAS unsigned*)F.lds;
    LAS unsigned* hist = vals + 8192;
    LAS int* tmp = (LAS int*)(hist + 256);
    const int tid = F.tid, lane = F.lane, wave = F.wave;
    for (int u = F.vcu; u < 32; u += F.G) {
        const int b = u >> 4, e = u & 15; const float* ar = AFF + (size_t)u * T;
        for (int t = tid; t < T; t += 512) vals[t] = __builtin_bit_cast(unsigned, ar[t]);
        if (tid == 0) { tmp[8] = 0; tmp[9] = CAP; }
        __syncthreads();
#pragma unroll 1
        for (int pass = 0; pass < 4; ++pass) {
            const int shift = 24 - 8 * pass;
            if (tid < 256) hist[tid] = 0u;
            __syncthreads();
            const unsigned prefix = (unsigned)tmp[8], himask = pass == 0 ? 0u : (0xffffffffu << (shift + 8));
            for (int t = tid; t < T; t += 512) { const unsigned v = vals[t]; if ((v & himask) == prefix) __hip_atomic_fetch_add(hist + ((v >> shift) & 255u), 1u, __ATOMIC_RELAXED, __HIP_MEMORY_SCOPE_WORKGROUP); }
            __syncthreads();
            if (wave == 0) {
                const unsigned kth = (unsigned)tmp[9];
                const unsigned c0 = hist[255 - 4 * lane], c1 = hist[254 - 4 * lane], c2 = hist[253 - 4 * lane], c3 = hist[252 - 4 * lane], sm = c0 + c1 + c2 + c3;
                unsigned inc = sm;
#pragma unroll
                for (int o = 1; o < 64; o <<= 1) { const unsigned y = __shfl_up(inc, o); if (lane >= o) inc += y; }
                const unsigned exc = inc - sm;
                if (exc < kth && kth <= inc) { unsigned r = kth - exc; int bin;
                    if (r <= c0) bin = 255 - 4 * lane; else if (r <= c0 + c1) { bin = 254 - 4 * lane; r -= c0; } else if (r <= c0 + c1 + c2) { bin = 253 - 4 * lane; r -= c0 + c1; } else { bin = 252 - 4 * lane; r -= c0 + c1 + c2; }
                    tmp[8] = (int)(prefix | ((unsigned)bin << shift)); tmp[9] = (int)r; }
            }
            __syncthreads();
        }
        const unsigned thr = (unsigned)tmp[8]; const int kth = tmp[9];
        const int t0 = tid * 16; int cg = 0, ce = 0;
#pragma unroll
        for (int i = 0; i < 16; ++i) { const unsigned v = vals[t0 + i]; cg += (v > thr) ? 1 : 0; ce += (v == thr) ? 1 : 0; }
        int tot; const int eqb = block_excl_scan(ce, tmp, lane, wave, tot);
        int take = kth - eqb; take = take < 0 ? 0 : (take > ce ? ce : take);
        int pos = block_excl_scan(cg + take, tmp, lane, wave, tot); int eqseen = 0;
#pragma unroll 1
        for (int i = 0; i < 16; ++i) { const unsigned v = vals[t0 + i]; bool sel = v > thr; if (v == thr) { sel = eqseen < take; ++eqseen; }
            if (sel) { const int t = t0 + i; IDX[u * CAP + pos] = b * T + t; GATE[u * CAP + pos] = __builtin_bit_cast(float, v); SEL[((size_t)b * T + t) * 16 + e] = pos; ++pos; } }
        __syncthreads();
    }
}
__device__ __forceinline__ void p7b_gather(Frame& F) {
    const int* IDX = (const int*)(F.ws + WS_IDX); const bf16* FIN = (const bf16*)(F.ws + WS_FIN); bf16* XE = (bf16*)(F.ws + WS_XE);
    const int gw = F.vcu * NWAVES + F.wave, NGW = F.G * NWAVES, lane = F.lane;
    for (int r = gw; r < 32 * CAP; r += 2 * NGW) { const int r1 = r + NGW; const int src0 = IDX[r], src1 = IDX[r1];
        const v4u* sp0 = (const v4u*)(FIN + (size_t)src0 * D); const v4u* sp1 = (const v4u*)(FIN + (size_t)src1 * D); v4u* dp0 = (v4u*)(XE + (size_t)r * D); v4u* dp1 = (v4u*)(XE + (size_t)r1 * D);
        const v4u a = sp0[lane], c = sp0[lane + 64], e = sp1[lane], f = sp1[lane + 64]; dp0[lane] = a; dp0[lane + 64] = c; dp1[lane] = e; dp1[lane + 64] = f; }
}
__device__ __forceinline__ void p10_final(Frame& F) {
    const float* MOD = (const float*)(F.ws + WS_MOD); const float* H1 = (const float*)(F.ws + WS_H1); const bf16* YE = (const bf16*)(F.ws + WS_YE); const int* SEL = (const int*)(F.ws + WS_SEL);
    const int gw = F.vcu * NWAVES + F.wave, NGW = F.G * NWAVES, lane = F.lane;
#pragma unroll 1
    for (int b = 0; b < 2; ++b) {
        f32x4 gt[4], fg[4];
#pragma unroll
        for (int j = 0; j < 4; ++j) { gt[j] = *(const f32x4*)(MOD + b * 6144 + 5120 + 4 * lane + 256 * j); fg[j] = *(const f32x4*)(F.final_norm_g + 4 * lane + 256 * j); }
        for (int m0 = b * T + gw; m0 < (b + 1) * T; m0 += 2 * NGW) {
            const int m1 = m0 + NGW;
            const int sel0 = lane < 16 ? SEL[(size_t)m0 * 16 + lane] : -1, sel1 = lane < 16 ? SEL[(size_t)m1 * 16 + lane] : -1;
            f32x4 h0[4], h1v[4], a0[4], a1[4];
#pragma unroll
            for (int j = 0; j < 4; ++j) { h0[j] = *(const f32x4*)(H1 + (size_t)m0 * D + 4 * lane + 256 * j); h1v[j] = *(const f32x4*)(H1 + (size_t)m1 * D + 4 * lane + 256 * j); a0[j] = a1[j] = (f32x4){0.f, 0.f, 0.f, 0.f}; }
#pragma unroll 1
            for (int e = 0; e < 16; ++e) { const int c0_ = __shfl(sel0, e), c1_ = __shfl(sel1, e);
                if (c0_ >= 0 || c1_ >= 0) {
                    const bf16* y0 = YE + ((size_t)(b * 16 + e) * CAP + (c0_ >= 0 ? c0_ : 0)) * D + 4 * lane; const bf16* y1 = YE + ((size_t)(b * 16 + e) * CAP + (c1_ >= 0 ? c1_ : 0)) * D + 4 * lane;
                    v2u w0[4], w1[4];
#pragma unroll
                    for (int j = 0; j < 4; ++j) { w0[j] = *(const v2u*)(y0 + 256 * j); w1[j] = *(const v2u*)(y1 + 256 * j); }
                    const float k0 = c0_ >= 0 ? 1.f : 0.f, k1 = c1_ >= 0 ? 1.f : 0.f;
#pragma unroll
                    for (int j = 0; j < 4; ++j) { a0[j] += k0 * (f32x4){bflo(w0[j].x), bfhi(w0[j].x), bflo(w0[j].y), bfhi(w0[j].y)}; a1[j] += k1 * (f32x4){bflo(w1[j].x), bfhi(w1[j].x), bflo(w1[j].y), bfhi(w1[j].y)}; } } }
            float s0 = 0.f, s1 = 0.f;
#pragma unroll
            for (int j = 0; j < 4; ++j) { h0[j] += gt[j] * a0[j]; h1v[j] += gt[j] * a1[j];
                s0 += (h0[j].x * h0[j].x + h0[j].y * h0[j].y) + (h0[j].z * h0[j].z + h0[j].w * h0[j].w); s1 += (h1v[j].x * h1v[j].x + h1v[j].y * h1v[j].y) + (h1v[j].z * h1v[j].z + h1v[j].w * h1v[j].w); }
            const float r0 = 1.0f / sqrtf(wave_sum(s0) * (1.0f / D) + EPS), r1 = 1.0f / sqrtf(wave_sum(s1) * (1.0f / D) + EPS);
#pragma unroll
            for (int j = 0; j < 4; ++j) { *(f32x4*)(F.out + (size_t)m0 * D + 4 * lane + 256 * j) = h0[j] * r0 * fg[j]; *(f32x4*)(F.out + (size_t)m1 * D + 4 * lane + 256 * j) = h1v[j] * r1 * fg[j]; }
        }
    }
}
struct Args { const float* in[23]; float* out; unsigned char* ws; int ph_lo, ph_hi; };
__global__ void __launch_bounds__(NWAVES * 64, 2) fwd_kernel(Args args) {
    extern __shared__ __attribute__((aligned(16))) unsigned char lds_raw[];
    Frame F;
    F.lds = (LAS unsigned char*)lds_raw;
    volatile LAS unsigned* MISC = (volatile LAS unsigned*)(F.lds + MISC_OFF);
    F.tid = threadIdx.x; F.lane = F.tid & 63; F.wave = __builtin_amdgcn_readfirstlane(F.tid >> 6);
    F.G = gridDim.x; { const int bx = blockIdx.x; F.vcu = (F.G % 8 == 0) ? (bx % 8) * (F.G / 8) + bx / 8 : bx; }
    F.ws = args.ws; F.out = args.out;
    F.x = args.in[0]; F.c = args.in[1]; F.ctx = args.in[2]; F.c_ctx = args.in[3]; F.w_mod = args.in[4]; F.b_mod = args.in[5]; F.norm1_g = args.in[6]; F.norm2_g = args.in[7];
    F.w_in = args.in[8]; F.conv_w = args.in[9]; F.a_log = args.in[10]; F.dt_bias = args.in[11]; F.gdn_norm_g = args.in[12]; F.gm_norm_g = args.in[13]; F.gm_ws = args.in[14]; F.gm_bs = args.in[15];
    F.w_out = args.in[16]; F.w_router = args.in[17]; F.b_router = args.in[18]; F.w_gate = args.in[19]; F.w_up = args.in[20]; F.w_down = args.in[21]; F.final_norm_g = args.in[22];
    for (int u = F.tid; u < 64; u += NWAVES * 64) MISC[u] = 0u;
    __syncthreads();
    XcdBarrier bar; bar.bar = (unsigned*)(F.ws + WS_CTL) + CW_BAR; bar.x = 0; bar.st = nullptr;
    if (!MK_PER_PHASE) bar = xcd_barrier_post((unsigned*)(F.ws + WS_CTL) + CW_BAR, MISC + 8);
    const int lo = args.ph_lo, hi = args.ph_hi;
#define IN(k) (lo <= (k) && (k) < hi)
#define SEAM(k) do { if (IN(k) && IN((k) + 1)) xcd_barrier(bar); } while (0)
    if (IN(0)) { p0_phase(F); } SEAM(0);
    if (IN(1)) { p1_phase(F); } SEAM(1);
    if (IN(2)) {
        pg8::Gemm g{(const bf16*)(F.ws + WS_AIN), (const bf16*)(F.ws + WS_WIN), MA, 3328, D, 0, 0, 0, nullptr}; pg8::StaticOrder S; S.init(MA, 3328, F.G, (int)blockIdx.x);
        pg8::EpiInProj E{(bf16*)(F.ws + WS_QKV), (bf16*)(F.ws + WS_Z), (bf16*)(F.ws + WS_UV), (float*)(F.ws + WS_AB)};
        pg8::gemm_phase<pg8::EpiInProj, pg8::StaticOrder, PG8_ALIGN, PG8_SP2>(F.lds, g, S, E);
    } SEAM(2);
    if (IN(3)) { p3_phase(F); } SEAM(3);
    if (IN(4)) { p4_scan(F); } SEAM(4);
    if (IN(5)) { p4b_correct(F); } SEAM(5);
    if (IN(6)) { p5a_combine(F); wgu_convert(F); } SEAM(6);
    if (IN(7)) {
        pg8::Gemm g{(const bf16*)(F.ws + WS_MIX), (const bf16*)(F.ws + WS_WOUT), M, D, D, 0, 0, 0, nullptr}; pg8::StaticOrder S; S.init(M, D, F.G, (int)blockIdx.x);
        pg8::EpiOutProj E{F.x, (const float*)(F.ws + WS_MOD), (float*)(F.ws + WS_H1)};
        pg8::gemm_phase<pg8::EpiOutProj, pg8::StaticOrder, PG8_ALIGN, PG8_SP2>(F.lds, g, S, E);
    } SEAM(7);
    if (IN(8)) { p6_phase(F); } SEAM(8);
    if (IN(9)) { p7_topk(F); wd_convert(F); } SEAM(9);
    if (IN(10)) {
        pg8::Gemm g{(const bf16*)(F.ws + WS_FIN), (const bf16*)(F.ws + WS_WGU), 32 * CAP, 2 * FF, D, (size_t)2 * FF * D * 2, 2, 15, (const int*)(F.ws + WS_IDX)};     pg8::StaticOrder S; S.init(32 * CAP, 2 * FF, F.G, (int)blockIdx.x);
        pg8::EpiSwiGLU E{(bf16*)(F.ws + WS_HID)};
        pg8::gemm_phase<pg8::EpiSwiGLU, pg8::StaticOrder, PG8_ALIGN, PG8_SP2, true>(F.lds, g, S, E, F.lds + 131072);
    } SEAM(10);
    if (IN(11)) {
        pg8::Gemm g{(const bf16*)(F.ws + WS_HID), (const bf16*)(F.ws + WS_WD), 32 * CAP, D, FF, (size_t)D * FF * 2, 2, 15, nullptr}; pg8::StaticOrder S; S.init(32 * CAP, D, F.G, (int)blockIdx.x);
        pg8::EpiDown E{(bf16*)(F.ws + WS_YE), (const float*)(F.ws + WS_GATE)};
        pg8::gemm_phase<pg8::EpiDown, pg8::StaticOrder, PG8_ALIGN, PG8_SP2>(F.lds, g, S, E);
    } SEAM(11);
    if (IN(12)) { p10_final(F); }
#undef IN
#undef SEAM
}

extern "C" void kernel_launch(void* const* d_in, const int* in_sizes, int n_in, void* d_out, int out_size, void* d_ws, size_t ws_size, hipStream_t stream) {
    static int grid = 0;
    if (grid == 0) {
        if (n_in != 23 || out_size != M * D || ws_size < WS_END) { fprintf(stderr, "kernel_launch: unexpected problem (n_in %d, out %d, ws %zu)\n", n_in, out_size, ws_size); grid = -1; return; }
        int dev = 0, cus = 0;
        if (hipGetDevice(&dev) != hipSuccess || hipDeviceGetAttribute(&cus, hipDeviceAttributeMultiprocessorCount, dev) != hipSuccess) { grid = -1; return; }
        if (hipFuncSetAttribute((const void*)fwd_kernel, hipFuncAttributeMaxDynamicSharedMemorySize, LDS_BYTES) != hipSuccess) { fprintf(stderr, "kernel_launch: hipFuncSetAttribute failed\n"); grid = -1; return; }
        grid = cus;
    }
    if (grid < 0) return;
    if (hipMemsetAsync((char*)d_ws + WS_CTL, 0, CTL_ZERO_BYTES, stream) != hipSuccess) return;
    Args a{};
    for (int i = 0; i < 23; ++i) a.in[i] = (const float*)d_in[i];
    a.out = (float*)d_out; a.ws = (unsigned char*)d_ws;
#if MK_PER_PHASE
    for (int p = 0; p < NPHASE; ++p) { a.ph_lo = p; a.ph_hi = p + 1; hipLaunchKernelGGL(fwd_kernel, dim3(grid), dim3(NWAVES * 64), LDS_BYTES, stream, a); }
#else
    a.ph_lo = 0; a.ph_hi = NPHASE;
    hipLaunchKernelGGL(fwd_kernel, dim3(grid), dim3(NWAVES * 64), LDS_BYTES, stream, a);
#endif
}
```

```cpp
#include <hip/hip_runtime.h>
#include <cstdio>
#include <cstdint>
namespace pg8 {
#define PG8_LAS __attribute__((address_space(3)))
typedef unsigned short bf16_t;
typedef short bf16x8 __attribute__((ext_vector_type(8)));
typedef float f32x4 __attribute__((ext_vector_type(4)));
typedef unsigned u32x4 __attribute__((ext_vector_type(4)));
constexpr int BM = 256, BK = 64, HALF = 128, HTB = HALF * BK * 2  , STAGE_BYTES = 8 * HTB, NXCD = 8, WGM = 8;

__host__ __device__ __forceinline__ int lds_byte(int r, int c) { const int st = (r >> 4) * 2 + (c >> 5), rr = r & 15, cc = c & 31, ob = rr * 64 + cc * 2; return st * 1024 + (ob ^ (((ob >> 9) & 1) << 5)); }
__host__ __device__ __forceinline__ void stage_rc(int b, int& R, int& C) { const int st = b / 1024, sb = b % 1024, swz = sb ^ (((sb >> 9) & 1) << 5); R = (st >> 1) * 16 + swz / 64; C = (st & 1) * 32 + (swz % 64) / 2; }
__host__ __device__ __forceinline__ int perm32(int rho) { const int n = rho >> 4, i = rho & 15; return 8 * (i >> 2) + 4 * n + (i & 3); }

struct Unit { int pm, pn; };
struct Gemm { const bf16_t* A; const bf16_t* Bt; int M, N, K; size_t bgs; int gsh, gmask; const int* gidx; };

struct StaticOrder {
    int nM, nN, nwg, G, c;
    __host__ __device__ void init(int M, int N, int G_, int c_) { nM = M / BM; nN = N / BM; nwg = nM * nN; G = G_; c = c_; }
    __host__ __device__ bool next(int i, Unit& u) const {
        const long L = (long)i * G + c; if (L >= nwg) return false;
        int wgid = (int)L; { const int q = nwg / NXCD, r = nwg % NXCD, xcd = wgid % NXCD, off = wgid / NXCD; wgid = (xcd < r ? xcd * (q + 1) : r * (q + 1) + (xcd - r) * q) + off; }
        const int nig = WGM * nN, gid = wgid / nig, fm = gid * WGM, gsz = (nM - fm) < WGM ? (nM - fm) : WGM;
        u.pm = fm + ((wgid % nig) % gsz); u.pn = (wgid % nig) / gsz; return true;
    }
    __device__ __forceinline__ void a_ready(const Unit&) const {}
    __device__ __forceinline__ void done(const Unit&) const {}
};

__device__ __forceinline__ unsigned cvt_pk_bf16(float lo, float hi) { unsigned r; asm volatile("v_cvt_pk_bf16_f32 %0, %1, %2" : "=v"(r) : "v"(lo), "v"(hi)); return r; }
typedef float f32x2 __attribute__((ext_vector_type(2)));
__device__ __forceinline__ f32x2 gelu_pk(f32x2 v) {
    const f32x2 av = __builtin_elementwise_abs(v), d = av * 0.2316418882f + 1.0f;
    f32x2 t; t.x = __builtin_amdgcn_rcpf(d.x); t.y = __builtin_amdgcn_rcpf(d.y);
    f32x2 q = t * 0.5307027145f + (-0.7265760135f); q = q * t + 0.7107068705f; q = q * t + (-0.142248368f); q = q * t + 0.127414796f; q = q * t;
    const f32x2 s = (v * v) * (-0.72134752044f);
    f32x2 e; e.x = __builtin_amdgcn_exp2f(s.x); e.y = __builtin_amdgcn_exp2f(s.y);
    const f32x2 m = v * (q * e), r = v - m;
    f32x2 o; o.x = v.x < 0.f ? m.x : r.x; o.y = v.y < 0.f ? m.y : r.y; return o;
}
__device__ __forceinline__ float silu_f(float x) { return x * __builtin_amdgcn_rcpf(1.0f + __expf(-x)); }
__device__ __forceinline__ void st8(bf16_t* p, const f32x4 v0, const f32x4 v1) { u32x4 w; w.x = cvt_pk_bf16(v0[0], v0[1]); w.y = cvt_pk_bf16(v0[2], v0[3]); w.z = cvt_pk_bf16(v1[0], v1[1]); w.w = cvt_pk_bf16(v1[2], v1[3]); *(u32x4*)p = w; }
struct EpiInProj {
    static constexpr bool PERM = true, AFTER_DRAIN = false;
    bf16_t* QKV; bf16_t* Z; bf16_t* UV; float* AB;
    __device__ __forceinline__ void operator()(const f32x4 (&acc)[2][2][4][2], const Unit& u, int wr, int wc, int fr, int fq) const {
        const int row0 = u.pm * BM + wr * 64 + fr, pn = u.pn;
        if (pn == 12) {
            if (wc == 0 && fq < 2) {
#pragma unroll
                for (int ai = 0; ai < 2; ++ai)
#pragma unroll
                    for (int m = 0; m < 4; ++m) { float* p = AB + (size_t)(row0 + ai * HALF + m * 16) * 16 + 8 * fq; *(f32x4*)p = acc[ai][0][m][0]; *(f32x4*)(p + 4) = acc[ai][0][m][1]; }
            }
            return;
        }
        bf16_t* base; int ldc, colt; bool act = false;
        if (pn < 6) { base = QKV; ldc = 1536; colt = pn * 256; }
        else { if (u.pm >= 64) return; if (pn < 8) { base = Z; ldc = 512; colt = (pn - 6) * 256; } else { base = UV; ldc = 1024; colt = (pn - 8) * 256; act = true; } }
        const int col0 = colt + wc * 32 + 8 * fq;
#pragma unroll
        for (int ai = 0; ai < 2; ++ai)
#pragma unroll
            for (int m = 0; m < 4; ++m) { bf16_t* rowp = base + (size_t)(row0 + ai * HALF + m * 16) * ldc + col0;
#pragma unroll
                for (int bj = 0; bj < 2; ++bj) { f32x4 v0 = acc[ai][bj][m][0], v1 = acc[ai][bj][m][1];
                    if (act) { f32x2 a = gelu_pk((f32x2){v0[0], v0[1]}), b = gelu_pk((f32x2){v0[2], v0[3]}), c = gelu_pk((f32x2){v1[0], v1[1]}), d = gelu_pk((f32x2){v1[2], v1[3]});
                        v0 = (f32x4){a.x, a.y, b.x, b.y}; v1 = (f32x4){c.x, c.y, d.x, d.y}; }
                    st8(rowp + bj * HALF, v0, v1); } }
    }
};
struct EpiOutProj {
    static constexpr bool PERM = false, AFTER_DRAIN = false;
    const float* x; const float* mod; float* H1;
    __device__ __forceinline__ void operator()(const f32x4 (&acc)[2][2][4][2], const Unit& u, int wr, int wc, int fr, int fq) const {
        const int row0 = u.pm * BM + wr * 64 + fr, col0 = u.pn * BM + wc * 32 + 4 * fq; const float* gt = mod + (u.pm >= 32 ? 6144 : 0) + 2048;
        f32x4 gv[2][2];
#pragma unroll
        for (int bj = 0; bj < 2; ++bj)
#pragma unroll
            for (int n = 0; n < 2; ++n) gv[bj][n] = *(const f32x4*)(gt + col0 + bj * HALF + n * 16);
#pragma unroll
        for (int ai = 0; ai < 2; ++ai)
#pragma unroll
            for (int m = 0; m < 4; ++m) { const size_t off = (size_t)(row0 + ai * HALF + m * 16) * 1024 + col0;
#pragma unroll
                for (int bj = 0; bj < 2; ++bj)
#pragma unroll
                    for (int n = 0; n < 2; ++n) { const f32x4 xv = *(const f32x4*)(x + off + bj * HALF + n * 16); *(f32x4*)(H1 + off + bj * HALF + n * 16) = xv + gv[bj][n] * acc[ai][bj][m][n]; } }
    }
};
struct EpiSwiGLU {
    static constexpr bool PERM = true, AFTER_DRAIN = false;
    bf16_t* HID;
    __device__ __forceinline__ void operator()(const f32x4 (&acc)[2][2][4][2], const Unit& u, int wr, int wc, int fr, int fq) const {
        const int row0 = u.pm * BM + wr * 64 + fr, col0 = u.pn * HALF + wc * 32 + 8 * fq;
#pragma unroll
        for (int ai = 0; ai < 2; ++ai)
#pragma unroll
            for (int m = 0; m < 4; ++m) { bf16_t* rowp = HID + (size_t)(row0 + ai * HALF + m * 16) * 1024 + col0; f32x4 h0, h1;
#pragma unroll
                for (int j = 0; j < 4; ++j) { h0[j] = silu_f(acc[ai][0][m][0][j]) * acc[ai][1][m][0][j]; h1[j] = silu_f(acc[ai][0][m][1][j]) * acc[ai][1][m][1][j]; }
                st8(rowp, h0, h1); }
    }
};
struct EpiDown {
    static constexpr bool PERM = true, AFTER_DRAIN = false;
    bf16_t* YE; const float* gate;
    __device__ __forceinline__ void operator()(const f32x4 (&acc)[2][2][4][2], const Unit& u, int wr, int wc, int fr, int fq) const {
        const int row0 = u.pm * BM + wr * 64 + fr, col0 = u.pn * BM + wc * 32 + 8 * fq;
#pragma unroll
        for (int ai = 0; ai < 2; ++ai)
#pragma unroll
            for (int m = 0; m < 4; ++m) { const int row = row0 + ai * HALF + m * 16; const float gv = gate[row]; bf16_t* rowp = YE + (size_t)row * 1024 + col0;
#pragma unroll
                for (int bj = 0; bj < 2; ++bj) st8(rowp + bj * HALF, acc[ai][bj][m][0] * gv, acc[ai][bj][m][1] * gv); }
    }
};
template <class Epi, class Sched, bool ALIGN_EPI = false, bool SP2 = false, bool GATHER = false>
__device__ __forceinline__ void gemm_phase(PG8_LAS unsigned char* lds, const Gemm g, const Sched& S, const Epi& E, PG8_LAS unsigned char* idx_lds = nullptr) {
    static_assert(!GATHER || SP2, "the gathered-A form exists only for the SP2 loop");
    const int tid = threadIdx.x, wid = __builtin_amdgcn_readfirstlane(tid >> 6), lane = tid & 63, wr = wid >> 2, wc = wid & 3, fr = lane & 15, fq = lane >> 4;
    const int K = g.K, nt = K / BK;
    unsigned voffA[2], voffB[2], colA2[2]; int rowA[2];
#pragma unroll
    for (int i = 0; i < 2; ++i) { int R, C; stage_rc(tid * 16 + i * 8192, R, C); const int Rb = Epi::PERM ? ((R & ~31) + perm32(R & 31)) : R;
        voffA[i] = (unsigned)(R * K + C) * 2u; voffB[i] = (unsigned)(Rb * K + C) * 2u; rowA[i] = R; colA2[i] = (unsigned)C * 2u; }
    unsigned gc[2][2] = {{0u, 0u}, {0u, 0u}}, gn[2][2] = {{0u, 0u}, {0u, 0u}};
    const size_t kstep = (size_t)(BK * 2);
    const size_t hstep = (size_t)HALF * K * 2;
    const size_t tstep = 2 * hstep;
    const unsigned ldsw = (unsigned)wid * 1024u;
    const int aoff = lds_byte(wr * 64 + fr, fq * 8), boff = lds_byte(wc * 32 + fr, fq * 8);
#define PG8_SA(b, h) (((b) * 2 + (h)) * HTB)
#define PG8_SB(b, h) ((4 + (b) * 2 + (h)) * HTB)
#define PG8_STAGE(bufoff, gbase, voff) do { _Pragma("unroll") for (int _i = 0; _i < 2; ++_i) \
        __builtin_amdgcn_global_load_lds((const unsigned*)((const char*)(gbase) + (voff)[_i]), (PG8_LAS unsigned*)(lds + (bufoff) + ldsw + _i * 8192), 16, 0, 0); } while (0)
#define PG8_STAGE_A(bufoff, ptr, hh, offs) do { if constexpr (GATHER) { PG8_STAGE(bufoff, ptr, offs[hh]); } else { PG8_STAGE(bufoff, (ptr) + (hh) * hstep, voffA); } } while (0)
#define PG8_GOFFS(dst, bufi) do { _Pragma("unroll") for (int h_ = 0; h_ < 2; ++h_) _Pragma("unroll") for (int i_ = 0; i_ < 2; ++i_) \
        dst[h_][i_] = (unsigned)(((const PG8_LAS int*)(idx_lds + (bufi) * 1024))[h_ * HALF + rowA[i_]]) * (unsigned)(K * 2) + colA2[i_]; } while (0)
#define PG8_IDX_ISSUE(unit, bufi) do { if (wid == 0) __builtin_amdgcn_global_load_lds((const unsigned*)(g.gidx + (size_t)(unit).pm * BM + lane * 4), (PG8_LAS unsigned*)(idx_lds + (bufi) * 1024), 16, 0, 0); } while (0)
#define PG8_LDA(dst, b, h) do { _Pragma("unroll") for (int m = 0; m < 4; ++m) _Pragma("unroll") for (int k = 0; k < 2; ++k) dst[m][k] = *(const PG8_LAS bf16x8*)(lds + PG8_SA(b, h) + aoff + m * 2048 + k * 1024); } while (0)
#define PG8_LDB(dst, b, h) do { _Pragma("unroll") for (int n = 0; n < 2; ++n) _Pragma("unroll") for (int k = 0; k < 2; ++k) dst[n][k] = *(const PG8_LAS bf16x8*)(lds + PG8_SB(b, h) + boff + n * 2048 + k * 1024); } while (0)
#define PG8_MMA(ai, bj, At, Bt) do { __builtin_amdgcn_s_setprio(1); _Pragma("unroll") for (int m = 0; m < 4; ++m) _Pragma("unroll") for (int n = 0; n < 2; ++n) _Pragma("unroll") for (int k = 0; k < 2; ++k) \
        acc[ai][bj][m][n] = __builtin_amdgcn_mfma_f32_16x16x32_bf16(Bt[n][k], At[m][k], acc[ai][bj][m][n], 0, 0, 0); __builtin_amdgcn_s_setprio(0); } while (0)
#define PG8_WAIT_V(n) asm volatile("s_waitcnt vmcnt(" #n ")" ::: "memory")
#define PG8_WAIT_L(n) asm volatile("s_waitcnt lgkmcnt(" #n ")" ::: "memory")
#define PG8_BAR __builtin_amdgcn_s_barrier()
#define PG8_SCHED __builtin_amdgcn_sched_barrier(0)
    Unit cur, nxt; int ui = 0;
    if (!S.next(0, cur)) return;
    f32x4 acc[2][2][4][2];
#pragma unroll
    for (int a = 0; a < 2; ++a)
#pragma unroll
        for (int b = 0; b < 2; ++b)
#pragma unroll
            for (int m = 0; m < 4; ++m)
#pragma unroll
                for (int n = 0; n < 2; ++n) acc[a][b][m][n] = (f32x4){0.f, 0.f, 0.f, 0.f};
    bf16x8 At[4][2], B0[2][2], B1[2][2];
    const char* cA = (const char*)g.A + (size_t)cur.pm * tstep; const char* cB = (const char*)g.Bt + (size_t)((cur.pm >> g.gsh) & g.gmask) * g.bgs + (size_t)cur.pn * tstep;
    if constexpr (GATHER) { cA = (const char*)g.A;
        PG8_IDX_ISSUE(cur, 0); asm volatile("s_waitcnt vmcnt(0)" ::: "memory"); PG8_BAR; PG8_GOFFS(gc, 0); asm volatile("s_waitcnt lgkmcnt(0)" ::: "memory"); }
    S.a_ready(cur);
    if constexpr (SP2) {
        PG8_STAGE(PG8_SB(0, 0), cB, voffB); PG8_STAGE(PG8_SB(0, 1), cB + hstep, voffB); PG8_STAGE_A(PG8_SA(0, 0), cA, 0, gc); PG8_STAGE_A(PG8_SA(0, 1), cA, 1, gc);
        if (wr == 1) PG8_BAR;
        PG8_WAIT_V(2); PG8_BAR;
        PG8_STAGE(PG8_SB(1, 0), cB + kstep, voffB); PG8_STAGE_A(PG8_SA(1, 0), cA + kstep, 0, gc); PG8_STAGE(PG8_SB(1, 1), cB + hstep + kstep, voffB);
        PG8_WAIT_V(6); PG8_BAR;
    } else {
        PG8_STAGE(PG8_SB(0, 0), cB, voffB); PG8_STAGE(PG8_SA(0, 0), cA, voffA); PG8_STAGE(PG8_SB(0, 1), cB + hstep, voffB); PG8_STAGE(PG8_SA(0, 1), cA + hstep, voffA);
        if (wr == 1) PG8_BAR;
        PG8_WAIT_V(4); PG8_BAR;
        PG8_STAGE(PG8_SB(1, 0), cB + kstep, voffB); PG8_STAGE(PG8_SA(1, 0), cA + kstep, voffA); PG8_STAGE(PG8_SB(1, 1), cB + hstep + kstep, voffB);
        PG8_WAIT_V(6); PG8_BAR;
    }
    for (;;) {
        const bool has_next = S.next(ui + 1, nxt);
        const char* nA = GATHER ? (const char*)g.A : (has_next ? (const char*)g.A + (size_t)nxt.pm * tstep : cA);
        if constexpr (GATHER) { if (has_next) PG8_IDX_ISSUE(nxt, (ui + 1) & 1); }
        const char* nB = has_next ? (const char*)g.Bt + (size_t)((nxt.pm >> g.gsh) & g.gmask) * g.bgs + (size_t)nxt.pn * tstep : cB;
        for (int t = 0; t < nt; t += 2) {
            const bool last = (t == nt - 2);
            const char* a1 = cA + (size_t)(t + 1) * kstep;
            const char* a2 = last ? nA : cA + (size_t)(t + 2) * kstep; const char* b2 = last ? nB : cB + (size_t)(t + 2) * kstep;
            const char* a3 = a2 + kstep; const char* b3 = b2 + kstep;
            if (last && has_next) S.a_ready(nxt);
            unsigned g2[2][2] = {{gc[0][0], gc[0][1]}, {gc[1][0], gc[1][1]}};
            if constexpr (GATHER) { if (last && has_next) { PG8_GOFFS(gn, (ui + 1) & 1); g2[0][0] = gn[0][0]; g2[0][1] = gn[0][1]; g2[1][0] = gn[1][0]; g2[1][1] = gn[1][1]; } }
            if constexpr (SP2) {
            PG8_LDB(B0, 0, 0); PG8_LDB(B1, 0, 1); PG8_SCHED; PG8_LDA(At, 0, 0); PG8_STAGE_A(PG8_SA(1, 1), a1, 1, gc);
            PG8_WAIT_V(8); PG8_WAIT_L(0); PG8_BAR; PG8_MMA(0, 0, At, B0); PG8_MMA(0, 1, At, B1); PG8_BAR; PG8_SCHED;
            PG8_LDA(At, 0, 1); PG8_STAGE(PG8_SB(0, 0), b2, voffB); PG8_STAGE(PG8_SB(0, 1), b2 + hstep, voffB); PG8_STAGE_A(PG8_SA(0, 0), a2, 0, g2);
            PG8_WAIT_V(8); PG8_WAIT_L(0); PG8_BAR; PG8_MMA(1, 0, At, B0); PG8_MMA(1, 1, At, B1); PG8_BAR; PG8_SCHED;
            PG8_LDB(B0, 1, 0); PG8_LDB(B1, 1, 1); PG8_SCHED; PG8_LDA(At, 1, 0); PG8_STAGE_A(PG8_SA(0, 1), a2, 1, g2);
            PG8_WAIT_V(8); PG8_WAIT_L(0); PG8_BAR; PG8_MMA(0, 0, At, B0); PG8_MMA(0, 1, At, B1); PG8_BAR; PG8_SCHED;
            PG8_LDA(At, 1, 1); PG8_STAGE(PG8_SB(1, 0), b3, voffB); PG8_STAGE(PG8_SB(1, 1), b3 + hstep, voffB); PG8_STAGE_A(PG8_SA(1, 0), a3, 0, g2);
            PG8_WAIT_V(8); PG8_WAIT_L(0); PG8_BAR; PG8_MMA(1, 0, At, B0); PG8_MMA(1, 1, At, B1); PG8_BAR; PG8_SCHED;
            } else {
            PG8_LDB(B0, 0, 0); PG8_SCHED; PG8_LDA(At, 0, 0); PG8_STAGE(PG8_SA(1, 1), a1 + hstep, voffA);
            PG8_WAIT_L(8); PG8_BAR; PG8_WAIT_L(0); PG8_MMA(0, 0, At, B0); PG8_BAR; PG8_SCHED;
            PG8_LDB(B1, 0, 1); PG8_STAGE(PG8_SB(0, 0), b2, voffB);
            PG8_BAR; PG8_WAIT_L(0); PG8_MMA(0, 1, At, B1); PG8_BAR;
            PG8_LDA(At, 0, 1); PG8_STAGE(PG8_SA(0, 0), a2, voffA);
            PG8_BAR; PG8_WAIT_L(0); PG8_MMA(1, 0, At, B0); PG8_BAR; PG8_SCHED;
            PG8_STAGE(PG8_SB(0, 1), b2 + hstep, voffB);
            PG8_WAIT_V(6); PG8_BAR; PG8_MMA(1, 1, At, B1); PG8_BAR;
            PG8_LDB(B0, 1, 0); PG8_SCHED; PG8_LDA(At, 1, 0); PG8_STAGE(PG8_SA(0, 1), a2 + hstep, voffA);
            PG8_WAIT_L(8); PG8_BAR; PG8_WAIT_L(0); PG8_MMA(0, 0, At, B0); PG8_BAR; PG8_SCHED;
            PG8_LDB(B1, 1, 1); PG8_STAGE(PG8_SB(1, 0), b3, voffB);
            PG8_BAR; PG8_WAIT_L(0); PG8_MMA(0, 1, At, B1); PG8_BAR;
            PG8_LDA(At, 1, 1); PG8_STAGE(PG8_SA(1, 0), a3, voffA);
            PG8_BAR; PG8_WAIT_L(0); PG8_MMA(1, 0, At, B0); PG8_BAR; PG8_SCHED;
            PG8_STAGE(PG8_SB(1, 1), b3 + hstep, voffB);
            PG8_WAIT_V(6); PG8_BAR; PG8_MMA(1, 1, At, B1); PG8_BAR;
            }
        }
        if constexpr (ALIGN_EPI) { if (wr == 0) PG8_BAR; }
        if constexpr (!Epi::AFTER_DRAIN) { E(acc, cur, wr, wc, fr, fq); S.done(cur); }
        if (!has_next) break;
#pragma unroll
        for (int a = 0; a < 2; ++a)
#pragma unroll
            for (int b = 0; b < 2; ++b)
#pragma unroll
                for (int m = 0; m < 4; ++m)
#pragma unroll
                    for (int n = 0; n < 2; ++n) acc[a][b][m][n] = (f32x4){0.f, 0.f, 0.f, 0.f};
        cur = nxt; cA = nA; cB = nB; ++ui;
        if constexpr (GATHER) { gc[0][0] = gn[0][0]; gc[0][1] = gn[0][1]; gc[1][0] = gn[1][0]; gc[1][1] = gn[1][1]; }
        if constexpr (ALIGN_EPI) { if (wr == 1) PG8_BAR; }
    }
    PG8_WAIT_V(0);
    if constexpr (!ALIGN_EPI) { if (wr == 0) PG8_BAR; }
    PG8_BAR;
    if constexpr (Epi::AFTER_DRAIN) { E.fused(acc, cur, wr, wc, fr, fq, lds, wid, lane); S.done(cur); }
#undef PG8_SA
#undef PG8_SB
#undef PG8_STAGE
#undef PG8_LDA
#undef PG8_STAGE_A
#undef PG8_GOFFS
#undef PG8_IDX_ISSUE
#undef PG8_LDB
#undef PG8_MMA
#undef PG8_WAIT_V
#undef PG8_WAIT_L
#undef PG8_BAR
#undef PG8_SCHED
}
}
#ifndef PG8_SP2
#define PG8_SP2 true
#endif
#ifndef PG8_ALIGN
#define PG8_ALIGN true
#endif
constexpr int NWAVES = 8;
#ifndef MK_PER_PHASE
#define MK_PER_PHASE 0
#endif
constexpr int NPHASE = 13;
constexpr int BATCH = 2, T = 8192, D = 1024, TC = 256, M = BATCH * T, MC = BATCH * TC, MA = M + MC;
constexpr int NEXP = 16, CAP = 1024, FF = 1024;
constexpr float EPS = 1e-6f;
constexpr size_t MiB = 1u << 20;
constexpr size_t WS_CTL = 0, CTL_ZERO_BYTES = 32768;
constexpr size_t WS_MOD = 1 * MiB;
constexpr size_t WS_EGL = 1 * MiB + 128 * 1024;
constexpr size_t WS_IDX = 1 * MiB + 512 * 1024;
constexpr size_t WS_GATE = WS_IDX + 128 * 1024;
constexpr size_t WS_AFF = 2 * MiB;
constexpr size_t WS_SEL = 3 * MiB;
constexpr size_t WS_WIN = 4 * MiB;
constexpr size_t WS_WOUT = 11 * MiB;
constexpr size_t WS_AIN = 13 * MiB;
constexpr size_t WS_MIX = 13 * MiB;
constexpr size_t WS_FIN = 13 * MiB;
constexpr size_t WS_QKV = 46 * MiB;
constexpr size_t WS_OF = 46 * MiB, WS_OB = 62 * MiB;
constexpr size_t WS_Z = 96 * MiB;
constexpr size_t WS_UV = 112 * MiB;
constexpr size_t WS_AB = 144 * MiB;
constexpr size_t WS_GDN = 146 * MiB;
constexpr size_t GDN_UNIT = 73728;
constexpr size_t WS_WGU = 142 * MiB;
constexpr size_t WS_H1 = 232 * MiB;
constexpr size_t WS_XE = 68 * MiB;
constexpr size_t WS_HID = 78 * MiB;
constexpr size_t WS_WD = 46 * MiB;
constexpr size_t WS_YE = 142 * MiB;
constexpr size_t WS_END = 296 * MiB;
static_assert(WS_GDN + 2112 * GDN_UNIT <= WS_END && WS_AB + (size_t)MA * 64 <= WS_GDN && WS_QKV + (size_t)MA * 3072 <= WS_Z, "ws map");
constexpr int CW_BAR = 4096;
constexpr int LDS_BYTES = 163840;
constexpr int MISC_OFF = LDS_BYTES - 256;
#define LAS __attribute__((address_space(3)))
#define GAS __attribute__((address_space(1)))
typedef unsigned short bf16;
typedef unsigned v4u __attribute__((ext_vector_type(4)));
typedef unsigned v2u __attribute__((ext_vector_type(2)));
typedef float f32x4 __attribute__((ext_vector_type(4)));
typedef short bf16x8 __attribute__((ext_vector_type(8)));
#define LDS_WAIT() asm volatile("s_waitcnt lgkmcnt(0)" ::: "memory")
#define VM_WAIT() asm volatile("s_waitcnt vmcnt(0)" ::: "memory")
__device__ __forceinline__ unsigned f2bf(float f) { unsigned u = __builtin_bit_cast(unsigned, f); return (u + 0x7fffu + ((u >> 16) & 1u)) >> 16; }
__device__ __forceinline__ unsigned pk2(float lo, float hi) { return f2bf(lo) | (f2bf(hi) << 16); }
__device__ __forceinline__ float bflo(unsigned w) { return __builtin_bit_cast(float, w << 16); }
__device__ __forceinline__ float bfhi(unsigned w) { return __builtin_bit_cast(float, w & 0xffff0000u); }
__device__ __forceinline__ float bf1(bf16 h) { return __builtin_bit_cast(float, (unsigned)h << 16); }
__device__ __forceinline__ float wave_sum(float v) {
#pragma unroll
    for (int o = 1; o < 64; o <<= 1) v += __shfl_xor(v, o);
    return v;
}
__device__ __forceinline__ float fnma1(float a, float b, float c) { float r; asm("v_fma_f32 %0, -%1, %2, %3" : "=v"(r) : "v"(a), "v"(b), "v"(c)); return r; }
__device__ __forceinline__ float silu_r(float x) { return x * __builtin_amdgcn_rcpf(1.0f + __expf(-x)); }
__device__ __forceinline__ float silu1(float x) { return x / (1.0f + __expf(-x)); }

#define XB_TMO      128
#define XB_XCNT(j)  (256  + 64 * (j))
#define XB_XSUB(j)  (1280 + 64 * (j))
#define XB_XGEN(j)  (2304 + 64 * (j))
#define XB_TOP      3328
#define XB_TOPGEN   3392
#define XCD_BAR_WORDS 3456
#define XB_SPIN_CAP (1u << 18)
__device__ __forceinline__ unsigned xb_ld(unsigned* p)              { return __hip_atomic_load(p, __ATOMIC_RELAXED, __HIP_MEMORY_SCOPE_AGENT); }
__device__ __forceinline__ unsigned xb_add(unsigned* p, unsigned v) { return __hip_atomic_fetch_add(p, v, __ATOMIC_RELAXED, __HIP_MEMORY_SCOPE_AGENT); }
__device__ __forceinline__ unsigned xb_xcc_id() { return (unsigned)__builtin_amdgcn_s_getreg((3 << 11) | 20) & 0xFu; }
#define XB_SPIN(cond, bar) do { unsigned _sp = 0; while (cond) { __builtin_amdgcn_s_sleep(1); \
    if ((++_sp & 255u) == 0u) { if (xb_ld(&(bar)[XB_TMO])) break; if (_sp > XB_SPIN_CAP) { atomicAdd(&(bar)[XB_TMO], 1u); break; } } } } while (0)
struct XcdBarrier { unsigned* bar; unsigned x; volatile LAS unsigned* st; };
__device__ __forceinline__ XcdBarrier xcd_barrier_post(unsigned* bar, volatile LAS unsigned* st) {
    XcdBarrier b; b.bar = bar; b.x = xb_xcc_id(); b.st = st;
    if (threadIdx.x == 0) (void)xb_add(&bar[XB_XCNT(b.x)], 1u);
    return b;
}
__device__ __forceinline__ void xcd_barrier_complete(unsigned* bar, unsigned x, unsigned& nloc, unsigned& nx) {
    const unsigned G = gridDim.x * gridDim.y * gridDim.z;
    unsigned sum, cnt, mine, sp = 0u;
    for (;;) {
        sum = 0u; cnt = 0u; mine = 0u;
#pragma unroll
        for (unsigned j = 0; j < 16; ++j) { const unsigned c = xb_ld(&bar[XB_XCNT(j)]); sum += c; cnt += (c > 0u) ? 1u : 0u; mine = (j == x) ? c : mine; }
        if (sum == G) break;
        __builtin_amdgcn_s_sleep(1);
        if ((++sp & 255u) == 0u) { if (xb_ld(&bar[XB_TMO])) break; if (sp > XB_SPIN_CAP) { atomicAdd(&bar[XB_TMO], 1u); break; } }
    }
    nloc = mine > 0u ? mine : 1u; nx = cnt > 0u ? cnt : 1u;
}
__device__ __forceinline__ void xcd_barrier(const XcdBarrier& b) {
    asm volatile("s_waitcnt vmcnt(0)" ::: "memory");
    __syncthreads();
    if (threadIdx.x == 0) {
        unsigned* bar = b.bar;
        __builtin_amdgcn_s_waitcnt(0);
        unsigned nloc = b.st[0], nx = b.st[1];
        if (nloc == 0u) { xcd_barrier_complete(bar, b.x, nloc, nx); b.st[0] = nloc; b.st[1] = nx; }
        const unsigned old = xb_add(&bar[XB_XSUB(b.x)], 1u);
        const unsigned gen = old / nloc;
        if (old + 1u == (gen + 1u) * nloc) {
            __builtin_amdgcn_fence(__ATOMIC_RELEASE, "agent");
            asm volatile("s_waitcnt vmcnt(0)" ::: "memory");
            const unsigned og = xb_add(&bar[XB_TOP], 1u);
            const unsigned tg = og / nx;
            if (og + 1u == (tg + 1u) * nx) xb_add(&bar[XB_TOPGEN], 1u);
            else XB_SPIN(xb_ld(&bar[XB_TOPGEN]) == tg, bar);
            __builtin_amdgcn_fence(__ATOMIC_ACQUIRE, "agent");
            xb_add(&bar[XB_XGEN(b.x)], 1u);
            asm volatile("s_waitcnt vmcnt(0)" ::: "memory");
        } else {
            XB_SPIN(xb_ld(&bar[XB_XGEN(b.x)]) == gen, bar);
            __builtin_amdgcn_fence(__ATOMIC_ACQUIRE, "agent");
            asm volatile("s_waitcnt vmcnt(0)" ::: "memory");
        }
    }
    __syncthreads();
}

struct Frame {
    LAS unsigned char* lds;
    int tid, lane, wave, vcu, G;
    unsigned char* ws;
    const float *x, *c, *ctx, *c_ctx, *w_mod, *b_mod, *norm1_g, *norm2_g, *w_in, *conv_w, *a_log, *dt_bias, *gdn_norm_g, *gm_norm_g, *gm_ws, *gm_bs, *w_out, *w_router, *b_router, *w_gate, *w_up, *w_down, *final_norm_g;
    float* out;
};
__device__ __forceinline__ f32x4 mma_tile(const LAS bf16* A, int lda, int r0, const LAS bf16* Bt, int ldb, int c0, int K, f32x4 acc, int lane) {
    const int fr = lane & 15, fq = lane >> 4;
    const LAS bf16* ap = A + (r0 + fr) * lda + 8 * fq; const LAS bf16* bp = Bt + (c0 + fr) * ldb + 8 * fq;
#pragma unroll 4
    for (int k0 = 0; k0 < K; k0 += 32) { const bf16x8 a = *(const LAS bf16x8*)(ap + k0), b = *(const LAS bf16x8*)(bp + k0); acc = __builtin_amdgcn_mfma_f32_16x16x32_bf16(a, b, acc, 0, 0, 0); }
    return acc;
}
__device__ __forceinline__ void transpose_item(const float* W, int ldw, int src_col0, int k0, bf16* WT, int Kp, int dst_row0, LAS float* scr, int lane) {
#pragma unroll 8
    for (int i = 0; i < 32; ++i) { const int kk = 2 * i + (lane >> 5); scr[kk * 33 + (lane & 31)] = W[(size_t)(k0 + kk) * ldw + src_col0 + (lane & 31)]; }
    LDS_WAIT(); asm volatile("" ::: "memory");
    const int c = lane & 7;
#pragma unroll
    for (int j = 0; j < 4; ++j) { const int n = (lane >> 3) + 8 * j; const LAS float* s = scr + (8 * c) * 33 + n;
        v4u o; o.x = pk2(s[0 * 33], s[1 * 33]); o.y = pk2(s[2 * 33], s[3 * 33]); o.z = pk2(s[4 * 33], s[5 * 33]); o.w = pk2(s[6 * 33], s[7 * 33]);
        *(v4u*)(WT + (size_t)(dst_row0 + n) * Kp + k0 + 8 * c) = o; }
    LDS_WAIT(); asm volatile("" ::: "memory");
}
__device__ __forceinline__ void p0_phase(Frame& F) {
    float* MOD = (float*)(F.ws + WS_MOD);
    if (F.vcu < 96) {
        LAS float* sv = (LAS float*)F.lds;
        LAS float* red = sv + 3072;
        for (int i = F.tid; i < 3072; i += 512) { const int v = i >> 10, k = i & 1023; const float s = v < 2 ? F.c[v * 1024 + k] : F.c_ctx[k]; sv[i] = silu1(s); }
        __syncthreads();
        for (int item = F.vcu; item < 96; item += F.G) {
            const int kq = F.tid >> 4, cq = F.tid & 15, col = item * 64 + cq * 4;
            f32x4 a0 = {0.f, 0.f, 0.f, 0.f}, a1 = a0, a2 = a0;
            f32x4 wv[32];
#pragma unroll
            for (int kk = 0; kk < 32; ++kk) wv[kk] = *(const f32x4*)(F.w_mod + (size_t)(kq * 32 + kk) * 6144 + col);
#pragma unroll
            for (int kk = 0; kk < 32; ++kk) { const int k = kq * 32 + kk; a0 += sv[k] * wv[kk]; a1 += sv[1024 + k] * wv[kk]; a2 += sv[2048 + k] * wv[kk]; }
            *(LAS f32x4*)(red + (kq * 3 + 0) * 64 + cq * 4) = a0; *(LAS f32x4*)(red + (kq * 3 + 1) * 64 + cq * 4) = a1; *(LAS f32x4*)(red + (kq * 3 + 2) * 64 + cq * 4) = a2;
            __syncthreads();
            if (F.tid < 192) { const int v = F.tid >> 6, cc = F.tid & 63; float s = F.b_mod[item * 64 + cc];
                for (int q = 0; q < 32; ++q) s += red[(q * 3 + v) * 64 + cc];
                MOD[v * 6144 + item * 64 + cc] = s; }
            __syncthreads();
        }
    }
    __syncthreads();
    LAS float* scr = (LAS float*)(F.lds + F.wave * 16384);
    const int gw = F.vcu * NWAVES + F.wave, NGW = F.G * NWAVES;
    bf16* WIN = (bf16*)(F.ws + WS_WIN); bf16* WOUT = (bf16*)(F.ws + WS_WOUT);
    constexpr int I_IN = 97 * 16, I_OUT = 32 * 16;
    for (int it = gw; it < I_IN + I_OUT; it += NGW) {
        if (it < I_IN) { const int blk = it >> 4, kb = it & 15;
            const int src = blk < 48 ? 32 * blk : (blk < 64 ? 1552 + 32 * (blk - 48) : (blk < 96 ? 2064 + 32 * (blk - 64) : 1536));
            transpose_item(F.w_in, 3088, src, kb * 64, WIN, 1024, blk * 32, scr, F.lane); }
        else { const int r = it - I_IN, blk = r >> 4, kb = r & 15; transpose_item(F.w_out, 1024, blk * 32, kb * 64, WOUT, 1024, blk * 32, scr, F.lane); }
    }
}
__device__ __forceinline__ void wgu_convert(Frame& F) {
    LAS float* scr = (LAS float*)(F.lds + F.wave * 16384);
    const int gw = F.vcu * NWAVES + F.wave, NGW = F.G * NWAVES;
    bf16* WGU = (bf16*)(F.ws + WS_WGU);
    for (int it = gw; it < 16 * 2 * 512; it += NGW) {
        const int kb = it & 15, fb = (it >> 4) & 31, mat = (it >> 9) & 1, e = it >> 10;
        const float* W = (mat ? F.w_up : F.w_gate) + (size_t)e * 1024 * 1024;
        const int f0 = fb * 32, pn = f0 >> 7, dst = 256 * pn + (mat ? 128 : 0) + (f0 & 127);
        transpose_item(W, 1024, f0, kb * 64, WGU + (size_t)e * 2048 * 1024, 1024, dst, scr, F.lane);
    }
}
__device__ __forceinline__ void wd_convert(Frame& F) {
    LAS float* scr = (LAS float*)(F.lds + F.wave * 16384);
    if (F.vcu < 32) return;
    const int gw = (F.vcu - 32) * NWAVES + F.wave, NGW = (F.G - 32) * NWAVES;
    bf16* WD = (bf16*)(F.ws + WS_WD);
    for (int it = gw; it < 16 * 512; it += NGW) { const int kb = it & 15, nb = (it >> 4) & 31, e = it >> 9;
        transpose_item(F.w_down + (size_t)e * 1024 * 1024, 1024, nb * 32, kb * 64, WD + (size_t)e * 1024 * 1024, 1024, nb * 32, scr, F.lane); }
}
__device__ __forceinline__ void p1_rows4(Frame& F, const float* const (&src)[4], bf16* const (&dst)[4], const bool (&ok)[4], const float* mv) {
    f32x4 v[4][4];
#pragma unroll
    for (int r = 0; r < 4; ++r)
#pragma unroll
        for (int j = 0; j < 4; ++j) v[r][j] = *(const f32x4*)(src[r] + 4 * F.lane + 256 * j);
    f32x4 sc[4], sh[4];
#pragma unroll
    for (int j = 0; j < 4; ++j) { const int k = 4 * F.lane + 256 * j; const f32x4 g = *(const f32x4*)(F.norm1_g + k), s1 = *(const f32x4*)(mv + 1024 + k); sc[j] = g * (1.0f + s1); sh[j] = *(const f32x4*)(mv + k); }
#pragma unroll
    for (int r = 0; r < 4; ++r) { float ss = 0.f;
#pragma unroll
        for (int j = 0; j < 4; ++j) ss += (v[r][j].x * v[r][j].x + v[r][j].y * v[r][j].y) + (v[r][j].z * v[r][j].z + v[r][j].w * v[r][j].w);
        const float rstd = 1.0f / sqrtf(wave_sum(ss) * (1.0f / D) + EPS);
        if (ok[r]) {
#pragma unroll
            for (int j = 0; j < 4; ++j) { const f32x4 a = v[r][j] * rstd * sc[j] + sh[j]; v2u o; o.x = pk2(a.x, a.y); o.y = pk2(a.z, a.w); *(v2u*)(dst[r] + 4 * F.lane + 256 * j) = o; } } }
}
__device__ __forceinline__ void p1_phase(Frame& F) {
    const float* MOD = (const float*)(F.ws + WS_MOD); bf16* AIN = (bf16*)(F.ws + WS_AIN);
    const int gw = F.vcu * NWAVES + F.wave, NGW = F.G * NWAVES;
#pragma unroll 1
    for (int seg = 0; seg < 2; ++seg) {
        const float* src[4]; bf16* dst[4]; bool ok[4];
#pragma unroll
        for (int r = 0; r < 4; ++r) { const int m = seg * T + gw + r * NGW; ok[r] = (gw + r * NGW) < T; const int mc = ok[r] ? m : seg * T; src[r] = F.x + (size_t)mc * D; dst[r] = AIN + (size_t)mc * D; }
        p1_rows4(F, src, dst, ok, MOD + seg * 6144);
    }
    if (gw < MC) {
        const float* src[4]; bf16* dst[4]; bool ok[4];
#pragma unroll
        for (int r = 0; r < 4; ++r) { ok[r] = (r == 0); src[r] = F.ctx + (size_t)gw * D; dst[r] = AIN + (size_t)(M + gw) * D; }
        p1_rows4(F, src, dst, ok, MOD + 2 * 6144);
    }
}
struct PF { unsigned a, b, c, d; };
__device__ __forceinline__ unsigned touch(const void* p) { return *(const GAS unsigned*)p; }
__device__ __forceinline__ PF p3_prefetch(Frame& F, int it) {
    PF r; r.a = r.b = r.c = r.d = 0u;
    if (it >= 1056 + 512) return r;
    const int tid = F.tid;
    if (it < 1056) {
        int b, n, h, L; size_t row_base;
        if (it < 1024) { b = it >> 9; n = (it >> 2) & 127; h = it & 3; L = T; row_base = (size_t)b * T; }
        else { const int j = it - 1024; b = j >> 4; n = (j >> 2) & 3; h = j & 3; L = TC; row_base = (size_t)M + (size_t)b * TC; }
        const bf16* QKV = (const bf16*)(F.ws + WS_QKV);
        { const int p = tid, rr = p / 12, q = p % 12, s = q >> 2, piece = q & 3; int t = 64 * n - 1 + rr; t = t < 0 ? 0 : (t >= L ? L - 1 : t); r.a = touch(QKV + (row_base + t) * 1536 + s * 512 + h * 128 + piece * 32); }
        if (tid < 280) { const int p = tid + 512, rr = p / 12, q = p % 12, s = q >> 2, piece = q & 3; int t = 64 * n - 1 + rr; t = t < 0 ? 0 : (t >= L ? L - 1 : t); r.b = touch(QKV + (row_base + t) * 1536 + s * 512 + h * 128 + piece * 32); }
        if (tid < 64) r.c = touch((const float*)(F.ws + WS_AB) + (row_base + 64 * n + tid) * 16);
    } else {
        const int i2 = it - 1056, g = i2 & 3, nc = (i2 >> 2) & 63, b = i2 >> 8; const size_t r0 = (size_t)b * T + (size_t)nc * 128;
        const bf16* UV = (const bf16*)(F.ws + WS_UV);
        const int t = tid >> 2, piece = tid & 3; r.a = touch(UV + (r0 + t) * 1024 + 512 + 128 * g + piece * 32); r.b = touch(UV + (r0 + t) * 1024 + 128 * g + piece * 32);
        r.c = touch(F.gm_ws + (size_t)g * 16384 + tid * 16); r.d = touch(F.gm_ws + (size_t)g * 16384 + (tid + 512) * 16);
    }
    return r;
}
__device__ __forceinline__ void pf_sink(Frame& F, const PF& r) { asm volatile("" :: "v"(r.a), "v"(r.b), "v"(r.c), "v"(r.d)); }
__device__ __forceinline__ void gdn_item(Frame& F, int it) {
    int b, n, h, L, slot; size_t row_base;
    if (it < 1024) { b = it >> 9; n = (it >> 2) & 127; h = it & 3; L = T; row_base = (size_t)b * T; slot = (b * 4 + h) * 128 + n; }
    else { const int j = it - 1024; b = j >> 4; n = (j >> 2) & 3; h = j & 3; L = TC; row_base = (size_t)M + (size_t)b * TC; slot = 1024 + (b * 4 + h) * 4 + n; }
    const bf16* QKV = (const bf16*)(F.ws + WS_QKV); const float* AB = (const float*)(F.ws + WS_AB);
    LAS bf16* QB = (LAS bf16*)(F.lds); LAS bf16* KB = (LAS bf16*)(F.lds + 17408); LAS bf16* VB = (LAS bf16*)(F.lds + 34816); LAS bf16* TB = (LAS bf16*)(F.lds + 34816);
    LAS bf16* KT = (LAS bf16*)(F.lds + 52224); LAS bf16* VT = (LAS bf16*)(F.lds + 70656);
    LAS float* KK = (LAS float*)(F.lds + 89088); LAS float* QK = (LAS float*)(F.lds + 105728);
    LAS bf16* T12 = (LAS bf16*)(F.lds + 89088);
    LAS float* AF = (LAS float*)(F.lds + 122368);
    LAS float* GC = (LAS float*)(F.lds + 155136); LAS float* BT = (LAS float*)(F.lds + 155648); LAS float* EG1 = (LAS float*)(F.lds + 156160); LAS float* EG2 = (LAS float*)(F.lds + 156672);
    LAS bf16* A10B = (LAS bf16*)(F.lds + 157184);
    const int tid = F.tid, lane = F.lane, wave = F.wave, fr = lane & 15, fq = lane >> 4;
    for (int q = tid; q < 1152; q += 512) { const int tap = q / 384, rem = q % 384, s = rem >> 7, c = rem & 127; ((LAS float*)(F.lds + 89088))[q] = F.conv_w[tap * 1536 + s * 512 + h * 128 + c]; }
    __syncthreads();
    {
        const int r = tid >> 3, part = tid & 7, t = 64 * n + r; const bool hasp = t > 0, hasn = t + 1 < L;
        const bf16* prow = QKV + (row_base + t) * 1536;
        const LAS float* cwl = (const LAS float*)(F.lds + 89088) + part * 16;
        const int offp = hasp ? 1536 : 0, offn = hasn ? 1536 : 0; const unsigned mp = hasp ? 0xffffffffu : 0u, mn = hasn ? 0xffffffffu : 0u;
        v4u dc[6], dn[6];
#define S1_LOAD(dst, s_) do { const bf16* pc_ = prow + (s_) * 512 + h * 128 + part * 16; const bf16* pp_ = pc_ - offp; const bf16* pn_ = pc_ + offn; \
            dst[0] = *(const v4u*)pc_; dst[1] = *(const v4u*)(pc_ + 8); dst[2] = *(const v4u*)pp_; dst[3] = *(const v4u*)(pp_ + 8); dst[4] = *(const v4u*)pn_; dst[5] = *(const v4u*)(pn_ + 8); } while (0)
        S1_LOAD(dc, 0);
#pragma unroll 1
        for (int s = 0; s < 3; ++s) {
            if (s < 2) S1_LOAD(dn, s + 1);
            float y[16]; float ss = 0.f;
#pragma unroll
            for (int q = 0; q < 4; ++q) { const f32x4 w0 = *(const LAS f32x4*)(cwl + (0 * 3 + s) * 128 + 4 * q), w1 = *(const LAS f32x4*)(cwl + (1 * 3 + s) * 128 + 4 * q), w2 = *(const LAS f32x4*)(cwl + (2 * 3 + s) * 128 + 4 * q);
#pragma unroll
                for (int e = 0; e < 2; ++e) { const unsigned cw = dc[q >> 1][(q & 1) * 2 + e], pw = dc[2 + (q >> 1)][(q & 1) * 2 + e] & mp, nw = dc[4 + (q >> 1)][(q & 1) * 2 + e] & mn;
                    const float a0 = w0[2 * e] * bflo(pw) + w1[2 * e] * bflo(cw) + w2[2 * e] * bflo(nw), a1 = w0[2 * e + 1] * bfhi(pw) + w1[2 * e + 1] * bfhi(cw) + w2[2 * e + 1] * bfhi(nw);
                    const float y0 = silu_r(a0), y1 = silu_r(a1); y[4 * q + 2 * e] = y0; y[4 * q + 2 * e + 1] = y1; ss += y0 * y0 + y1 * y1; } }
            float sc = 1.0f;
            if (s < 2) { ss += __shfl_xor(ss, 1); ss += __shfl_xor(ss, 2); ss += __shfl_xor(ss, 4); sc = (1.0f / sqrtf(ss + EPS)) * (s == 0 ? 0.08838834764831845f : 1.0f); }
            LAS bf16* dst = (s == 0 ? QB : (s == 1 ? KB : VB)) + r * 136 + part * 16;
            v4u o0, o1;
            o0.x = pk2(y[0] * sc, y[1] * sc); o0.y = pk2(y[2] * sc, y[3] * sc); o0.z = pk2(y[4] * sc, y[5] * sc); o0.w = pk2(y[6] * sc, y[7] * sc);
            o1.x = pk2(y[8] * sc, y[9] * sc); o1.y = pk2(y[10] * sc, y[11] * sc); o1.z = pk2(y[12] * sc, y[13] * sc); o1.w = pk2(y[14] * sc, y[15] * sc);
            *(LAS v4u*)dst = o0; *(LAS v4u*)(dst + 8) = o1;
#pragma unroll
            for (int q = 0; q < 6; ++q) dc[q] = dn[q];
        }
#undef S1_LOAD
        if (wave < 2) { const int d = wave, i = lane, tl = d ? 63 - i : i; const float* abr = AB + (row_base + 64 * n + tl) * 16;
            const float a = abr[d * 4 + h], bb = abr[8 + d * 4 + h];
            const float xx = a + F.dt_bias[d * 4 + h]; const float sp = fmaxf(xx, 0.f) + log1pf(expf(-fabsf(xx)));
            float g = -expf(F.a_log[d * 4 + h]) * sp;
#pragma unroll
            for (int o = 1; o < 64; o <<= 1) { const float yv = __shfl_up(g, o); if (i >= o) g += yv; }
            GC[d * 64 + i] = g; BT[d * 64 + i] = 1.0f / (1.0f + expf(-bb)); const float gl = __shfl(g, 63); EG1[d * 64 + i] = __expf(g); EG2[d * 64 + i] = __expf(gl - g); }
    }
    __syncthreads();
    const PF pf = p3_prefetch(F, it + F.G);
    {
        const int mat = wave >> 2, tr = wave & 3;
#pragma unroll
        for (int tc = 0; tc < 4; ++tc) { f32x4 acc = {0.f, 0.f, 0.f, 0.f}; acc = mma_tile(mat ? QB : KB, 136, 16 * tr, KB, 136, 16 * tc, 128, acc, lane);
            LAS float* dst = (mat ? QK : KK) + (16 * tr + 4 * fq) * 65 + 16 * tc + fr;
#pragma unroll
            for (int j = 0; j < 4; ++j) dst[j * 65] = acc[j]; }
        bf16x8 id0, id1;
#pragma unroll
        for (int j = 0; j < 8; ++j) { id0[j] = (8 * fq + j == fr) ? (short)0x3F80 : (short)0; id1[j] = (8 * fq + j == fr + 16) ? (short)0x3F80 : (short)0; }
#pragma unroll 1
        for (int q = 0; q < 8; ++q) { const int job = wave * 8 + q, mt = job >> 5, tt = (job >> 3) & 3, ct = job & 7;
            const bf16x8 a = *(const LAS bf16x8*)((mt ? KB : VB) + (16 * tt + fr) * 136 + 32 * (ct >> 1) + 8 * fq);
            f32x4 acc = {0.f, 0.f, 0.f, 0.f}; acc = __builtin_amdgcn_mfma_f32_16x16x32_bf16(a, (ct & 1) ? id1 : id0, acc, 0, 0, 0);
            v2u o; o.x = pk2(acc[0], acc[1]); o.y = pk2(acc[2], acc[3]); *(LAS v2u*)((mt ? KT : VT) + (16 * ct + fr) * 72 + 16 * tt + 4 * fq) = o; }
    }
    __syncthreads();
    for (int idx = tid; idx < 8192; idx += 512) { const int d = idx >> 12, i = (idx >> 6) & 63, j = idx & 63; const int ti = d ? 63 - i : i, tj = d ? 63 - j : j;
        const float av = (i > j) ? BT[d * 64 + i] * KK[ti * 65 + tj] * __expf(GC[d * 64 + i] - GC[d * 64 + j]) : 0.f; AF[idx] = av;
        if (i >= 32 && j < 32) A10B[d * 1280 + (i - 32) * 40 + j] = (bf16)f2bf(av); }
    __syncthreads();
    unsigned char* gout = F.ws + WS_GDN + (size_t)slot * 2 * GDN_UNIT;
    if (wave < 2) {
        const int d = wave, blk = lane >> 5, jc = lane & 31; const LAS float* A = AF + d * 4096 + (blk * 32) * 64 + blk * 32; LAS bf16* TBd = TB + d * 4096;
        float Tc[32];
#pragma unroll
        for (int i = 0; i < 32; ++i) { float s0 = (i == jc) ? 1.f : 0.f, s1 = 0.f, s2 = 0.f, s3 = 0.f;
#pragma unroll
            for (int j = 0; j < i; ++j) { const float a = A[i * 64 + j]; if ((j & 3) == 0) s0 = fnma1(a, Tc[j], s0); else if ((j & 3) == 1) s1 = fnma1(a, Tc[j], s1); else if ((j & 3) == 2) s2 = fnma1(a, Tc[j], s2); else s3 = fnma1(a, Tc[j], s3); }
            Tc[i] = (s0 + s1) + (s2 + s3); TBd[(blk * 32 + i) * 64 + blk * 32 + jc] = (bf16)f2bf(Tc[i]);
            if (blk) TBd[i * 64 + 32 + jc] = (bf16)0;
            asm volatile("" ::: "memory"); }
        LAS bf16* DT0 = (LAS bf16*)(AF + d * 4096); LAS bf16* PT = DT0 + 1280;
        if (!blk) {
#pragma unroll
            for (int q = 0; q < 4; ++q) { v4u o; o.x = pk2(Tc[8 * q], Tc[8 * q + 1]); o.y = pk2(Tc[8 * q + 2], Tc[8 * q + 3]); o.z = pk2(Tc[8 * q + 4], Tc[8 * q + 5]); o.w = pk2(Tc[8 * q + 6], Tc[8 * q + 7]); *(LAS v4u*)(DT0 + jc * 40 + 8 * q) = o; } }
#pragma unroll
        for (int tl = 0; tl < 4; ++tl) { const int ti = tl >> 1, tj = tl & 1; f32x4 acc = {0.f, 0.f, 0.f, 0.f}; acc = mma_tile(A10B + d * 1280, 40, 16 * ti, DT0, 40, 16 * tj, 32, acc, lane);
            v2u o; o.x = pk2(acc[0], acc[1]); o.y = pk2(acc[2], acc[3]); *(LAS v2u*)(PT + (16 * tj + fr) * 40 + 16 * ti + 4 * fq) = o; }
#pragma unroll
        for (int tl = 0; tl < 4; ++tl) { const int ti = tl >> 1, tj = tl & 1; f32x4 acc = {0.f, 0.f, 0.f, 0.f}; acc = mma_tile(TBd + 32 * 64 + 32, 64, 16 * ti, PT, 40, 16 * tj, 32, acc, lane);
#pragma unroll
            for (int j = 0; j < 4; ++j) TBd[(32 + 16 * ti + 4 * fq + j) * 64 + 16 * tj + fr] = (bf16)f2bf(-acc[j]); }
    } else {
        const int t2 = tid - 128;
        for (int q = t2; q < 2048; q += 384) { const int d = q >> 10, i = (q >> 4) & 63, cg = q & 15, tok = d ? 63 - i : i; const float e = EG1[d * 64 + i];
            const v4u s = *(const LAS v4u*)(QB + tok * 136 + cg * 8); v4u o;
            o.x = pk2(bflo(s.x) * e, bfhi(s.x) * e); o.y = pk2(bflo(s.y) * e, bfhi(s.y) * e); o.z = pk2(bflo(s.z) * e, bfhi(s.z) * e); o.w = pk2(bflo(s.w) * e, bfhi(s.w) * e);
            *(v4u*)(gout + (size_t)d * GDN_UNIT + 16384 + (i * 128 + cg * 8) * 2) = o; }
        for (int q = t2; q < 2048; q += 384) { const int d = q >> 10, c = (q >> 3) & 127, ig = q & 7;
            float v[8];
            if (d == 0) { const v4u s = *(const LAS v4u*)(KT + c * 72 + ig * 8); v[0] = bflo(s.x); v[1] = bfhi(s.x); v[2] = bflo(s.y); v[3] = bfhi(s.y); v[4] = bflo(s.z); v[5] = bfhi(s.z); v[6] = bflo(s.w); v[7] = bfhi(s.w); }
            else { const v4u s = *(const LAS v4u*)(KT + c * 72 + 56 - ig * 8); v[7] = bflo(s.x); v[6] = bfhi(s.x); v[5] = bflo(s.y); v[4] = bfhi(s.y); v[3] = bflo(s.z); v[2] = bfhi(s.z); v[1] = bflo(s.w); v[0] = bfhi(s.w); }
            const LAS float* e2 = EG2 + d * 64 + ig * 8; v4u o;
            o.x = pk2(v[0] * e2[0], v[1] * e2[1]); o.y = pk2(v[2] * e2[2], v[3] * e2[3]); o.z = pk2(v[4] * e2[4], v[5] * e2[5]); o.w = pk2(v[6] * e2[6], v[7] * e2[7]);
            *(v4u*)(gout + (size_t)d * GDN_UNIT + 32768 + (c * 64 + ig * 8) * 2) = o; }
        for (int q = t2; q < 1024; q += 384) { const int d = q >> 9, i = (q >> 3) & 63, jg = q & 7, ti = d ? 63 - i : i; const float gi = GC[d * 64 + i]; float v[8];
#pragma unroll
            for (int jj = 0; jj < 8; ++jj) { const int j = jg * 8 + jj, tj = d ? 63 - j : j; v[jj] = (i >= j) ? QK[ti * 65 + tj] * __expf(gi - GC[d * 64 + j]) : 0.f; }
            v4u o; o.x = pk2(v[0], v[1]); o.y = pk2(v[2], v[3]); o.z = pk2(v[4], v[5]); o.w = pk2(v[6], v[7]);
            *(v4u*)(gout + (size_t)d * GDN_UNIT + 49152 + (i * 64 + jg * 8) * 2) = o; }
        if (t2 < 2) ((float*)(F.ws + WS_EGL))[slot * 2 + t2] = EG1[t2 * 64 + 63];
    }
    __syncthreads();
    for (int q = tid; q < 1024; q += 512) { const int d = q >> 9, i = (q >> 3) & 63, tg = q & 7;
        float v[8];
        if (d == 0) { const v4u s = *(const LAS v4u*)(TB + i * 64 + tg * 8); v[0] = bflo(s.x); v[1] = bfhi(s.x); v[2] = bflo(s.y); v[3] = bfhi(s.y); v[4] = bflo(s.z); v[5] = bfhi(s.z); v[6] = bflo(s.w); v[7] = bfhi(s.w); }
        else { const v4u s = *(const LAS v4u*)(TB + 4096 + i * 64 + 56 - tg * 8); v[7] = bflo(s.x); v[6] = bfhi(s.x); v[5] = bflo(s.y); v[4] = bfhi(s.y); v[3] = bflo(s.z); v[2] = bfhi(s.z); v[1] = bflo(s.w); v[0] = bfhi(s.w); }
        float t1[8], t2v[8];
#pragma unroll
        for (int e = 0; e < 8; ++e) { const int tok = tg * 8 + e, j = d ? 63 - tok : tok; t1[e] = v[e] * BT[d * 64 + j]; t2v[e] = t1[e] * EG1[d * 64 + j]; }
        v4u o; o.x = pk2(t1[0], t1[1]); o.y = pk2(t1[2], t1[3]); o.z = pk2(t1[4], t1[5]); o.w = pk2(t1[6], t1[7]); *(LAS v4u*)(T12 + (d * 2 + 0) * 4608 + i * 72 + tg * 8) = o;
        o.x = pk2(t2v[0], t2v[1]); o.y = pk2(t2v[2], t2v[3]); o.z = pk2(t2v[4], t2v[5]); o.w = pk2(t2v[6], t2v[7]); *(LAS v4u*)(T12 + (d * 2 + 1) * 4608 + i * 72 + tg * 8) = o; }
    __syncthreads();
#pragma unroll 1
    for (int q = 0; q < 16; ++q) { const int tile = wave * 16 + q, d = tile >> 6, kind = (tile >> 5) & 1, ti = (tile >> 3) & 3, tc = tile & 7; f32x4 acc = {0.f, 0.f, 0.f, 0.f};
        unsigned char* go = gout + (size_t)d * GDN_UNIT;
        if (kind == 0) { acc = mma_tile(T12 + (d * 2 + 0) * 4608, 72, 16 * ti, VT, 72, 16 * tc, 64, acc, lane);
            v2u o; o.x = pk2(acc[0], acc[1]); o.y = pk2(acc[2], acc[3]); *(v2u*)(go + 57344 + ((16 * tc + fr) * 64 + 16 * ti + 4 * fq) * 2) = o; }
        else { acc = mma_tile(KT, 72, 16 * tc, T12 + (d * 2 + 1) * 4608, 72, 16 * ti, 64, acc, lane);
            v2u o; o.x = pk2(acc[0], acc[1]); o.y = pk2(acc[2], acc[3]); *(v2u*)(go + ((16 * ti + fr) * 128 + 16 * tc + 4 * fq) * 2) = o; } }
    __syncthreads();
    pf_sink(F, pf);
}
__device__ __forceinline__ void gmlp_item(Frame& F, int it) {
    const int g = it & 3, nc = (it >> 2) & 63, b = it >> 8; const size_t r0 = (size_t)b * T + (size_t)nc * 128;
    const bf16* UV = (const bf16*)(F.ws + WS_UV); bf16* MIX = (bf16*)(F.ws + WS_MIX);
    LAS bf16* VNT = (LAS bf16*)(F.lds); LAS bf16* WSB = (LAS bf16*)(F.lds + 34816);
    const int tid = F.tid, lane = F.lane, wave = F.wave;
    {
        const int t = tid >> 2, part = tid & 3; const bf16* vp = UV + (r0 + t) * 1024 + 512 + 128 * g + part * 32;
        float v[32]; float ss = 0.f;
#pragma unroll
        for (int q = 0; q < 4; ++q) { const v4u xw = *(const v4u*)(vp + 8 * q);
#pragma unroll
            for (int e = 0; e < 4; ++e) { v[8 * q + 2 * e] = bflo(xw[e]); v[8 * q + 2 * e + 1] = bfhi(xw[e]); ss += v[8 * q + 2 * e] * v[8 * q + 2 * e] + v[8 * q + 2 * e + 1] * v[8 * q + 2 * e + 1]; } }
        ss += __shfl_xor(ss, 1); ss += __shfl_xor(ss, 2);
        const float rstd = 1.0f / sqrtf(ss * (1.0f / 128.0f) + EPS); const float* gn = F.gm_norm_g + 128 * g + part * 32;
#pragma unroll
        for (int cc = 0; cc < 32; ++cc) VNT[(part * 32 + cc) * 136 + t] = (bf16)f2bf(v[cc] * rstd * gn[cc]);
        const float* wp = F.gm_ws + ((size_t)g * 128 + t) * 128 + part * 32;
#pragma unroll
        for (int q = 0; q < 4; ++q) { const f32x4 w0 = *(const f32x4*)(wp + 8 * q), w1 = *(const f32x4*)(wp + 8 * q + 4); v4u o; o.x = pk2(w0.x, w0.y); o.y = pk2(w0.z, w0.w); o.z = pk2(w1.x, w1.y); o.w = pk2(w1.z, w1.w);
            *(LAS v4u*)(WSB + t * 136 + part * 32 + 8 * q) = o; }
    }
    __syncthreads();
    const PF pf = p3_prefetch(F, it + 1056 + F.G);
    {
        const int td = wave, fr = lane & 15, fq = lane >> 4;
        v2u uws[8]; float bss[8];
#pragma unroll
        for (int tt = 0; tt < 8; ++tt) { const int tl = 16 * tt + fr; uws[tt] = *(const v2u*)(UV + (r0 + tl) * 1024 + 128 * g + 16 * td + 4 * fq); bss[tt] = F.gm_bs[g * 128 + tl]; }
#pragma unroll
        for (int tt = 0; tt < 8; ++tt) { f32x4 acc = {0.f, 0.f, 0.f, 0.f}; acc = mma_tile(VNT, 136, 16 * td, WSB, 136, 16 * tt, 128, acc, lane);
            const int tl = 16 * tt + fr; const size_t off = (r0 + tl) * 1024 + 128 * g + 16 * td + 4 * fq; const float bsv = bss[tt];
            const v2u uw = uws[tt]; v2u o;
            o.x = pk2(bflo(uw.x) * (acc[0] + bsv), bfhi(uw.x) * (acc[1] + bsv)); o.y = pk2(bflo(uw.y) * (acc[2] + bsv), bfhi(uw.y) * (acc[3] + bsv));
            *(v2u*)(MIX + off) = o; }
    }
    __syncthreads();
    pf_sink(F, pf);
}
__device__ __forceinline__ void p3_phase(Frame& F) {
    if (F.G != 256) { for (int it = F.vcu; it < 1056 + 512; it += F.G) { if (it < 1056) gdn_item(F, it); else gmlp_item(F, it - 1056); } return; }
    for (int k = 0; k < 4; ++k) gdn_item(F, F.vcu + 256 * k);
    if (F.vcu < 32) gdn_item(F, 1024 + F.vcu);
    else for (int j = F.vcu - 32; j < 512; j += 224) gmlp_item(F, j);
}
constexpr size_t WS_CB = 112 * MiB;
constexpr size_t WS_ZT = 136 * MiB;
constexpr size_t WS_XB = 140 * MiB;
constexpr size_t WS_CORRF = 78 * MiB, WS_CORRB = 206 * MiB;
#ifndef P4_TOUCHES
#define P4_TOUCHES 0
#endif
__device__ __forceinline__ void p4_scan(Frame& F) {
    const int j14 = F.vcu & 31;
    if (j14 >= 28) return;
    const int chain = 2 * (F.vcu >> 5) + (j14 >= 14 ? 1 : 0), role = j14 % 14;
    const int g = role < 2 ? 0 : 1 + ((role - 2) >> 2), kindP = role < 2 ? 0 : ((role - 2) >> 1) & 1, ch = role < 2 ? role : (role - 2) & 1;
    const int b = chain >> 3, h = (chain >> 1) & 3, d = chain & 1, c0 = ch * 64;
    const int NS = g == 0 ? 36 : 32;
    constexpr int BUFB = 65536, ST_OFF = 2 * BUFB, VNT_OFF = ST_OFF + 64 * 288, EGS_OFF = VNT_OFF + 64 * 160, JUNK_OFF = EGS_OFF + 256;
    const unsigned char* gdn = F.ws + WS_GDN; const float* EGL = (const float*)(F.ws + WS_EGL);
    const int lane = F.lane, wave = F.wave;
#define P4_SLOT(s) (g == 0 ? ((s) < 4 ? 1024 + (b * 4 + h) * 4 + (d ? 3 - (s) : (s)) : (b * 4 + h) * 128 + (d ? 127 - ((s) - 4) : ((s) - 4))) : (b * 4 + h) * 128 + (d ? 127 - (32 * g + (s)) : (32 * g + (s))))
#define P4_BAR() do { asm volatile("s_waitcnt lgkmcnt(0)" ::: "memory"); __builtin_amdgcn_s_barrier(); asm volatile("" ::: "memory"); } while (0)
#define P4_ISSUE(s, bufi) do { const unsigned char* gb = gdn + (size_t)(P4_SLOT(s) * 2 + d) * GDN_UNIT; \
            _Pragma("unroll") for (int q = 0; q < 7; ++q) { const int k = wave + 8 * q; unsigned so; \
                if (k < 32) { const int qi = (k & 15) * 64 + lane, r = qi >> 4, sl = qi & 15; so = (unsigned)((k >> 4) * 16384 + r * 256 + ((sl ^ (r & 15)) << 4)); } \
                else { const int kk = k < 48 ? k - 32 : k - 48, qi = kk * 64 + lane, r = qi >> 3, sl = qi & 7; so = (unsigned)((k < 48 ? 32768 : 49152) + r * 128 + ((sl ^ ((r >> 1) & 7)) << 4)); } \
                __builtin_amdgcn_global_load_lds((const unsigned*)(gb + so), (LAS unsigned*)(F.lds + (bufi) * BUFB + k * 1024), 16, 0, 0); } \
            if (!kindP) __builtin_amdgcn_global_load_lds((const unsigned*)(gb + 57344 + (size_t)c0 * 128 + wave * 1024 + lane * 16), (LAS unsigned*)(F.lds + (bufi) * BUFB + 57344 + wave * 1024), 16, 0, 0); } while (0)
#define P4_TOUCH(s) do { const unsigned char* gb = gdn + (size_t)(P4_SLOT(s) * 2 + d) * GDN_UNIT; const int li = wave * 64 + lane, ln = li < 448 ? li : 448 + c0 + (li - 448); \
            __builtin_amdgcn_global_load_lds((const unsigned*)(gb + (size_t)ln * 128), (LAS unsigned*)(F.lds + JUNK_OFF + wave * 256), 4, 0, 0); } while (0)
    const int m = wave & 3, nh = wave >> 2, fr = lane & 15, fq = lane >> 4;
    for (int i = F.tid; i < 64 * 72; i += 512) { const int c = i / 72, w4 = i % 72;
        unsigned v = 0u; if (kindP) { const int dk = c0 + c; if ((dk >> 1) == w4) v = (dk & 1) ? 0x3F800000u : 0x00003F80u; }
        ((LAS unsigned*)(F.lds + ST_OFF))[i] = v; }
    for (int i = F.tid; i < NS; i += 512) ((LAS float*)(F.lds + EGS_OFF))[i] = EGL[P4_SLOT(i) * 2 + d];
    f32x4 S[2][2];
#pragma unroll
    for (int t2 = 0; t2 < 2; ++t2)
#pragma unroll
        for (int n2 = 0; n2 < 2; ++n2) {
#pragma unroll
            for (int jj = 0; jj < 4; ++jj) S[t2][n2][jj] = (kindP && (32 * m + 16 * t2 + 4 * fq + jj == c0 + 32 * nh + 16 * n2 + fr)) ? 1.0f : 0.0f; }
    bf16* OD = (bf16*)(F.ws + (d ? WS_OB : WS_OF)); bf16* CB = (bf16*)(F.ws + WS_CB);
    P4_ISSUE(0, 0);
    VM_WAIT(); P4_BAR();
    if (P4_TOUCHES) { P4_TOUCH(1); P4_TOUCH(2); }
#pragma unroll 1
    for (int s = 0; s < NS; ++s) {
        const int cur = s & 1; const LAS unsigned char* buf = F.lds + cur * BUFB; LAS unsigned char* ST = F.lds + ST_OFF; LAS unsigned char* VNT = F.lds + VNT_OFF;
        if (s + 1 < NS) P4_ISSUE(s + 1, cur ^ 1);
        const float eg = ((const LAS float*)(F.lds + EGS_OFF))[s];
        bf16x8 bS[2][4]; f32x4 acc[2];
#pragma unroll
        for (int n2 = 0; n2 < 2; ++n2) acc[n2] = (f32x4){0.f, 0.f, 0.f, 0.f};
        const int r = 16 * m + fr;
#pragma unroll
        for (int ks = 0; ks < 4; ++ks) { const bf16x8 a = *(const LAS bf16x8*)(buf + r * 256 + (((4 * ks + fq) ^ fr) << 4));
#pragma unroll
            for (int n2 = 0; n2 < 2; ++n2) { bS[n2][ks] = *(const LAS bf16x8*)(ST + (32 * nh + 16 * n2 + fr) * 288 + (32 * ks + 8 * fq) * 2); acc[n2] = __builtin_amdgcn_mfma_f32_16x16x32_bf16(a, bS[n2][ks], acc[n2], 0, 0, 0); } }
#pragma unroll
        for (int n2 = 0; n2 < 2; ++n2) { const int cl = 32 * nh + 16 * n2 + fr; v2u ucn = {0u, 0u}; if (!kindP) ucn = *(const LAS v2u*)(buf + 57344 + cl * 128 + (16 * m + 4 * fq) * 2);
            const float v0 = bflo(ucn.x) - acc[n2][0], v1 = bfhi(ucn.x) - acc[n2][1], v2 = bflo(ucn.y) - acc[n2][2], v3 = bfhi(ucn.y) - acc[n2][3]; v2u o; o.x = pk2(v0, v1); o.y = pk2(v2, v3);
            *(LAS v2u*)(VNT + cl * 160 + (16 * m + 4 * fq) * 2) = o; }
        P4_BAR();
        bf16x8 bV[2][2];
#pragma unroll
        for (int n2 = 0; n2 < 2; ++n2)
#pragma unroll
            for (int ks = 0; ks < 2; ++ks) bV[n2][ks] = *(const LAS bf16x8*)(VNT + (32 * nh + 16 * n2 + fr) * 160 + (32 * ks + 8 * fq) * 2);
        const bool outp = (g > 0 || s >= 4);
        if (outp) {
            f32x4 o[2];
#pragma unroll
            for (int n2 = 0; n2 < 2; ++n2) o[n2] = (f32x4){0.f, 0.f, 0.f, 0.f};
#pragma unroll
            for (int ks = 0; ks < 4; ++ks) { const bf16x8 a = *(const LAS bf16x8*)(buf + 16384 + r * 256 + (((4 * ks + fq) ^ fr) << 4));
#pragma unroll
                for (int n2 = 0; n2 < 2; ++n2) o[n2] = __builtin_amdgcn_mfma_f32_16x16x32_bf16(bS[n2][ks], a, o[n2], 0, 0, 0); }
#pragma unroll
            for (int ks = 0; ks < 2; ++ks) { const bf16x8 a = *(const LAS bf16x8*)(buf + 49152 + r * 128 + (((4 * ks + fq) ^ ((r >> 1) & 7)) << 4));
#pragma unroll
                for (int n2 = 0; n2 < 2; ++n2) o[n2] = __builtin_amdgcn_mfma_f32_16x16x32_bf16(bV[n2][ks], a, o[n2], 0, 0, 0); }
            const int sp = g == 0 ? s - 4 : 32 * g + s;
            const int i = 16 * m + fr;
            if (kindP) { bf16* cb = CB + ((size_t)(chain * 96 + (sp - 32)) * 64 + i) * 128 + c0 + 32 * nh + 4 * fq;
#pragma unroll
                for (int n2 = 0; n2 < 2; ++n2) { v2u w; w.x = pk2(o[n2][0], o[n2][1]); w.y = pk2(o[n2][2], o[n2][3]); *(v2u*)(cb + 16 * n2) = w; } }
            else { const int nn = d ? 127 - sp : sp, tl = d ? 63 - i : i; bf16* op = OD + ((size_t)b * T + 64 * nn + tl) * 512 + h * 128 + c0 + 32 * nh + 4 * fq;
#pragma unroll
                for (int n2 = 0; n2 < 2; ++n2) { v2u w; w.x = pk2(o[n2][0], o[n2][1]); w.y = pk2(o[n2][2], o[n2][3]); *(v2u*)(op + 16 * n2) = w; } }
        }
#pragma unroll
        for (int t2 = 0; t2 < 2; ++t2)
#pragma unroll
            for (int n2 = 0; n2 < 2; ++n2) S[t2][n2] *= eg;
#pragma unroll
        for (int ks = 0; ks < 2; ++ks)
#pragma unroll
            for (int t2 = 0; t2 < 2; ++t2) { const int rr = 32 * m + 16 * t2 + fr; const bf16x8 a = *(const LAS bf16x8*)(buf + 32768 + rr * 128 + (((4 * ks + fq) ^ ((rr >> 1) & 7)) << 4));
#pragma unroll
                for (int n2 = 0; n2 < 2; ++n2) S[t2][n2] = __builtin_amdgcn_mfma_f32_16x16x32_bf16(a, bV[n2][ks], S[t2][n2], 0, 0, 0); }
#pragma unroll
        for (int t2 = 0; t2 < 2; ++t2)
#pragma unroll
            for (int n2 = 0; n2 < 2; ++n2) { v2u o; o.x = pk2(S[t2][n2][0], S[t2][n2][1]); o.y = pk2(S[t2][n2][2], S[t2][n2][3]); *(LAS v2u*)(ST + (32 * nh + 16 * n2 + fr) * 288 + (32 * m + 16 * t2 + 4 * fq) * 2) = o; }
        if (P4_TOUCHES && s + 3 < NS) { P4_TOUCH(s + 3); if (outp) asm volatile("s_waitcnt vmcnt(3)" ::: "memory"); else asm volatile("s_waitcnt vmcnt(1)" ::: "memory"); }
        else { if (outp) asm volatile("s_waitcnt vmcnt(2)" ::: "memory"); else asm volatile("s_waitcnt vmcnt(0)" ::: "memory"); }
        P4_BAR();
    }
    if (g < 3 && !kindP) { float* zt = (float*)(F.ws + WS_ZT) + (size_t)(chain * 4 + g) * 16384;
#pragma unroll
        for (int t2 = 0; t2 < 2; ++t2)
#pragma unroll
            for (int n2 = 0; n2 < 2; ++n2) *(f32x4*)(zt + (c0 + 32 * nh + 16 * n2 + fr) * 128 + 32 * m + 16 * t2 + 4 * fq) = S[t2][n2]; }
    if (kindP && g < 3) { bf16* xb = (bf16*)(F.ws + WS_XB) + (size_t)(chain * 4 + g) * 16384;
#pragma unroll
        for (int t2 = 0; t2 < 2; ++t2)
#pragma unroll
            for (int n2 = 0; n2 < 2; ++n2)
#pragma unroll
                for (int jj = 0; jj < 4; ++jj) xb[(32 * m + 16 * t2 + 4 * fq + jj) * 128 + c0 + 32 * nh + 16 * n2 + fr] = (bf16)f2bf(S[t2][n2][jj]); }
    VM_WAIT();
#undef P4_TOUCH
#undef P4_ISSUE
#undef P4_SLOT
#undef P4_BAR
}
__device__ __forceinline__ void p4b_correct(Frame& F) {
    if (F.vcu >= 192) return;
    const int chain = F.vcu / 12, g = 1 + (F.vcu % 12) / 4, qt = F.vcu & 3;
    const int b = chain >> 3, h = (chain >> 1) & 3, d = chain & 1;
    LAS bf16* Y = (LAS bf16*)F.lds;
    LAS bf16* Y2 = (LAS bf16*)(F.lds + 34816);
    LAS bf16* XL = (LAS bf16*)(F.lds + 69632);
    const float* ZT = (const float*)(F.ws + WS_ZT) + (size_t)chain * 4 * 16384; const bf16* XB = (const bf16*)(F.ws + WS_XB) + (size_t)chain * 4 * 16384;
    const int tid = F.tid, lane = F.lane, wave = F.wave, fr = lane & 15, fq = lane >> 4;
    for (int q = tid; q < 128 * 32; q += 512) { const int c = q >> 5, k4 = q & 31; const f32x4 z = *(const f32x4*)(ZT + c * 128 + 4 * k4); v2u o; o.x = pk2(z.x, z.y); o.y = pk2(z.z, z.w); *(LAS v2u*)(Y + c * 136 + 4 * k4) = o; }
    __syncthreads();
    LAS bf16* Yc = Y; LAS bf16* Yn = Y2;
#pragma unroll 1
    for (int gg = 1; gg < g; ++gg) {
        for (int q = tid; q < 128 * 16; q += 512) { const int rr = q >> 4, k8 = q & 15; *(LAS v4u*)(XL + rr * 136 + 8 * k8) = *(const v4u*)(XB + (size_t)gg * 16384 + rr * 128 + 8 * k8); }
        __syncthreads();
#pragma unroll 1
        for (int tn = 0; tn < 8; ++tn) { f32x4 acc = {0.f, 0.f, 0.f, 0.f}; acc = mma_tile(Yc, 136, 16 * wave, XL, 136, 16 * tn, 128, acc, lane);
#pragma unroll
            for (int jj = 0; jj < 4; ++jj) { const int col = 16 * wave + 4 * fq + jj, dk = 16 * tn + fr; Yn[col * 136 + dk] = (bf16)f2bf(acc[jj] + ZT[(size_t)gg * 16384 + col * 128 + dk]); } }
        __syncthreads();
        LAS bf16* t_ = Yc; Yc = Yn; Yn = t_;
    }
    bf16* OD = (bf16*)(F.ws + (d ? WS_CORRB : WS_CORRF)); const bf16* CB = (const bf16*)(F.ws + WS_CB);
    v4u cpre0, cpre1;
    { const bf16* cb0 = CB + ((size_t)(chain * 96 + (32 * g + 8 * qt - 32)) * 64) * 128; cpre0 = *(const v4u*)(cb0 + tid * 8); cpre1 = *(const v4u*)(cb0 + (tid + 512) * 8); }
#pragma unroll 1
    for (int cc = 0; cc < 8; ++cc) {
        const int sp = 32 * g + 8 * qt + cc, nn = d ? 127 - sp : sp;
        { const int q0 = tid, q1 = tid + 512; *(LAS v4u*)(XL + (q0 >> 4) * 136 + 8 * (q0 & 15)) = cpre0; *(LAS v4u*)(XL + (q1 >> 4) * 136 + 8 * (q1 & 15)) = cpre1; }
        if (cc + 1 < 8) { const int sp1 = sp + 1; const bf16* cb1 = CB + ((size_t)(chain * 96 + (sp1 - 32)) * 64) * 128; cpre0 = *(const v4u*)(cb1 + tid * 8); cpre1 = *(const v4u*)(cb1 + (tid + 512) * 8); }
        __syncthreads();
#pragma unroll 1
        for (int ti = 0; ti < 4; ++ti) { f32x4 acc = {0.f, 0.f, 0.f, 0.f}; acc = mma_tile(Yc, 136, 16 * wave, XL, 136, 16 * ti, 128, acc, lane);
            const int i = 16 * ti + fr, tl = d ? 63 - i : i; v2u w; w.x = pk2(acc[0], acc[1]); w.y = pk2(acc[2], acc[3]);
            *(v2u*)(OD + ((size_t)b * T + 64 * nn + tl) * 512 + h * 128 + 16 * wave + 4 * fq) = w; }
        __syncthreads();
    }
}
__device__ __forceinline__ void p5a_combine(Frame& F) {
    const bf16* OFp = (const bf16*)(F.ws + WS_OF); const bf16* OBp = (const bf16*)(F.ws + WS_OB); const bf16* Z = (const bf16*)(F.ws + WS_Z); bf16* MIX = (bf16*)(F.ws + WS_MIX);
    const int gw = F.vcu * NWAVES + F.wave, NGW = F.G * NWAVES, lane = F.lane;
    float gn[8];
#pragma unroll
    for (int e = 0; e < 8; ++e) gn[e] = F.gdn_norm_g[(lane & 15) * 8 + e];
    for (int mb = gw; mb < M; mb += 2 * NGW) {
        v4u a[2], bq[2], zz[2], cf[2], cbk[2];
#pragma unroll
        for (int u = 0; u < 2; ++u) { const int m = mb + u * NGW, tt = m & (T - 1);
            a[u] = *(const v4u*)(OFp + (size_t)m * 512 + lane * 8); bq[u] = *(const v4u*)(OBp + (size_t)m * 512 + lane * 8); zz[u] = *(const v4u*)(Z + (size_t)m * 512 + lane * 8);
            cf[u] = cbk[u] = (v4u){0u, 0u, 0u, 0u};
            if (tt >= 2048) cf[u] = *(const v4u*)((const bf16*)(F.ws + WS_CORRF) + (size_t)m * 512 + lane * 8);
            if (tt < 6144) cbk[u] = *(const v4u*)((const bf16*)(F.ws + WS_CORRB) + (size_t)m * 512 + lane * 8); }
#pragma unroll
        for (int u = 0; u < 2; ++u) { const int m = mb + u * NGW;
            float o[8]; float ss = 0.f;
#pragma unroll
            for (int e = 0; e < 4; ++e) { o[2 * e] = (bflo(a[u][e]) + bflo(bq[u][e])) + (bflo(cf[u][e]) + bflo(cbk[u][e])); o[2 * e + 1] = (bfhi(a[u][e]) + bfhi(bq[u][e])) + (bfhi(cf[u][e]) + bfhi(cbk[u][e])); ss += o[2 * e] * o[2 * e] + o[2 * e + 1] * o[2 * e + 1]; }
            ss += __shfl_xor(ss, 1); ss += __shfl_xor(ss, 2); ss += __shfl_xor(ss, 4); ss += __shfl_xor(ss, 8);
            const float rstd = 1.0f / sqrtf(ss * (1.0f / 128.0f) + EPS);
            float y[8];
#pragma unroll
            for (int e = 0; e < 4; ++e) { y[2 * e] = o[2 * e] * rstd * gn[2 * e] * silu_r(bflo(zz[u][e])); y[2 * e + 1] = o[2 * e + 1] * rstd * gn[2 * e + 1] * silu_r(bfhi(zz[u][e])); }
            v4u w; w.x = pk2(y[0], y[1]); w.y = pk2(y[2], y[3]); w.z = pk2(y[4], y[5]); w.w = pk2(y[6], y[7]);
            *(v4u*)(MIX + (size_t)m * 1024 + 512 + lane * 8) = w; }
    }
}
__device__ __forceinline__ void p6_phase(Frame& F) {
    const float* MOD = (const float*)(F.ws + WS_MOD); const float* H1 = (const float*)(F.ws + WS_H1); bf16* FIN = (bf16*)(F.ws + WS_FIN);
    float* AFF = (float*)(F.ws + WS_AFF); int* SEL = (int*)(F.ws + WS_SEL);
    LAS float* WR = (LAS float*)F.lds;
    for (int i = F.tid; i < 1024 * 4; i += 512) { const int k = i >> 2, q = i & 3; *(LAS f32x4*)(WR + k * 20 + q * 4) = *(const f32x4*)(F.w_router + k * 16 + q * 4); }
    __syncthreads();
    const int gw = F.vcu * NWAVES + F.wave, NGW = F.G * NWAVES, lane = F.lane;
#pragma unroll 1
    for (int b = 0; b < 2; ++b) {
        const float* mv = MOD + b * 6144;
        float sc[16], sh[16];
#pragma unroll
        for (int j = 0; j < 16; ++j) { const int k = lane + 64 * j; sc[j] = F.norm2_g[k] * (1.0f + mv[4096 + k]); sh[j] = mv[3072 + k]; }
        float vn[16];
        { const float* hr = H1 + (size_t)(b * T + gw) * D;
#pragma unroll
          for (int j = 0; j < 16; ++j) vn[j] = hr[lane + 64 * j]; }
        for (int m = b * T + gw; m < (b + 1) * T; m += NGW) {
            float v[16]; float ss = 0.f;
#pragma unroll
            for (int j = 0; j < 16; ++j) { v[j] = vn[j]; ss += v[j] * v[j]; }
            { const int mn = (m + NGW < (b + 1) * T) ? m + NGW : m; const float* hr = H1 + (size_t)mn * D;
#pragma unroll
              for (int j = 0; j < 16; ++j) vn[j] = hr[lane + 64 * j]; }
            const float rstd = 1.0f / sqrtf(wave_sum(ss) * (1.0f / D) + EPS);
            float lg[16];
#pragma unroll
            for (int e = 0; e < 16; ++e) lg[e] = 0.f;
            bf16* fr_ = FIN + (size_t)m * D;
#pragma unroll
            for (int j = 0; j < 16; ++j) { const float f = v[j] * rstd * sc[j] + sh[j]; fr_[lane + 64 * j] = (bf16)f2bf(f);
                const LAS float* wr = WR + (lane + 64 * j) * 20;
#pragma unroll
                for (int q = 0; q < 4; ++q) { const f32x4 w = *(const LAS f32x4*)(wr + 4 * q); lg[4 * q] += f * w.x; lg[4 * q + 1] += f * w.y; lg[4 * q + 2] += f * w.z; lg[4 * q + 3] += f * w.w; }
                asm volatile("" ::: "memory"); }
            float r8[8], r4[4], r2[2], r1;
#pragma unroll
            for (int e = 0; e < 8; ++e) { const bool hi = lane & 32; const float keep = hi ? lg[e + 8] : lg[e], give = hi ? lg[e] : lg[e + 8]; r8[e] = keep + __shfl_xor(give, 32); }
#pragma unroll
            for (int e = 0; e < 4; ++e) { const bool hi = lane & 16; const float keep = hi ? r8[e + 4] : r8[e], give = hi ? r8[e] : r8[e + 4]; r4[e] = keep + __shfl_xor(give, 16); }
#pragma unroll
            for (int e = 0; e < 2; ++e) { const bool hi = lane & 8; const float keep = hi ? r4[e + 2] : r4[e], give = hi ? r4[e] : r4[e + 2]; r2[e] = keep + __shfl_xor(give, 8); }
            { const bool hi = lane & 4; const float keep = hi ? r2[1] : r2[0], give = hi ? r2[0] : r2[1]; r1 = keep + __shfl_xor(give, 4); }
            r1 += __shfl_xor(r1, 2); r1 += __shfl_xor(r1, 1);
            const int eL = ((lane >> 5) & 1) * 8 + ((lane >> 4) & 1) * 4 + ((lane >> 3) & 1) * 2 + ((lane >> 2) & 1);
            const float lgt = r1 + F.b_router[eL];
            float mx = lgt; mx = fmaxf(mx, __shfl_xor(mx, 4)); mx = fmaxf(mx, __shfl_xor(mx, 8)); mx = fmaxf(mx, __shfl_xor(mx, 16)); mx = fmaxf(mx, __shfl_xor(mx, 32));
            const float ex = expf(lgt - mx); float den = ex; den += __shfl_xor(den, 4); den += __shfl_xor(den, 8); den += __shfl_xor(den, 16); den += __shfl_xor(den, 32);
            if ((lane & 3) == 0) AFF[((size_t)b * 16 + eL) * T + (m - b * T)] = ex / den;
            if (lane < 16) SEL[(size_t)m * 16 + lane] = -1;
        }
    }
}
__device__ __forceinline__ int block_excl_scan(int v, LAS int* tmp, int lane, int wave, int& total) {
    int inc = v;
#pragma unroll
    for (int o = 1; o < 64; o <<= 1) { const int y = __shfl_up(inc, o); if (lane >= o) inc += y; }
    if (lane == 63) tmp[wave] = inc;
    __syncthreads();
    int woff = 0, tot = 0;
#pragma unroll
    for (int w = 0; w < 8; ++w) { const int sv = tmp[w]; woff += (w < wave) ? sv : 0; tot += sv; }
    __syncthreads();
    total = tot; return woff + inc - v;
}
__device__ __forceinline__ void p7_topk(Frame& F) {
    const float* AFF = (const float*)(F.ws + WS_AFF); int* SEL = (int*)(F.ws + WS_SEL); int* IDX = (int*)(F.ws + WS_IDX); float* GATE = (float*)(F.ws + WS_GATE);
    LAS unsigned* vals = (LAS unsigned*)F.lds;
    LAS unsigned* hist = vals + 8192;
    LAS int* tmp = (LAS int*)(hist + 256);
    const int tid = F.tid, lane = F.lane, wave = F.wave;
    for (int u = F.vcu; u < 32; u += F.G) {
        const int b = u >> 4, e = u & 15; const float* ar = AFF + (size_t)u * T;
        for (int t = tid; t < T; t += 512) vals[t] = __builtin_bit_cast(unsigned, ar[t]);
        if (tid == 0) { tmp[8] = 0; tmp[9] = CAP; }
        __syncthreads();
#pragma unroll 1
        for (int pass = 0; pass < 4; ++pass) {
            const int shift = 24 - 8 * pass;
            if (tid < 256) hist[tid] = 0u;
            __syncthreads();
            const unsigned prefix = (unsigned)tmp[8], himask = pass == 0 ? 0u : (0xffffffffu << (shift + 8));
            for (int t = tid; t < T; t += 512) { const unsigned v = vals[t]; if ((v & himask) == prefix) __hip_atomic_fetch_add(hist + ((v >> shift) & 255u), 1u, __ATOMIC_RELAXED, __HIP_MEMORY_SCOPE_WORKGROUP); }
            __syncthreads();
            if (wave == 0) {
                const unsigned kth = (unsigned)tmp[9];
                const unsigned c0 = hist[255 - 4 * lane], c1 = hist[254 - 4 * lane], c2 = hist[253 - 4 * lane], c3 = hist[252 - 4 * lane], sm = c0 + c1 + c2 + c3;
                unsigned inc = sm;
#pragma unroll
                for (int o = 1; o < 64; o <<= 1) { const unsigned y = __shfl_up(inc, o); if (lane >= o) inc += y; }
                const unsigned exc = inc - sm;
                if (exc < kth && kth <= inc) { unsigned r = kth - exc; int bin;
                    if (r <= c0) bin = 255 - 4 * lane; else if (r <= c0 + c1) { bin = 254 - 4 * lane; r -= c0; } else if (r <= c0 + c1 + c2) { bin = 253 - 4 * lane; r -= c0 + c1; } else { bin = 252 - 4 * lane; r -= c0 + c1 + c2; }
                    tmp[8] = (int)(prefix | ((unsigned)bin << shift)); tmp[9] = (int)r; }
            }
            __syncthreads();
        }
        const unsigned thr = (unsigned)tmp[8]; const int kth = tmp[9];
        const int t0 = tid * 16; int cg = 0, ce = 0;
#pragma unroll
        for (int i = 0; i < 16; ++i) { const unsigned v = vals[t0 + i]; cg += (v > thr) ? 1 : 0; ce += (v == thr) ? 1 : 0; }
        int tot; const int eqb = block_excl_scan(ce, tmp, lane, wave, tot);
        int take = kth - eqb; take = take < 0 ? 0 : (take > ce ? ce : take);
        int pos = block_excl_scan(cg + take, tmp, lane, wave, tot); int eqseen = 0;
#pragma unroll 1
        for (int i = 0; i < 16; ++i) { const unsigned v = vals[t0 + i]; bool sel = v > thr; if (v == thr) { sel = eqseen < take; ++eqseen; }
            if (sel) { const int t = t0 + i; IDX[u * CAP + pos] = b * T + t; GATE[u * CAP + pos] = __builtin_bit_cast(float, v); SEL[((size_t)b * T + t) * 16 + e] = pos; ++pos; } }
        __syncthreads();
    }
}
__device__ __forceinline__ void p7b_gather(Frame& F) {
    const int* IDX = (const int*)(F.ws + WS_IDX); const bf16* FIN = (const bf16*)(F.ws + WS_FIN); bf16* XE = (bf16*)(F.ws + WS_XE);
    const int gw = F.vcu * NWAVES + F.wave, NGW = F.G * NWAVES, lane = F.lane;
    for (int r = gw; r < 32 * CAP; r += 2 * NGW) { const int r1 = r + NGW; const int src0 = IDX[r], src1 = IDX[r1];
        const v4u* sp0 = (const v4u*)(FIN + (size_t)src0 * D); const v4u* sp1 = (const v4u*)(FIN + (size_t)src1 * D); v4u* dp0 = (v4u*)(XE + (size_t)r * D); v4u* dp1 = (v4u*)(XE + (size_t)r1 * D);
        const v4u a = sp0[lane], c = sp0[lane + 64], e = sp1[lane], f = sp1[lane + 64]; dp0[lane] = a; dp0[lane + 64] = c; dp1[lane] = e; dp1[lane + 64] = f; }
}
__device__ __forceinline__ void p10_final(Frame& F) {
    const float* MOD = (const float*)(F.ws + WS_MOD); const float* H1 = (const float*)(F.ws + WS_H1); const bf16* YE = (const bf16*)(F.ws + WS_YE); const int* SEL = (const int*)(F.ws + WS_SEL);
    const int gw = F.vcu * NWAVES + F.wave, NGW = F.G * NWAVES, lane = F.lane;
#pragma unroll 1
    for (int b = 0; b < 2; ++b) {
        f32x4 gt[4], fg[4];
#pragma unroll
        for (int j = 0; j < 4; ++j) { gt[j] = *(const f32x4*)(MOD + b * 6144 + 5120 + 4 * lane + 256 * j); fg[j] = *(const f32x4*)(F.final_norm_g + 4 * lane + 256 * j); }
        for (int m0 = b * T + gw; m0 < (b + 1) * T; m0 += 2 * NGW) {
            const int m1 = m0 + NGW;
            const int sel0 = lane < 16 ? SEL[(size_t)m0 * 16 + lane] : -1, sel1 = lane < 16 ? SEL[(size_t)m1 * 16 + lane] : -1;
            f32x4 h0[4], h1v[4], a0[4], a1[4];
#pragma unroll
            for (int j = 0; j < 4; ++j) { h0[j] = *(const f32x4*)(H1 + (size_t)m0 * D + 4 * lane + 256 * j); h1v[j] = *(const f32x4*)(H1 + (size_t)m1 * D + 4 * lane + 256 * j); a0[j] = a1[j] = (f32x4){0.f, 0.f, 0.f, 0.f}; }
#pragma unroll 1
            for (int e = 0; e < 16; ++e) { const int c0_ = __shfl(sel0, e), c1_ = __shfl(sel1, e);
                if (c0_ >= 0 || c1_ >= 0) {
                    const bf16* y0 = YE + ((size_t)(b * 16 + e) * CAP + (c0_ >= 0 ? c0_ : 0)) * D + 4 * lane; const bf16* y1 = YE + ((size_t)(b * 16 + e) * CAP + (c1_ >= 0 ? c1_ : 0)) * D + 4 * lane;
                    v2u w0[4], w1[4];
#pragma unroll
                    for (int j = 0; j < 4; ++j) { w0[j] = *(const v2u*)(y0 + 256 * j); w1[j] = *(const v2u*)(y1 + 256 * j); }
                    const float k0 = c0_ >= 0 ? 1.f : 0.f, k1 = c1_ >= 0 ? 1.f : 0.f;
#pragma unroll
                    for (int j = 0; j < 4; ++j) { a0[j] += k0 * (f32x4){bflo(w0[j].x), bfhi(w0[j].x), bflo(w0[j].y), bfhi(w0[j].y)}; a1[j] += k1 * (f32x4){bflo(w1[j].x), bfhi(w1[j].x), bflo(w1[j].y), bfhi(w1[j].y)}; } } }
            float s0 = 0.f, s1 = 0.f;
#pragma unroll
            for (int j = 0; j < 4; ++j) { h0[j] += gt[j] * a0[j]; h1v[j] += gt[j] * a1[j];
                s0 += (h0[j].x * h0[j].x + h0[j].y * h0[j].y) + (h0[j].z * h0[j].z + h0[j].w * h0[j].w); s1 += (h1v[j].x * h1v[j].x + h1v[j].y * h1v[j].y) + (h1v[j].z * h1v[j].z + h1v[j].w * h1v[j].w); }
            const float r0 = 1.0f / sqrtf(wave_sum(s0) * (1.0f / D) + EPS), r1 = 1.0f / sqrtf(wave_sum(s1) * (1.0f / D) + EPS);
#pragma unroll
            for (int j = 0; j < 4; ++j) { *(f32x4*)(F.out + (size_t)m0 * D + 4 * lane + 256 * j) = h0[j] * r0 * fg[j]; *(f32x4*)(F.out + (size_t)m1 * D + 4 * lane + 256 * j) = h1v[j] * r1 * fg[j]; }
        }
    }
}
struct Args { const float* in[23]; float* out; unsigned char* ws; int ph_lo, ph_hi; };
__global__ void __launch_bounds__(NWAVES * 64, 2) fwd_kernel(Args args) {
    extern __shared__ __attribute__((aligned(16))) unsigned char lds_raw[];
    Frame F;
    F.lds = (LAS unsigned char*)lds_raw;
    volatile LAS unsigned* MISC = (volatile LAS unsigned*)(F.lds + MISC_OFF);
    F.tid = threadIdx.x; F.lane = F.tid & 63; F.wave = __builtin_amdgcn_readfirstlane(F.tid >> 6);
    F.G = gridDim.x; { const int bx = blockIdx.x; F.vcu = (F.G % 8 == 0) ? (bx % 8) * (F.G / 8) + bx / 8 : bx; }
    F.ws = args.ws; F.out = args.out;
    F.x = args.in[0]; F.c = args.in[1]; F.ctx = args.in[2]; F.c_ctx = args.in[3]; F.w_mod = args.in[4]; F.b_mod = args.in[5]; F.norm1_g = args.in[6]; F.norm2_g = args.in[7];
    F.w_in = args.in[8]; F.conv_w = args.in[9]; F.a_log = args.in[10]; F.dt_bias = args.in[11]; F.gdn_norm_g = args.in[12]; F.gm_norm_g = args.in[13]; F.gm_ws = args.in[14]; F.gm_bs = args.in[15];
    F.w_out = args.in[16]; F.w_router = args.in[17]; F.b_router = args.in[18]; F.w_gate = args.in[19]; F.w_up = args.in[20]; F.w_down = args.in[21]; F.final_norm_g = args.in[22];
    for (int u = F.tid; u < 64; u += NWAVES * 64) MISC[u] = 0u;
    __syncthreads();
    XcdBarrier bar; bar.bar = (unsigned*)(F.ws + WS_CTL) + CW_BAR; bar.x = 0; bar.st = nullptr;
    if (!MK_PER_PHASE) bar = xcd_barrier_post((unsigned*)(F.ws + WS_CTL) + CW_BAR, MISC + 8);
    const int lo = args.ph_lo, hi = args.ph_hi;
#define IN(k) (lo <= (k) && (k) < hi)
#define SEAM(k) do { if (IN(k) && IN((k) + 1)) xcd_barrier(bar); } while (0)
    if (IN(0)) { p0_phase(F); } SEAM(0);
    if (IN(1)) { p1_phase(F); } SEAM(1);
    if (IN(2)) {
        pg8::Gemm g{(const bf16*)(F.ws + WS_AIN), (const bf16*)(F.ws + WS_WIN), MA, 3328, D, 0, 0, 0, nullptr}; pg8::StaticOrder S; S.init(MA, 3328, F.G, (int)blockIdx.x);
        pg8::EpiInProj E{(bf16*)(F.ws + WS_QKV), (bf16*)(F.ws + WS_Z), (bf16*)(F.ws + WS_UV), (float*)(F.ws + WS_AB)};
        pg8::gemm_phase<pg8::EpiInProj, pg8::StaticOrder, PG8_ALIGN, PG8_SP2>(F.lds, g, S, E);
    } SEAM(2);
    if (IN(3)) { p3_phase(F); } SEAM(3);
    if (IN(4)) { p4_scan(F); } SEAM(4);
    if (IN(5)) { p4b_correct(F); __syncthreads(); wgu_convert(F); } SEAM(5);
    if (IN(6)) { p5a_combine(F); } SEAM(6);
    if (IN(7)) {
        pg8::Gemm g{(const bf16*)(F.ws + WS_MIX), (const bf16*)(F.ws + WS_WOUT), M, D, D, 0, 0, 0, nullptr}; pg8::StaticOrder S; S.init(M, D, F.G, (int)blockIdx.x);
        pg8::EpiOutProj E{F.x, (const float*)(F.ws + WS_MOD), (float*)(F.ws + WS_H1)};
        pg8::gemm_phase<pg8::EpiOutProj, pg8::StaticOrder, PG8_ALIGN, PG8_SP2>(F.lds, g, S, E);
    } SEAM(7);
    if (IN(8)) { p6_phase(F); } SEAM(8);
    if (IN(9)) { p7_topk(F); wd_convert(F); } SEAM(9);
    if (IN(10)) {
        pg8::Gemm g{(const bf16*)(F.ws + WS_FIN), (const bf16*)(F.ws + WS_WGU), 32 * CAP, 2 * FF, D, (size_t)2 * FF * D * 2, 2, 15, (const int*)(F.ws + WS_IDX)};     pg8::StaticOrder S; S.init(32 * CAP, 2 * FF, F.G, (int)blockIdx.x);
        pg8::EpiSwiGLU E{(bf16*)(F.ws + WS_HID)};
        pg8::gemm_phase<pg8::EpiSwiGLU, pg8::StaticOrder, PG8_ALIGN, PG8_SP2, true>(F.lds, g, S, E, F.lds + 131072);
    } SEAM(10);
    if (IN(11)) {
        pg8::Gemm g{(const bf16*)(F.ws + WS_HID), (const bf16*)(F.ws + WS_WD), 32 * CAP, D, FF, (size_t)D * FF * 2, 2, 15, nullptr}; pg8::StaticOrder S; S.init(32 * CAP, D, F.G, (int)blockIdx.x);
        pg8::EpiDown E{(bf16*)(F.ws + WS_YE), (const float*)(F.ws + WS_GATE)};
        pg8::gemm_phase<pg8::EpiDown, pg8::StaticOrder, PG8_ALIGN, PG8_SP2>(F.lds, g, S, E);
    } SEAM(11);
    if (IN(12)) { p10_final(F); }
#undef IN
#undef SEAM
}

extern "C" void kernel_launch(void* const* d_in, const int* in_sizes, int n_in, void* d_out, int out_size, void* d_ws, size_t ws_size, hipStream_t stream) {
    static int grid = 0;
    if (grid == 0) {
        if (n_in != 23 || out_size != M * D || ws_size < WS_END) { fprintf(stderr, "kernel_launch: unexpected problem (n_in %d, out %d, ws %zu)\n", n_in, out_size, ws_size); grid = -1; return; }
        int dev = 0, cus = 0;
        if (hipGetDevice(&dev) != hipSuccess || hipDeviceGetAttribute(&cus, hipDeviceAttributeMultiprocessorCount, dev) != hipSuccess) { grid = -1; return; }
        if (hipFuncSetAttribute((const void*)fwd_kernel, hipFuncAttributeMaxDynamicSharedMemorySize, LDS_BYTES) != hipSuccess) { fprintf(stderr, "kernel_launch: hipFuncSetAttribute failed\n"); grid = -1; return; }
        grid = cus;
    }
    if (grid < 0) return;
    if (hipMemsetAsync((char*)d_ws + WS_CTL, 0, CTL_ZERO_BYTES, stream) != hipSuccess) return;
    Args a{};
    for (int i = 0; i < 23; ++i) a.in[i] = (const float*)d_in[i];
    a.out = (float*)d_out; a.ws = (unsigned char*)d_ws;
#if MK_PER_PHASE
    for (int p = 0; p < NPHASE; ++p) { a.ph_lo = p; a.ph_hi = p + 1; hipLaunchKernelGGL(fwd_kernel, dim3(grid), dim3(NWAVES * 64), LDS_BYTES, stream, a); }
#else
    a.ph_lo = 0; a.ph_hi = NPHASE;
    hipLaunchKernelGGL(fwd_kernel, dim3(grid), dim3(NWAVES * 64), LDS_BYTES, stream, a);
#endif
}
```

```cpp
#include <hip/hip_runtime.h>
#include <cstdio>
#include <cstdint>
namespace pg8 {
#define PG8_LAS __attribute__((address_space(3)))
typedef unsigned short bf16_t;
typedef short bf16x8 __attribute__((ext_vector_type(8)));
typedef float f32x4 __attribute__((ext_vector_type(4)));
typedef unsigned u32x4 __attribute__((ext_vector_type(4)));
constexpr int BM = 256, BK = 64, HALF = 128, HTB = HALF * BK * 2  , STAGE_BYTES = 8 * HTB, NXCD = 8, WGM = 8;

__host__ __device__ __forceinline__ int lds_byte(int r, int c) { const int st = (r >> 4) * 2 + (c >> 5), rr = r & 15, cc = c & 31, ob = rr * 64 + cc * 2; return st * 1024 + (ob ^ (((ob >> 9) & 1) << 5)); }
__host__ __device__ __forceinline__ void stage_rc(int b, int& R, int& C) { const int st = b / 1024, sb = b % 1024, swz = sb ^ (((sb >> 9) & 1) << 5); R = (st >> 1) * 16 + swz / 64; C = (st & 1) * 32 + (swz % 64) / 2; }
__host__ __device__ __forceinline__ int perm32(int rho) { const int n = rho >> 4, i = rho & 15; return 8 * (i >> 2) + 4 * n + (i & 3); }

struct Unit { int pm, pn; };
struct Gemm { const bf16_t* A; const bf16_t* Bt; int M, N, K; size_t bgs; int gsh, gmask; const int* gidx; };

struct ListOrder { int c;
    __device__ __forceinline__ bool next(int i, Unit& u) const { if (i > 0 || c >= 14) return false; if (c < 2) { u.pm = 64 + c; u.pn = 12; } else { u.pm = 64 + (c - 2) / 6; u.pn = (c - 2) % 6; } return true; }
    __device__ __forceinline__ void a_ready(const Unit&) const {}
    __device__ __forceinline__ void done(const Unit&) const {} };
struct GroupOrder {
    int v;
    __host__ __device__ bool next(int i, Unit& u) const { if (i > 0) return false; u.pm = v >> 2; u.pn = v & 3; return true; }
    __device__ __forceinline__ void a_ready(const Unit&) const {}
    __device__ __forceinline__ void done(const Unit&) const {}
};
struct StaticOrder {
    int nM, nN, nwg, G, c, wgm;
    __host__ __device__ void init(int M, int N, int G_, int c_, int wgm_ = WGM) { nM = M / BM; nN = N / BM; nwg = nM * nN; G = G_; c = c_; wgm = wgm_; }
    __host__ __device__ bool next(int i, Unit& u) const {
        const long L = (long)i * G + c; if (L >= nwg) return false;
        int wgid = (int)L; { const int q = nwg / NXCD, r = nwg % NXCD, xcd = wgid % NXCD, off = wgid / NXCD; wgid = (xcd < r ? xcd * (q + 1) : r * (q + 1) + (xcd - r) * q) + off; }
        const int nig = wgm * nN, gid = wgid / nig, fm = gid * wgm, gsz = (nM - fm) < wgm ? (nM - fm) : wgm;
        u.pm = fm + ((wgid % nig) % gsz); u.pn = (wgid % nig) / gsz; return true;
    }
    __device__ __forceinline__ void a_ready(const Unit&) const {}
    __device__ __forceinline__ void done(const Unit&) const {}
};

__device__ __forceinline__ unsigned cvt_pk_bf16(float lo, float hi) { unsigned r; asm volatile("v_cvt_pk_bf16_f32 %0, %1, %2" : "=v"(r) : "v"(lo), "v"(hi)); return r; }
typedef float f32x2 __attribute__((ext_vector_type(2)));
__device__ __forceinline__ f32x2 gelu_pk(f32x2 v) {
    const f32x2 av = __builtin_elementwise_abs(v), d = av * 0.2316418882f + 1.0f;
    f32x2 t; t.x = __builtin_amdgcn_rcpf(d.x); t.y = __builtin_amdgcn_rcpf(d.y);
    f32x2 q = t * 0.5307027145f + (-0.7265760135f); q = q * t + 0.7107068705f; q = q * t + (-0.142248368f); q = q * t + 0.127414796f; q = q * t;
    const f32x2 s = (v * v) * (-0.72134752044f);
    f32x2 e; e.x = __builtin_amdgcn_exp2f(s.x); e.y = __builtin_amdgcn_exp2f(s.y);
    const f32x2 m = v * (q * e), r = v - m;
    f32x2 o; o.x = v.x < 0.f ? m.x : r.x; o.y = v.y < 0.f ? m.y : r.y; return o;
}
__device__ __forceinline__ float silu_f(float x) { return x * __builtin_amdgcn_rcpf(1.0f + __expf(-x)); }
__device__ __forceinline__ void st8(bf16_t* p, const f32x4 v0, const f32x4 v1) { u32x4 w; w.x = cvt_pk_bf16(v0[0], v0[1]); w.y = cvt_pk_bf16(v0[2], v0[3]); w.z = cvt_pk_bf16(v1[0], v1[1]); w.w = cvt_pk_bf16(v1[2], v1[3]);
    *(u32x4*)p = w; }
__device__ __forceinline__ void st8_nt(bf16_t* p, const f32x4 v0, const f32x4 v1) { u32x4 w; w.x = cvt_pk_bf16(v0[0], v0[1]); w.y = cvt_pk_bf16(v0[2], v0[3]); w.z = cvt_pk_bf16(v1[0], v1[1]); w.w = cvt_pk_bf16(v1[2], v1[3]);
    __builtin_nontemporal_store(w, (u32x4*)p); }
__device__ __forceinline__ void st4f_wt(float* p, const f32x4 v) { *(f32x4*)p = v; }
struct EpiInProj {
    static constexpr bool PERM = true, AFTER_DRAIN = false;
    bf16_t* QKV; bf16_t* Z; bf16_t* UV; float* AB;
    __device__ __forceinline__ void operator()(const f32x4 (&acc)[2][2][4][2], const Unit& u, int wr, int wc, int fr, int fq) const {
        const int row0 = u.pm * BM + wr * 64 + fr, pn = u.pn;
        if (pn == 12) {
            if (wc == 0 && fq < 2) {
#pragma unroll
                for (int ai = 0; ai < 2; ++ai)
#pragma unroll
                    for (int m = 0; m < 4; ++m) { float* p = AB + (size_t)(row0 + ai * HALF + m * 16) * 16 + 8 * fq; *(f32x4*)p = acc[ai][0][m][0]; *(f32x4*)(p + 4) = acc[ai][0][m][1]; }
            }
            return;
        }
        bf16_t* base; int ldc, colt; bool act = false;
        if (pn < 6) { base = QKV; ldc = 1536; colt = pn * 256; }
        else { if (u.pm >= 64) return; if (pn < 8) { base = Z; ldc = 512; colt = (pn - 6) * 256; } else { base = UV; ldc = 1024; colt = (pn - 8) * 256; act = true; } }
        const int col0 = colt + wc * 32 + 8 * fq;
#pragma unroll
        for (int ai = 0; ai < 2; ++ai)
#pragma unroll
            for (int m = 0; m < 4; ++m) { bf16_t* rowp = base + (size_t)(row0 + ai * HALF + m * 16) * ldc + col0;
#pragma unroll
                for (int bj = 0; bj < 2; ++bj) { f32x4 v0 = acc[ai][bj][m][0], v1 = acc[ai][bj][m][1];
                    if (act) { f32x2 a = gelu_pk((f32x2){v0[0], v0[1]}), b = gelu_pk((f32x2){v0[2], v0[3]}), c = gelu_pk((f32x2){v1[0], v1[1]}), d = gelu_pk((f32x2){v1[2], v1[3]});
                        v0 = (f32x4){a.x, a.y, b.x, b.y}; v1 = (f32x4){c.x, c.y, d.x, d.y}; }
                    if (pn == 6 || pn == 7) st8_nt(rowp + bj * HALF, v0, v1); else st8(rowp + bj * HALF, v0, v1); } }
    }
};
struct EpiOutProj {
    static constexpr bool PERM = true, AFTER_DRAIN = false;
    const float* mod; bf16_t* G1;
    __device__ __forceinline__ void operator()(const f32x4 (&acc)[2][2][4][2], const Unit& u, int wr, int wc, int fr, int fq) const {
        const int row0 = u.pm * BM + wr * 64 + fr, col0 = u.pn * BM + wc * 32 + 8 * fq; const float* gt = mod + (u.pm >= 32 ? 6144 : 0) + 2048;
        f32x4 gv[2][2];
#pragma unroll
        for (int bj = 0; bj < 2; ++bj)
#pragma unroll
            for (int n = 0; n < 2; ++n) gv[bj][n] = *(const f32x4*)(gt + col0 + bj * HALF + 4 * n);
#pragma unroll
        for (int ai = 0; ai < 2; ++ai)
#pragma unroll
            for (int m = 0; m < 4; ++m) { bf16_t* rowp = G1 + (size_t)(row0 + ai * HALF + m * 16) * 1024 + col0;
#pragma unroll
                for (int bj = 0; bj < 2; ++bj) st8(rowp + bj * HALF, gv[bj][0] * acc[ai][bj][m][0], gv[bj][1] * acc[ai][bj][m][1]); }
    }
};
struct EpiSwiGLU {
    static constexpr bool PERM = true, AFTER_DRAIN = false;
    bf16_t* HID;
    __device__ __forceinline__ void operator()(const f32x4 (&acc)[2][2][4][2], const Unit& u, int wr, int wc, int fr, int fq) const {
        const int row0 = u.pm * BM + wr * 64 + fr, col0 = u.pn * HALF + wc * 32 + 8 * fq;
#pragma unroll
        for (int ai = 0; ai < 2; ++ai)
#pragma unroll
            for (int m = 0; m < 4; ++m) { bf16_t* rowp = HID + (size_t)(row0 + ai * HALF + m * 16) * 1024 + col0; f32x4 h0, h1;
#pragma unroll
                for (int j = 0; j < 4; ++j) { h0[j] = silu_f(acc[ai][0][m][0][j]) * acc[ai][1][m][0][j]; h1[j] = silu_f(acc[ai][0][m][1][j]) * acc[ai][1][m][1][j]; }
                st8(rowp, h0, h1); }
    }
};
struct EpiDown {
    static constexpr bool PERM = true, AFTER_DRAIN = false;
    bf16_t* YE; const float* gate;
    __device__ __forceinline__ void operator()(const f32x4 (&acc)[2][2][4][2], const Unit& u, int wr, int wc, int fr, int fq) const {
        const int row0 = u.pm * BM + wr * 64 + fr, col0 = u.pn * BM + wc * 32 + 8 * fq;
#pragma unroll
        for (int ai = 0; ai < 2; ++ai)
#pragma unroll
            for (int m = 0; m < 4; ++m) { const int row = row0 + ai * HALF + m * 16; const float gv = gate[row]; bf16_t* rowp = YE + (size_t)row * 1024 + col0;
#pragma unroll
                for (int bj = 0; bj < 2; ++bj) st8(rowp + bj * HALF, acc[ai][bj][m][0] * gv, acc[ai][bj][m][1] * gv); }
    }
};
template <class Epi, class Sched, bool ALIGN_EPI = false, bool SP2 = false, bool GATHER = false>
__device__ __forceinline__ void gemm_phase(PG8_LAS unsigned char* lds, const Gemm g, const Sched& S, const Epi& E, PG8_LAS unsigned char* idx_lds = nullptr) {
    static_assert(!GATHER || SP2, "the gathered-A form exists only for the SP2 loop");
    const int tid = threadIdx.x, wid = __builtin_amdgcn_readfirstlane(tid >> 6), lane = tid & 63, wr = wid >> 2, wc = wid & 3, fr = lane & 15, fq = lane >> 4;
    const int K = g.K, nt = K / BK;
    unsigned voffA[2], voffB[2], colA2[2]; int rowA[2];
#pragma unroll
    for (int i = 0; i < 2; ++i) { int R, C; stage_rc(tid * 16 + i * 8192, R, C); const int Rb = Epi::PERM ? ((R & ~31) + perm32(R & 31)) : R;
        voffA[i] = (unsigned)(R * K + C) * 2u; voffB[i] = (unsigned)(Rb * K + C) * 2u; rowA[i] = R; colA2[i] = (unsigned)C * 2u; }
    unsigned gc[2][2] = {{0u, 0u}, {0u, 0u}}, gn[2][2] = {{0u, 0u}, {0u, 0u}};
    const size_t kstep = (size_t)(BK * 2);
    const size_t hstep = (size_t)HALF * K * 2;
    const size_t tstep = 2 * hstep;
    const unsigned ldsw = (unsigned)wid * 1024u;
    const int aoff = lds_byte(wr * 64 + fr, fq * 8), boff = lds_byte(wc * 32 + fr, fq * 8);
#define PG8_SA(b, h) (((b) * 2 + (h)) * HTB)
#define PG8_SB(b, h) ((4 + (b) * 2 + (h)) * HTB)
#define PG8_STAGE(bufoff, gbase, voff) do { _Pragma("unroll") for (int _i = 0; _i < 2; ++_i) \
        __builtin_amdgcn_global_load_lds((const unsigned*)((const char*)(gbase) + (voff)[_i]), (PG8_LAS unsigned*)(lds + (bufoff) + ldsw + _i * 8192), 16, 0, 0); } while (0)
#define PG8_STAGE_A(bufoff, ptr, hh, offs) do { if constexpr (GATHER) { PG8_STAGE(bufoff, ptr, offs[hh]); } else { PG8_STAGE(bufoff, (ptr) + (hh) * hstep, voffA); } } while (0)
#define PG8_GOFFS(dst, bufi) do { _Pragma("unroll") for (int h_ = 0; h_ < 2; ++h_) _Pragma("unroll") for (int i_ = 0; i_ < 2; ++i_) \
        dst[h_][i_] = (unsigned)(((const PG8_LAS int*)(idx_lds + (bufi) * 1024))[h_ * HALF + rowA[i_]]) * (unsigned)(K * 2) + colA2[i_]; } while (0)
#define PG8_IDX_ISSUE(unit, bufi) do { if (wid == 0) __builtin_amdgcn_global_load_lds((const unsigned*)(g.gidx + (size_t)(unit).pm * BM + lane * 4), (PG8_LAS unsigned*)(idx_lds + (bufi) * 1024), 16, 0, 0); } while (0)
#define PG8_LDA(dst, b, h) do { _Pragma("unroll") for (int m = 0; m < 4; ++m) _Pragma("unroll") for (int k = 0; k < 2; ++k) dst[m][k] = *(const PG8_LAS bf16x8*)(lds + PG8_SA(b, h) + aoff + m * 2048 + k * 1024); } while (0)
#define PG8_LDB(dst, b, h) do { _Pragma("unroll") for (int n = 0; n < 2; ++n) _Pragma("unroll") for (int k = 0; k < 2; ++k) dst[n][k] = *(const PG8_LAS bf16x8*)(lds + PG8_SB(b, h) + boff + n * 2048 + k * 1024); } while (0)
#define PG8_MMA(ai, bj, At, Bt) do { __builtin_amdgcn_s_setprio(1); _Pragma("unroll") for (int m = 0; m < 4; ++m) _Pragma("unroll") for (int n = 0; n < 2; ++n) _Pragma("unroll") for (int k = 0; k < 2; ++k) \
        acc[ai][bj][m][n] = __builtin_amdgcn_mfma_f32_16x16x32_bf16(Bt[n][k], At[m][k], acc[ai][bj][m][n], 0, 0, 0); __builtin_amdgcn_s_setprio(0); } while (0)
#define PG8_WAIT_V(n) asm volatile("s_waitcnt vmcnt(" #n ")" ::: "memory")
#define PG8_WAIT_L(n) asm volatile("s_waitcnt lgkmcnt(" #n ")" ::: "memory")
#define PG8_BAR __builtin_amdgcn_s_barrier()
#define PG8_SCHED __builtin_amdgcn_sched_barrier(0)
    Unit cur, nxt; int ui = 0;
    if (!S.next(0, cur)) return;
    f32x4 acc[2][2][4][2];
#pragma unroll
    for (int a = 0; a < 2; ++a)
#pragma unroll
        for (int b = 0; b < 2; ++b)
#pragma unroll
            for (int m = 0; m < 4; ++m)
#pragma unroll
                for (int n = 0; n < 2; ++n) acc[a][b][m][n] = (f32x4){0.f, 0.f, 0.f, 0.f};
    bf16x8 At[4][2], B0[2][2], B1[2][2];
    const char* cA = (const char*)g.A + (size_t)cur.pm * tstep; const char* cB = (const char*)g.Bt + (size_t)((cur.pm >> g.gsh) & g.gmask) * g.bgs + (size_t)cur.pn * tstep;
    if constexpr (GATHER) { cA = (const char*)g.A;
        PG8_IDX_ISSUE(cur, 0); asm volatile("s_waitcnt vmcnt(0)" ::: "memory"); PG8_BAR; PG8_GOFFS(gc, 0); asm volatile("s_waitcnt lgkmcnt(0)" ::: "memory"); }
    S.a_ready(cur);
    if constexpr (SP2) {
        PG8_STAGE(PG8_SB(0, 0), cB, voffB); PG8_STAGE(PG8_SB(0, 1), cB + hstep, voffB); PG8_STAGE_A(PG8_SA(0, 0), cA, 0, gc); PG8_STAGE_A(PG8_SA(0, 1), cA, 1, gc);
        if (wr == 1) PG8_BAR;
        PG8_WAIT_V(2); PG8_BAR;
        PG8_STAGE(PG8_SB(1, 0), cB + kstep, voffB); PG8_STAGE_A(PG8_SA(1, 0), cA + kstep, 0, gc); PG8_STAGE(PG8_SB(1, 1), cB + hstep + kstep, voffB);
        PG8_WAIT_V(6); PG8_BAR;
    } else {
        PG8_STAGE(PG8_SB(0, 0), cB, voffB); PG8_STAGE(PG8_SA(0, 0), cA, voffA); PG8_STAGE(PG8_SB(0, 1), cB + hstep, voffB); PG8_STAGE(PG8_SA(0, 1), cA + hstep, voffA);
        if (wr == 1) PG8_BAR;
        PG8_WAIT_V(4); PG8_BAR;
        PG8_STAGE(PG8_SB(1, 0), cB + kstep, voffB); PG8_STAGE(PG8_SA(1, 0), cA + kstep, voffA); PG8_STAGE(PG8_SB(1, 1), cB + hstep + kstep, voffB);
        PG8_WAIT_V(6); PG8_BAR;
    }
    for (;;) {
        const bool has_next = S.next(ui + 1, nxt);
        const char* nA = GATHER ? (const char*)g.A : (has_next ? (const char*)g.A + (size_t)nxt.pm * tstep : cA);
        if constexpr (GATHER) { if (has_next) PG8_IDX_ISSUE(nxt, (ui + 1) & 1); }
        const char* nB = has_next ? (const char*)g.Bt + (size_t)((nxt.pm >> g.gsh) & g.gmask) * g.bgs + (size_t)nxt.pn * tstep : cB;
        for (int t = 0; t < nt; t += 2) {
            const bool last = (t == nt - 2);
            const char* a1 = cA + (size_t)(t + 1) * kstep;
            const char* a2 = last ? nA : cA + (size_t)(t + 2) * kstep; const char* b2 = last ? nB : cB + (size_t)(t + 2) * kstep;
            const char* a3 = a2 + kstep; const char* b3 = b2 + kstep;
            if (last && has_next) S.a_ready(nxt);
            unsigned g2[2][2] = {{gc[0][0], gc[0][1]}, {gc[1][0], gc[1][1]}};
            if constexpr (GATHER) { if (last && has_next) { PG8_GOFFS(gn, (ui + 1) & 1); g2[0][0] = gn[0][0]; g2[0][1] = gn[0][1]; g2[1][0] = gn[1][0]; g2[1][1] = gn[1][1]; } }
            if constexpr (SP2) {
            PG8_LDB(B0, 0, 0); PG8_LDB(B1, 0, 1); PG8_SCHED; PG8_LDA(At, 0, 0); PG8_STAGE_A(PG8_SA(1, 1), a1, 1, gc);
            PG8_WAIT_V(8); PG8_WAIT_L(0); PG8_BAR; PG8_MMA(0, 0, At, B0); PG8_MMA(0, 1, At, B1); PG8_BAR; PG8_SCHED;
            PG8_LDA(At, 0, 1); PG8_STAGE(PG8_SB(0, 0), b2, voffB); PG8_STAGE(PG8_SB(0, 1), b2 + hstep, voffB); PG8_STAGE_A(PG8_SA(0, 0), a2, 0, g2);
            PG8_WAIT_V(8); PG8_WAIT_L(0); PG8_BAR; PG8_MMA(1, 0, At, B0); PG8_MMA(1, 1, At, B1); PG8_BAR; PG8_SCHED;
            PG8_LDB(B0, 1, 0); PG8_LDB(B1, 1, 1); PG8_SCHED; PG8_LDA(At, 1, 0); PG8_STAGE_A(PG8_SA(0, 1), a2, 1, g2);
            PG8_WAIT_V(8); PG8_WAIT_L(0); PG8_BAR; PG8_MMA(0, 0, At, B0); PG8_MMA(0, 1, At, B1); PG8_BAR; PG8_SCHED;
            PG8_LDA(At, 1, 1); PG8_STAGE(PG8_SB(1, 0), b3, voffB); PG8_STAGE(PG8_SB(1, 1), b3 + hstep, voffB); PG8_STAGE_A(PG8_SA(1, 0), a3, 0, g2);
            PG8_WAIT_V(8); PG8_WAIT_L(0); PG8_BAR; PG8_MMA(1, 0, At, B0); PG8_MMA(1, 1, At, B1); PG8_BAR; PG8_SCHED;
            } else {
            PG8_LDB(B0, 0, 0); PG8_SCHED; PG8_LDA(At, 0, 0); PG8_STAGE(PG8_SA(1, 1), a1 + hstep, voffA);
            PG8_WAIT_L(8); PG8_BAR; PG8_WAIT_L(0); PG8_MMA(0, 0, At, B0); PG8_BAR; PG8_SCHED;
            PG8_LDB(B1, 0, 1); PG8_STAGE(PG8_SB(0, 0), b2, voffB);
            PG8_BAR; PG8_WAIT_L(0); PG8_MMA(0, 1, At, B1); PG8_BAR;
            PG8_LDA(At, 0, 1); PG8_STAGE(PG8_SA(0, 0), a2, voffA);
            PG8_BAR; PG8_WAIT_L(0); PG8_MMA(1, 0, At, B0); PG8_BAR; PG8_SCHED;
            PG8_STAGE(PG8_SB(0, 1), b2 + hstep, voffB);
            PG8_WAIT_V(6); PG8_BAR; PG8_MMA(1, 1, At, B1); PG8_BAR;
            PG8_LDB(B0, 1, 0); PG8_SCHED; PG8_LDA(At, 1, 0); PG8_STAGE(PG8_SA(0, 1), a2 + hstep, voffA);
            PG8_WAIT_L(8); PG8_BAR; PG8_WAIT_L(0); PG8_MMA(0, 0, At, B0); PG8_BAR; PG8_SCHED;
            PG8_LDB(B1, 1, 1); PG8_STAGE(PG8_SB(1, 0), b3, voffB);
            PG8_BAR; PG8_WAIT_L(0); PG8_MMA(0, 1, At, B1); PG8_BAR;
            PG8_LDA(At, 1, 1); PG8_STAGE(PG8_SA(1, 0), a3, voffA);
            PG8_BAR; PG8_WAIT_L(0); PG8_MMA(1, 0, At, B0); PG8_BAR; PG8_SCHED;
            PG8_STAGE(PG8_SB(1, 1), b3 + hstep, voffB);
            PG8_WAIT_V(6); PG8_BAR; PG8_MMA(1, 1, At, B1); PG8_BAR;
            }
        }
        if constexpr (ALIGN_EPI) { if (wr == 0) PG8_BAR; }
        if constexpr (!Epi::AFTER_DRAIN) { E(acc, cur, wr, wc, fr, fq); S.done(cur); }
        if (!has_next) break;
#pragma unroll
        for (int a = 0; a < 2; ++a)
#pragma unroll
            for (int b = 0; b < 2; ++b)
#pragma unroll
                for (int m = 0; m < 4; ++m)
#pragma unroll
                    for (int n = 0; n < 2; ++n) acc[a][b][m][n] = (f32x4){0.f, 0.f, 0.f, 0.f};
        cur = nxt; cA = nA; cB = nB; ++ui;
        if constexpr (GATHER) { gc[0][0] = gn[0][0]; gc[0][1] = gn[0][1]; gc[1][0] = gn[1][0]; gc[1][1] = gn[1][1]; }
        if constexpr (ALIGN_EPI) { if (wr == 1) PG8_BAR; }
    }
    PG8_WAIT_V(0);
    if constexpr (!ALIGN_EPI) { if (wr == 0) PG8_BAR; }
    PG8_BAR;
    if constexpr (Epi::AFTER_DRAIN) { E.fused(acc, cur, wr, wc, fr, fq, lds, wid, lane); S.done(cur); }
#undef PG8_SA
#undef PG8_SB
#undef PG8_STAGE
#undef PG8_LDA
#undef PG8_STAGE_A
#undef PG8_GOFFS
#undef PG8_IDX_ISSUE
#undef PG8_LDB
#undef PG8_MMA
#undef PG8_WAIT_V
#undef PG8_WAIT_L
#undef PG8_BAR
#undef PG8_SCHED
}
}
#ifndef PG8_SP2
#define PG8_SP2 true
#endif
#ifndef PG8_ALIGN
#define PG8_ALIGN true
#endif
constexpr int NWAVES = 8;
#ifndef MK_PER_PHASE
#define MK_PER_PHASE 0
#endif
constexpr int NPHASE = 10;
constexpr int BATCH = 2, T = 8192, D = 1024, TC = 256, M = BATCH * T, MC = BATCH * TC, MA = M + MC;
constexpr int NEXP = 16, CAP = 1024, FF = 1024;
constexpr float EPS = 1e-6f;
constexpr size_t MiB = 1u << 20;
constexpr size_t WS_CTL = 0, CTL_ZERO_BYTES = 32768;
constexpr size_t WS_MOD = 1 * MiB;
constexpr size_t WS_ATB = 640 * 1024;
constexpr size_t WS_RTB = 512 * 1024;
constexpr size_t WS_EGL = 1 * MiB + 128 * 1024;
constexpr size_t WS_IDX = 1 * MiB + 512 * 1024;
constexpr size_t WS_GATE = WS_IDX + 128 * 1024;
constexpr size_t WS_AFF = 2 * MiB;
constexpr size_t WS_SEL = 3 * MiB;
constexpr size_t WS_WIN = 4 * MiB;
constexpr size_t WS_WOUT = 11 * MiB;
constexpr size_t WS_AIN = 260 * MiB;
constexpr size_t WS_MIX = 13 * MiB;
constexpr size_t WS_FIN = 13 * MiB;
constexpr size_t WS_QKV = 46 * MiB;
constexpr size_t WS_OF = 46 * MiB, WS_OB = 62 * MiB;
constexpr size_t WS_Z = 96 * MiB;
constexpr size_t WS_UV = 112 * MiB;
constexpr size_t WS_AB = 144 * MiB;
constexpr size_t WS_GDN = 146 * MiB;
constexpr size_t GDN_UNIT = 73728;
constexpr size_t WS_WGU = 142 * MiB;
constexpr size_t WS_H1 = 232 * MiB;
constexpr size_t WS_XE = 68 * MiB;
constexpr size_t WS_HID = 78 * MiB;
constexpr size_t WS_WD = 46 * MiB;
constexpr size_t WS_YE = 142 * MiB;
constexpr size_t WS_END = 296 * MiB;
static_assert(WS_GDN + 2112 * GDN_UNIT <= WS_END && WS_AB + (size_t)MA * 64 <= WS_GDN && WS_QKV + (size_t)MA * 3072 <= WS_Z, "ws map");
constexpr int CW_BAR = 4096;
constexpr int LDS_BYTES = 163840;
constexpr int MISC_OFF = LDS_BYTES - 256;
#define LAS __attribute__((address_space(3)))
#define GAS __attribute__((address_space(1)))
typedef unsigned short bf16;
typedef unsigned v4u __attribute__((ext_vector_type(4)));
typedef unsigned v2u __attribute__((ext_vector_type(2)));
typedef float f32x4 __attribute__((ext_vector_type(4)));
typedef short bf16x8 __attribute__((ext_vector_type(8)));
typedef short bf16x4 __attribute__((ext_vector_type(4)));
#define LDS_WAIT() asm volatile("s_waitcnt lgkmcnt(0)" ::: "memory")
#define VM_WAIT() asm volatile("s_waitcnt vmcnt(0)" ::: "memory")
__device__ __forceinline__ unsigned f2bf(float f) { return (unsigned)__builtin_bit_cast(unsigned short, (__bf16)f); }
typedef float f32x2_t __attribute__((ext_vector_type(2)));
typedef __bf16 bf16x2_t __attribute__((ext_vector_type(2)));
__device__ __forceinline__ unsigned pk2(float lo, float hi) { const f32x2_t f = {lo, hi}; const bf16x2_t b = __builtin_convertvector(f, bf16x2_t); return __builtin_bit_cast(unsigned, b); }
__device__ __forceinline__ float bflo(unsigned w) { return __builtin_bit_cast(float, w << 16); }
__device__ __forceinline__ float bfhi(unsigned w) { return __builtin_bit_cast(float, w & 0xffff0000u); }
__device__ __forceinline__ float bf1(bf16 h) { return __builtin_bit_cast(float, (unsigned)h << 16); }
__device__ __forceinline__ void st16_wt(void* p, const v4u v) { asm volatile("global_store_dwordx4 %0, %1, off sc1\n\ts_nop 1" :: "v"(p), "v"(v) : "memory"); }
__device__ __forceinline__ void st4_wt(void* p, const unsigned v) { asm volatile("global_store_dword %0, %1, off sc1\n\ts_nop 1" :: "v"(p), "v"(v) : "memory"); }
__device__ __forceinline__ void st2_wt(void* p, const unsigned v) { asm volatile("global_store_short %0, %1, off sc1\n\ts_nop 1" :: "v"(p), "v"(v) : "memory"); }
__device__ __forceinline__ void st16_wt_nt(void* p, const v4u v) { asm volatile("global_store_dwordx4 %0, %1, off sc1 nt\n\ts_nop 1" :: "v"(p), "v"(v) : "memory"); }
__device__ __forceinline__ void st8_wt(void* p, const v2u v) { asm volatile("global_store_dwordx2 %0, %1, off sc1\n\ts_nop 1" :: "v"(p), "v"(v) : "memory"); }
__device__ __forceinline__ float wave_sum(float v) {
#pragma unroll
    for (int o = 1; o < 64; o <<= 1) v += __shfl_xor(v, o);
    return v;
}
__device__ __forceinline__ float fnma1(float a, float b, float c) { float r; asm("v_fma_f32 %0, -%1, %2, %3" : "=v"(r) : "v"(a), "v"(b), "v"(c)); return r; }
__device__ __forceinline__ float silu_r(float x) { return x * __builtin_amdgcn_rcpf(1.0f + __expf(-x)); }
__device__ __forceinline__ float silu1(float x) { return x / (1.0f + __expf(-x)); }

#define XB_TMO      128
#define XB_XCNT(j)  (256  + 64 * (j))
#define XB_XSUB(j)  (1280 + 64 * (j))
#define XB_XGEN(j)  (2304 + 64 * (j))
#define XB_TOP      3328
#define XB_TOPGEN   3392
#define XCD_BAR_WORDS 3456
#define XB_SPIN_CAP (1u << 18)
__device__ __forceinline__ unsigned xb_ld(unsigned* p)              { return __hip_atomic_load(p, __ATOMIC_RELAXED, __HIP_MEMORY_SCOPE_AGENT); }
__device__ __forceinline__ unsigned xb_add(unsigned* p, unsigned v) { return __hip_atomic_fetch_add(p, v, __ATOMIC_RELAXED, __HIP_MEMORY_SCOPE_AGENT); }
__device__ __forceinline__ unsigned xb_xcc_id() { return (unsigned)__builtin_amdgcn_s_getreg((3 << 11) | 20) & 0xFu; }
#define XB_SPIN(cond, bar) do { unsigned _sp = 0; while (cond) { __builtin_amdgcn_s_sleep(1); \
    if ((++_sp & 255u) == 0u) { if (xb_ld(&(bar)[XB_TMO])) break; if (_sp > XB_SPIN_CAP) { atomicAdd(&(bar)[XB_TMO], 1u); break; } } } } while (0)
struct XcdBarrier { unsigned* bar; unsigned x; volatile LAS unsigned* st; };
__device__ __forceinline__ XcdBarrier xcd_barrier_post(unsigned* bar, volatile LAS unsigned* st) {
    XcdBarrier b; b.bar = bar; b.x = xb_xcc_id(); b.st = st;
    if (threadIdx.x == 0) (void)xb_add(&bar[XB_XCNT(b.x)], 1u);
    return b;
}
__device__ __forceinline__ void xcd_barrier_complete(unsigned* bar, unsigned x, unsigned& nloc, unsigned& nx) {
    const unsigned G = gridDim.x * gridDim.y * gridDim.z;
    unsigned sum, cnt, mine, sp = 0u;
    for (;;) {
        sum = 0u; cnt = 0u; mine = 0u;
#pragma unroll
        for (unsigned j = 0; j < 16; ++j) { const unsigned c = xb_ld(&bar[XB_XCNT(j)]); sum += c; cnt += (c > 0u) ? 1u : 0u; mine = (j == x) ? c : mine; }
        if (sum == G) break;
        __builtin_amdgcn_s_sleep(1);
        if ((++sp & 255u) == 0u) { if (xb_ld(&bar[XB_TMO])) break; if (sp > XB_SPIN_CAP) { atomicAdd(&bar[XB_TMO], 1u); break; } }
    }
    nloc = mine > 0u ? mine : 1u; nx = cnt > 0u ? cnt : 1u;
}
__device__ __forceinline__ void xcd_barrier(const XcdBarrier& b) {
    asm volatile("s_waitcnt vmcnt(0)" ::: "memory");
    __syncthreads();
    if (threadIdx.x == 0) {
        unsigned* bar = b.bar;
        __builtin_amdgcn_s_waitcnt(0);
        unsigned nloc = b.st[0], nx = b.st[1]; const unsigned epoch = b.st[2];
        if (nloc == 0u) { xcd_barrier_complete(bar, b.x, nloc, nx); b.st[0] = nloc; b.st[1] = nx; }
        const unsigned old = xb_add(&bar[XB_XSUB(b.x)], 1u);
        const unsigned gen = old / nloc;
        if (old + 1u == (gen + 1u) * nloc) {
            __builtin_amdgcn_fence(__ATOMIC_RELEASE, "agent");
            asm volatile("s_waitcnt vmcnt(0)" ::: "memory");
            const unsigned og = xb_add(&bar[XB_TOP], 1u);
            const unsigned tg = og / nx;
            if (og + 1u == (tg + 1u) * nx) xb_add(&bar[XB_TOPGEN], 1u);
            else XB_SPIN(xb_ld(&bar[XB_TOPGEN]) == tg, bar);
            __builtin_amdgcn_fence(__ATOMIC_ACQUIRE, "agent");
            asm volatile("s_waitcnt vmcnt(0)" ::: "memory");
        } else {
            XB_SPIN(xb_ld(&bar[XB_TOPGEN]) < epoch + 1u, bar);
            __builtin_amdgcn_fence(__ATOMIC_ACQUIRE, "agent");
            asm volatile("s_waitcnt vmcnt(0)" ::: "memory");
        }
        b.st[2] = epoch + 1u;
    }
    __syncthreads();
}

struct Frame {
    LAS unsigned char* lds;
    int tid, lane, wave, vcu, G;
    unsigned char* ws;
    const float *x, *c, *ctx, *c_ctx, *w_mod, *b_mod, *norm1_g, *norm2_g, *w_in, *conv_w, *a_log, *dt_bias, *gdn_norm_g, *gm_norm_g, *gm_ws, *gm_bs, *w_out, *w_router, *b_router, *w_gate, *w_up, *w_down, *final_norm_g;
    float* out;
};
__device__ __forceinline__ void group_sync(Frame& F, unsigned* w, unsigned n, int st = 64) {
    asm volatile("s_waitcnt vmcnt(0)" ::: "memory");
    __syncthreads();
    if (F.tid == 0) { unsigned* tmo = (unsigned*)(F.ws + WS_CTL) + CW_BAR + XB_TMO; unsigned sp = 0;
        (void)__hip_atomic_fetch_or(w + st, 1u << xb_xcc_id(), __ATOMIC_RELAXED, __HIP_MEMORY_SCOPE_AGENT); asm volatile("s_waitcnt vmcnt(0)" ::: "memory"); (void)xb_add(w, 1u);
        while (xb_ld(w) < n) { __builtin_amdgcn_s_sleep(1); if ((++sp & 255u) == 0u) { if (xb_ld(tmo)) break; if (sp > XB_SPIN_CAP) { atomicAdd(tmo, 1u); break; } } }
        const unsigned xm = xb_ld(w + st);
        if (xm & (xm - 1u)) {
            __builtin_amdgcn_fence(__ATOMIC_RELEASE, "agent"); asm volatile("s_waitcnt vmcnt(0)" ::: "memory"); (void)xb_add(w + 2 * st, 1u); sp = 0;
            while (xb_ld(w + 2 * st) < n) { __builtin_amdgcn_s_sleep(1); if ((++sp & 255u) == 0u) { if (xb_ld(tmo)) break; if (sp > XB_SPIN_CAP) { atomicAdd(tmo, 1u); break; } } } }
        __builtin_amdgcn_fence(__ATOMIC_ACQUIRE, "agent"); asm volatile("s_waitcnt vmcnt(0)" ::: "memory"); }
    __syncthreads();
}
__device__ __forceinline__ f32x4 mma_tile(const LAS bf16* A, int lda, int r0, const LAS bf16* Bt, int ldb, int c0, int K, f32x4 acc, int lane) {
    const int fr = lane & 15, fq = lane >> 4;
    const LAS bf16* ap = A + (r0 + fr) * lda + 8 * fq; const LAS bf16* bp = Bt + (c0 + fr) * ldb + 8 * fq;
#pragma unroll 4
    for (int k0 = 0; k0 < K; k0 += 32) { const bf16x8 a = *(const LAS bf16x8*)(ap + k0), b = *(const LAS bf16x8*)(bp + k0); acc = __builtin_amdgcn_mfma_f32_16x16x32_bf16(a, b, acc, 0, 0, 0); }
    return acc;
}
__device__ __forceinline__ void transpose_item(const float* W, int ldw, int src_col0, int k0, bf16* WT, int Kp, int dst_row0, LAS float* scr, int lane) {
    float wv[32];
#pragma unroll
    for (int i = 0; i < 32; ++i) wv[i] = __builtin_nontemporal_load(W + (size_t)(k0 + 2 * i + (lane >> 5)) * ldw + src_col0 + (lane & 31));
#pragma unroll
    for (int i = 0; i < 32; ++i) scr[(2 * i + (lane >> 5)) * 33 + (lane & 31)] = wv[i];
    LDS_WAIT(); asm volatile("" ::: "memory");
    const int c = lane & 7;
#pragma unroll
    for (int j = 0; j < 4; ++j) { const int n = (lane >> 3) + 8 * j; const LAS float* s = scr + (8 * c) * 33 + n;
        v4u o; o.x = pk2(s[0 * 33], s[1 * 33]); o.y = pk2(s[2 * 33], s[3 * 33]); o.z = pk2(s[4 * 33], s[5 * 33]); o.w = pk2(s[6 * 33], s[7 * 33]);
        st16_wt(WT + (size_t)(dst_row0 + n) * Kp + k0 + 8 * c, o); }
    LDS_WAIT(); asm volatile("" ::: "memory");
}

__device__ __forceinline__ void transpose_item32k(const float* W, int ldw, int src_col0, int k0, bf16* WT, int Kp, int dst_row0, LAS float* scr, int lane) {
    { float wv[32];
#pragma unroll
        for (int i = 0; i < 32; ++i) wv[i] = __builtin_nontemporal_load(W + (size_t)(k0 + i) * ldw + src_col0 + lane);
#pragma unroll
        for (int i = 0; i < 32; ++i) scr[i * 65 + lane] = wv[i]; }
    LDS_WAIT(); asm volatile("" ::: "memory");
    const int c = lane & 3;
#pragma unroll
    for (int j = 0; j < 4; ++j) { const int n = (lane >> 2) + 16 * j; const LAS float* s = scr + (8 * c) * 65 + n;
        v4u o; o.x = pk2(s[0 * 65], s[1 * 65]); o.y = pk2(s[2 * 65], s[3 * 65]); o.z = pk2(s[4 * 65], s[5 * 65]); o.w = pk2(s[6 * 65], s[7 * 65]);
        st16_wt(WT + (size_t)(dst_row0 + n) * Kp + k0 + 8 * c, o); }
    LDS_WAIT(); asm volatile("" ::: "memory");
}
__device__ __forceinline__ void transpose_item64(const float* W, int ldw, int src_col0, int k0, bf16* WT, int Kp, int dst_row0, LAS float* scr, int lane) {
    { float wv[64];
#pragma unroll
        for (int i = 0; i < 64; ++i) wv[i] = __builtin_nontemporal_load(W + (size_t)(k0 + i) * ldw + src_col0 + lane);
#pragma unroll
        for (int i = 0; i < 64; ++i) scr[i * 65 + lane] = wv[i]; }
    LDS_WAIT(); asm volatile("" ::: "memory");
    const int c = lane & 7;
#pragma unroll
    for (int j = 0; j < 8; ++j) { const int n = (lane >> 3) + 8 * j; const LAS float* s = scr + (8 * c) * 65 + n;
        v4u o; o.x = pk2(s[0 * 65], s[1 * 65]); o.y = pk2(s[2 * 65], s[3 * 65]); o.z = pk2(s[4 * 65], s[5 * 65]); o.w = pk2(s[6 * 65], s[7 * 65]);
        st16_wt(WT + (size_t)(dst_row0 + n) * Kp + k0 + 8 * c, o); }
    LDS_WAIT(); asm volatile("" ::: "memory");
}
__device__ __forceinline__ void p0_phase(Frame& F) {
    float* MOD = (float*)(F.ws + WS_MOD);
    if (F.vcu < 192) {
        LAS float* sv = (LAS float*)F.lds;
        LAS float* red = sv + 3072;
        for (int item = F.vcu; item < 192; item += F.G) {
            const int kq = F.tid >> 3, cq = F.tid & 7, col = item * 32 + cq * 4;
            f32x4 a0 = {0.f, 0.f, 0.f, 0.f}, a1 = a0, a2 = a0;
            f32x4 wv[16];
#pragma unroll
            for (int kk = 0; kk < 16; ++kk) wv[kk] = __builtin_nontemporal_load((const f32x4*)(F.w_mod + (size_t)(kq * 16 + kk) * 6144 + col));
            for (int i = F.tid; i < 3072; i += 512) { const int v = i >> 10, k = i & 1023; const float s = v < 2 ? F.c[v * 1024 + k] : F.c_ctx[k]; sv[i] = silu1(s); }
            __syncthreads();
#pragma unroll
            for (int kk = 0; kk < 16; ++kk) { const int k = kq * 16 + kk; a0 += sv[k] * wv[kk]; a1 += sv[1024 + k] * wv[kk]; a2 += sv[2048 + k] * wv[kk]; }
            *(LAS f32x4*)(red + (kq * 3 + 0) * 32 + cq * 4) = a0; *(LAS f32x4*)(red + (kq * 3 + 1) * 32 + cq * 4) = a1; *(LAS f32x4*)(red + (kq * 3 + 2) * 32 + cq * 4) = a2;
            __syncthreads();
            if (F.tid < 96) { const int v = F.tid >> 5, cc = F.tid & 31; float s = F.b_mod[item * 32 + cc];
                for (int q = 0; q < 64; ++q) s += red[(q * 3 + v) * 32 + cc];
                st4_wt(MOD + v * 6144 + item * 32 + cc, __builtin_bit_cast(unsigned, s)); }
            __syncthreads();
        }
    }
    __syncthreads();
    if (F.vcu >= 192 && F.vcu < 224) { const int idx = (F.vcu - 192) * 512 + F.tid, e = idx >> 10, k = idx & 1023;
        bf16* RTB = (bf16*)(F.ws + WS_RTB); const float w = F.w_router[k * 16 + e]; const unsigned hi = f2bf(w); RTB[e * 1032 + k] = (bf16)hi; RTB[16512 + e * 1032 + k] = (bf16)f2bf(w - __builtin_bit_cast(float, hi << 16)); }
    if (F.vcu >= 224) { const int idx = (F.vcu - 224) * 512 + F.tid, e = idx >> 10, k = idx & 1023;
        bf16* ATB = (bf16*)(F.ws + WS_ATB); const float w = F.w_in[(size_t)k * 3088 + 1536 + e]; const unsigned hi = f2bf(w); st2_wt(ATB + e * 1032 + k, hi); st2_wt(ATB + 16512 + e * 1032 + k, f2bf(w - __builtin_bit_cast(float, hi << 16))); }
    asm volatile("s_waitcnt vmcnt(0)" ::: "memory");
    __syncthreads();
    if (F.tid == 0 && (F.vcu < 192 || F.vcu >= 224)) (void)xb_add((unsigned*)(F.ws + WS_CTL) + 1600, 1u);
    LAS float* scr = (LAS float*)(F.lds + F.wave * 16384);
    const int gw = F.vcu * NWAVES + F.wave, NGW = F.G * NWAVES;
    bf16* WIN = (bf16*)(F.ws + WS_WIN); bf16* WOUT = (bf16*)(F.ws + WS_WOUT);
    constexpr int I_IN = 97 * 16, I_OUT = 32 * 16;
    for (int it = gw; it < I_IN + I_OUT; it += NGW) {
        if (it < I_IN) { const int blk = it >> 4, kb = it & 15;
            const int src = blk < 48 ? 32 * blk : (blk < 64 ? 1552 + 32 * (blk - 48) : (blk < 96 ? 2064 + 32 * (blk - 64) : 1536));
            transpose_item(F.w_in, 3088, src, kb * 64, WIN, 1024, blk * 32, scr, F.lane); }
        else { const int r = it - I_IN, blk = r >> 4, kb = r & 15; transpose_item(F.w_out, 1024, blk * 32, kb * 64, WOUT, 1024, blk * 32, scr, F.lane); }
    }
}
__device__ __forceinline__ void wgu_convert(Frame& F) {
    LAS float* scr = (LAS float*)(F.lds + F.wave * 16640);
    bf16* WGU = (bf16*)(F.ws + WS_WGU);
    const bool late = F.vcu < 192; const int gw = late ? F.vcu * NWAVES + F.wave : 4608 + (F.vcu - 192) * NWAVES + F.wave, NGW = late ? 192 * NWAVES : 64 * NWAVES, it_hi = late ? 4608 : 8192;
    for (int it = gw; it < it_hi; it += NGW) {
        const int kb = it & 15, fb = (it >> 4) & 15, mat = (it >> 8) & 1, e = it >> 9;
        const float* W = (mat ? F.w_up : F.w_gate) + (size_t)e * 1024 * 1024;
        const int f0 = fb * 64, pn = f0 >> 7, dst = 256 * pn + (mat ? 128 : 0) + (f0 & 127);
        transpose_item64(W, 1024, f0, kb * 64, WGU + (size_t)e * 2048 * 1024, 1024, dst, scr, F.lane);
    }
}
__device__ __forceinline__ void wd_convert(Frame& F) {
    LAS float* scr = (LAS float*)(F.lds + F.wave * 16640);
    if (F.vcu < 32) return;
    const int gw = (F.vcu - 32) * NWAVES + F.wave, NGW = (F.G - 32) * NWAVES;
    bf16* WD = (bf16*)(F.ws + WS_WD);
    const int nfull = (16 * 256 / NGW) * NGW;
    for (int it = gw; it < nfull; it += NGW) { const int kb = it & 15, nb = (it >> 4) & 15, e = it >> 8;
        transpose_item64(F.w_down + (size_t)e * 1024 * 1024, 1024, nb * 64, kb * 64, WD + (size_t)e * 1024 * 1024, 1024, nb * 64, scr, F.lane); }
    for (int hi = gw; hi < 2 * (16 * 256 - nfull); hi += NGW) { const int it = nfull + (hi >> 1), kb = it & 15, nb = (it >> 4) & 15, e = it >> 8;
        transpose_item32k(F.w_down + (size_t)e * 1024 * 1024, 1024, nb * 64, kb * 64 + 32 * (hi & 1), WD + (size_t)e * 1024 * 1024, 1024, nb * 64, scr, F.lane); }
}
__device__ __forceinline__ void p1_rows4(Frame& F, const float* const (&src)[4], bf16* const (&dst)[4], const bool (&ok)[4], const float* mv) {
    f32x4 v[4][4];
#pragma unroll
    for (int r = 0; r < 4; ++r)
#pragma unroll
        for (int j = 0; j < 4; ++j) v[r][j] = *(const f32x4*)(src[r] + 8 * F.lane + 512 * (j >> 1) + 4 * (j & 1));
    f32x4 sc[4], sh[4];
#pragma unroll
    for (int j = 0; j < 4; ++j) { const int k = 8 * F.lane + 512 * (j >> 1) + 4 * (j & 1); const f32x4 g = *(const f32x4*)(F.norm1_g + k), s1 = *(const f32x4*)(mv + 1024 + k); sc[j] = g * (1.0f + s1); sh[j] = *(const f32x4*)(mv + k); }
#pragma unroll
    for (int r = 0; r < 4; ++r) { float ss = 0.f;
#pragma unroll
        for (int j = 0; j < 4; ++j) ss += (v[r][j].x * v[r][j].x + v[r][j].y * v[r][j].y) + (v[r][j].z * v[r][j].z + v[r][j].w * v[r][j].w);
        const float rstd = 1.0f / sqrtf(wave_sum(ss) * (1.0f / D) + EPS);
        if (ok[r]) {
#pragma unroll
            for (int jj = 0; jj < 2; ++jj) { const f32x4 a = v[r][2 * jj] * rstd * sc[2 * jj] + sh[2 * jj], c = v[r][2 * jj + 1] * rstd * sc[2 * jj + 1] + sh[2 * jj + 1];
                v4u o; o.x = pk2(a.x, a.y); o.y = pk2(a.z, a.w); o.z = pk2(c.x, c.y); o.w = pk2(c.z, c.w); st16_wt(dst[r] + 8 * F.lane + 512 * jj, o); } } }
}
__device__ __forceinline__ void p1_ctx_load(Frame& F, f32x4 (&cv)[4]) {
    const int gw = F.vcu * NWAVES + F.wave, cr = gw < MC ? gw : 0;
#pragma unroll
    for (int j = 0; j < 4; ++j) cv[j] = *(const f32x4*)(F.ctx + (size_t)cr * D + 8 * F.lane + 512 * (j >> 1) + 4 * (j & 1));
}
__device__ __forceinline__ void p1_ctx_finish(Frame& F, const f32x4 (&cv)[4]) {
    const float* mv = (const float*)(F.ws + WS_MOD) + 2 * 6144; bf16* AIN = (bf16*)(F.ws + WS_AIN);
    const int gw = F.vcu * NWAVES + F.wave;
    if (gw >= MC) return;
    float ss = 0.f;
#pragma unroll
    for (int j = 0; j < 4; ++j) ss += (cv[j].x * cv[j].x + cv[j].y * cv[j].y) + (cv[j].z * cv[j].z + cv[j].w * cv[j].w);
    const float rstd = 1.0f / sqrtf(wave_sum(ss) * (1.0f / D) + EPS);
    bf16* dst = AIN + (size_t)(M + gw) * D;
#pragma unroll
    for (int jj = 0; jj < 2; ++jj) { f32x4 r[2];
#pragma unroll
        for (int q = 0; q < 2; ++q) { const int j = 2 * jj + q, k = 8 * F.lane + 512 * (j >> 1) + 4 * (j & 1); const f32x4 g = *(const f32x4*)(F.norm1_g + k), s1 = *(const f32x4*)(mv + 1024 + k), sh = *(const f32x4*)(mv + k); r[q] = cv[j] * rstd * (g * (1.0f + s1)) + sh; }
        v4u o; o.x = pk2(r[0].x, r[0].y); o.y = pk2(r[0].z, r[0].w); o.z = pk2(r[1].x, r[1].y); o.w = pk2(r[1].z, r[1].w); st16_wt(dst + 8 * F.lane + 512 * jj, o); }
}
struct PF { unsigned a, b, c, d; };
__device__ __forceinline__ unsigned touch(const void* p) { return *(const GAS unsigned*)p; }
__device__ __forceinline__ PF p3_prefetch(Frame& F, int it) {
    PF r; r.a = r.b = r.c = r.d = 0u;
    if (it >= 1056 + 512) return r;
    const int tid = F.tid;
    if (it < 1056) {
        int b, n, h, L; size_t row_base;
        if (it < 1024) { b = it >> 9; n = (it >> 2) & 127; h = it & 3; L = T; row_base = (size_t)b * T; }
        else { const int j = it - 1024; b = j >> 4; n = (j >> 2) & 3; h = j & 3; L = TC; row_base = (size_t)M + (size_t)b * TC; }
        const bf16* QKV = (const bf16*)(F.ws + WS_QKV);
        { const int p = tid, rr = p / 12, q = p % 12, s = q >> 2, piece = q & 3; int t = 64 * n - 1 + rr; t = t < 0 ? 0 : (t >= L ? L - 1 : t); r.a = touch(QKV + (row_base + t) * 1536 + s * 512 + h * 128 + piece * 32); }
        if (tid < 280) { const int p = tid + 512, rr = p / 12, q = p % 12, s = q >> 2, piece = q & 3; int t = 64 * n - 1 + rr; t = t < 0 ? 0 : (t >= L ? L - 1 : t); r.b = touch(QKV + (row_base + t) * 1536 + s * 512 + h * 128 + piece * 32); }
        if (tid < 64) r.c = touch((const float*)(F.ws + WS_AB) + (row_base + 64 * n + tid) * 16);
    } else {
        const int i2 = it - 1056, g = i2 & 3, nc = (i2 >> 2) & 63, b = i2 >> 8; const size_t r0 = (size_t)b * T + (size_t)nc * 128;
        const bf16* UV = (const bf16*)(F.ws + WS_UV);
        const int t = tid >> 2, piece = tid & 3; r.a = touch(UV + (r0 + t) * 1024 + 512 + 128 * g + piece * 32); r.b = touch(UV + (r0 + t) * 1024 + 128 * g + piece * 32);
        r.c = touch(F.gm_ws + (size_t)g * 16384 + tid * 16); r.d = touch(F.gm_ws + (size_t)g * 16384 + (tid + 512) * 16);
    }
    return r;
}
__device__ __forceinline__ void pf_sink(Frame& F, const PF& r) { asm volatile("" :: "v"(r.a), "v"(r.b), "v"(r.c), "v"(r.d)); }
__device__ __forceinline__ int p3_queue_item(int x, unsigned q, bool tailq) {
    if (tailq) return q < 64u ? 1056 + 64 * x + (int)q : (1 << 20);
    if (q < 128u) return 32 * x + (int)(q & 31u) + 256 * (int)(q >> 5);
    return q < 132u ? 1024 + 4 * x + (int)(q - 128u) : (1 << 20); }
__device__ __forceinline__ unsigned p3_dq_issue(Frame& F, bool tailq = false) { unsigned q = 0u; if (F.tid == 0) q = __hip_atomic_fetch_add((unsigned*)(F.ws + WS_CTL) + 128 + 64 * (int)(blockIdx.x & 7) + (tailq ? 32 : 0), 1u, __ATOMIC_RELAXED, __HIP_MEMORY_SCOPE_AGENT) + (tailq ? 0u : 64u); return q; }
__device__ __forceinline__ void p3_dq_publish(Frame& F, unsigned q, int slot, bool tailq = false) { if (F.tid == 0) ((volatile LAS unsigned*)(F.lds + MISC_OFF))[12 + slot] = (unsigned)p3_queue_item((int)(blockIdx.x & 7), q, tailq); }
struct GdnPre { v4u dc[6]; float ab_a, ab_b, cw[3]; };
__device__ __forceinline__ void gdn_preload(Frame& F, int it, GdnPre& P) {
    int b, n, h, L; size_t row_base;
    if (it < 1024) { b = it >> 9; n = (it >> 2) & 127; h = it & 3; L = T; row_base = (size_t)b * T; }
    else { const int j = it - 1024; b = j >> 4; n = (j >> 2) & 3; h = j & 3; L = TC; row_base = (size_t)M + (size_t)b * TC; }
    const bf16* QKV = (const bf16*)(F.ws + WS_QKV); const float* AB = (const float*)(F.ws + WS_AB);
    const int tid = F.tid, lane = F.lane, wave = F.wave;
    const int r = tid >> 3, part = tid & 7, t = 64 * n + r; const bool hasp = t > 0, hasn = t + 1 < L;
    const bf16* pc_ = QKV + (row_base + t) * 1536 + h * 128 + part * 16; const bf16* pp_ = pc_ - (hasp ? 1536 : 0); const bf16* pn_ = pc_ + (hasn ? 1536 : 0);
    P.dc[0] = *(const v4u*)pc_; P.dc[1] = *(const v4u*)(pc_ + 8); P.dc[2] = *(const v4u*)pp_; P.dc[3] = *(const v4u*)(pp_ + 8); P.dc[4] = *(const v4u*)pn_; P.dc[5] = *(const v4u*)(pn_ + 8);
    P.ab_a = 0.f; P.ab_b = 0.f;
    if (wave < 2) { const int tl = wave ? 63 - lane : lane; const float* abr = AB + (row_base + 64 * n + tl) * 16; P.ab_a = abr[wave * 4 + h]; P.ab_b = abr[8 + wave * 4 + h]; }
#pragma unroll
    for (int k = 0; k < 3; ++k) { const int q = min(tid + 512 * k, 1151), tap = q / 384, rem = q % 384, s = rem >> 7, cc = rem & 127; P.cw[k] = F.conv_w[tap * 1536 + s * 512 + h * 128 + cc]; }
}
__device__ __forceinline__ int gdn_item(Frame& F, int it, int nxt_it, int qslot, GdnPre& P, bool pre_next) {
    volatile LAS unsigned* MS = (volatile LAS unsigned*)(F.lds + MISC_OFF);
    const unsigned ticket = p3_dq_issue(F);
    int b, n, h, L, slot; size_t row_base;
    if (it < 1024) { b = it >> 9; n = (it >> 2) & 127; h = it & 3; L = T; row_base = (size_t)b * T; slot = (b * 4 + h) * 128 + n; }
    else { const int j = it - 1024; b = j >> 4; n = (j >> 2) & 3; h = j & 3; L = TC; row_base = (size_t)M + (size_t)b * TC; slot = 1024 + (b * 4 + h) * 4 + n; }
    const bf16* QKV = (const bf16*)(F.ws + WS_QKV); const float* AB = (const float*)(F.ws + WS_AB);
    LAS bf16* QB = (LAS bf16*)(F.lds); LAS bf16* KB = (LAS bf16*)(F.lds + 17408); LAS bf16* VB = (LAS bf16*)(F.lds + 34816); LAS bf16* TB = (LAS bf16*)(F.lds + 34816);
    LAS bf16* KT = (LAS bf16*)(F.lds + 52224); LAS bf16* VT = (LAS bf16*)(F.lds + 70656);
    LAS float* KK = (LAS float*)(F.lds + 89088); LAS float* QK = (LAS float*)(F.lds + 105728);
    LAS bf16* T12 = (LAS bf16*)(F.lds + 89088);
    LAS float* AF = (LAS float*)(F.lds + 122368);
    LAS float* GC = (LAS float*)(F.lds + 155136); LAS float* BT = (LAS float*)(F.lds + 155648); LAS float* EG1 = (LAS float*)(F.lds + 156160); LAS float* EG2 = (LAS float*)(F.lds + 156672);
    LAS bf16* A10B = (LAS bf16*)(F.lds + 157184);
    const int tid = F.tid, lane = F.lane, wave = F.wave, fr = lane & 15, fq = lane >> 4;
    const int r = tid >> 3, part = tid & 7, t = 64 * n + r; const bool hasp = t > 0, hasn = t + 1 < L;
    const bf16* prow = QKV + (row_base + t) * 1536;
    const int offp = hasp ? 1536 : 0, offn = hasn ? 1536 : 0; const unsigned mp = hasp ? 0xffffffffu : 0u, mn = hasn ? 0xffffffffu : 0u;
    v4u dc[6], dn[6];
#define S1_LOAD(dst, s_) do { const bf16* pc_ = prow + (s_) * 512 + h * 128 + part * 16; const bf16* pp_ = pc_ - offp; const bf16* pn_ = pc_ + offn; \
            dst[0] = *(const v4u*)pc_; dst[1] = *(const v4u*)(pc_ + 8); dst[2] = *(const v4u*)pp_; dst[3] = *(const v4u*)(pp_ + 8); dst[4] = *(const v4u*)pn_; dst[5] = *(const v4u*)(pn_ + 8); } while (0)
#pragma unroll
    for (int q = 0; q < 6; ++q) dc[q] = P.dc[q];
    const float ab_a = P.ab_a, ab_b = P.ab_b;
#pragma unroll
    for (int k = 0; k < 3; ++k) { const int q = tid + 512 * k; if (q < 1152) ((LAS float*)(F.lds + 89088))[q] = P.cw[k]; }
    __syncthreads();
    {
        const LAS float* cwl = (const LAS float*)(F.lds + 89088) + part * 16;
#pragma unroll
        for (int s = 0; s < 3; ++s) {
            if (s < 2) S1_LOAD(dn, s + 1);
            float y[16]; float ss = 0.f;
#pragma unroll
            for (int q = 0; q < 4; ++q) { const f32x4 w0 = *(const LAS f32x4*)(cwl + (0 * 3 + s) * 128 + 4 * q), w1 = *(const LAS f32x4*)(cwl + (1 * 3 + s) * 128 + 4 * q), w2 = *(const LAS f32x4*)(cwl + (2 * 3 + s) * 128 + 4 * q);
#pragma unroll
                for (int e = 0; e < 2; ++e) { const unsigned cw = dc[q >> 1][(q & 1) * 2 + e], pw = dc[2 + (q >> 1)][(q & 1) * 2 + e] & mp, nw = dc[4 + (q >> 1)][(q & 1) * 2 + e] & mn;
                    const float a0 = w0[2 * e] * bflo(pw) + w1[2 * e] * bflo(cw) + w2[2 * e] * bflo(nw), a1 = w0[2 * e + 1] * bfhi(pw) + w1[2 * e + 1] * bfhi(cw) + w2[2 * e + 1] * bfhi(nw);
                    const float y0 = silu_r(a0), y1 = silu_r(a1); y[4 * q + 2 * e] = y0; y[4 * q + 2 * e + 1] = y1; ss += y0 * y0 + y1 * y1; } }
            float sc = 1.0f;
            if (s < 2) { ss += __shfl_xor(ss, 1); ss += __shfl_xor(ss, 2); ss += __shfl_xor(ss, 4); sc = (1.0f / sqrtf(ss + EPS)) * (s == 0 ? 0.08838834764831845f : 1.0f); }
            LAS bf16* dst = (s == 0 ? QB : (s == 1 ? KB : VB)) + r * 136 + part * 16;
            v4u o0, o1;
            o0.x = pk2(y[0] * sc, y[1] * sc); o0.y = pk2(y[2] * sc, y[3] * sc); o0.z = pk2(y[4] * sc, y[5] * sc); o0.w = pk2(y[6] * sc, y[7] * sc);
            o1.x = pk2(y[8] * sc, y[9] * sc); o1.y = pk2(y[10] * sc, y[11] * sc); o1.z = pk2(y[12] * sc, y[13] * sc); o1.w = pk2(y[14] * sc, y[15] * sc);
            *(LAS v4u*)dst = o0; *(LAS v4u*)(dst + 8) = o1;
#pragma unroll
            for (int q = 0; q < 6; ++q) dc[q] = dn[q];
        }
#undef S1_LOAD
        if (wave < 2) { const int d = wave, i = lane;
            const float a = ab_a, bb = ab_b;
            const float xx = a + F.dt_bias[d * 4 + h]; const float sp = fmaxf(xx, 0.f) + log1pf(expf(-fabsf(xx)));
            float g = -expf(F.a_log[d * 4 + h]) * sp;
#pragma unroll
            for (int o = 1; o < 64; o <<= 1) { const float yv = __shfl_up(g, o); if (i >= o) g += yv; }
            GC[d * 64 + i] = g; BT[d * 64 + i] = 1.0f / (1.0f + expf(-bb)); const float gl = __shfl(g, 63); EG1[d * 64 + i] = __expf(g); EG2[d * 64 + i] = __expf(gl - g); }
    }
    __syncthreads();
    const PF pf = p3_prefetch(F, nxt_it);
    {
        const int mat = wave >> 2, tr = wave & 3;
#pragma unroll
        for (int tc = 0; tc < 4; ++tc) { f32x4 acc = {0.f, 0.f, 0.f, 0.f}; acc = mma_tile(mat ? QB : KB, 136, 16 * tr, KB, 136, 16 * tc, 128, acc, lane);
            LAS float* dst = (mat ? QK : KK) + (16 * tr + 4 * fq) * 65 + 16 * tc + fr;
#pragma unroll
            for (int j = 0; j < 4; ++j) dst[j * 65] = acc[j]; }
        bf16x8 id0, id1;
#pragma unroll
        for (int j = 0; j < 8; ++j) { id0[j] = (8 * fq + j == fr) ? (short)0x3F80 : (short)0; id1[j] = (8 * fq + j == fr + 16) ? (short)0x3F80 : (short)0; }
#pragma unroll 4
        for (int q = 0; q < 8; ++q) { const int mt = wave >> 2, tt = wave & 3, ct = q;
            const bf16x8 a = *(const LAS bf16x8*)((mt ? KB : VB) + (16 * tt + fr) * 136 + 32 * (ct >> 1) + 8 * fq);
            f32x4 acc = {0.f, 0.f, 0.f, 0.f}; acc = __builtin_amdgcn_mfma_f32_16x16x32_bf16(a, (ct & 1) ? id1 : id0, acc, 0, 0, 0);
            v2u o; o.x = pk2(acc[0], acc[1]); o.y = pk2(acc[2], acc[3]); *(LAS v2u*)((mt ? KT : VT) + (16 * ct + fr) * 72 + 16 * tt + 4 * fq) = o; }
    }
    __syncthreads();
    for (int idx = tid; idx < 8192; idx += 512) { const int d = idx >> 12, i = (idx >> 6) & 63, j = idx & 63; const int ti = d ? 63 - i : i, tj = d ? 63 - j : j;
        const float av = (i > j) ? BT[d * 64 + i] * KK[ti * 65 + tj] * __expf(GC[d * 64 + i] - GC[d * 64 + j]) : 0.f; AF[idx] = av;
        if ((j >> 4) > (i >> 4)) TB[idx] = (bf16)0; }
    __syncthreads();
    unsigned char* gout = F.ws + WS_GDN + (size_t)slot * 2 * GDN_UNIT;
    if (wave < 2) {
        const int d = wave, blk = fq, jc = fr; const LAS float* Ad = AF + d * 4096; const LAS float* A = Ad + (16 * blk) * 64 + 16 * blk; LAS bf16* TBd = TB + d * 4096;
        float Tc[16];
#pragma unroll
        for (int i = 0; i < 16; ++i) { float s0 = (i == jc) ? 1.f : 0.f, s1 = 0.f, s2 = 0.f, s3 = 0.f;
#pragma unroll
            for (int j = 0; j < i; ++j) { const float a = A[i * 64 + j]; if ((j & 3) == 0) s0 = fnma1(a, Tc[j], s0); else if ((j & 3) == 1) s1 = fnma1(a, Tc[j], s1); else if ((j & 3) == 2) s2 = fnma1(a, Tc[j], s2); else s3 = fnma1(a, Tc[j], s3); }
            Tc[i] = (s0 + s1) + (s2 + s3); TBd[(16 * blk + i) * 64 + 16 * blk + jc] = (bf16)f2bf(Tc[i]);
            asm volatile("" ::: "memory"); }
#define S4_AOP(r0_, c0_) ({ const f32x4 a_ = *(const LAS f32x4*)(Ad + ((r0_) + fr) * 64 + (c0_) + 4 * fq); v2u o_; o_.x = pk2(a_.x, a_.y); o_.y = pk2(a_.z, a_.w); __builtin_bit_cast(bf16x4, o_); })
#define S4_TROW(r0_, c0_) (*(const LAS bf16x4*)(TBd + ((r0_) + fr) * 64 + (c0_) + 4 * fq))
#define S4_TCOL(r0_, c0_) ({ const LAS bf16* t_ = TBd + ((r0_) + 4 * fq) * 64 + (c0_) + fr; bf16x4 o_; o_[0] = (short)t_[0]; o_[1] = (short)t_[64]; o_[2] = (short)t_[128]; o_[3] = (short)t_[192]; o_; })
#define S4_ACC(acc_) ({ v2u o_; o_.x = pk2((acc_)[0], (acc_)[1]); o_.y = pk2((acc_)[2], (acc_)[3]); __builtin_bit_cast(bf16x4, o_); })
#define S4_PUT(r0_, c0_, acc_) do { _Pragma("unroll") for (int j_ = 0; j_ < 4; ++j_) TBd[((r0_) + 4 * fq + j_) * 64 + (c0_) + fr] = (bf16)f2bf(-(acc_)[j_]); } while (0)
        const f32x4 z4 = {0.f, 0.f, 0.f, 0.f};
#pragma unroll
        for (int B2 = 0; B2 < 2; ++B2) { const int ra = 32 * B2, rb = ra + 16;
            const f32x4 P = __builtin_amdgcn_mfma_f32_16x16x16bf16_1k(S4_AOP(rb, ra), S4_TCOL(ra, ra), z4, 0, 0, 0);
            const f32x4 R = __builtin_amdgcn_mfma_f32_16x16x16bf16_1k(S4_TROW(rb, rb), S4_ACC(P), z4, 0, 0, 0);
            S4_PUT(rb, ra, R); }
        asm volatile("" ::: "memory");
#pragma unroll
        for (int tj = 0; tj < 2; ++tj) {
            f32x4 P2[2];
#pragma unroll
            for (int kb = 0; kb < 2; ++kb) { f32x4 acc = z4;
#pragma unroll
                for (int ks = 0; ks < 2; ++ks) acc = __builtin_amdgcn_mfma_f32_16x16x16bf16_1k(S4_AOP(32 + 16 * kb, 16 * ks), S4_TCOL(16 * ks, 16 * tj), acc, 0, 0, 0);
                P2[kb] = acc; }
            const bf16x4 p0 = S4_ACC(P2[0]), p1 = S4_ACC(P2[1]);
#pragma unroll
            for (int ti = 0; ti < 2; ++ti) { f32x4 acc = __builtin_amdgcn_mfma_f32_16x16x16bf16_1k(S4_TROW(32 + 16 * ti, 32), p0, z4, 0, 0, 0);
                acc = __builtin_amdgcn_mfma_f32_16x16x16bf16_1k(S4_TROW(32 + 16 * ti, 48), p1, acc, 0, 0, 0);
                S4_PUT(32 + 16 * ti, 16 * tj, acc); } }
#undef S4_AOP
#undef S4_TROW
#undef S4_TCOL
#undef S4_ACC
#undef S4_PUT
    } else {
        const int t2 = tid - 128;
        for (int q = t2; q < 2048; q += 384) { const int d = q >> 10, i = (q >> 4) & 63, cg = q & 15, tok = d ? 63 - i : i; const float e = EG1[d * 64 + i];
            const v4u s = *(const LAS v4u*)(QB + tok * 136 + cg * 8); v4u o;
            o.x = pk2(bflo(s.x) * e, bfhi(s.x) * e); o.y = pk2(bflo(s.y) * e, bfhi(s.y) * e); o.z = pk2(bflo(s.z) * e, bfhi(s.z) * e); o.w = pk2(bflo(s.w) * e, bfhi(s.w) * e);
            st16_wt(gout + (size_t)d * GDN_UNIT + 16384 + (i * 128 + cg * 8) * 2, o); }
        for (int q = t2; q < 2048; q += 384) { const int d = q >> 10, c = (q >> 3) & 127, ig = q & 7;
            float v[8];
            if (d == 0) { const v4u s = *(const LAS v4u*)(KT + c * 72 + ig * 8); v[0] = bflo(s.x); v[1] = bfhi(s.x); v[2] = bflo(s.y); v[3] = bfhi(s.y); v[4] = bflo(s.z); v[5] = bfhi(s.z); v[6] = bflo(s.w); v[7] = bfhi(s.w); }
            else { const v4u s = *(const LAS v4u*)(KT + c * 72 + 56 - ig * 8); v[7] = bflo(s.x); v[6] = bfhi(s.x); v[5] = bflo(s.y); v[4] = bfhi(s.y); v[3] = bflo(s.z); v[2] = bfhi(s.z); v[1] = bflo(s.w); v[0] = bfhi(s.w); }
            const LAS float* e2 = EG2 + d * 64 + ig * 8; v4u o;
            o.x = pk2(v[0] * e2[0], v[1] * e2[1]); o.y = pk2(v[2] * e2[2], v[3] * e2[3]); o.z = pk2(v[4] * e2[4], v[5] * e2[5]); o.w = pk2(v[6] * e2[6], v[7] * e2[7]);
            st16_wt(gout + (size_t)d * GDN_UNIT + 32768 + (c * 64 + ig * 8) * 2, o); }
        for (int q = t2; q < 1024; q += 384) { const int d = q >> 9, i = (q >> 3) & 63, jg = q & 7, ti = d ? 63 - i : i; const float gi = GC[d * 64 + i]; float v[8];
#pragma unroll
            for (int jj = 0; jj < 8; ++jj) { const int j = jg * 8 + jj, tj = d ? 63 - j : j; v[jj] = (i >= j) ? QK[ti * 65 + tj] * __expf(gi - GC[d * 64 + j]) : 0.f; }
            v4u o; o.x = pk2(v[0], v[1]); o.y = pk2(v[2], v[3]); o.z = pk2(v[4], v[5]); o.w = pk2(v[6], v[7]);
            st16_wt(gout + (size_t)d * GDN_UNIT + 49152 + (i * 64 + jg * 8) * 2, o); }
        if (t2 < 2) ((float*)(F.ws + WS_EGL))[slot * 2 + t2] = EG1[t2 * 64 + 63];
    }
    __syncthreads();
    for (int q = tid; q < 1024; q += 512) { const int d = q >> 9, i = (q >> 3) & 63, tg = q & 7;
        float v[8];
        if (d == 0) { const v4u s = *(const LAS v4u*)(TB + i * 64 + tg * 8); v[0] = bflo(s.x); v[1] = bfhi(s.x); v[2] = bflo(s.y); v[3] = bfhi(s.y); v[4] = bflo(s.z); v[5] = bfhi(s.z); v[6] = bflo(s.w); v[7] = bfhi(s.w); }
        else { const v4u s = *(const LAS v4u*)(TB + 4096 + i * 64 + 56 - tg * 8); v[7] = bflo(s.x); v[6] = bfhi(s.x); v[5] = bflo(s.y); v[4] = bfhi(s.y); v[3] = bflo(s.z); v[2] = bfhi(s.z); v[1] = bflo(s.w); v[0] = bfhi(s.w); }
        float t1[8], t2v[8];
#pragma unroll
        for (int e = 0; e < 8; ++e) { const int tok = tg * 8 + e, j = d ? 63 - tok : tok; t1[e] = v[e] * BT[d * 64 + j]; t2v[e] = t1[e] * EG1[d * 64 + j]; }
        v4u o; o.x = pk2(t1[0], t1[1]); o.y = pk2(t1[2], t1[3]); o.z = pk2(t1[4], t1[5]); o.w = pk2(t1[6], t1[7]); *(LAS v4u*)(T12 + (d * 2 + 0) * 4608 + i * 72 + tg * 8) = o;
        o.x = pk2(t2v[0], t2v[1]); o.y = pk2(t2v[2], t2v[3]); o.z = pk2(t2v[4], t2v[5]); o.w = pk2(t2v[6], t2v[7]); *(LAS v4u*)(T12 + (d * 2 + 1) * 4608 + i * 72 + tg * 8) = o; }
    __syncthreads();
    if (pre_next) gdn_preload(F, nxt_it, P);
    else { const v4u z4_ = {0u, 0u, 0u, 0u};
#pragma unroll
        for (int q = 0; q < 6; ++q) P.dc[q] = z4_;
        P.ab_a = P.ab_b = 0.f; P.cw[0] = P.cw[1] = P.cw[2] = 0.f; }
#pragma unroll 4
    for (int q = 0; q < 16; ++q) { const int d = wave >> 2, kind = (wave >> 1) & 1, ti = (wave & 1) * 2 + (q >> 3), tc = q & 7; f32x4 acc = {0.f, 0.f, 0.f, 0.f};
        unsigned char* go = gout + (size_t)d * GDN_UNIT;
        if (kind == 0) { acc = mma_tile(T12 + (d * 2 + 0) * 4608, 72, 16 * ti, VT, 72, 16 * tc, 64, acc, lane);
            v2u o; o.x = pk2(acc[0], acc[1]); o.y = pk2(acc[2], acc[3]); *(v2u*)(go + 57344 + ((16 * tc + fr) * 64 + 16 * ti + 4 * fq) * 2) = o; }
        else { acc = mma_tile(KT, 72, 16 * tc, T12 + (d * 2 + 1) * 4608, 72, 16 * ti, 64, acc, lane);
            v2u o; o.x = pk2(acc[0], acc[1]); o.y = pk2(acc[2], acc[3]); *(v2u*)(go + ((16 * ti + fr) * 128 + 16 * tc + 4 * fq) * 2) = o; } }
    p3_dq_publish(F, ticket, qslot);
    __syncthreads();
    pf_sink(F, pf);
    return (int)MS[12 + qslot];
}
__device__ __forceinline__ int gmlp_item(Frame& F, int it, int nxt_it, int slot) {
    volatile LAS unsigned* MS = (volatile LAS unsigned*)(F.lds + MISC_OFF);
    const unsigned ticket = p3_dq_issue(F, true);
    const int g = it & 3, nc = (it >> 2) & 63, b = it >> 8; const size_t r0 = (size_t)b * T + (size_t)nc * 128;
    const bf16* UV = (const bf16*)(F.ws + WS_UV); bf16* MIX = (bf16*)(F.ws + WS_MIX);
    LAS bf16* VNT = (LAS bf16*)(F.lds); LAS bf16* WSB = (LAS bf16*)(F.lds + 34816);
    const int tid = F.tid, lane = F.lane, wave = F.wave;
    {
        const int t = tid >> 2, part = tid & 3; const bf16* vp = UV + (r0 + t) * 1024 + 512 + 128 * g + part * 32;
        float v[32]; float ss = 0.f;
#pragma unroll
        for (int q = 0; q < 4; ++q) { const v4u xw = *(const v4u*)(vp + 8 * q);
#pragma unroll
            for (int e = 0; e < 4; ++e) { v[8 * q + 2 * e] = bflo(xw[e]); v[8 * q + 2 * e + 1] = bfhi(xw[e]); ss += v[8 * q + 2 * e] * v[8 * q + 2 * e] + v[8 * q + 2 * e + 1] * v[8 * q + 2 * e + 1]; } }
        ss += __shfl_xor(ss, 1); ss += __shfl_xor(ss, 2);
        const float rstd = 1.0f / sqrtf(ss * (1.0f / 128.0f) + EPS); const float* gn = F.gm_norm_g + 128 * g + part * 32;
#pragma unroll
        for (int cc = 0; cc < 32; ++cc) VNT[(part * 32 + cc) * 136 + t] = (bf16)f2bf(v[cc] * rstd * gn[cc]);
        const float* wp = F.gm_ws + ((size_t)g * 128 + t) * 128 + part * 32;
#pragma unroll
        for (int q = 0; q < 4; ++q) { const f32x4 w0 = *(const f32x4*)(wp + 8 * q), w1 = *(const f32x4*)(wp + 8 * q + 4); v4u o; o.x = pk2(w0.x, w0.y); o.y = pk2(w0.z, w0.w); o.z = pk2(w1.x, w1.y); o.w = pk2(w1.z, w1.w);
            *(LAS v4u*)(WSB + t * 136 + part * 32 + 8 * q) = o; }
    }
    __syncthreads();
    const PF pf = p3_prefetch(F, nxt_it);
    {
        const int td = wave, fr = lane & 15, fq = lane >> 4;
        v2u uws[8]; float bss[8];
#pragma unroll
        for (int tt = 0; tt < 8; ++tt) { const int tl = 16 * tt + fr; uws[tt] = *(const v2u*)(UV + (r0 + tl) * 1024 + 128 * g + 16 * td + 4 * fq); bss[tt] = F.gm_bs[g * 128 + tl]; }
#pragma unroll
        for (int tt = 0; tt < 8; ++tt) { f32x4 acc = {0.f, 0.f, 0.f, 0.f}; acc = mma_tile(VNT, 136, 16 * td, WSB, 136, 16 * tt, 128, acc, lane);
            const int tl = 16 * tt + fr; const size_t off = (r0 + tl) * 1024 + 128 * g + 16 * td + 4 * fq; const float bsv = bss[tt];
            const v2u uw = uws[tt]; v2u o;
            o.x = pk2(bflo(uw.x) * (acc[0] + bsv), bfhi(uw.x) * (acc[1] + bsv)); o.y = pk2(bflo(uw.y) * (acc[2] + bsv), bfhi(uw.y) * (acc[3] + bsv));
            __builtin_nontemporal_store(o, (v2u*)(MIX + off)); }
    }
    p3_dq_publish(F, ticket, slot, true);
    __syncthreads();
    pf_sink(F, pf);
    return (int)MS[12 + slot];
}
__device__ __forceinline__ void p3_phase(Frame& F) {
    volatile LAS unsigned* MS = (volatile LAS unsigned*)(F.lds + MISC_OFF);
    int it = p3_queue_item((int)(blockIdx.x & 7), (unsigned)(blockIdx.x >> 3), false), nx = p3_queue_item((int)(blockIdx.x & 7), 32u + (unsigned)(blockIdx.x >> 3), false), slot = 0;
    if ((blockIdx.x >> 3) >= 32) { it = nx = 1 << 20; }
    bool synced = false, primed = false; unsigned tb = 0u;
    GdnPre P; if (it < 1056) gdn_preload(F, it, P);
    while (it < 1056) {
        if (!synced && (it >= 1024 || (nx >= 1024 && nx < 1056))) {
            if (F.tid == 0) { unsigned* done = (unsigned*)(F.ws + WS_CTL) + 1024; unsigned* tmo = (unsigned*)(F.ws + WS_CTL) + CW_BAR + XB_TMO; unsigned sp = 0;
                while (xb_ld(done) < 14u) { __builtin_amdgcn_s_sleep(2); if ((++sp & 255u) == 0u) { if (xb_ld(tmo)) break; if (sp > XB_SPIN_CAP) { atomicAdd(tmo, 1u); break; } } }
                __builtin_amdgcn_fence(__ATOMIC_ACQUIRE, "agent"); asm volatile("s_waitcnt vmcnt(0)" ::: "memory"); }
            __syncthreads(); synced = true; }
        if (nx >= 1056 && !primed) { tb = p3_dq_issue(F, true); primed = true; }
        { const int n2 = gdn_item(F, it, nx, slot, P, nx < 1056); it = nx; nx = n2; slot ^= 1; }
    }
    if (!primed) tb = p3_dq_issue(F, true);
    p3_dq_publish(F, tb, 0, true);
    __syncthreads();
    it = (int)MS[12];
    __syncthreads();
    while (it < 1056 + 512) it = gmlp_item(F, it - 1056, 1 << 20, 0);
}
constexpr size_t WS_CB = 112 * MiB;
__device__ __forceinline__ int seg_lo(int g) { return g == 0 ? 0 : (g == 1 ? 28 : (g == 2 ? 61 : 94)); }
__device__ __forceinline__ int seg_len(int g) { return g == 0 ? 28 : (g == 3 ? 34 : 33); }
constexpr size_t WS_ZT = 4 * MiB;
constexpr size_t WS_XB = 8 * MiB;
constexpr size_t WS_CORRF = 78 * MiB, WS_CORRB = 206 * MiB;
#ifndef P4_TOUCHES
#define P4_TOUCHES 0
#endif
__device__ __forceinline__ void p4_scan(Frame& F) {
    const int j14 = F.vcu & 31;
    if (j14 >= 28) return;
    const int chain = 2 * (F.vcu >> 5) + (j14 >= 14 ? 1 : 0), role = j14 % 14;
    const int g = role < 2 ? 0 : 1 + ((role - 2) >> 2), kindP = role < 2 ? 0 : ((role - 2) >> 1) & 1, ch = role < 2 ? role : (role - 2) & 1;
    const int b = chain >> 3, h = (chain >> 1) & 3, d = chain & 1, c0 = ch * 64;
    const int NS = g == 0 ? 4 + seg_len(0) : seg_len(g), SLO = seg_lo(g);
    constexpr int BUFB = 65536, ST_OFF = 2 * BUFB, VNT_OFF = ST_OFF + 64 * 288, EGS_OFF = VNT_OFF + 64 * 160, JUNK_OFF = EGS_OFF + 256;
    const unsigned char* gdn = F.ws + WS_GDN; const float* EGL = (const float*)(F.ws + WS_EGL);
    const int lane = F.lane, wave = F.wave;
#define P4_SLOT(s) (g == 0 ? ((s) < 4 ? 1024 + (b * 4 + h) * 4 + (d ? 3 - (s) : (s)) : (b * 4 + h) * 128 + (d ? 127 - ((s) - 4) : ((s) - 4))) : (b * 4 + h) * 128 + (d ? 127 - (SLO + (s)) : (SLO + (s))))
#define P4_BAR() do { asm volatile("s_waitcnt lgkmcnt(0)" ::: "memory"); __builtin_amdgcn_s_barrier(); asm volatile("" ::: "memory"); } while (0)
#define P4_SOFF(dst, k) do { \
            if ((k) < 32) { const int qi = ((k) & 15) * 64 + lane, r = qi >> 4, sl = qi & 15; dst = (unsigned)(((k) >> 4) * 16384 + r * 256 + ((sl ^ (r & 15)) << 4)); } \
            else if ((k) < 56) { const int kk = (k) < 48 ? (k) - 32 : (k) - 48, qi = kk * 64 + lane, r = qi >> 3, sl = qi & 7; dst = (unsigned)(((k) < 48 ? 32768 : 49152) + r * 128 + ((sl ^ ((r >> 1) & 7)) << 4)); } \
            else dst = (unsigned)(57344 + c0 * 128 + ((k) - 56) * 1024 + lane * 16); } while (0)
    unsigned soQ[5], soW[3];
#pragma unroll
    for (int q = 0; q < 5; ++q) P4_SOFF(soQ[q], 16 + wave + 8 * q);
    P4_SOFF(soW[0], wave); P4_SOFF(soW[1], wave + 8); P4_SOFF(soW[2], 56 + wave);
#define P4_ISSUE_QAK(s, bufi) do { const unsigned char* gb = gdn + (size_t)(P4_SLOT(s) * 2 + d) * GDN_UNIT; \
            _Pragma("unroll") for (int q = 0; q < 5; ++q) __builtin_amdgcn_global_load_lds((const unsigned*)(gb + soQ[q]), (LAS unsigned*)(F.lds + (bufi) * BUFB + (16 + wave + 8 * q) * 1024), 16, 0, 0); } while (0)
#define P4_ISSUE_WU(s, bufi) do { const unsigned char* gb = gdn + (size_t)(P4_SLOT(s) * 2 + d) * GDN_UNIT; \
            __builtin_amdgcn_global_load_lds((const unsigned*)(gb + soW[0]), (LAS unsigned*)(F.lds + (bufi) * BUFB + wave * 1024), 16, 0, 0); \
            __builtin_amdgcn_global_load_lds((const unsigned*)(gb + soW[1]), (LAS unsigned*)(F.lds + (bufi) * BUFB + (wave + 8) * 1024), 16, 0, 0); \
            __builtin_amdgcn_global_load_lds((const unsigned*)(gb + soW[2]), (LAS unsigned*)(F.lds + (bufi) * BUFB + (56 + wave) * 1024), 16, 0, 0); } while (0)
#define P4_WAITVM(n) do { switch (n) { case 0: asm volatile("s_waitcnt vmcnt(0)" ::: "memory"); break; case 1: asm volatile("s_waitcnt vmcnt(1)" ::: "memory"); break; case 2: asm volatile("s_waitcnt vmcnt(2)" ::: "memory"); break; \
            case 3: asm volatile("s_waitcnt vmcnt(3)" ::: "memory"); break; case 4: asm volatile("s_waitcnt vmcnt(4)" ::: "memory"); break; case 5: asm volatile("s_waitcnt vmcnt(5)" ::: "memory"); break; \
            case 6: asm volatile("s_waitcnt vmcnt(6)" ::: "memory"); break; case 7: asm volatile("s_waitcnt vmcnt(7)" ::: "memory"); break; case 8: asm volatile("s_waitcnt vmcnt(8)" ::: "memory"); break; \
            case 9: asm volatile("s_waitcnt vmcnt(9)" ::: "memory"); break; case 10: asm volatile("s_waitcnt vmcnt(10)" ::: "memory"); break; case 11: asm volatile("s_waitcnt vmcnt(11)" ::: "memory"); break; \
            default: asm volatile("s_waitcnt vmcnt(12)" ::: "memory"); break; } } while (0)
#define P4_TOUCH(s) do { const unsigned char* gb = gdn + (size_t)(P4_SLOT(s) * 2 + d) * GDN_UNIT; const int li = wave * 64 + lane, ln = li < 448 ? li : 448 + c0 + (li - 448); \
            __builtin_amdgcn_global_load_lds((const unsigned*)(gb + (size_t)ln * 128), (LAS unsigned*)(F.lds + JUNK_OFF + wave * 256), 4, 0, 0); } while (0)
    const int m = wave & 3, nh = wave >> 2, fr = lane & 15, fq = lane >> 4;
    for (int i = F.tid; i < 64 * 72; i += 512) { const int c = i / 72, w4 = i % 72;
        unsigned v = 0u; if (kindP) { const int dk = c0 + c; if ((dk >> 1) == w4) v = (dk & 1) ? 0x3F800000u : 0x00003F80u; }
        ((LAS unsigned*)(F.lds + ST_OFF))[i] = v; }
    for (int i = F.tid; i < NS; i += 512) ((LAS float*)(F.lds + EGS_OFF))[i] = EGL[P4_SLOT(i) * 2 + d];
    f32x4 S[2][2];
#pragma unroll
    for (int t2 = 0; t2 < 2; ++t2)
#pragma unroll
        for (int n2 = 0; n2 < 2; ++n2) {
#pragma unroll
            for (int jj = 0; jj < 4; ++jj) S[t2][n2][jj] = (kindP && (32 * m + 16 * t2 + 4 * fq + jj == c0 + 32 * nh + 16 * n2 + fr)) ? 1.0f : 0.0f; }
    bf16* OD = (bf16*)(F.ws + (d ? WS_OB : WS_OF)); bf16* CB = (bf16*)(F.ws + WS_CB);
    P4_ISSUE_WU(0, 0); P4_ISSUE_QAK(0, 0); P4_ISSUE_WU(1, 1);
    asm volatile("s_waitcnt vmcnt(3)" ::: "memory"); P4_BAR();
#pragma unroll 1
    for (int s = 0; s < NS; ++s) {
        const int cur = s & 1; const LAS unsigned char* buf = F.lds + cur * BUFB; LAS unsigned char* ST = F.lds + ST_OFF; LAS unsigned char* VNT = F.lds + VNT_OFF;
        const bool outp = (g > 0 || s >= 4), outp_prev = (g > 0 || s >= 5);
        const int c_q = (s + 1 < NS) ? 5 : 0, c_w1 = (s + 1 < NS) ? 3 : 0, c_w2 = (s + 2 < NS) ? 3 : 0, c_sp = (s >= 1 && outp_prev) ? 2 : 0, c_s = outp ? 2 : 0;
        if (s + 1 < NS) P4_ISSUE_QAK(s + 1, cur ^ 1);
        const float eg = ((const LAS float*)(F.lds + EGS_OFF))[s];
        bf16x8 bS[2][4]; f32x4 acc[2];
#pragma unroll
        for (int n2 = 0; n2 < 2; ++n2) acc[n2] = (f32x4){0.f, 0.f, 0.f, 0.f};
        const int r = 16 * m + fr;
#pragma unroll
        for (int ks = 0; ks < 4; ++ks) { const bf16x8 a = *(const LAS bf16x8*)(buf + r * 256 + (((4 * ks + fq) ^ fr) << 4));
#pragma unroll
            for (int n2 = 0; n2 < 2; ++n2) { bS[n2][ks] = *(const LAS bf16x8*)(ST + (32 * nh + 16 * n2 + fr) * 288 + (32 * ks + 8 * fq) * 2); acc[n2] = __builtin_amdgcn_mfma_f32_16x16x32_bf16(a, bS[n2][ks], acc[n2], 0, 0, 0); } }
#pragma unroll
        for (int n2 = 0; n2 < 2; ++n2) { const int cl = 32 * nh + 16 * n2 + fr; v2u ucn = {0u, 0u}; if (!kindP) ucn = *(const LAS v2u*)(buf + 57344 + cl * 128 + (16 * m + 4 * fq) * 2);
            const float v0 = bflo(ucn.x) - acc[n2][0], v1 = bfhi(ucn.x) - acc[n2][1], v2 = bflo(ucn.y) - acc[n2][2], v3 = bfhi(ucn.y) - acc[n2][3]; v2u o; o.x = pk2(v0, v1); o.y = pk2(v2, v3);
            *(LAS v2u*)(VNT + cl * 160 + (16 * m + 4 * fq) * 2) = o; }
        { const int nA = c_w1 + c_sp + c_q; P4_WAITVM(nA); }
        P4_BAR();
        if (s + 2 < NS) P4_ISSUE_WU(s + 2, cur);
        bf16x8 bV[2][2];
#pragma unroll
        for (int n2 = 0; n2 < 2; ++n2)
#pragma unroll
            for (int ks = 0; ks < 2; ++ks) bV[n2][ks] = *(const LAS bf16x8*)(VNT + (32 * nh + 16 * n2 + fr) * 160 + (32 * ks + 8 * fq) * 2);
        if (outp) {
            f32x4 o[2];
#pragma unroll
            for (int n2 = 0; n2 < 2; ++n2) o[n2] = (f32x4){0.f, 0.f, 0.f, 0.f};
#pragma unroll
            for (int ks = 0; ks < 4; ++ks) { const bf16x8 a = *(const LAS bf16x8*)(buf + 16384 + r * 256 + (((4 * ks + fq) ^ fr) << 4));
#pragma unroll
                for (int n2 = 0; n2 < 2; ++n2) o[n2] = __builtin_amdgcn_mfma_f32_16x16x32_bf16(bS[n2][ks], a, o[n2], 0, 0, 0); }
#pragma unroll
            for (int ks = 0; ks < 2; ++ks) { const bf16x8 a = *(const LAS bf16x8*)(buf + 49152 + r * 128 + (((4 * ks + fq) ^ ((r >> 1) & 7)) << 4));
#pragma unroll
                for (int n2 = 0; n2 < 2; ++n2) o[n2] = __builtin_amdgcn_mfma_f32_16x16x32_bf16(bV[n2][ks], a, o[n2], 0, 0, 0); }
            const int sp = g == 0 ? s - 4 : SLO + s;
            const int i = 16 * m + fr;
            if (kindP) { bf16* cb = CB + ((size_t)(chain * 100 + (sp - 28)) * 64 + i) * 128 + c0 + 32 * nh + 4 * fq;
#pragma unroll
                for (int n2 = 0; n2 < 2; ++n2) { v2u w; w.x = pk2(o[n2][0], o[n2][1]); w.y = pk2(o[n2][2], o[n2][3]); *(v2u*)(cb + 16 * n2) = w; } }
            else { const int nn = d ? 127 - sp : sp, tl = d ? 63 - i : i; bf16* op = OD + ((size_t)b * T + 64 * nn + tl) * 512 + h * 128 + c0 + 32 * nh + 4 * fq;
#pragma unroll
                for (int n2 = 0; n2 < 2; ++n2) { v2u w; w.x = pk2(o[n2][0], o[n2][1]); w.y = pk2(o[n2][2], o[n2][3]); *(v2u*)(op + 16 * n2) = w; } }
        }
#pragma unroll
        for (int t2 = 0; t2 < 2; ++t2)
#pragma unroll
            for (int n2 = 0; n2 < 2; ++n2) S[t2][n2] *= eg;
#pragma unroll
        for (int ks = 0; ks < 2; ++ks)
#pragma unroll
            for (int t2 = 0; t2 < 2; ++t2) { const int rr = 32 * m + 16 * t2 + fr; const bf16x8 a = *(const LAS bf16x8*)(buf + 32768 + rr * 128 + (((4 * ks + fq) ^ ((rr >> 1) & 7)) << 4));
#pragma unroll
                for (int n2 = 0; n2 < 2; ++n2) S[t2][n2] = __builtin_amdgcn_mfma_f32_16x16x32_bf16(a, bV[n2][ks], S[t2][n2], 0, 0, 0); }
#pragma unroll
        for (int t2 = 0; t2 < 2; ++t2)
#pragma unroll
            for (int n2 = 0; n2 < 2; ++n2) { v2u o; o.x = pk2(S[t2][n2][0], S[t2][n2][1]); o.y = pk2(S[t2][n2][2], S[t2][n2][3]); *(LAS v2u*)(ST + (32 * nh + 16 * n2 + fr) * 288 + (32 * m + 16 * t2 + 4 * fq) * 2) = o; }
        { const int nB = c_sp + c_q + c_w2 + c_s; P4_WAITVM(nB); }
        P4_BAR();
    }
    if (g < 3 && !kindP) { float* zt = (float*)(F.ws + WS_ZT) + (size_t)(chain * 4 + g) * 16384;
#pragma unroll
        for (int t2 = 0; t2 < 2; ++t2)
#pragma unroll
            for (int n2 = 0; n2 < 2; ++n2) *(f32x4*)(zt + (c0 + 32 * nh + 16 * n2 + fr) * 128 + 32 * m + 16 * t2 + 4 * fq) = S[t2][n2]; }
    if (kindP && g < 3) { bf16* xb = (bf16*)(F.ws + WS_XB) + (size_t)(chain * 4 + g) * 16384;
#pragma unroll
        for (int t2 = 0; t2 < 2; ++t2)
#pragma unroll
            for (int n2 = 0; n2 < 2; ++n2)
#pragma unroll
                for (int jj = 0; jj < 4; ++jj) xb[(32 * m + 16 * t2 + 4 * fq + jj) * 128 + c0 + 32 * nh + 16 * n2 + fr] = (bf16)f2bf(S[t2][n2][jj]); }
    VM_WAIT();
#undef P4_TOUCH
#undef P4_ISSUE_QAK
#undef P4_ISSUE_WU
#undef P4_SOFF
#undef P4_WAITVM
#undef P4_SLOT
#undef P4_BAR
}
__device__ __forceinline__ void p4b_correct(Frame& F) {
    if (F.vcu >= 192) return;
    const int chain = F.vcu / 12, g = 1 + (F.vcu % 12) / 4, qt = F.vcu & 3;
    const int b = chain >> 3, h = (chain >> 1) & 3, d = chain & 1;
    LAS bf16* Y = (LAS bf16*)F.lds;
    LAS bf16* Y2 = (LAS bf16*)(F.lds + 34816);
    LAS bf16* XL = (LAS bf16*)(F.lds + 69632);
    const float* ZT = (const float*)(F.ws + WS_ZT) + (size_t)chain * 4 * 16384; const bf16* XB = (const bf16*)(F.ws + WS_XB) + (size_t)chain * 4 * 16384;
    const int tid = F.tid, lane = F.lane, wave = F.wave, fr = lane & 15, fq = lane >> 4;
    const bf16* CB = (const bf16*)(F.ws + WS_CB);
    v4u cpre0, cpre1;
    const int q_lo = seg_lo(g) + (seg_len(g) * qt) / 4, q_hi = seg_lo(g) + (seg_len(g) * (qt + 1)) / 4;
    { const bf16* cb0 = CB + ((size_t)(chain * 100 + (q_lo - 28)) * 64) * 128; cpre0 = *(const v4u*)(cb0 + tid * 8); cpre1 = *(const v4u*)(cb0 + (tid + 512) * 8); }
    for (int q = tid; q < 128 * 32; q += 512) { const int c = q >> 5, k4 = q & 31; const f32x4 z = *(const f32x4*)(ZT + c * 128 + 4 * k4); v2u o; o.x = pk2(z.x, z.y); o.y = pk2(z.z, z.w); *(LAS v2u*)(Y + c * 136 + 4 * k4) = o; }
    __syncthreads();
    LAS bf16* Yc = Y; LAS bf16* Yn = Y2;
#pragma unroll 1
    for (int gg = 1; gg < g; ++gg) {
        for (int q = tid; q < 128 * 16; q += 512) { const int rr = q >> 4, k8 = q & 15; *(LAS v4u*)(XL + rr * 136 + 8 * k8) = *(const v4u*)(XB + (size_t)gg * 16384 + rr * 128 + 8 * k8); }
        __syncthreads();
#pragma unroll 1
        for (int tn = 0; tn < 8; ++tn) { f32x4 acc = {0.f, 0.f, 0.f, 0.f}; acc = mma_tile(Yc, 136, 16 * wave, XL, 136, 16 * tn, 128, acc, lane);
#pragma unroll
            for (int jj = 0; jj < 4; ++jj) { const int col = 16 * wave + 4 * fq + jj, dk = 16 * tn + fr; Yn[col * 136 + dk] = (bf16)f2bf(acc[jj] + ZT[(size_t)gg * 16384 + col * 128 + dk]); } }
        __syncthreads();
        LAS bf16* t_ = Yc; Yc = Yn; Yn = t_;
    }
    bf16* OD = (bf16*)(F.ws + (d ? WS_CORRB : WS_CORRF));
#pragma unroll 1
    for (int sp = q_lo; sp < q_hi; ++sp) {
        const int nn = d ? 127 - sp : sp;
        { const int q0 = tid, q1 = tid + 512; *(LAS v4u*)(XL + (q0 >> 4) * 136 + 8 * (q0 & 15)) = cpre0; *(LAS v4u*)(XL + (q1 >> 4) * 136 + 8 * (q1 & 15)) = cpre1; }
        if (sp + 1 < q_hi) { const int sp1 = sp + 1; const bf16* cb1 = CB + ((size_t)(chain * 100 + (sp1 - 28)) * 64) * 128; cpre0 = *(const v4u*)(cb1 + tid * 8); cpre1 = *(const v4u*)(cb1 + (tid + 512) * 8); }
        __syncthreads();
#pragma unroll 1
        for (int ti = 0; ti < 4; ++ti) { f32x4 acc = {0.f, 0.f, 0.f, 0.f}; acc = mma_tile(Yc, 136, 16 * wave, XL, 136, 16 * ti, 128, acc, lane);
            const int i = 16 * ti + fr, tl = d ? 63 - i : i; v2u w; w.x = pk2(acc[0], acc[1]); w.y = pk2(acc[2], acc[3]);
            *(v2u*)(OD + ((size_t)b * T + 64 * nn + tl) * 512 + h * 128 + 16 * wave + 4 * fq) = w; }
        __syncthreads();
    }
}
__device__ __forceinline__ void p5a_combine(Frame& F) {
    const bf16* OFp = (const bf16*)(F.ws + WS_OF); const bf16* OBp = (const bf16*)(F.ws + WS_OB); const bf16* Z = (const bf16*)(F.ws + WS_Z); bf16* MIX = (bf16*)(F.ws + WS_MIX);
    const int lane = F.lane;
    float gn[8];
#pragma unroll
    for (int e = 0; e < 8; ++e) gn[e] = F.gdn_norm_g[(lane & 15) * 8 + e];
    for (int mb = 64 * F.vcu + F.wave; mb < 64 * F.vcu + 64; mb += 32) {
        v4u a[4], bq[4], zz[4], cf[4], cbk[4];
#pragma unroll
        for (int u = 0; u < 4; ++u) { const int m = mb + u * 8, tt = m & (T - 1);
            a[u] = *(const v4u*)(OFp + (size_t)m * 512 + lane * 8); bq[u] = *(const v4u*)(OBp + (size_t)m * 512 + lane * 8); zz[u] = __builtin_nontemporal_load((const v4u*)(Z + (size_t)m * 512 + lane * 8));
            cf[u] = cbk[u] = (v4u){0u, 0u, 0u, 0u};
            if (tt >= 1792) cf[u] = *(const v4u*)((const bf16*)(F.ws + WS_CORRF) + (size_t)m * 512 + lane * 8);
            if (tt < 6400) cbk[u] = *(const v4u*)((const bf16*)(F.ws + WS_CORRB) + (size_t)m * 512 + lane * 8); }
#pragma unroll
        for (int u = 0; u < 4; ++u) { const int m = mb + u * 8;
            float o[8]; float ss = 0.f;
#pragma unroll
            for (int e = 0; e < 4; ++e) { o[2 * e] = (bflo(a[u][e]) + bflo(bq[u][e])) + (bflo(cf[u][e]) + bflo(cbk[u][e])); o[2 * e + 1] = (bfhi(a[u][e]) + bfhi(bq[u][e])) + (bfhi(cf[u][e]) + bfhi(cbk[u][e])); ss += o[2 * e] * o[2 * e] + o[2 * e + 1] * o[2 * e + 1]; }
            ss += __shfl_xor(ss, 1); ss += __shfl_xor(ss, 2); ss += __shfl_xor(ss, 4); ss += __shfl_xor(ss, 8);
            const float rstd = 1.0f / sqrtf(ss * (1.0f / 128.0f) + EPS);
            float y[8];
#pragma unroll
            for (int e = 0; e < 4; ++e) { y[2 * e] = o[2 * e] * rstd * gn[2 * e] * silu_r(bflo(zz[u][e])); y[2 * e + 1] = o[2 * e + 1] * rstd * gn[2 * e + 1] * silu_r(bfhi(zz[u][e])); }
            v4u w; w.x = pk2(y[0], y[1]); w.y = pk2(y[2], y[3]); w.z = pk2(y[4], y[5]); w.w = pk2(y[6], y[7]);
            st16_wt(MIX + (size_t)m * 1024 + 512 + lane * 8, w); }
    }
}
#define LDS_BAR() do { asm volatile("s_waitcnt lgkmcnt(0)" ::: "memory"); __builtin_amdgcn_s_barrier(); asm volatile("" ::: "memory"); } while (0)
#define P6_LOAD(tl_) { const size_t o_ = (size_t)(16 * (tl_) + i) * D + 128 * wave + 8 * g; \
    _Pragma("unroll") for (int ks = 0; ks < 4; ++ks) { rx0[ks] = __builtin_nontemporal_load((const f32x4*)(F.x + o_ + 32 * ks)); rx1[ks] = __builtin_nontemporal_load((const f32x4*)(F.x + o_ + 32 * ks + 4)); rg[ks] = *(const v4u*)(G1 + o_ + 32 * ks); } }
__device__ __forceinline__ f32x4 p6_mma(const float (&v)[8], const LAS bf16* wt, f32x4 acc) {
    bf16x8 ah, al; float lo[8];
#pragma unroll
    for (int e = 0; e < 4; ++e) { const unsigned p = pk2(v[2 * e], v[2 * e + 1]); ah[2 * e] = (short)(p & 0xffffu); ah[2 * e + 1] = (short)(p >> 16); lo[2 * e] = v[2 * e] - bflo(p); lo[2 * e + 1] = v[2 * e + 1] - bfhi(p); }
#pragma unroll
    for (int e = 0; e < 4; ++e) { const unsigned p = pk2(lo[2 * e], lo[2 * e + 1]); al[2 * e] = (short)(p & 0xffffu); al[2 * e + 1] = (short)(p >> 16); }
    const bf16x8 bh = *(const LAS bf16x8*)wt, bl = *(const LAS bf16x8*)(wt + 16512);
    acc = __builtin_amdgcn_mfma_f32_16x16x32_bf16(ah, bh, acc, 0, 0, 0); acc = __builtin_amdgcn_mfma_f32_16x16x32_bf16(ah, bl, acc, 0, 0, 0); return __builtin_amdgcn_mfma_f32_16x16x32_bf16(al, bh, acc, 0, 0, 0);
}
__device__ __forceinline__ void p6_phase(Frame& F) {
    const float* MOD = (const float*)(F.ws + WS_MOD); const bf16* G1 = (const bf16*)(F.ws + WS_H1); bf16* FIN = (bf16*)(F.ws + WS_FIN);
    float* AFF = (float*)(F.ws + WS_AFF); int* SEL = (int*)(F.ws + WS_SEL);
    LAS bf16* WHL = (LAS bf16*)F.lds;
    LAS float* SCL = (LAS float*)(F.lds + 66048); LAS float* SHL = SCL + 2048; LAS float* BIA = SHL + 2048;
    LAS float* RED = BIA + 32; LAS float* SSP = RED + 8 * 256; LAS float* RSTD = SSP + 128;
    const int tid = F.tid, lane = F.lane, wave = F.wave, i = lane & 15, g = lane >> 4;
    f32x4 rx0[4], rx1[4]; v4u rg[4];
    int tl = 4 * F.vcu; const int tl_end = tl + 4;
    { v4u tb[9]; float ng[4], m1[4], m2[4];
#pragma unroll
        for (int q = 0; q < 9; ++q) { const int c = min(tid + 512 * q, 66048 / 16 - 1); tb[q] = *(const v4u*)(F.ws + WS_RTB + 16 * c); }
#pragma unroll
        for (int q = 0; q < 4; ++q) { const int k = (tid + 512 * q) & 1023, bb = q >> 1; ng[q] = F.norm2_g[k]; m1[q] = MOD[bb * 6144 + 4096 + k]; m2[q] = MOD[bb * 6144 + 3072 + k]; }
        P6_LOAD(tl)
#pragma unroll
        for (int q = 0; q < 9; ++q) { const int c = tid + 512 * q; if (c < 66048 / 16) *(LAS v4u*)(F.lds + 16 * c) = tb[q]; }
#pragma unroll
        for (int q = 0; q < 4; ++q) { SCL[tid + 512 * q] = ng[q] * (1.0f + m1[q]); SHL[tid + 512 * q] = m2[q]; } }
    __syncthreads();
    const LAS bf16* wt = WHL + i * 1032 + 128 * wave + 8 * g;
    { f32x4 acc = {0.f, 0.f, 0.f, 0.f};
#pragma unroll
        for (int ks = 0; ks < 4; ++ks) { float v[8]; const LAS float* shp = SHL + (i & 1) * 1024 + 128 * wave + 32 * ks + 8 * g; const f32x4 t0 = *(const LAS f32x4*)shp, t1 = *(const LAS f32x4*)(shp + 4); const float m = i < 2 ? 1.0f : 0.0f;
            v[0] = t0.x * m; v[1] = t0.y * m; v[2] = t0.z * m; v[3] = t0.w * m; v[4] = t1.x * m; v[5] = t1.y * m; v[6] = t1.z * m; v[7] = t1.w * m;
            acc = p6_mma(v, wt + 32 * ks, acc); }
#pragma unroll
        for (int j = 0; j < 4; ++j) RED[wave * 256 + (4 * g + j) * 16 + i] = acc[j];
        __syncthreads();
        if (tid < 32) { float s = F.b_router[tid & 15];
#pragma unroll
            for (int w = 0; w < 8; ++w) s += RED[w * 256 + tid];
            BIA[tid] = s; }
        __syncthreads(); }
#pragma unroll 1
    for (; tl < tl_end; ++tl) {
        const int b = tl >> 9; const size_t off = (size_t)(16 * tl + i) * D + 128 * wave + 8 * g;
        float h[4][8];
#pragma unroll
        for (int ks = 0; ks < 4; ++ks) { const f32x4 x0 = rx0[ks], x1 = rx1[ks]; const v4u gq = rg[ks];
            h[ks][0] = x0.x + bflo(gq.x); h[ks][1] = x0.y + bfhi(gq.x); h[ks][2] = x0.z + bflo(gq.y); h[ks][3] = x0.w + bfhi(gq.y);
            h[ks][4] = x1.x + bflo(gq.z); h[ks][5] = x1.y + bfhi(gq.z); h[ks][6] = x1.z + bflo(gq.w); h[ks][7] = x1.w + bfhi(gq.w); }
        if (tl + 1 < tl_end) P6_LOAD(tl + 1)
        f32x4 acc = {0.f, 0.f, 0.f, 0.f}; float ss = 0.f;
#pragma unroll
        for (int ks = 0; ks < 4; ++ks) { const LAS float* scp = SCL + b * 1024 + 128 * wave + 32 * ks + 8 * g; const f32x4 s0 = *(const LAS f32x4*)scp, s1 = *(const LAS f32x4*)(scp + 4);
#pragma unroll
            for (int e = 0; e < 8; ++e) ss += h[ks][e] * h[ks][e];
            h[ks][0] *= s0.x; h[ks][1] *= s0.y; h[ks][2] *= s0.z; h[ks][3] *= s0.w; h[ks][4] *= s1.x; h[ks][5] *= s1.y; h[ks][6] *= s1.z; h[ks][7] *= s1.w;
            acc = p6_mma(h[ks], wt + 32 * ks, acc); }
        ss += __shfl_xor(ss, 16); ss += __shfl_xor(ss, 32);
#pragma unroll
        for (int j = 0; j < 4; ++j) RED[wave * 256 + (4 * g + j) * 16 + i] = acc[j];
        if (g == 0) SSP[wave * 16 + i] = ss;
        LDS_BAR();
        if (tid < 256) { const int r = tid >> 4, e = tid & 15; float lg = 0.f, sq = 0.f;
#pragma unroll
            for (int w = 0; w < 8; ++w) { lg += RED[w * 256 + r * 16 + e]; sq += SSP[w * 16 + r]; }
            const float rstd = 1.0f / sqrtf(sq * (1.0f / D) + EPS); const float lgt = rstd * lg + BIA[b * 16 + e];
            float mx = lgt; mx = fmaxf(mx, __shfl_xor(mx, 1)); mx = fmaxf(mx, __shfl_xor(mx, 2)); mx = fmaxf(mx, __shfl_xor(mx, 4)); mx = fmaxf(mx, __shfl_xor(mx, 8));
            const float ex = expf(lgt - mx); float den = ex; den += __shfl_xor(den, 1); den += __shfl_xor(den, 2); den += __shfl_xor(den, 4); den += __shfl_xor(den, 8);
            AFF[((size_t)b * 16 + e) * T + (16 * (tl & 511) + r)] = ex / den; SEL[(size_t)(16 * tl + r) * 16 + e] = -1;
            if (e == 0) RSTD[r] = rstd; }
        LDS_BAR();
        const float rs = RSTD[i];
        LAS unsigned char* ob = F.lds + 92160 + wave * 4352;
#pragma unroll
        for (int ks = 0; ks < 4; ++ks) { const LAS float* shp = SHL + b * 1024 + 128 * wave + 32 * ks + 8 * g; const f32x4 t0 = *(const LAS f32x4*)shp, t1 = *(const LAS f32x4*)(shp + 4);
            v4u o; o.x = pk2(h[ks][0] * rs + t0.x, h[ks][1] * rs + t0.y); o.y = pk2(h[ks][2] * rs + t0.z, h[ks][3] * rs + t0.w);
            o.z = pk2(h[ks][4] * rs + t1.x, h[ks][5] * rs + t1.y); o.w = pk2(h[ks][6] * rs + t1.z, h[ks][7] * rs + t1.w);
            *(LAS v4u*)(ob + i * 272 + (32 * ks + 8 * g) * 2) = o; }
        asm volatile("s_waitcnt lgkmcnt(0)" ::: "memory");
#pragma unroll
        for (int q = 0; q < 4; ++q) { const int row = 4 * q + g, ch = i; const v4u o = *(const LAS v4u*)(ob + row * 272 + ch * 16);
            *(v4u*)(FIN + (size_t)(16 * tl + row) * D + 128 * wave + 8 * ch) = o; }
        asm volatile("s_waitcnt lgkmcnt(0)" ::: "memory");
    }
}
#define P1_LOAD(tl_) { const size_t o_ = (size_t)(16 * (tl_) + i) * D + 128 * wave + 8 * g; \
    _Pragma("unroll") for (int ks = 0; ks < 4; ++ks) { rx0[ks] = __builtin_nontemporal_load((const f32x4*)(F.x + o_ + 32 * ks)); rx1[ks] = __builtin_nontemporal_load((const f32x4*)(F.x + o_ + 32 * ks + 4)); } }
__device__ __forceinline__ void p1_tiles(Frame& F) {
    const float* MOD = (const float*)(F.ws + WS_MOD); bf16* AIN = (bf16*)(F.ws + WS_AIN); float* AB = (float*)(F.ws + WS_AB);
    LAS bf16* WHL = (LAS bf16*)F.lds;
    LAS float* SCL = (LAS float*)(F.lds + 66048); LAS float* SHL = SCL + 2048; LAS float* BIA = SHL + 2048;
    LAS float* RED = BIA + 32; LAS float* SSP = RED + 8 * 256; LAS float* RSTD = SSP + 128;
    const int tid = F.tid, lane = F.lane, wave = F.wave, i = lane & 15, g = lane >> 4;
    f32x4 rx0[4], rx1[4];
    int tl = F.vcu; constexpr int NT = M / 16;
    if (tl < NT) P1_LOAD(tl)
    if (tid == 0) { unsigned* w = (unsigned*)(F.ws + WS_CTL) + 1600; unsigned* tmo = (unsigned*)(F.ws + WS_CTL) + CW_BAR + XB_TMO; unsigned sp = 0;
        while (xb_ld(w) < 224u) { __builtin_amdgcn_s_sleep(1); if ((++sp & 255u) == 0u) { if (xb_ld(tmo)) break; if (sp > XB_SPIN_CAP) { atomicAdd(tmo, 1u); break; } } }
        __builtin_amdgcn_fence(__ATOMIC_ACQUIRE, "agent"); asm volatile("s_waitcnt vmcnt(0)" ::: "memory"); }
    __syncthreads();
    { v4u tb[9]; float ng[4], m1[4], m2[4];
#pragma unroll
        for (int q = 0; q < 9; ++q) { const int c = min(tid + 512 * q, 66048 / 16 - 1); tb[q] = *(const v4u*)(F.ws + WS_ATB + 16 * c); }
#pragma unroll
        for (int q = 0; q < 4; ++q) { const int k = (tid + 512 * q) & 1023, bb = q >> 1; ng[q] = F.norm1_g[k]; m1[q] = MOD[bb * 6144 + 1024 + k]; m2[q] = MOD[bb * 6144 + k]; }
#pragma unroll
        for (int q = 0; q < 9; ++q) { const int c = tid + 512 * q; if (c < 66048 / 16) *(LAS v4u*)(F.lds + 16 * c) = tb[q]; }
#pragma unroll
        for (int q = 0; q < 4; ++q) { SCL[tid + 512 * q] = ng[q] * (1.0f + m1[q]); SHL[tid + 512 * q] = m2[q]; } }
    __syncthreads();
    const LAS bf16* wt = WHL + i * 1032 + 128 * wave + 8 * g;
    { f32x4 acc = {0.f, 0.f, 0.f, 0.f};
#pragma unroll
        for (int ks = 0; ks < 4; ++ks) { float v[8]; const LAS float* shp = SHL + (i & 1) * 1024 + 128 * wave + 32 * ks + 8 * g; const f32x4 t0 = *(const LAS f32x4*)shp, t1 = *(const LAS f32x4*)(shp + 4); const float m = i < 2 ? 1.0f : 0.0f;
            v[0] = t0.x * m; v[1] = t0.y * m; v[2] = t0.z * m; v[3] = t0.w * m; v[4] = t1.x * m; v[5] = t1.y * m; v[6] = t1.z * m; v[7] = t1.w * m;
            acc = p6_mma(v, wt + 32 * ks, acc); }
#pragma unroll
        for (int j = 0; j < 4; ++j) RED[wave * 256 + (4 * g + j) * 16 + i] = acc[j];
        __syncthreads();
        if (tid < 32) { float s = 0.f;
#pragma unroll
            for (int w = 0; w < 8; ++w) s += RED[w * 256 + tid];
            BIA[tid] = s; }
        __syncthreads(); }
#pragma unroll 1
    for (; tl < NT; tl += F.G) {
        const int b = tl >> 9; const size_t off = (size_t)(16 * tl + i) * D + 128 * wave + 8 * g;
        float h[4][8];
#pragma unroll
        for (int ks = 0; ks < 4; ++ks) { const f32x4 x0 = rx0[ks], x1 = rx1[ks];
            h[ks][0] = x0.x; h[ks][1] = x0.y; h[ks][2] = x0.z; h[ks][3] = x0.w; h[ks][4] = x1.x; h[ks][5] = x1.y; h[ks][6] = x1.z; h[ks][7] = x1.w; }
        if (tl + F.G < NT) P1_LOAD(tl + F.G)
        f32x4 acc = {0.f, 0.f, 0.f, 0.f}; float ss = 0.f;
#pragma unroll
        for (int ks = 0; ks < 4; ++ks) { const LAS float* scp = SCL + b * 1024 + 128 * wave + 32 * ks + 8 * g; const f32x4 s0 = *(const LAS f32x4*)scp, s1 = *(const LAS f32x4*)(scp + 4);
#pragma unroll
            for (int e = 0; e < 8; ++e) ss += h[ks][e] * h[ks][e];
            h[ks][0] *= s0.x; h[ks][1] *= s0.y; h[ks][2] *= s0.z; h[ks][3] *= s0.w; h[ks][4] *= s1.x; h[ks][5] *= s1.y; h[ks][6] *= s1.z; h[ks][7] *= s1.w;
            acc = p6_mma(h[ks], wt + 32 * ks, acc); }
        ss += __shfl_xor(ss, 16); ss += __shfl_xor(ss, 32);
#pragma unroll
        for (int j = 0; j < 4; ++j) RED[wave * 256 + (4 * g + j) * 16 + i] = acc[j];
        if (g == 0) SSP[wave * 16 + i] = ss;
        LDS_BAR();
        if (tid < 256) { const int r = tid >> 4, e = tid & 15; float lg = 0.f, sq = 0.f;
#pragma unroll
            for (int w = 0; w < 8; ++w) { lg += RED[w * 256 + r * 16 + e]; sq += SSP[w * 16 + r]; }
            const float rstd = 1.0f / sqrtf(sq * (1.0f / D) + EPS);
            AB[(size_t)(16 * tl + r) * 16 + e] = rstd * lg + BIA[b * 16 + e];
            if (e == 0) RSTD[r] = rstd; }
        LDS_BAR();
        const float rs = RSTD[i];
        LAS unsigned char* ob = F.lds + 92160 + wave * 4352;
#pragma unroll
        for (int ks = 0; ks < 4; ++ks) { const LAS float* shp = SHL + b * 1024 + 128 * wave + 32 * ks + 8 * g; const f32x4 t0 = *(const LAS f32x4*)shp, t1 = *(const LAS f32x4*)(shp + 4);
            v4u o; o.x = pk2(h[ks][0] * rs + t0.x, h[ks][1] * rs + t0.y); o.y = pk2(h[ks][2] * rs + t0.z, h[ks][3] * rs + t0.w);
            o.z = pk2(h[ks][4] * rs + t1.x, h[ks][5] * rs + t1.y); o.w = pk2(h[ks][6] * rs + t1.z, h[ks][7] * rs + t1.w);
            *(LAS v4u*)(ob + i * 272 + (32 * ks + 8 * g) * 2) = o; }
        asm volatile("s_waitcnt lgkmcnt(0)" ::: "memory");
#pragma unroll
        for (int q = 0; q < 4; ++q) { const int row = 4 * q + g, ch = i; const v4u o = *(const LAS v4u*)(ob + row * 272 + ch * 16);
            st16_wt(AIN + (size_t)(16 * tl + row) * D + 128 * wave + 8 * ch, o); }
        asm volatile("s_waitcnt lgkmcnt(0)" ::: "memory");
    }
}
__device__ __forceinline__ int block_excl_scan(int v, LAS int* tmp, int lane, int wave, int& total) {
    int inc = v;
#pragma unroll
    for (int o = 1; o < 64; o <<= 1) { const int y = __shfl_up(inc, o); if (lane >= o) inc += y; }
    if (lane == 63) tmp[wave] = inc;
    __syncthreads();
    int woff = 0, tot = 0;
#pragma unroll
    for (int w = 0; w < 8; ++w) { const int sv = tmp[w]; woff += (w < wave) ? sv : 0; tot += sv; }
    __syncthreads();
    total = tot; return woff + inc - v;
}
__device__ __forceinline__ void p7_topk(Frame& F) {
    const float* AFF = (const float*)(F.ws + WS_AFF); int* SEL = (int*)(F.ws + WS_SEL); int* IDX = (int*)(F.ws + WS_IDX); float* GATE = (float*)(F.ws + WS_GATE);
    LAS unsigned* vals = (LAS unsigned*)F.lds;
    LAS unsigned* hist = vals + 8192;
    LAS int* tmp = (LAS int*)(hist + 512);
    const int tid = F.tid, lane = F.lane, wave = F.wave;
    for (int u = F.vcu; u < 32; u += F.G) {
        const int b = u >> 4, e = u & 15; const float* ar = AFF + (size_t)u * T;
        for (int t = tid; t < T; t += 512) vals[t] = __builtin_bit_cast(unsigned, ar[t]);
        hist[tid] = 0u;
        if (tid == 0) { tmp[8] = 0; tmp[9] = CAP; }
        __syncthreads();
#pragma unroll 1
        for (int pass = 0; pass < 4; ++pass) {
            const int shift = 24 - 8 * pass; LAS unsigned* h = hist + 256 * (pass & 1);
            const unsigned prefix = (unsigned)tmp[8], himask = pass == 0 ? 0u : (0xffffffffu << (shift + 8));
            for (int t = tid; t < T; t += 512) { const unsigned v = vals[t]; bool m = (v & himask) == prefix; const unsigned dg = (v >> shift) & 255u;
                if (pass == 0) {
#pragma unroll
                    for (int rnd = 0; rnd < 2; ++rnd) { const unsigned long long am = __ballot(m);
                        if (am) { const int ld = __ffsll((long long)am) - 1; const unsigned d0 = (unsigned)__builtin_amdgcn_readlane((int)dg, ld); const bool same = m && dg == d0; const unsigned long long sm = __ballot(same);
                            if (lane == ld) __hip_atomic_fetch_add(h + d0, (unsigned)__popcll(sm), __ATOMIC_RELAXED, __HIP_MEMORY_SCOPE_WORKGROUP); m = m && !same; } } }
                if (m) __hip_atomic_fetch_add(h + dg, 1u, __ATOMIC_RELAXED, __HIP_MEMORY_SCOPE_WORKGROUP); }
            __syncthreads();
            if (wave == 0) {
                const unsigned kth = (unsigned)tmp[9];
                const unsigned c0 = h[255 - 4 * lane], c1 = h[254 - 4 * lane], c2 = h[253 - 4 * lane], c3 = h[252 - 4 * lane], sm = c0 + c1 + c2 + c3;
                unsigned inc = sm;
#pragma unroll
                for (int o = 1; o < 64; o <<= 1) { const unsigned y = __shfl_up(inc, o); if (lane >= o) inc += y; }
                const unsigned exc = inc - sm;
                if (exc < kth && kth <= inc) { unsigned r = kth - exc; int bin;
                    if (r <= c0) bin = 255 - 4 * lane; else if (r <= c0 + c1) { bin = 254 - 4 * lane; r -= c0; } else if (r <= c0 + c1 + c2) { bin = 253 - 4 * lane; r -= c0 + c1; } else { bin = 252 - 4 * lane; r -= c0 + c1 + c2; }
                    tmp[8] = (int)(prefix | ((unsigned)bin << shift)); tmp[9] = (int)r; }
            } else if (tid >= 256) { hist[256 * ((pass + 1) & 1) + (tid - 256)] = 0u; }
            __syncthreads();
        }
        const unsigned thr = (unsigned)tmp[8]; const int kth = tmp[9];
        const int t0 = tid * 16; int cg = 0, ce = 0;
#pragma unroll
        for (int i = 0; i < 16; ++i) { const unsigned v = vals[t0 + i]; cg += (v > thr) ? 1 : 0; ce += (v == thr) ? 1 : 0; }
        int tot; const int eqb = block_excl_scan(ce, tmp, lane, wave, tot);
        int take = kth - eqb; take = take < 0 ? 0 : (take > ce ? ce : take);
        int pos = block_excl_scan(cg + take, tmp, lane, wave, tot); int eqseen = 0;
#pragma unroll 1
        for (int i = 0; i < 16; ++i) { const unsigned v = vals[t0 + i]; bool sel = v > thr; if (v == thr) { sel = eqseen < take; ++eqseen; }
            if (sel) { const int t = t0 + i; IDX[u * CAP + pos] = b * T + t; GATE[u * CAP + pos] = __builtin_bit_cast(float, v); SEL[((size_t)b * T + t) * 16 + e] = pos; ++pos; } }
        __syncthreads();
    }
}
__device__ __forceinline__ void p7b_gather(Frame& F) {
    const int* IDX = (const int*)(F.ws + WS_IDX); const bf16* FIN = (const bf16*)(F.ws + WS_FIN); bf16* XE = (bf16*)(F.ws + WS_XE);
    const int gw = F.vcu * NWAVES + F.wave, NGW = F.G * NWAVES, lane = F.lane;
    for (int r = gw; r < 32 * CAP; r += 2 * NGW) { const int r1 = r + NGW; const int src0 = IDX[r], src1 = IDX[r1];
        const v4u* sp0 = (const v4u*)(FIN + (size_t)src0 * D); const v4u* sp1 = (const v4u*)(FIN + (size_t)src1 * D); v4u* dp0 = (v4u*)(XE + (size_t)r * D); v4u* dp1 = (v4u*)(XE + (size_t)r1 * D);
        const v4u a = sp0[lane], c = sp0[lane + 64], e = sp1[lane], f = sp1[lane + 64]; dp0[lane] = a; dp0[lane + 64] = c; dp1[lane] = e; dp1[lane + 64] = f; }
}
__device__ __forceinline__ void p10_final(Frame& F) {
    const float* MOD = (const float*)(F.ws + WS_MOD); const bf16* G1 = (const bf16*)(F.ws + WS_H1); const bf16* YE = (const bf16*)(F.ws + WS_YE); const int* SEL = (const int*)(F.ws + WS_SEL);
    const int gw = F.vcu * NWAVES + F.wave, NGW = F.G * NWAVES, lane = F.lane;
#pragma unroll 1
    for (int b = 0; b < 2; ++b) {
        f32x4 gt[4], fg[4];
#pragma unroll
        for (int j = 0; j < 4; ++j) { gt[j] = *(const f32x4*)(MOD + b * 6144 + 5120 + 4 * lane + 256 * j); fg[j] = *(const f32x4*)(F.final_norm_g + 4 * lane + 256 * j); }
        for (int m0 = b * T + gw; m0 < (b + 1) * T; m0 += 2 * NGW) {
            const int m1 = m0 + NGW;
            const int sel0 = lane < 16 ? SEL[(size_t)m0 * 16 + lane] : -1, sel1 = lane < 16 ? SEL[(size_t)m1 * 16 + lane] : -1;
            f32x4 h0[4], h1v[4], a0[4], a1[4];
#pragma unroll
            for (int j = 0; j < 4; ++j) { const v2u g0 = __builtin_nontemporal_load((const v2u*)(G1 + (size_t)m0 * D + 4 * lane + 256 * j)), g1 = __builtin_nontemporal_load((const v2u*)(G1 + (size_t)m1 * D + 4 * lane + 256 * j));
                h0[j] = __builtin_nontemporal_load((const f32x4*)(F.x + (size_t)m0 * D + 4 * lane + 256 * j)) + (f32x4){bflo(g0.x), bfhi(g0.x), bflo(g0.y), bfhi(g0.y)};
                h1v[j] = __builtin_nontemporal_load((const f32x4*)(F.x + (size_t)m1 * D + 4 * lane + 256 * j)) + (f32x4){bflo(g1.x), bfhi(g1.x), bflo(g1.y), bfhi(g1.y)}; a0[j] = a1[j] = (f32x4){0.f, 0.f, 0.f, 0.f}; }
            unsigned mk0 = (unsigned)(__ballot(sel0 >= 0) & 0xffffull), mk1 = (unsigned)(__ballot(sel1 >= 0) & 0xffffull);
#pragma unroll 1
            while (mk0 | mk1) {
                v2u w0[4][4], w1[4][4]; float k0[4], k1[4];
#pragma unroll
                for (int q = 0; q < 4; ++q) {
                    const int e0_ = mk0 ? __builtin_ctz(mk0) : 0, e1_ = mk1 ? __builtin_ctz(mk1) : 0; k0[q] = mk0 ? 1.f : 0.f; k1[q] = mk1 ? 1.f : 0.f;
                    const int c0_ = mk0 ? __builtin_amdgcn_readlane(sel0, e0_) : 0, c1_ = mk1 ? __builtin_amdgcn_readlane(sel1, e1_) : 0;
                    mk0 &= mk0 - 1u; mk1 &= mk1 - 1u;
                    const bf16* y0 = YE + ((size_t)(b * 16 + e0_) * CAP + c0_) * D + 4 * lane; const bf16* y1 = YE + ((size_t)(b * 16 + e1_) * CAP + c1_) * D + 4 * lane;
#pragma unroll
                    for (int j = 0; j < 4; ++j) { w0[q][j] = __builtin_nontemporal_load((const v2u*)(y0 + 256 * j)); w1[q][j] = __builtin_nontemporal_load((const v2u*)(y1 + 256 * j)); } }
#pragma unroll
                for (int q = 0; q < 4; ++q)
#pragma unroll
                    for (int j = 0; j < 4; ++j) { a0[j] += k0[q] * (f32x4){bflo(w0[q][j].x), bfhi(w0[q][j].x), bflo(w0[q][j].y), bfhi(w0[q][j].y)}; a1[j] += k1[q] * (f32x4){bflo(w1[q][j].x), bfhi(w1[q][j].x), bflo(w1[q][j].y), bfhi(w1[q][j].y)}; }
            }
            float s0 = 0.f, s1 = 0.f;
#pragma unroll
            for (int j = 0; j < 4; ++j) { h0[j] += gt[j] * a0[j]; h1v[j] += gt[j] * a1[j];
                s0 += (h0[j].x * h0[j].x + h0[j].y * h0[j].y) + (h0[j].z * h0[j].z + h0[j].w * h0[j].w); s1 += (h1v[j].x * h1v[j].x + h1v[j].y * h1v[j].y) + (h1v[j].z * h1v[j].z + h1v[j].w * h1v[j].w); }
            const float r0 = 1.0f / sqrtf(wave_sum(s0) * (1.0f / D) + EPS), r1 = 1.0f / sqrtf(wave_sum(s1) * (1.0f / D) + EPS);
#pragma unroll
            for (int j = 0; j < 4; ++j) { __builtin_nontemporal_store(h0[j] * r0 * fg[j], (f32x4*)(F.out + (size_t)m0 * D + 4 * lane + 256 * j)); __builtin_nontemporal_store(h1v[j] * r1 * fg[j], (f32x4*)(F.out + (size_t)m1 * D + 4 * lane + 256 * j)); }
        }
    }
}
struct Args { const float* in[23]; float* out; unsigned char* ws; int ph_lo, ph_hi; };
__global__ void __launch_bounds__(NWAVES * 64, 2) fwd_kernel(Args args) {
    extern __shared__ __attribute__((aligned(16))) unsigned char lds_raw[];
    Frame F;
    F.lds = (LAS unsigned char*)lds_raw;
    volatile LAS unsigned* MISC = (volatile LAS unsigned*)(F.lds + MISC_OFF);
    F.tid = threadIdx.x; F.lane = F.tid & 63; F.wave = __builtin_amdgcn_readfirstlane(F.tid >> 6);
    F.G = gridDim.x; { const int bx = blockIdx.x; F.vcu = (F.G % 8 == 0) ? (bx % 8) * (F.G / 8) + bx / 8 : bx; }
    F.ws = args.ws; F.out = args.out;
    F.x = args.in[0]; F.c = args.in[1]; F.ctx = args.in[2]; F.c_ctx = args.in[3]; F.w_mod = args.in[4]; F.b_mod = args.in[5]; F.norm1_g = args.in[6]; F.norm2_g = args.in[7];
    F.w_in = args.in[8]; F.conv_w = args.in[9]; F.a_log = args.in[10]; F.dt_bias = args.in[11]; F.gdn_norm_g = args.in[12]; F.gm_norm_g = args.in[13]; F.gm_ws = args.in[14]; F.gm_bs = args.in[15];
    F.w_out = args.in[16]; F.w_router = args.in[17]; F.b_router = args.in[18]; F.w_gate = args.in[19]; F.w_up = args.in[20]; F.w_down = args.in[21]; F.final_norm_g = args.in[22];
    for (int u = F.tid; u < 64; u += NWAVES * 64) MISC[u] = 0u;
    __syncthreads();
    XcdBarrier bar; bar.bar = (unsigned*)(F.ws + WS_CTL) + CW_BAR; bar.x = 0; bar.st = nullptr;
    if (!MK_PER_PHASE) bar = xcd_barrier_post((unsigned*)(F.ws + WS_CTL) + CW_BAR, MISC + 8);
    const int lo = args.ph_lo, hi = args.ph_hi;
#define IN(k) (lo <= (k) && (k) < hi)
#define SEAM(k) do { if (IN(k) && IN((k) + 1)) xcd_barrier(bar); } while (0)
    if (IN(0)) { p0_phase(F); f32x4 cv[4]; p1_ctx_load(F, cv); p1_tiles(F); p1_ctx_finish(F, cv); } SEAM(0);
    if (IN(1)) {
        pg8::Gemm g{(const bf16*)(F.ws + WS_AIN), (const bf16*)(F.ws + WS_WIN), M, 3072, D, 0, 0, 0, nullptr}; pg8::StaticOrder S; S.init(M, 3072, F.G, (int)blockIdx.x);
        pg8::EpiInProj E{(bf16*)(F.ws + WS_QKV), (bf16*)(F.ws + WS_Z), (bf16*)(F.ws + WS_UV), (float*)(F.ws + WS_AB)};
        pg8::gemm_phase<pg8::EpiInProj, pg8::StaticOrder, PG8_ALIGN, PG8_SP2>(F.lds, g, S, E);
    } SEAM(1);
    if (IN(2)) {
        if (blockIdx.x < 14) {
            pg8::Gemm g{(const bf16*)(F.ws + WS_AIN), (const bf16*)(F.ws + WS_WIN), MA, 3328, D, 0, 0, 0, nullptr}; pg8::ListOrder S{(int)blockIdx.x};
            pg8::EpiInProj E{(bf16*)(F.ws + WS_QKV), (bf16*)(F.ws + WS_Z), (bf16*)(F.ws + WS_UV), (float*)(F.ws + WS_AB)};
            pg8::gemm_phase<pg8::EpiInProj, pg8::ListOrder, PG8_ALIGN, PG8_SP2>(F.lds, g, S, E);
            asm volatile("s_waitcnt vmcnt(0)" ::: "memory");
            __syncthreads();
            if (F.tid == 0) { __builtin_amdgcn_fence(__ATOMIC_RELEASE, "agent"); asm volatile("s_waitcnt vmcnt(0)" ::: "memory");
                (void)xb_add((unsigned*)(F.ws + WS_CTL) + 1024, 1u); }
            __syncthreads();
        }
        p3_phase(F);
    } SEAM(2);
    if (IN(3)) { p4_scan(F); } SEAM(3);
    if (IN(4)) { p4b_correct(F); __syncthreads(); wgu_convert(F); } SEAM(4);
    if (IN(5)) {
        unsigned* cnt = (unsigned*)(F.ws + WS_CTL) + 1100;
        const int grp = F.vcu >> 2;
        p5a_combine(F);
        group_sync(F, cnt + grp, 4u);
        { pg8::Gemm g{(const bf16*)(F.ws + WS_MIX), (const bf16*)(F.ws + WS_WOUT), M, D, D, 0, 0, 0, nullptr}; pg8::GroupOrder S{F.vcu};
            pg8::EpiOutProj E{(const float*)(F.ws + WS_MOD), (bf16*)(F.ws + WS_H1)};
            pg8::gemm_phase<pg8::EpiOutProj, pg8::GroupOrder, PG8_ALIGN, PG8_SP2>(F.lds, g, S, E); }
        group_sync(F, cnt + 192 + grp, 4u);
        p6_phase(F);
    } SEAM(5);
    if (IN(6)) { p7_topk(F); wd_convert(F); } SEAM(6);
    if (IN(7)) {
        pg8::Gemm g{(const bf16*)(F.ws + WS_FIN), (const bf16*)(F.ws + WS_WGU), 32 * CAP, 2 * FF, D, (size_t)2 * FF * D * 2, 2, 15, (const int*)(F.ws + WS_IDX)};     pg8::StaticOrder S; S.init(32 * CAP, 2 * FF, F.G, (int)blockIdx.x);
        pg8::EpiSwiGLU E{(bf16*)(F.ws + WS_HID)};
        pg8::gemm_phase<pg8::EpiSwiGLU, pg8::StaticOrder, PG8_ALIGN, PG8_SP2, true>(F.lds, g, S, E, F.lds + 131072);
    } SEAM(7);
    if (IN(8)) {
        pg8::Gemm g{(const bf16*)(F.ws + WS_HID), (const bf16*)(F.ws + WS_WD), 32 * CAP, D, FF, (size_t)D * FF * 2, 2, 15, nullptr}; pg8::StaticOrder S; S.init(32 * CAP, D, F.G, (int)blockIdx.x);
        pg8::EpiDown E{(bf16*)(F.ws + WS_YE), (const float*)(F.ws + WS_GATE)};
        pg8::gemm_phase<pg8::EpiDown, pg8::StaticOrder, PG8_ALIGN, PG8_SP2>(F.lds, g, S, E);
    } SEAM(8);
    if (IN(9)) { p10_final(F); }
#undef IN
#undef SEAM
}

extern "C" void kernel_launch(void* const* d_in, const int* in_sizes, int n_in, void* d_out, int out_size, void* d_ws, size_t ws_size, hipStream_t stream) {
    static int grid = 0;
    if (grid == 0) {
        if (n_in != 23 || out_size != M * D || ws_size < WS_END) { fprintf(stderr, "kernel_launch: unexpected problem (n_in %d, out %d, ws %zu)\n", n_in, out_size, ws_size); grid = -1; return; }
        int dev = 0, cus = 0;
        if (hipGetDevice(&dev) != hipSuccess || hipDeviceGetAttribute(&cus, hipDeviceAttributeMultiprocessorCount, dev) != hipSuccess) { grid = -1; return; }
        if (hipFuncSetAttribute((const void*)fwd_kernel, hipFuncAttributeMaxDynamicSharedMemorySize, LDS_BYTES) != hipSuccess) { fprintf(stderr, "kernel_launch: hipFuncSetAttribute failed\n"); grid = -1; return; }
        if (cus < 256) { fprintf(stderr, "kernel_launch: %d CUs, the phase programme needs 256 resident workgroups\n", cus); grid = -1; return; }
        grid = 256;
    }
    if (grid < 0) return;
    if (hipMemsetAsync((char*)d_ws + WS_CTL, 0, CTL_ZERO_BYTES, stream) != hipSuccess) return;
    Args a{};
    for (int i = 0; i < 23; ++i) a.in[i] = (const float*)d_in[i];
    a.out = (float*)d_out; a.ws = (unsigned char*)d_ws;
#if MK_PER_PHASE
    for (int p = 0; p < NPHASE; ++p) { a.ph_lo = p; a.ph_hi = p + 1; hipLaunchKernelGGL(fwd_kernel, dim3(grid), dim3(NWAVES * 64), LDS_BYTES, stream, a); }
#else
    a.ph_lo = 0; a.ph_hi = NPHASE;
    hipLaunchKernelGGL(fwd_kernel, dim3(grid), dim3(NWAVES * 64), LDS_BYTES, stream, a);
#endif
}
```
